# Optimizing an MI355X kernel written in HIP

```python
import math
import jax
import jax.numpy as jnp
from jax import lax
import numpy as np

D_MODEL = 1024
BATCH = 8
SEQ = 4096
DEPTH = 2
DEC_BATCH = 32
DEC_SEQ = 16
PAST_LEN = 4096

CHUNK = 64
N_META = 16
Q_BLOCK = 128
EPS = 1e-6
ROPE_BASE = 10000.0

MLA_HEADS = 8
MLA_NOPE = 64
MLA_ROPE = 32
MLA_V = 64
MLA_Q_LORA = 384
MLA_KV_LORA = 256
MLA_WIDTH = MLA_HEADS * MLA_V

M_HEADS = 4
M_DH = 128
M_WIDTH = M_HEADS * M_DH

G_HEADS = 4
G_DK = 128
G_DV = 128
G_WIDTH = G_HEADS * G_DV
G_QKV = G_HEADS * (2 * G_DK + G_DV)
CONV_W = 4

D_MIX = MLA_WIDTH + M_WIDTH + G_WIDTH

IN_SPLITS = (
    MLA_Q_LORA, MLA_KV_LORA, MLA_ROPE, MLA_WIDTH,
    M_WIDTH, M_WIDTH, M_WIDTH, M_HEADS, M_HEADS, M_WIDTH, M_WIDTH,
    G_QKV, G_HEADS, G_HEADS, G_WIDTH,
)
IN_COLS = sum(IN_SPLITS)

kernel_name = "hybrid_mla_mlstm_gdn_stream_step"


def rms_norm(x, w):
    xf = x.astype(jnp.float32)
    y = xf * lax.rsqrt(jnp.mean(xf * xf, axis=-1, keepdims=True) + EPS)
    return (y * w.astype(jnp.float32)).astype(x.dtype)


def l2_norm(x):
    xf = x.astype(jnp.float32)
    return (xf * lax.rsqrt(jnp.sum(xf * xf, axis=-1, keepdims=True) + EPS)).astype(x.dtype)


def apply_rope(x, pos):
    half = x.shape[-1] // 2
    freq = ROPE_BASE ** (-jnp.arange(half, dtype=jnp.float32) / half)
    ang = pos.astype(jnp.float32)[:, None] * freq[None, :]
    ang = ang.reshape((ang.shape[0],) + (1,) * (x.ndim - 3) + (half,))
    cos = jnp.cos(ang).astype(x.dtype)
    sin = jnp.sin(ang).astype(x.dtype)
    x1, x2 = x[..., :half], x[..., half:]
    return jnp.concatenate([x1 * cos - x2 * sin, x2 * cos + x1 * sin], axis=-1)


def to_chunks(a, blk):
    b, l = a.shape[:2]
    a = a.reshape((b, l // blk, blk) + a.shape[2:])
    return jnp.swapaxes(jnp.moveaxis(a, 1, 0), 2, 3).astype(jnp.float32)


def from_chunks(o):
    n, b, h, t, d = o.shape
    return jnp.transpose(o, (1, 0, 3, 2, 4)).reshape(b, n * t, h, d)


def mla_attention(q_nope, q_rope, c_kv, k_rope, w_uk, w_uv, n_prefix, absorbed):
    L = q_nope.shape[1]
    scale = 1.0 / math.sqrt(MLA_NOPE + MLA_ROPE)
    if absorbed:
        q_lat = jnp.einsum('blhd,rhd->blhr', q_nope, w_uk)
    else:
        k_nope = jnp.einsum('bkr,rhd->bkhd', c_kv, w_uk)
        v = jnp.einsum('bkr,rhd->bkhd', c_kv, w_uv)
    outs = []
    for s in range(0, L, Q_BLOCK):
        e = min(s + Q_BLOCK, L)
        n_own = min(L, -(-e // CHUNK) * CHUNK)
        n_keys = n_prefix + n_own
        q_chunk = jnp.arange(s, e) // CHUNK
        k_chunk = jnp.arange(n_own) // CHUNK
        mask = jnp.concatenate([jnp.ones((e - s, n_prefix), dtype=bool),
                                k_chunk[None, :] <= q_chunk[:, None]], axis=1)
        sc = jnp.einsum('blhd,bkd->bhlk', q_rope[:, s:e], k_rope[:, :n_keys])
        if absorbed:
            sc = sc + jnp.einsum('blhr,bkr->bhlk', q_lat[:, s:e], c_kv[:, :n_keys])
        else:
            sc = sc + jnp.einsum('blhd,bkhd->bhlk', q_nope[:, s:e], k_nope[:, :n_keys])
        p = jax.nn.softmax(jnp.where(mask, sc.astype(jnp.float32) * scale, -jnp.inf), axis=-1).astype(c_kv.dtype)
        if absorbed:
            o = jnp.einsum('blhr,rhd->blhd', jnp.einsum('bhlk,bkr->blhr', p, c_kv[:, :n_keys]), w_uv)
        else:
            o = jnp.einsum('bhlk,bkhd->blhd', p, v[:, :n_keys])
        outs.append(o)
    return jnp.concatenate(outs, axis=1)


def mlstm_chunkwise(q, k, v, i_pre, log_f, C0, n0, m0, blk):
    dt = q.dtype
    xs = tuple(to_chunks(a, blk) for a in (q, k, v, i_pre, log_f))
    causal = jnp.tril(jnp.ones((blk, blk), dtype=bool))

    def step(carry, xs_c):
        C, n, m = carry
        qc, kc, vc, ic, fc = xs_c
        b = jnp.cumsum(fc, axis=-1)
        dmat = jnp.where(causal, b[..., :, None] - b[..., None, :] + ic[..., None, :], -jnp.inf)
        inter = b + m[..., None]
        m_t = jnp.maximum(inter, jnp.max(dmat, axis=-1))
        w_inter = jnp.exp(inter - m_t)
        qk = jnp.einsum('bhtd,bhsd->bhts', qc, kc) * jnp.exp(dmat - m_t[..., None])
        num = w_inter[..., None] * jnp.einsum('bhed,bhtd->bhte', C, qc) + jnp.einsum('bhts,bhse->bhte', qk, vc)
        den = w_inter * jnp.einsum('bhd,bhtd->bht', n, qc) + jnp.sum(qk, axis=-1)
        h = num / jnp.maximum(jnp.abs(den), jnp.exp(-m_t))[..., None]
        m_new = m_t[..., -1]
        g_state = jnp.exp(inter[..., -1] - m_new)
        g_tok = jnp.exp(b[..., -1:] - b + ic - m_new[..., None])
        C_new = g_state[..., None, None] * C + jnp.einsum('bhs,bhse,bhsd->bhed', g_tok, vc, kc)
        n_new = g_state[..., None] * n + jnp.einsum('bhs,bhsd->bhd', g_tok, kc)
        return (C_new, n_new, m_new), h

    carry0 = (C0.astype(jnp.float32), n0.astype(jnp.float32), m0.astype(jnp.float32))
    (C, n, m), h = lax.scan(step, carry0, xs)
    return from_chunks(h).astype(dt), C.astype(dt), n.astype(dt), m.astype(dt)


def gdn_chunkwise(q, k, v, log_a, beta, S0, blk):
    dt = q.dtype
    xs = tuple(to_chunks(a, blk) for a in (q, k, v, log_a, beta))
    incl = jnp.tril(jnp.ones((blk, blk), dtype=bool))
    strict = jnp.tril(jnp.ones((blk, blk), dtype=bool), -1)
    eye = jnp.eye(blk, dtype=jnp.float32)

    def step(S, xs_c):
        qc, kc, vc, gc, bc = xs_c
        G = jnp.cumsum(gc, axis=-1)
        gam = jnp.exp(jnp.where(incl, G[..., :, None] - G[..., None, :], -jnp.inf))
        A = jnp.where(strict, bc[..., :, None] * jnp.einsum('bhtd,bhsd->bhts', kc, kc) * gam, 0.0)
        rhs = jnp.concatenate([bc[..., None] * vc, (bc * jnp.exp(G))[..., None] * kc], axis=-1)
        sol = lax.linalg.triangular_solve(A + eye, rhs, left_side=True, lower=True, unit_diagonal=True)
        u, w = sol[..., :G_DV], sol[..., G_DV:]
        delta = u - jnp.einsum('bhtk,bhkv->bhtv', w, S)
        o = (jnp.einsum('bhtk,bhkv->bhtv', qc * jnp.exp(G)[..., None], S)
             + jnp.einsum('bhts,bhsv->bhtv', jnp.einsum('bhtd,bhsd->bhts', qc, kc) * gam, delta))
        S = (jnp.exp(G[..., -1])[..., None, None] * S
             + jnp.einsum('bhsk,bhsv->bhkv', kc * jnp.exp(G[..., -1:] - G)[..., None], delta))
        return S, o

    S, o = lax.scan(step, S0.astype(jnp.float32), xs)
    return from_chunks(o).astype(dt), S.astype(dt)


def mixer_layer(x, pos0, prefix_c, prefix_kr, m_C, m_n, m_m, g_S, g_buf, absorbed,
                norm_w, w_in, q_norm, w_uq, kv_norm, w_uk, w_uv, m_gate_b, m_norm,
                g_conv_w, g_a_log, g_dt_bias, g_norm, w_out):
    B, L, _ = x.shape
    blk = min(CHUNK, L)
    proj = rms_norm(x, norm_w) @ w_in
    (c_q, c_kv, k_r, z_a, m_q, m_k, m_v, m_i, m_f, m_o, z_m,
     g_qkv, g_a, g_b, z_g) = jnp.split(proj, np.cumsum(IN_SPLITS)[:-1].tolist(), axis=-1)

    pos = pos0 + jnp.arange(L)
    q = (rms_norm(c_q, q_norm) @ w_uq).reshape(B, L, MLA_HEADS, MLA_NOPE + MLA_ROPE)
    q_nope, q_rope = q[..., :MLA_NOPE], apply_rope(q[..., MLA_NOPE:], pos)
    c_new = rms_norm(c_kv, kv_norm)
    kr_new = apply_rope(k_r, pos)
    if prefix_c is None:
        c_all, kr_all, n_prefix = c_new, kr_new, 0
    else:
        c_all = jnp.concatenate([prefix_c.astype(c_new.dtype), c_new], axis=1)
        kr_all = jnp.concatenate([prefix_kr.astype(kr_new.dtype), kr_new], axis=1)
        n_prefix = prefix_c.shape[1]
    o_a = mla_attention(q_nope, q_rope, c_all, kr_all, w_uk, w_uv, n_prefix, absorbed).reshape(B, L, MLA_WIDTH)

    hd = (B, L, M_HEADS, M_DH)
    h_m, m_C, m_n, m_m = mlstm_chunkwise(
        m_q.reshape(hd), m_k.reshape(hd) * (M_DH ** -0.5), m_v.reshape(hd),
        m_i + m_gate_b[0], jax.nn.log_sigmoid(m_f + m_gate_b[1]), m_C, m_n, m_m, blk)
    h_m = jax.nn.sigmoid(m_o).reshape(hd) * h_m
    o_m = rms_norm(h_m, m_norm.reshape(M_HEADS, M_DH)).reshape(B, L, M_WIDTH)

    xc = jnp.concatenate([g_buf.astype(g_qkv.dtype), g_qkv], axis=1)
    conv = xc[:, 0:L] * g_conv_w[0]
    for j in range(1, CONV_W):
        conv = conv + xc[:, j:j + L] * g_conv_w[j]
    g_buf = xc[:, L:]
    conv = jax.nn.silu(conv)
    g_q, g_k, g_v = jnp.split(conv, [G_HEADS * G_DK, 2 * G_HEADS * G_DK], axis=-1)
    g_q = l2_norm(g_q.reshape(B, L, G_HEADS, G_DK)) * (G_DK ** -0.5)
    g_k = l2_norm(g_k.reshape(B, L, G_HEADS, G_DK))
    log_decay = -jnp.exp(g_a_log) * jax.nn.softplus(g_a + g_dt_bias)
    h_g, g_S = gdn_chunkwise(g_q, g_k, g_v.reshape(B, L, G_HEADS, G_DV), log_decay,
                             jax.nn.sigmoid(g_b), g_S, blk)
    o_g = rms_norm(h_g, g_norm).reshape(B, L, G_WIDTH)

    mixed = jnp.concatenate([o_a * jax.nn.silu(z_a), o_m * jax.nn.silu(z_m), o_g * jax.nn.silu(z_g)], axis=-1)
    return x + mixed @ w_out, c_new, kr_new, m_C, m_n, m_m, g_S, g_buf


def stack_layers(rows, i):
    return jnp.stack([r[i] for r in rows])


def setup_inputs(seed: int = 0) -> dict:
    key = jax.random.key(seed)
    ks = jax.random.split(key, 26)
    f32 = jnp.float32

    def nrm(k, shape, scale=1.0):
        return scale * jax.random.normal(k, shape, f32)

    def gain(k, shape):
        return 1.0 + 0.02 * jax.random.normal(k, shape, f32)

    n_cache = N_META + PAST_LEN
    dt_init = jnp.exp(jax.random.uniform(ks[20], (DEPTH, G_HEADS), f32, math.log(1e-3), math.log(1e-1)))
    gate_b = jnp.stack([nrm(ks[17], (DEPTH, M_HEADS), 0.1),
                        jnp.linspace(3.0, 6.0, M_HEADS, dtype=f32)[None, :] + nrm(ks[18], (DEPTH, M_HEADS), 0.1)],
                       axis=1)
    return {
        'x_prompt': nrm(ks[0], (BATCH, SEQ, D_MODEL)),
        'x_sample': nrm(ks[1], (DEC_BATCH, DEC_SEQ, D_MODEL)),
        'cache_mla_latent': nrm(ks[2], (DEPTH, DEC_BATCH, n_cache, MLA_KV_LORA)),
        'cache_mla_krope': nrm(ks[3], (DEPTH, DEC_BATCH, n_cache, MLA_ROPE)),
        'state_mlstm_C': nrm(ks[4], (DEPTH, DEC_BATCH, M_HEADS, M_DH, M_DH), 0.5),
        'state_mlstm_n': nrm(ks[5], (DEPTH, DEC_BATCH, M_HEADS, M_DH), 0.5),
        'state_mlstm_m': nrm(ks[6], (DEPTH, DEC_BATCH, M_HEADS)),
        'state_gdn_S': nrm(ks[7], (DEPTH, DEC_BATCH, G_HEADS, G_DK, G_DV), 0.5),
        'state_gdn_conv': nrm(ks[8], (DEPTH, DEC_BATCH, CONV_W - 1, G_QKV)),
        'meta_tokens': nrm(ks[9], (N_META, D_MODEL)),
        'norm_w': gain(ks[10], (DEPTH, D_MODEL)),
        'w_in': nrm(ks[11], (DEPTH, D_MODEL, IN_COLS), D_MODEL ** -0.5),
        'mla_q_norm': gain(ks[12], (DEPTH, MLA_Q_LORA)),
        'mla_w_uq': nrm(ks[13], (DEPTH, MLA_Q_LORA, MLA_HEADS * (MLA_NOPE + MLA_ROPE)), MLA_Q_LORA ** -0.5),
        'mla_kv_norm': gain(ks[14], (DEPTH, MLA_KV_LORA)),
        'mla_w_uk': nrm(ks[15], (DEPTH, MLA_KV_LORA, MLA_HEADS, MLA_NOPE), MLA_KV_LORA ** -0.5),
        'mla_w_uv': nrm(ks[16], (DEPTH, MLA_KV_LORA, MLA_HEADS, MLA_V), MLA_KV_LORA ** -0.5),
        'mlstm_gate_b': gate_b,
        'mlstm_norm': gain(ks[19], (DEPTH, M_WIDTH)),
        'gdn_conv_w': nrm(ks[21], (DEPTH, CONV_W, G_QKV), CONV_W ** -0.5),
        'gdn_a_log': jnp.log(jax.random.uniform(ks[22], (DEPTH, G_HEADS), f32, 1.0, 16.0)),
        'gdn_dt_bias': dt_init + jnp.log(-jnp.expm1(-dt_init)),
        'gdn_norm': gain(ks[23], (DEPTH, G_DV)),
        'w_out': nrm(ks[24], (DEPTH, D_MIX, D_MODEL), D_MIX ** -0.5),
        'final_norm': gain(ks[25], (D_MODEL,)),
    }


def reference(x_prompt, x_sample, cache_mla_latent, cache_mla_krope, state_mlstm_C, state_mlstm_n,
              state_mlstm_m, state_gdn_S, state_gdn_conv, meta_tokens, norm_w, w_in, mla_q_norm,
              mla_w_uq, mla_kv_norm, mla_w_uk, mla_w_uv, mlstm_gate_b, mlstm_norm, gdn_conv_w,
              gdn_a_log, gdn_dt_bias, gdn_norm, w_out, final_norm):
    B = x_prompt.shape[0]
    dt = x_prompt.dtype
    sample_pos0 = cache_mla_latent.shape[2]
    h_meta = jnp.broadcast_to(meta_tokens.astype(dt)[None], (B, N_META, D_MODEL))
    h_p, h_s = x_prompt, x_sample
    z_C = jnp.zeros((B, M_HEADS, M_DH, M_DH), dt)
    z_n = jnp.zeros((B, M_HEADS, M_DH), dt)
    z_m = jnp.zeros((B, M_HEADS), dt)
    z_S = jnp.zeros((B, G_HEADS, G_DK, G_DV), dt)
    z_buf = jnp.zeros((B, CONV_W - 1, G_QKV), dt)
    p_rows, s_rows = [], []
    for l in range(DEPTH):
        w = tuple(p[l] for p in (norm_w, w_in, mla_q_norm, mla_w_uq, mla_kv_norm, mla_w_uk, mla_w_uv,
                                 mlstm_gate_b, mlstm_norm, gdn_conv_w, gdn_a_log, gdn_dt_bias, gdn_norm, w_out))
        h_meta, c_m, kr_m, mC, mn, mm, gS, gbuf = mixer_layer(
            h_meta, 0, None, None, z_C, z_n, z_m, z_S, z_buf, False, *w)
        h_p, c_p, kr_p, mC, mn, mm, gS, gbuf = mixer_layer(
            h_p, N_META, c_m, kr_m, mC, mn, mm, gS, gbuf, False, *w)
        p_rows.append((jnp.concatenate([c_m, c_p], axis=1), jnp.concatenate([kr_m, kr_p], axis=1),
                       mC, mn, mm, gS, gbuf))
        h_s, c_s, kr_s, sC, sn, sm, sS, sbuf = mixer_layer(
            h_s, sample_pos0, cache_mla_latent[l], cache_mla_krope[l], state_mlstm_C[l], state_mlstm_n[l],
            state_mlstm_m[l], state_gdn_S[l], state_gdn_conv[l], True, *w)
        s_rows.append((c_s, kr_s, sC, sn, sm, sS, sbuf))
    y_prompt = rms_norm(h_p, final_norm)
    y_sample = rms_norm(h_s, final_norm)
    p_mla_latent = stack_layers(p_rows, 0)
    p_mla_krope = stack_layers(p_rows, 1)
    p_mlstm_C = stack_layers(p_rows, 2)
    p_mlstm_n = stack_layers(p_rows, 3)
    p_mlstm_m = stack_layers(p_rows, 4)
    p_gdn_S = stack_layers(p_rows, 5)
    p_gdn_conv = stack_layers(p_rows, 6)
    s_mla_latent = stack_layers(s_rows, 0)
    s_mla_krope = stack_layers(s_rows, 1)
    s_mlstm_C = stack_layers(s_rows, 2)
    s_mlstm_n = stack_layers(s_rows, 3)
    s_mlstm_m = stack_layers(s_rows, 4)
    s_gdn_S = stack_layers(s_rows, 5)
    s_gdn_conv = stack_layers(s_rows, 6)
    return (y_prompt, y_sample, p_mla_latent, p_mla_krope, p_mlstm_C, p_mlstm_n, p_mlstm_m, p_gdn_S, p_gdn_conv,
            s_mla_latent, s_mla_krope, s_mlstm_C, s_mlstm_n, s_mlstm_m, s_gdn_S, s_gdn_conv)
```

```cpp
#include <hip/hip_runtime.h>
#include <hip/hip_cooperative_groups.h>
#include <cstdio>
#include <cstdint>
namespace cg = cooperative_groups;

#define LAS __attribute__((address_space(3)))
typedef unsigned short bf16_t;
typedef short bf16x8 __attribute__((ext_vector_type(8)));
typedef short s16x4 __attribute__((ext_vector_type(4)));
typedef float f32x4 __attribute__((ext_vector_type(4)));
typedef float f32x2 __attribute__((ext_vector_type(2)));
typedef float f32x16 __attribute__((ext_vector_type(16)));
typedef unsigned u32x4 __attribute__((ext_vector_type(4)));
typedef unsigned u32x2 __attribute__((ext_vector_type(2)));
typedef __bf16 bf16x2_t __attribute__((ext_vector_type(2)));

__device__ __forceinline__ unsigned cvtpk(float lo, float hi) { f32x2 v = {lo, hi}; bf16x2_t b = __builtin_convertvector(v, bf16x2_t); return __builtin_bit_cast(unsigned, b); }
__device__ __forceinline__ bf16_t f2bf(float x) { return (bf16_t)(cvtpk(x, 0.f) & 0xffffu); }
__device__ __forceinline__ float bf2f(bf16_t x) { return __uint_as_float(((unsigned)x) << 16); }
__device__ __forceinline__ float bflo(unsigned w) { return __uint_as_float(w << 16); }
__device__ __forceinline__ float bfhi(unsigned w) { return __uint_as_float(w & 0xffff0000u); }

constexpr int D = 1024, NB = 8, SEQ = 4096, DEPTH = 2, DB = 32, DS = 16, NMETA = 16, NCACHE = 4112;
constexpr int NP = NB * SEQ;
constexpr int NS = DB * DS;
constexpr int ROW_S = NP, ROW_M = NP + NS, MROWS = ROW_M + NMETA, MPAD = 33536;
constexpr int INC = 5808;
constexpr int PJ = 5888;
constexpr int PC_CKV = 0, PC_CQ = 256, PC_KR = 640, PC_G16 = 672, PC_MQ = 704, PC_MK = 1216, PC_MV = 1728, PC_MO = 2240,
              PC_GQ = 2752, PC_GK = 3264, PC_GV = 3776, PC_ZA = 4288, PC_ZM = 4800, PC_ZG = 5312, PC_END = 5824;
constexpr int DMIX = 1536;
constexpr int NTHREADS = 512, NWAVES = 8;
constexpr float EPS = 1e-6f;
constexpr float QSCALE = 0.10206207261596575f * 1.4426950408889634f;

constexpr long long O_YP = 0;
constexpr long long O_YS = O_YP + (long long)NB * SEQ * D;
constexpr long long O_PLAT = O_YS + (long long)DB * DS * D;
constexpr long long O_PKR = O_PLAT + (long long)DEPTH * NB * NCACHE * 256;
constexpr long long O_PC = O_PKR + (long long)DEPTH * NB * NCACHE * 32;
constexpr long long O_PN = O_PC + (long long)DEPTH * NB * 4 * 128 * 128;
constexpr long long O_PM = O_PN + (long long)DEPTH * NB * 4 * 128;
constexpr long long O_PS = O_PM + (long long)DEPTH * NB * 4;
constexpr long long O_PCONV = O_PS + (long long)DEPTH * NB * 4 * 128 * 128;
constexpr long long O_SLAT = O_PCONV + (long long)DEPTH * NB * 3 * 1536;
constexpr long long O_SKR = O_SLAT + (long long)DEPTH * DB * DS * 256;
constexpr long long O_SC = O_SKR + (long long)DEPTH * DB * DS * 32;
constexpr long long O_SN = O_SC + (long long)DEPTH * DB * 4 * 128 * 128;
constexpr long long O_SM = O_SN + (long long)DEPTH * DB * 4 * 128;
constexpr long long O_SS = O_SM + (long long)DEPTH * DB * 4;
constexpr long long O_SCONV = O_SS + (long long)DEPTH * DB * 4 * 128 * 128;
constexpr long long O_END = O_SCONV + (long long)DEPTH * DB * 3 * 1536;

constexpr size_t al256(size_t x) { return (x + 255) & ~(size_t)255; }
constexpr size_t WS_CTL = 0;
constexpr size_t WS_ROPE = 4096;
constexpr size_t ROPE_N = 4160;
constexpr size_t WS_WIN = al256(WS_ROPE + ROPE_N * 16 * 4 * 2);
constexpr size_t WS_WUQ = al256(WS_WIN + (size_t)2 * PJ * 1024 * 2);
constexpr size_t WS_WUKV = al256(WS_WUQ + (size_t)2 * 768 * 384 * 2);
constexpr size_t WS_WOUT = al256(WS_WUKV + (size_t)2 * 1024 * 256 * 2);
constexpr size_t WS_WUKR = al256(WS_WOUT + (size_t)2 * 1024 * 1536 * 2);
constexpr size_t WS_WUVT = al256(WS_WUKR + (size_t)2 * 256 * 512 * 2);
constexpr size_t WS_XMETA = al256(WS_WUVT + (size_t)2 * 512 * 256 * 2);
constexpr size_t WS_RSTD = al256(WS_XMETA + 16 * 1024 * 4);
constexpr size_t WS_XN = al256(WS_RSTD + (size_t)MPAD * 2 * 4);
constexpr size_t WS_PROJ = al256(WS_XN + (size_t)MPAD * 1024 * 2);
constexpr size_t WS_GATES = al256(WS_PROJ + (size_t)MPAD * PJ * 2);
constexpr size_t WS_QATT = al256(WS_GATES + (size_t)MPAD * 16 * 4);
constexpr size_t WS_QMETA = al256(WS_QATT + (size_t)NB * 8 * SEQ * 96 * 2);
constexpr size_t WS_QS = al256(WS_QMETA + (size_t)8 * 256 * 96 * 2);
constexpr int KVROWS = 64 + SEQ;
constexpr size_t WS_KV = al256(WS_QS + (size_t)NS * 768 * 2);
constexpr size_t WS_END0 = al256(WS_KV + (size_t)NB * 8 * KVROWS * 160 * 2);

struct Params {
  const float* in[25];
  float* out;
  unsigned char* ws;
  int ph_lo, ph_hi;
  int probe, pad;
};

__device__ __forceinline__ float wave_sum(float v) {
#pragma unroll
  for (int o = 1; o < 64; o <<= 1) v += __shfl_xor(v, o);
  return v;
}
__device__ __forceinline__ float sigmoidf_(float x) { return 1.f / (1.f + __expf(-x)); }
__device__ __forceinline__ float siluf_(float x) { return x / (1.f + __expf(-x)); }

__device__ __forceinline__ int orig_col(int pc, float& sc) {
  sc = 1.f;
  if (pc < 256) return 384 + pc;
  if (pc < 640) return pc - 256;
  if (pc < 672) return pc;
  if (pc < 688) { int g = pc - 672; return g < 8 ? 2720 + g : 5288 + (g - 8); }
  if (pc < 704) return -1;
  if (pc < 1216) return 1184 + (pc - 704);
  if (pc < 1728) { sc = 0.08838834764831845f; return 1696 + (pc - 1216); }
  if (pc < 2240) return 2208 + (pc - 1728);
  if (pc < 2752) return 2728 + (pc - 2240);
  if (pc < 4288) return 3752 + (pc - 2752);
  if (pc < 4800) return 672 + (pc - 4288);
  if (pc < 5312) return 3240 + (pc - 4800);
  if (pc < 5824) return 5296 + (pc - 5312);
  return -1;
}

template <class F>
__device__ __forceinline__ void transpose_item(F src, int K, bf16_t* WT, LAS float* scr, int kb, int nb, int lane) {
  const int k0 = 64 * kb, n0 = 32 * nb;
#pragma unroll 8
  for (int i = 0; i < 32; ++i) { const int kk = 2 * i + (lane >> 5); scr[kk * 33 + (lane & 31)] = src(k0 + kk, n0 + (lane & 31)); }
  asm volatile("s_waitcnt lgkmcnt(0)" ::: "memory");
  const int c = lane & 7;
#pragma unroll
  for (int j = 0; j < 4; ++j) {
    const int n = (lane >> 3) + 8 * j; const LAS float* s = scr + (8 * c) * 33 + n;
    u32x4 o; o.x = cvtpk(s[0 * 33], s[1 * 33]); o.y = cvtpk(s[2 * 33], s[3 * 33]); o.z = cvtpk(s[4 * 33], s[5 * 33]); o.w = cvtpk(s[6 * 33], s[7 * 33]);
    *(u32x4*)(WT + (size_t)(n0 + n) * K + k0 + 8 * c) = o;
  }
  asm volatile("s_waitcnt lgkmcnt(0)" ::: "memory");
}

__device__ __forceinline__ void rms_row_to_bf16(const float* xrow, const float* w, bf16_t* orow, int lane) {
  const f32x4* xr = (const f32x4*)xrow + lane; const f32x4* wr = (const f32x4*)w + lane;
  f32x4 v[4]; float s = 0.f;
#pragma unroll
  for (int j = 0; j < 4; ++j) { v[j] = xr[64 * j]; s += (v[j].x * v[j].x + v[j].y * v[j].y) + (v[j].z * v[j].z + v[j].w * v[j].w); }
  const float rstd = rsqrtf(wave_sum(s) * (1.f / D) + EPS);
  unsigned long long* o8 = (unsigned long long*)orow + lane;
#pragma unroll
  for (int j = 0; j < 4; ++j) { const f32x4 ww = wr[64 * j];
    o8[64 * j] = (unsigned long long)cvtpk(v[j].x * rstd * ww.x, v[j].y * rstd * ww.y) | ((unsigned long long)cvtpk(v[j].z * rstd * ww.z, v[j].w * rstd * ww.w) << 32); }
}

__device__ __forceinline__ const float* xrow_in(const Params& p, int l, int r) {
  if (l == 0) {
    if (r < ROW_S) return p.in[0] + (size_t)r * D;
    if (r < ROW_M) return p.in[1] + (size_t)(r - ROW_S) * D;
    return p.in[9] + (size_t)(r - ROW_M) * D;
  }
  if (r < ROW_S) return p.out + O_YP + (size_t)r * D;
  if (r < ROW_M) return p.out + O_YS + (size_t)(r - ROW_S) * D;
  return (const float*)(p.ws + WS_XMETA) + (size_t)(r - ROW_M) * D;
}
__device__ __forceinline__ float* xrow_out(const Params& p, int r) {
  if (r < ROW_S) return p.out + O_YP + (size_t)r * D;
  if (r < ROW_M) return p.out + O_YS + (size_t)(r - ROW_S) * D;
  return (float*)(p.ws + WS_XMETA) + (size_t)(r - ROW_M) * D;
}

__device__ __forceinline__ void phase_norm_rows(const Params& p, int l, int gw, int NGW, int lane) {
  bf16_t* XN = (bf16_t*)(p.ws + WS_XN);
  for (int r = gw; r < MPAD; r += NGW) {
    if (r < MROWS) rms_row_to_bf16(xrow_in(p, l, r), p.in[10] + (size_t)l * D, XN + (size_t)r * D, lane);
    else { u32x4 z = {0u, 0u, 0u, 0u}; ((u32x4*)(XN + (size_t)r * D))[lane] = z; ((u32x4*)(XN + (size_t)r * D))[lane + 64] = z; }
  }
}

__device__ __forceinline__ void phase0(const Params& p, LAS unsigned char* lds, int tid) {
  const int lane = tid & 63, wave = tid >> 6;
  const int gw = blockIdx.x * NWAVES + wave, NGW = gridDim.x * NWAVES;
  LAS float* scr = (LAS float*)(lds + wave * 16384);
  if (blockIdx.x == 0 && tid < 1024 / 4) ((unsigned*)(p.ws + WS_CTL))[tid] = 0u;
  constexpr int I_WIN = 16 * (PJ / 32), I_WUQ = 6 * 24, I_WUKV = 4 * 32, I_WOUT = 24 * 32, I_WUVT = 4 * 16;
  constexpr int I_L = I_WIN + I_WUQ + I_WUKV + I_WOUT + I_WUVT, I_ALL = 2 * I_L;
  for (int it = gw; it < I_ALL; it += NGW) {
    const int l = it / I_L; int r = it % I_L;
    if (r < I_WIN) {
      const float* W = p.in[11] + (size_t)l * D * INC; const int nblk = PJ / 32;
      transpose_item([&](int k, int n) { float sc; const int oc = orig_col(n, sc); return oc >= 0 ? W[(size_t)k * INC + oc] * sc : 0.f; },
                     1024, (bf16_t*)(p.ws + WS_WIN) + (size_t)l * PJ * 1024, scr, r / nblk, r % nblk, lane);
      continue; }
    r -= I_WIN;
    if (r < I_WUQ) {
      const float* W = p.in[13] + (size_t)l * 384 * 768; const float* qn = p.in[12] + (size_t)l * 384;
      transpose_item([&](int k, int n) { return W[(size_t)k * 768 + n] * qn[k] * QSCALE; }, 384, (bf16_t*)(p.ws + WS_WUQ) + (size_t)l * 768 * 384, scr, r / 24, r % 24, lane);
      continue; }
    r -= I_WUQ;
    if (r < I_WUKV) {
      const float* Wk = p.in[15] + (size_t)l * 256 * 512; const float* Wv = p.in[16] + (size_t)l * 256 * 512; const float* kn = p.in[14] + (size_t)l * 256;
      transpose_item([&](int k, int n) { return (n < 512 ? Wk[(size_t)k * 512 + n] : Wv[(size_t)k * 512 + n - 512]) * kn[k]; }, 256, (bf16_t*)(p.ws + WS_WUKV) + (size_t)l * 1024 * 256, scr, r / 32, r % 32, lane);
      continue; }
    r -= I_WUKV;
    if (r < I_WOUT) {
      const float* W = p.in[23] + (size_t)l * DMIX * D;
      transpose_item([&](int k, int n) { return W[(size_t)k * D + n]; }, DMIX, (bf16_t*)(p.ws + WS_WOUT) + (size_t)l * D * DMIX, scr, r / 32, r % 32, lane);
      continue; }
    r -= I_WOUT;
    { const float* Wv = p.in[16] + (size_t)l * 256 * 512;
      transpose_item([&](int k, int n) { return Wv[(size_t)k * 512 + n]; }, 256, (bf16_t*)(p.ws + WS_WUVT) + (size_t)l * 512 * 256, scr, r / 16, r % 16, lane); }
  }
  const long long gt = (long long)blockIdx.x * NTHREADS + tid, GT = (long long)gridDim.x * NTHREADS;
  { bf16_t* o = (bf16_t*)(p.ws + WS_WUKR); const float* W = p.in[15];
    for (long long i = gt; i < 2LL * 256 * 512; i += GT) o[i] = f2bf(W[i]); }
  { float* ct = (float*)(p.ws + WS_ROPE); float* st = ct + ROPE_N * 16;
    for (long long i = gt; i < (long long)ROPE_N * 16; i += GT) {
      const int pos = (int)(i >> 4), k = (int)(i & 15);
      const float freq = powf(10000.f, -(float)k / 16.f); const float ang = (float)pos * freq;
      float s, c; sincosf(ang, &s, &c); ct[i] = c; st[i] = s; } }
  phase_norm_rows(p, 0, gw, NGW, lane);
}

namespace pg8 {
constexpr int BM = 256, BK = 64, HALF = 128, HTB = HALF * BK * 2, STAGE_BYTES = 8 * HTB, NXCD = 8, WGM = 8;
__device__ __forceinline__ int lds_byte(int r, int c) { const int st = (r >> 4) * 2 + (c >> 5), rr = r & 15, cc = c & 31, ob = rr * 64 + cc * 2; return st * 1024 + (ob ^ (((ob >> 9) & 1) << 5)); }
__device__ __forceinline__ void stage_rc(int b, int& R, int& C) { const int st = b / 1024, sb = b % 1024, swz = sb ^ (((sb >> 9) & 1) << 5); R = (st >> 1) * 16 + swz / 64; C = (st & 1) * 32 + (swz % 64) / 2; }
__device__ __forceinline__ int perm32(int rho) { const int n = rho >> 4, i = rho & 15; return 8 * (i >> 2) + 4 * n + (i & 3); }
struct Unit { int pm, pn; };
struct Gemm { const bf16_t* A; const bf16_t* Bt; int lda, ldb, K; };
struct StaticOrder {
  int nM, nN, nwg, G, c;
  __device__ void init(int nM_, int nN_, int G_, int c_) { nM = nM_; nN = nN_; nwg = nM * nN; G = G_; c = c_; }
  __device__ bool next(int i, Unit& u) const {
    const long L = (long)i * G + c; if (L >= nwg) return false;
    int wgid = (int)L; { const int q = nwg / NXCD, r = nwg % NXCD, xcd = wgid % NXCD, off = wgid / NXCD; wgid = (xcd < r ? xcd * (q + 1) : r * (q + 1) + (xcd - r) * q) + off; }
    const int nig = WGM * nN, gid = wgid / nig, fm = gid * WGM, gsz = (nM - fm) < WGM ? (nM - fm) : WGM;
    u.pm = fm + ((wgid % nig) % gsz); u.pn = (wgid % nig) / gsz; return true;
  }
};
template <class Epi, class Sched>
__device__ __forceinline__ void gemm_phase(LAS unsigned char* lds, const Gemm g, const Sched& S, const Epi& E) {
  int tid = threadIdx.x; asm volatile("" : "+v"(tid)); const int wid = __builtin_amdgcn_readfirstlane(tid >> 6), lane = tid & 63, wr = wid >> 2, wc = wid & 3, fr = lane & 15, fq = lane >> 4;
  const int nt = g.K / BK;
  unsigned voffA[2], voffB[2];
#pragma unroll
  for (int i = 0; i < 2; ++i) { int R, C; stage_rc(tid * 16 + i * 8192, R, C); const int Rb = (R & ~31) + perm32(R & 31);
    voffA[i] = (unsigned)(R * g.lda + C) * 2u; voffB[i] = (unsigned)(Rb * g.ldb + C) * 2u; }
  const size_t kstep = (size_t)(BK * 2);
  const size_t hstepA = (size_t)HALF * g.lda * 2, hstepB = (size_t)HALF * g.ldb * 2;
  const size_t tstepA = 2 * hstepA, tstepB = 2 * hstepB;
  const unsigned ldsw = (unsigned)wid * 1024u;
  const int aoff = lds_byte(wr * 64 + fr, fq * 8), boff = lds_byte(wc * 32 + fr, fq * 8);
#define PG8_SA(b, h) (((b) * 2 + (h)) * HTB)
#define PG8_SB(b, h) ((4 + (b) * 2 + (h)) * HTB)
#define PG8_STAGE(bufoff, gbase, voff) do { _Pragma("unroll") for (int _i = 0; _i < 2; ++_i) \
    __builtin_amdgcn_global_load_lds((const unsigned*)((const char*)(gbase) + (voff)[_i]), (LAS unsigned*)(lds + (bufoff) + ldsw + _i * 8192), 16, 0, 0); } while (0)
#define PG8_LDA(dst, b, h) do { _Pragma("unroll") for (int m = 0; m < 4; ++m) _Pragma("unroll") for (int k = 0; k < 2; ++k) dst[m][k] = *(const LAS bf16x8*)(lds + PG8_SA(b, h) + aoff + m * 2048 + k * 1024); } while (0)
#define PG8_LDB(dst, b, h) do { _Pragma("unroll") for (int n = 0; n < 2; ++n) _Pragma("unroll") for (int k = 0; k < 2; ++k) dst[n][k] = *(const LAS bf16x8*)(lds + PG8_SB(b, h) + boff + n * 2048 + k * 1024); } while (0)
#define PG8_MMA(ai, bj, At, Bt) do { __builtin_amdgcn_s_setprio(1); _Pragma("unroll") for (int m = 0; m < 4; ++m) _Pragma("unroll") for (int n = 0; n < 2; ++n) _Pragma("unroll") for (int k = 0; k < 2; ++k) \
    acc[ai][bj][m][n] = __builtin_amdgcn_mfma_f32_16x16x32_bf16(Bt[n][k], At[m][k], acc[ai][bj][m][n], 0, 0, 0); __builtin_amdgcn_s_setprio(0); } while (0)
#define PG8_WAIT_V(n) asm volatile("s_waitcnt vmcnt(" #n ")" ::: "memory")
#define PG8_WAIT_L(n) asm volatile("s_waitcnt lgkmcnt(" #n ")" ::: "memory")
#define PG8_BAR __builtin_amdgcn_s_barrier()
#define PG8_SCHED __builtin_amdgcn_sched_barrier(0)
  Unit cur, nxt; int ui = 0;
  if (!S.next(0, cur)) return;
  f32x4 acc[2][2][4][2];
#pragma unroll
  for (int a = 0; a < 2; ++a)
#pragma unroll
    for (int b = 0; b < 2; ++b)
#pragma unroll
      for (int m = 0; m < 4; ++m)
#pragma unroll
        for (int n = 0; n < 2; ++n) acc[a][b][m][n] = (f32x4){0.f, 0.f, 0.f, 0.f};
  bf16x8 At[4][2], B0[2][2], B1[2][2];
  const char* cA = (const char*)g.A + (size_t)S.tile_m(cur.pm) * tstepA; const char* cB = (const char*)g.Bt + (size_t)cur.pn * tstepB;
  PG8_STAGE(PG8_SB(0, 0), cB, voffB); PG8_STAGE(PG8_SB(0, 1), cB + hstepB, voffB); PG8_STAGE(PG8_SA(0, 0), cA, voffA); PG8_STAGE(PG8_SA(0, 1), cA + hstepA, voffA);
  if (wr == 1) PG8_BAR;
  PG8_WAIT_V(2); PG8_BAR;
  PG8_STAGE(PG8_SB(1, 0), cB + kstep, voffB); PG8_STAGE(PG8_SA(1, 0), cA + kstep, voffA); PG8_STAGE(PG8_SB(1, 1), cB + hstepB + kstep, voffB);
  PG8_WAIT_V(6); PG8_BAR;
  for (;;) {
    const bool has_next = S.next(ui + 1, nxt);
    const char* nA = has_next ? (const char*)g.A + (size_t)S.tile_m(nxt.pm) * tstepA : cA; const char* nB = has_next ? (const char*)g.Bt + (size_t)nxt.pn * tstepB : cB;
#pragma unroll 1
    for (int t = 0; t < nt; t += 2) {
      const bool last = (t == nt - 2);
      const char* a1 = cA + (size_t)(t + 1) * kstep;
      const char* a2 = last ? nA : cA + (size_t)(t + 2) * kstep; const char* b2 = last ? nB : cB + (size_t)(t + 2) * kstep;
      const char* a3 = a2 + kstep; const char* b3 = b2 + kstep;
      PG8_LDB(B0, 0, 0); PG8_LDB(B1, 0, 1); PG8_SCHED; PG8_LDA(At, 0, 0); PG8_STAGE(PG8_SA(1, 1), a1 + hstepA, voffA);
      PG8_WAIT_V(8); PG8_WAIT_L(0); PG8_BAR; PG8_MMA(0, 0, At, B0); PG8_MMA(0, 1, At, B1); PG8_BAR; PG8_SCHED;
      PG8_LDA(At, 0, 1); PG8_STAGE(PG8_SB(0, 0), b2, voffB); PG8_STAGE(PG8_SB(0, 1), b2 + hstepB, voffB); PG8_STAGE(PG8_SA(0, 0), a2, voffA);
      PG8_WAIT_V(8); PG8_WAIT_L(0); PG8_BAR; PG8_MMA(1, 0, At, B0); PG8_MMA(1, 1, At, B1); PG8_BAR; PG8_SCHED;
      PG8_LDB(B0, 1, 0); PG8_LDB(B1, 1, 1); PG8_SCHED; PG8_LDA(At, 1, 0); PG8_STAGE(PG8_SA(0, 1), a2 + hstepA, voffA);
      PG8_WAIT_V(8); PG8_WAIT_L(0); PG8_BAR; PG8_MMA(0, 0, At, B0); PG8_MMA(0, 1, At, B1); PG8_BAR; PG8_SCHED;
      PG8_LDA(At, 1, 1); PG8_STAGE(PG8_SB(1, 0), b3, voffB); PG8_STAGE(PG8_SB(1, 1), b3 + hstepB, voffB); PG8_STAGE(PG8_SA(1, 0), a3, voffA);
      PG8_WAIT_V(8); PG8_WAIT_L(0); PG8_BAR; PG8_MMA(1, 0, At, B0); PG8_MMA(1, 1, At, B1); PG8_BAR; PG8_SCHED;
    }
    if (wr == 0) PG8_BAR;
    E(acc, S.tile_m(cur.pm), cur.pn, wr, wc, fr, fq);
    if (!has_next) break;
#pragma unroll
    for (int a = 0; a < 2; ++a)
#pragma unroll
      for (int b = 0; b < 2; ++b)
#pragma unroll
        for (int m = 0; m < 4; ++m)
#pragma unroll
          for (int n = 0; n < 2; ++n) acc[a][b][m][n] = (f32x4){0.f, 0.f, 0.f, 0.f};
    cur = nxt; cA = nA; cB = nB; ++ui;
    if (wr == 1) PG8_BAR;
  }
  PG8_WAIT_V(0);
  PG8_BAR;
#undef PG8_SA
#undef PG8_SB
#undef PG8_STAGE
#undef PG8_LDA
#undef PG8_LDB
#undef PG8_MMA
#undef PG8_WAIT_V
#undef PG8_WAIT_L
#undef PG8_BAR
#undef PG8_SCHED
}
}

struct OrderAll : pg8::StaticOrder { __device__ __forceinline__ int tile_m(int pm) const { return pm; } };

struct EpiProj {
  bf16_t* O; int ldc;
  __device__ __forceinline__ void operator()(const f32x4 (&acc)[2][2][4][2], int tm, int pn, int wr, int wc, int fr, int fq) const {
    const int row0 = tm * 256 + wr * 64 + fr, col0 = pn * 256 + wc * 32 + 8 * fq;
#pragma unroll
    for (int ai = 0; ai < 2; ++ai)
#pragma unroll
      for (int m = 0; m < 4; ++m) { int r_ = row0; asm volatile("" : "+v"(r_) :: "memory"); bf16_t* rowp = O + (size_t)(r_ + ai * 128 + m * 16) * ldc + col0;
#pragma unroll
        for (int bj = 0; bj < 2; ++bj) { const f32x4 v0 = acc[ai][bj][m][0], v1 = acc[ai][bj][m][1];
          u32x4 w; w.x = cvtpk(v0[0], v0[1]); w.y = cvtpk(v0[2], v0[3]); w.z = cvtpk(v1[0], v1[1]); w.w = cvtpk(v1[2], v1[3]);
          *(u32x4*)(rowp + bj * 128) = w; } }
  }
};


struct RowInfo { int kind  , b, t, pos; };
__device__ __forceinline__ RowInfo row_info(int r) {
  RowInfo ri;
  if (r < ROW_S) { ri.kind = 0; ri.b = r >> 12; ri.t = r & 4095; ri.pos = NMETA + ri.t; }
  else if (r < ROW_M) { ri.kind = 1; ri.b = (r - ROW_S) >> 4; ri.t = (r - ROW_S) & 15; ri.pos = NCACHE + ri.t; }
  else if (r < MROWS) { ri.kind = 2; ri.b = 0; ri.t = r - ROW_M; ri.pos = ri.t; }
  else { ri.kind = 3; ri.b = 0; ri.t = 0; ri.pos = 0; }
  return ri;
}
__device__ __forceinline__ float softplusf_(float x) { return x > 20.f ? x : log1pf(__expf(x)); }
__device__ __forceinline__ float logsigmoidf_(float x) { return x >= 0.f ? -log1pf(__expf(-x)) : x - log1pf(__expf(x)); }

__device__ __forceinline__ void phase_rowpass(const Params& p, int l, int gw, int NGW, int lane) {
  const bf16_t* PROJ = (const bf16_t*)(p.ws + WS_PROJ);
  float* RSTD = (float*)(p.ws + WS_RSTD); float* GATES = (float*)(p.ws + WS_GATES);
  const float* ct = (const float*)(p.ws + WS_ROPE); const float* st = ct + ROPE_N * 16;
  bf16_t* KV = (bf16_t*)(p.ws + WS_KV);
  const float* kvn = p.in[14] + (size_t)l * 256;
  for (int r = gw; r < MROWS; r += NGW) {
    const RowInfo ri = row_info(r);
    const bf16_t* pr = PROJ + (size_t)r * PJ;
    const u32x2 ck = *(const u32x2*)(pr + PC_CKV + 4 * lane);
    float c0 = bflo(ck.x), c1 = bfhi(ck.x), c2 = bflo(ck.y), c3 = bfhi(ck.y);
    const float rs_kv = rsqrtf(wave_sum(c0 * c0 + c1 * c1 + c2 * c2 + c3 * c3) * (1.f / 256.f) + EPS);
    const f32x4 kn = *(const f32x4*)(kvn + 4 * lane);
    const f32x4 lat = {c0 * rs_kv * kn.x, c1 * rs_kv * kn.y, c2 * rs_kv * kn.z, c3 * rs_kv * kn.w};
    const unsigned* cq = (const unsigned*)(pr + PC_CQ + 6 * lane);
    float sq = 0.f;
#pragma unroll
    for (int j = 0; j < 3; ++j) { const unsigned w = cq[j]; const float a = bflo(w), b = bfhi(w); sq += a * a + b * b; }
    const float rs_q = rsqrtf(wave_sum(sq) * (1.f / 384.f) + EPS);
    if (lane == 0) { RSTD[2 * r] = rs_q; RSTD[2 * r + 1] = rs_kv; }
    float o1 = 0.f, o2 = 0.f;
    if (lane < 16) { const float x1 = bf2f(pr[PC_KR + lane]), x2 = bf2f(pr[PC_KR + 16 + lane]);
      const float c = ct[ri.pos * 16 + lane], s = st[ri.pos * 16 + lane]; o1 = x1 * c - x2 * s; o2 = x2 * c + x1 * s; }
    if (ri.kind == 0) {
      float* ol = p.out + O_PLAT + (((size_t)l * NB + ri.b) * NCACHE + NMETA + ri.t) * 256; *(f32x4*)(ol + 4 * lane) = lat;
      if (lane < 16) { float* ok = p.out + O_PKR + (((size_t)l * NB + ri.b) * NCACHE + NMETA + ri.t) * 32; ok[lane] = o1; ok[16 + lane] = o2;
#pragma unroll
        for (int h = 0; h < 8; ++h) { bf16_t* kd = KV + ((size_t)(ri.b * 8 + h) * KVROWS + 64 + ri.t) * 160 + 64; kd[lane] = f2bf(o1); kd[16 + lane] = f2bf(o2); } }
    } else if (ri.kind == 1) {
      float* ol = p.out + O_SLAT + (((size_t)l * DB + ri.b) * DS + ri.t) * 256; *(f32x4*)(ol + 4 * lane) = lat;
      if (lane < 16) { float* ok = p.out + O_SKR + (((size_t)l * DB + ri.b) * DS + ri.t) * 32; ok[lane] = o1; ok[16 + lane] = o2; }
    } else {
      for (int b = 0; b < NB; ++b) {
        float* ol = p.out + O_PLAT + (((size_t)l * NB + b) * NCACHE + ri.t) * 256; *(f32x4*)(ol + 4 * lane) = lat;
        if (lane < 16) { float* ok = p.out + O_PKR + (((size_t)l * NB + b) * NCACHE + ri.t) * 32; ok[lane] = o1; ok[16 + lane] = o2;
#pragma unroll
          for (int h = 0; h < 8; ++h) { bf16_t* kd = KV + ((size_t)(b * 8 + h) * KVROWS + ri.t) * 160 + 64; kd[lane] = f2bf(o1); kd[16 + lane] = f2bf(o2); } }
      }
    }
    if (lane < 16) {
      const float v = bf2f(pr[PC_G16 + lane]); const int h = lane & 3; float g;
      if (lane < 4) g = v + p.in[17][(l * 2 + 0) * 4 + h];
      else if (lane < 8) g = logsigmoidf_(v + p.in[17][(l * 2 + 1) * 4 + h]);
      else if (lane < 12) g = -__expf(p.in[20][l * 4 + h]) * softplusf_(v + p.in[21][l * 4 + h]);
      else g = sigmoidf_(v);
      GATES[(size_t)r * 16 + lane] = g;
    }
    float* co = nullptr;
    if (ri.kind == 0 && ri.t >= SEQ - 3) co = p.out + O_PCONV + (((size_t)l * NB + ri.b) * 3 + (ri.t - (SEQ - 3))) * 1536;
    if (ri.kind == 1 && ri.t >= DS - 3) co = p.out + O_SCONV + (((size_t)l * DB + ri.b) * 3 + (ri.t - (DS - 3))) * 1536;
    if (co) { for (int c = lane * 8; c < 1536; c += 512) { const u32x4 w = *(const u32x4*)(pr + PC_GQ + c);
        *(f32x4*)(co + c) = (f32x4){bflo(w.x), bfhi(w.x), bflo(w.y), bfhi(w.y)}; *(f32x4*)(co + c + 4) = (f32x4){bflo(w.z), bfhi(w.z), bflo(w.w), bfhi(w.w)}; } }
  }
}

struct OrderKV : pg8::StaticOrder { __device__ __forceinline__ int tile_m(int pm) const { return pm < 128 ? pm : 130; } };

struct EpiQ {
  const float* rstd; const float* ct; const float* st; bf16_t* QATT; bf16_t* QMETA; bf16_t* QS;
  __device__ __forceinline__ void operator()(const f32x4 (&acc)[2][2][4][2], int tm, int pn, int wr, int wc, int fr, int fq) const {
#pragma unroll
    for (int ai = 0; ai < 2; ++ai)
#pragma unroll
      for (int m = 0; m < 4; ++m) {
        int fr_ = fr; asm volatile("" : "+v"(fr_) :: "memory");
        const int r = tm * 256 + ai * 128 + wr * 64 + m * 16 + fr_; const RowInfo ri = row_info(r);
        const float rs = r < MROWS ? rstd[2 * r] : 0.f;
        bf16_t* dst; int hstride;
        if (ri.kind == 0) { dst = QATT + ((size_t)(ri.b * 8) * SEQ + ri.t) * 96; hstride = SEQ * 96; }
        else if (ri.kind == 1) { dst = QS + (size_t)(r - ROW_S) * 768; hstride = 96; }
        else { dst = QMETA + (size_t)ri.t * 96; hstride = 256 * 96; }
#pragma unroll
        for (int bj = 0; bj < 2; ++bj) {
          const int gb = pn * 256 + bj * 128 + wc * 32; const int h = gb / 96, gm = gb - h * 96;
          float v[8];
#pragma unroll
          for (int j = 0; j < 4; ++j) { v[j] = acc[ai][bj][m][0][j] * rs; v[4 + j] = acc[ai][bj][m][1][j] * rs; }
          if (gm == 64) {
            const float* cp = ct + ri.pos * 16 + 8 * (fq & 1); const float* sp = st + ri.pos * 16 + 8 * (fq & 1);
            const f32x4 c0 = *(const f32x4*)cp, c1 = *(const f32x4*)(cp + 4), s0 = *(const f32x4*)sp, s1 = *(const f32x4*)(sp + 4);
            const float sg = fq < 2 ? -1.f : 1.f;
#pragma unroll
            for (int j = 0; j < 8; ++j) { const float pv = __shfl_xor(v[j], 32); const float c = j < 4 ? c0[j & 3] : c1[j & 3], s = j < 4 ? s0[j & 3] : s1[j & 3];
              v[j] = v[j] * c + sg * pv * s; }
          }
          u32x4 w; w.x = cvtpk(v[0], v[1]); w.y = cvtpk(v[2], v[3]); w.z = cvtpk(v[4], v[5]); w.w = cvtpk(v[6], v[7]);
          if (ri.kind != 3) *(u32x4*)(dst + (size_t)h * hstride + gm + 8 * fq) = w;
        }
      }
  }
};

struct EpiKV {
  const float* rstd; bf16_t* KV;
  __device__ __forceinline__ void operator()(const f32x4 (&acc)[2][2][4][2], int tm, int pn, int wr, int wc, int fr, int fq) const {
#pragma unroll
    for (int ai = 0; ai < 2; ++ai)
#pragma unroll
      for (int m = 0; m < 4; ++m) {
        int fr_ = fr; asm volatile("" : "+v"(fr_) :: "memory");
        const int r = tm * 256 + ai * 128 + wr * 64 + m * 16 + fr_; const RowInfo ri = row_info(r);
        if (ri.kind != 0 && ri.kind != 2) continue;
        const float rs = rstd[2 * r + 1];
#pragma unroll
        for (int bj = 0; bj < 2; ++bj) {
          const int col0 = pn * 256 + bj * 128 + wc * 32 + 8 * fq; const int isv = col0 >= 512; const int cc = col0 & 511; const int h = cc >> 6, d0 = (cc & 63) + (isv ? 96 : 0);
          const f32x4 v0 = acc[ai][bj][m][0] * rs, v1 = acc[ai][bj][m][1] * rs;
          u32x4 w; w.x = cvtpk(v0[0], v0[1]); w.y = cvtpk(v0[2], v0[3]); w.z = cvtpk(v1[0], v1[1]); w.w = cvtpk(v1[2], v1[3]);
          if (ri.kind == 0) *(u32x4*)(KV + ((size_t)(ri.b * 8 + h) * KVROWS + 64 + ri.t) * 160 + d0) = w;
          else for (int b = 0; b < NB; ++b) *(u32x4*)(KV + ((size_t)(b * 8 + h) * KVROWS + ri.t) * 160 + d0) = w;
        }
        asm volatile("" ::: "memory");
      }
  }
};

struct AttnUnit { const bf16_t* q; const bf16_t* kv; int ntiles, chunk0, nq_valid, out_row0, h, is_meta; };
constexpr int AT_KP = 208, AT_VP = 192, AT_KB = 64 * AT_KP, AT_STAGE = AT_KB + 64 * AT_VP;
typedef short v4i16_t __attribute__((ext_vector_type(4)));

__device__ __forceinline__ void attn_unit(LAS unsigned char* lds, const AttnUnit u, bf16_t* PROJ, int tid) {
  asm volatile("" : "+v"(tid));
  const int lane = tid & 63, w = tid >> 6, r32 = lane & 31, hi = lane >> 5;
  const int jmax = u.is_meta ? 0 : (1 + u.chunk0 + (w >> 1));
  bf16x8 qf[6];
  { const bf16_t* qp = u.q + (size_t)(32 * w + r32) * 96 + 8 * hi;
#pragma unroll
    for (int s = 0; s < 6; ++s) qf[s] = *(const bf16x8*)(qp + 16 * s); }
  f32x16 o0, o1;
#pragma unroll
  for (int i = 0; i < 16; ++i) { o0[i] = 0.f; o1[i] = 0.f; }
  float mrun = -INFINITY, lrun = 0.f;
  u32x4 st0, st1, st2; st2 = (u32x4){0u, 0u, 0u, 0u};
  auto lds_off = [](int c) { const int row = c / 20, cc = c - row * 20; return cc < 12 ? row * AT_KP + cc * 16 : AT_KB + row * AT_VP + (cc - 12) * 16; };
  const int off0 = lds_off(tid), off1 = lds_off(tid + 512), off2 = lds_off(tid < 256 ? tid + 1024 : 0);
  { const u32x4* g = (const u32x4*)u.kv; st0 = g[tid]; st1 = g[tid + 512]; if (tid < 256) st2 = g[tid + 1024]; }
  *(LAS u32x4*)(lds + off0) = st0; *(LAS u32x4*)(lds + off1) = st1; if (tid < 256) *(LAS u32x4*)(lds + off2) = st2;
  __syncthreads();
  const int koff = r32 * AT_KP + 16 * hi;
  const int l16 = lane & 15, cg = (lane >> 4) & 1;
  const int voff = AT_KB + (4 * hi + (l16 >> 2)) * AT_VP + (16 * cg + 4 * (l16 & 3)) * 2;
  for (int j = 0; j < u.ntiles; ++j) {
    const bool more = (j + 1 < u.ntiles);
    if (more) { const u32x4* g = (const u32x4*)(u.kv + (size_t)(j + 1) * 64 * 160); st0 = g[tid]; st1 = g[tid + 512]; if (tid < 256) st2 = g[tid + 1024]; }
    LAS unsigned char* sb = lds + (j & 1) * AT_STAGE;
    if (j <= jmax) {
      f32x16 p0, p1;
#pragma unroll
      for (int i = 0; i < 16; ++i) { p0[i] = 0.f; p1[i] = 0.f; }
#pragma unroll
      for (int s = 0; s < 6; ++s) {
        const bf16x8 k0 = *(const LAS bf16x8*)(sb + koff + s * 32);
        const bf16x8 k1 = *(const LAS bf16x8*)(sb + koff + 32 * AT_KP + s * 32);
        p0 = __builtin_amdgcn_mfma_f32_32x32x16_bf16(k0, qf[s], p0, 0, 0, 0);
        p1 = __builtin_amdgcn_mfma_f32_32x32x16_bf16(k1, qf[s], p1, 0, 0, 0);
      }
      if (j == 0) {
#pragma unroll
        for (int i = 8; i < 16; ++i) p0[i] = -INFINITY;
#pragma unroll
        for (int i = 0; i < 16; ++i) p1[i] = -INFINITY;
      }
      float tm = p0[0];
#pragma unroll
      for (int i = 1; i < 16; ++i) tm = fmaxf(tm, p0[i]);
#pragma unroll
      for (int i = 0; i < 16; ++i) tm = fmaxf(tm, p1[i]);
      tm = fmaxf(tm, __shfl_xor(tm, 32));
      const float mnew = fmaxf(mrun, tm); const float alpha = exp2f(mrun - mnew); mrun = mnew;
      float ps = 0.f;
#pragma unroll
      for (int i = 0; i < 16; ++i) { p0[i] = exp2f(p0[i] - mnew); p1[i] = exp2f(p1[i] - mnew); ps += p0[i] + p1[i]; }
      lrun = lrun * alpha + ps;
#pragma unroll
      for (int i = 0; i < 16; ++i) { o0[i] *= alpha; o1[i] *= alpha; }
      bf16x8 pb[4];
#pragma unroll
      for (int s = 0; s < 2; ++s) {
        u32x4 a, b;
        a.x = cvtpk(p0[8 * s + 0], p0[8 * s + 1]); a.y = cvtpk(p0[8 * s + 2], p0[8 * s + 3]); a.z = cvtpk(p0[8 * s + 4], p0[8 * s + 5]); a.w = cvtpk(p0[8 * s + 6], p0[8 * s + 7]);
        b.x = cvtpk(p1[8 * s + 0], p1[8 * s + 1]); b.y = cvtpk(p1[8 * s + 2], p1[8 * s + 3]); b.z = cvtpk(p1[8 * s + 4], p1[8 * s + 5]); b.w = cvtpk(p1[8 * s + 6], p1[8 * s + 7]);
        pb[s] = __builtin_bit_cast(bf16x8, a); pb[2 + s] = __builtin_bit_cast(bf16x8, b);
      }
#pragma unroll
      for (int ks = 0; ks < 4; ++ks) {
        const v4i16_t a0 = __builtin_amdgcn_ds_read_tr16_b64_v4i16((LAS v4i16_t*)(sb + voff + ks * 16 * AT_VP));
        const v4i16_t a1 = __builtin_amdgcn_ds_read_tr16_b64_v4i16((LAS v4i16_t*)(sb + voff + ks * 16 * AT_VP + 8 * AT_VP));
        const v4i16_t b0 = __builtin_amdgcn_ds_read_tr16_b64_v4i16((LAS v4i16_t*)(sb + voff + ks * 16 * AT_VP + 64));
        const v4i16_t b1 = __builtin_amdgcn_ds_read_tr16_b64_v4i16((LAS v4i16_t*)(sb + voff + ks * 16 * AT_VP + 8 * AT_VP + 64));
        const bf16x8 va = {a0[0], a0[1], a0[2], a0[3], a1[0], a1[1], a1[2], a1[3]};
        const bf16x8 vb = {b0[0], b0[1], b0[2], b0[3], b1[0], b1[1], b1[2], b1[3]};
        o0 = __builtin_amdgcn_mfma_f32_32x32x16_bf16(va, pb[ks], o0, 0, 0, 0);
        o1 = __builtin_amdgcn_mfma_f32_32x32x16_bf16(vb, pb[ks], o1, 0, 0, 0);
      }
    }
    if (more) { LAS unsigned char* nb = lds + ((j + 1) & 1) * AT_STAGE;
      *(LAS u32x4*)(nb + off0) = st0; *(LAS u32x4*)(nb + off1) = st1; if (tid < 256) *(LAS u32x4*)(nb + off2) = st2; }
    __syncthreads();
  }
  const float ltot = lrun + __shfl_xor(lrun, 32); const float inv = 1.f / ltot;
  const int qi = 32 * w + r32;
  if (qi < u.nq_valid) {
    bf16_t* zr = PROJ + (size_t)(u.out_row0 + qi) * PJ + PC_ZA + u.h * 64;
#pragma unroll
    for (int dvt = 0; dvt < 2; ++dvt)
#pragma unroll
      for (int g = 0; g < 4; ++g) {
        const int dv0 = 32 * dvt + 8 * g + 4 * hi; u32x2 z = *(const u32x2*)(zr + dv0);
        float v[4];
#pragma unroll
        for (int e = 0; e < 4; ++e) v[e] = (dvt ? o1[4 * g + e] : o0[4 * g + e]) * inv;
        z.x = cvtpk(v[0] * siluf_(bflo(z.x)), v[1] * siluf_(bfhi(z.x))); z.y = cvtpk(v[2] * siluf_(bflo(z.y)), v[3] * siluf_(bfhi(z.y)));
        *(u32x2*)(zr + dv0) = z;
      }
  }
  __syncthreads();
}

constexpr int NSLOT = 32 * 65 + 128;
constexpr int MSLOT_B = 57344 + 2048;
constexpr int GSLOT_B = 73728 + 256;
constexpr int MS_Q = 0, MS_QK = 8192, MS_KHT = 12288, MS_VT = 20480, MS_SC_B = 57344;
constexpr int MSC_B = 0, MSC_MLOC = 64, MSC_RS = 128, MSC_DN = 192, MSC_A = 320, MSC_BB = 321;
constexpr int GS_NW = 0, GS_QT = 8192, GS_QK = 16384, GS_KTT = 20480, GS_UT = 28672, GS_SC_B = 73728;
constexpr size_t WS_MSLOT = WS_END0;
constexpr size_t WS_GSLOT = al256(WS_MSLOT + (size_t)NSLOT * MSLOT_B);
constexpr size_t WS_HM = al256(WS_GSLOT + (size_t)NSLOT * GSLOT_B);
constexpr size_t WS_OG = al256(WS_HM + (size_t)MROWS * 512 * 2);
constexpr size_t WS_END1 = al256(WS_OG + (size_t)MROWS * 512 * 2);

struct ChunkDesc { int row0, nvalid, kind  , b, h, tok0; };
__device__ __forceinline__ ChunkDesc chunk_of_slot(int slot) {
  ChunkDesc c;
  if (slot < 32 * 65) { const int ch = slot / 65, ci = slot - ch * 65; c.b = ch >> 2; c.h = ch & 3;
    if (ci == 0) { c.kind = 2; c.row0 = ROW_M; c.nvalid = 16; c.tok0 = 0; } else { c.kind = 0; c.row0 = c.b * SEQ + 64 * (ci - 1); c.nvalid = 64; c.tok0 = 64 * (ci - 1); } }
  else { const int ch = slot - 32 * 65; c.b = ch >> 2; c.h = ch & 3; c.kind = 1; c.row0 = ROW_S + 16 * c.b; c.nvalid = 16; c.tok0 = 0; }
  return c;
}
__device__ __forceinline__ float scan_add(float v, int lane) {
#pragma unroll
  for (int o = 1; o < 64; o <<= 1) { const float t = __shfl_up(v, o); if (lane >= o) v += t; }
  return v;
}
__device__ __forceinline__ float scan_max(float v, int lane) {
#pragma unroll
  for (int o = 1; o < 64; o <<= 1) { const float t = __shfl_up(v, o); if (lane >= o) v = fmaxf(v, t); }
  return v;
}
__device__ __forceinline__ float wave_max(float v) {
#pragma unroll
  for (int o = 1; o < 64; o <<= 1) v = fmaxf(v, __shfl_xor(v, o));
  return v;
}
__device__ __forceinline__ float sum8(float v) { v += __shfl_xor(v, 1); v += __shfl_xor(v, 2); v += __shfl_xor(v, 4); return v; }

__device__ __forceinline__ void mlstm_prep(LAS unsigned char* lds, const Params& p, int l, int slot, int tid) {
  asm volatile("" : "+v"(tid));
  const ChunkDesc cd = chunk_of_slot(slot);
  const bf16_t* PROJ = (const bf16_t*)(p.ws + WS_PROJ);
  bf16_t* SL = (bf16_t*)(p.ws + WS_MSLOT + (size_t)slot * MSLOT_B); float* SC = (float*)(p.ws + WS_MSLOT + (size_t)slot * MSLOT_B + MS_SC_B);
  const int lane = tid & 63, w = tid >> 6, c16 = lane & 15, q4 = lane >> 4;
  constexpr int L_Q = 0, L_K = 17408, L_V = 34816, L_QK = 52224, L_SC = 69632;
  LAS float* sc = (LAS float*)(lds + L_SC);
#pragma unroll
  for (int k = 0; k < 6; ++k) { const int ci = tid + 512 * k; const int ten = ci >> 10, row = (ci >> 4) & 63, c = ci & 15;
    u32x4 v = {0u, 0u, 0u, 0u};
    if (row < cd.nvalid) v = *(const u32x4*)(PROJ + (size_t)(cd.row0 + row) * PJ + (ten == 0 ? PC_MQ : (ten == 1 ? PC_MK : PC_MV)) + cd.h * 128 + c * 8);
    *(LAS u32x4*)(lds + ten * 17408 + row * 272 + c * 16) = v; }
  if (w == 0) {
    float ig = -INFINITY, fg = 0.f;
    if (lane < cd.nvalid) { const bf16_t* pr = PROJ + (size_t)(cd.row0 + lane) * PJ + PC_G16;
      ig = bf2f(pr[cd.h]) + p.in[17][(l * 2 + 0) * 4 + cd.h]; fg = logsigmoidf_(bf2f(pr[4 + cd.h]) + p.in[17][(l * 2 + 1) * 4 + cd.h]); }
    const float b = scan_add(fg, lane); const float g = ig - b; const float cm = scan_max(g, lane); const float gmax = wave_max(g); const float blast = __shfl(b, 63);
    sc[lane] = b; sc[64 + lane] = g; sc[128 + lane] = b + cm; sc[192 + lane] = __expf(g - gmax);
    SC[MSC_B + lane] = b; SC[MSC_MLOC + lane] = b + cm;
    if (lane == 0) { SC[MSC_A] = blast + gmax; SC[MSC_BB] = blast; }
  }
  if (tid >= 64 && tid < 192) sc[256 + tid - 64] = 0.f;
  __syncthreads();
#pragma unroll
  for (int ti = 0; ti < 2; ++ti) { const int id = 2 * w + ti, tm = id >> 2, tn = id & 3; f32x4 acc = {0.f, 0.f, 0.f, 0.f};
#pragma unroll
    for (int kk = 0; kk < 4; ++kk) { const bf16x8 a = *(const LAS bf16x8*)(lds + L_Q + (16 * tm + c16) * 272 + (32 * kk + 8 * q4) * 2);
      const bf16x8 b = *(const LAS bf16x8*)(lds + L_K + (16 * tn + c16) * 272 + (32 * kk + 8 * q4) * 2);
      acc = __builtin_amdgcn_mfma_f32_16x16x32_bf16(a, b, acc, 0, 0, 0); }
    const int s = 16 * tn + c16; const float gs = sc[64 + s];
#pragma unroll
    for (int i = 0; i < 4; ++i) { const int t = 16 * tm + 4 * q4 + i; const float e = (s <= t) ? __expf(sc[t] + gs - sc[128 + t]) : 0.f;
      ((LAS float*)(lds + L_QK))[t * 68 + s] = (s <= t) ? acc[i] * e : 0.f; } }
  __syncthreads();
  { const int row = tid >> 3, c8 = tid & 7; const LAS float* qr = (const LAS float*)(lds + L_QK) + row * 68 + c8 * 8; float v[8]; float rs = 0.f;
#pragma unroll
    for (int j = 0; j < 8; ++j) { v[j] = qr[j]; rs += v[j]; }
    u32x4 o; o.x = cvtpk(v[0], v[1]); o.y = cvtpk(v[2], v[3]); o.z = cvtpk(v[4], v[5]); o.w = cvtpk(v[6], v[7]);
    *(u32x4*)(SL + MS_QK + row * 64 + c8 * 8) = o; rs = sum8(rs); if (c8 == 0) SC[MSC_RS + row] = rs; }
#pragma unroll
  for (int k = 0; k < 2; ++k) { const int ci = tid + 512 * k, row = ci >> 4, c = ci & 15; *(u32x4*)(SL + MS_Q + row * 128 + c * 8) = *(const LAS u32x4*)(lds + L_Q + row * 272 + c * 16); }
#pragma unroll
  for (int k = 0; k < 2; ++k) { const int id = tid + 512 * k, d = id & 127, s8 = id >> 7; float kv[8], vv[8]; float dsum = 0.f;
#pragma unroll
    for (int j = 0; j < 8; ++j) { const int s = 8 * s8 + j; kv[j] = bf2f(*(const LAS bf16_t*)(lds + L_K + s * 272 + d * 2)) * sc[192 + s]; vv[j] = bf2f(*(const LAS bf16_t*)(lds + L_V + s * 272 + d * 2)); }
    u32x4 o; o.x = cvtpk(kv[0], kv[1]); o.y = cvtpk(kv[2], kv[3]); o.z = cvtpk(kv[4], kv[5]); o.w = cvtpk(kv[6], kv[7]);
    dsum = bflo(o.x) + bfhi(o.x) + bflo(o.y) + bfhi(o.y) + bflo(o.z) + bfhi(o.z) + bflo(o.w) + bfhi(o.w);
    *(u32x4*)(SL + MS_KHT + d * 64 + 8 * s8) = o; atomicAdd((float*)(sc + 256 + d), dsum);
    u32x4 ov; ov.x = cvtpk(vv[0], vv[1]); ov.y = cvtpk(vv[2], vv[3]); ov.z = cvtpk(vv[4], vv[5]); ov.w = cvtpk(vv[6], vv[7]);
    *(u32x4*)(SL + MS_VT + d * 64 + 8 * s8) = ov; }
  __syncthreads();
  if (tid < 128) SC[MSC_DN + tid] = sc[256 + tid];
  __syncthreads();
}

__device__ __forceinline__ void gdn_conv_taps(const Params& p, int l, const ChunkDesc& cd, int t, int col  , float (&x)[4][8]) {
  const bf16_t* PROJ = (const bf16_t*)(p.ws + WS_PROJ);
#pragma unroll
  for (int j = 0; j < 4; ++j) {
    const int T = cd.tok0 + t - 3 + j; int row = -1; const float* fsrc = nullptr;
    if (T >= 0) row = (cd.kind == 0 ? cd.b * SEQ : (cd.kind == 1 ? ROW_S + 16 * cd.b : ROW_M)) + T;
    else if (cd.kind == 0) row = ROW_M + 16 + T;
    else if (cd.kind == 1) fsrc = p.in[8] + (((size_t)l * DB + cd.b) * 3 + (3 + T)) * 1536 + col;
    if (row >= 0) { const u32x4 w = *(const u32x4*)(PROJ + (size_t)row * PJ + PC_GQ + col);
      x[j][0] = bflo(w.x); x[j][1] = bfhi(w.x); x[j][2] = bflo(w.y); x[j][3] = bfhi(w.y); x[j][4] = bflo(w.z); x[j][5] = bfhi(w.z); x[j][6] = bflo(w.w); x[j][7] = bfhi(w.w); }
    else if (fsrc) { const f32x4 a = *(const f32x4*)fsrc, b = *(const f32x4*)(fsrc + 4); x[j][0] = a.x; x[j][1] = a.y; x[j][2] = a.z; x[j][3] = a.w; x[j][4] = b.x; x[j][5] = b.y; x[j][6] = b.z; x[j][7] = b.w; }
    else {
#pragma unroll
      for (int e = 0; e < 8; ++e) x[j][e] = 0.f; }
  }
}

__device__ __forceinline__ void gdn_prep(LAS unsigned char* lds, const Params& p, int l, int slot, int tid) {
  asm volatile("" : "+v"(tid));
  const ChunkDesc cd = chunk_of_slot(slot);
  const bf16_t* PROJ = (const bf16_t*)(p.ws + WS_PROJ);
  bf16_t* SL = (bf16_t*)(p.ws + WS_GSLOT + (size_t)slot * GSLOT_B); float* SC = (float*)(p.ws + WS_GSLOT + (size_t)slot * GSLOT_B + GS_SC_B);
  const int lane = tid & 63, w = tid >> 6, c16 = lane & 15, q4 = lane >> 4;
  constexpr int L_Q = 0, L_K = 17408, L_RHS = 34816, L_AM = 101376, L_QK = 118784, L_SC = 136192;
  LAS float* sc = (LAS float*)(lds + L_SC);
  LAS float* RHS = (LAS float*)(lds + L_RHS); LAS float* AM = (LAS float*)(lds + L_AM); LAS float* QKf = (LAS float*)(lds + L_QK);
  if (w == 0) {
    float ld = 0.f, be = 0.f;
    if (lane < cd.nvalid) { const bf16_t* pr = PROJ + (size_t)(cd.row0 + lane) * PJ + PC_G16;
      ld = -__expf(p.in[20][l * 4 + cd.h]) * softplusf_(bf2f(pr[8 + cd.h]) + p.in[21][l * 4 + cd.h]); be = sigmoidf_(bf2f(pr[12 + cd.h])); }
    const float G = scan_add(ld, lane); sc[lane] = G; sc[64 + lane] = be;
    if (lane == 63) SC[0] = __expf(G);
  }
  __syncthreads();
  { const int t = tid >> 3, part = tid & 7; const float G = sc[t], be = sc[64 + t], eG = __expf(G);
    const float* cw = p.in[19] + (size_t)l * 4 * 1536;
#pragma unroll
    for (int ten = 0; ten < 3; ++ten) {
      float y[16];
#pragma unroll
      for (int hh = 0; hh < 2; ++hh) { const int col = ten * 512 + cd.h * 128 + 16 * part + 8 * hh; float x[4][8]; gdn_conv_taps(p, l, cd, t, col, x);
#pragma unroll
        for (int e = 0; e < 8; ++e) { float a = 0.f;
#pragma unroll
          for (int j = 0; j < 4; ++j) a += x[j][e] * cw[j * 1536 + col + e];
          y[8 * hh + e] = siluf_(a); } }
      if (ten < 2) { float ss = 0.f;
#pragma unroll
        for (int e = 0; e < 16; ++e) ss += y[e] * y[e];
        ss = sum8(ss); const float rn = rsqrtf(ss + EPS) * (ten == 0 ? 0.08838834764831845f : 1.f);
#pragma unroll
        for (int e = 0; e < 16; ++e) y[e] *= rn; }
      if (t >= cd.nvalid) {
#pragma unroll
        for (int e = 0; e < 16; ++e) y[e] = 0.f; }
      if (ten < 2) { u32x4 o0, o1; o0.x = cvtpk(y[0], y[1]); o0.y = cvtpk(y[2], y[3]); o0.z = cvtpk(y[4], y[5]); o0.w = cvtpk(y[6], y[7]);
        o1.x = cvtpk(y[8], y[9]); o1.y = cvtpk(y[10], y[11]); o1.z = cvtpk(y[12], y[13]); o1.w = cvtpk(y[14], y[15]);
        LAS unsigned char* dst = lds + (ten == 0 ? L_Q : L_K) + t * 272 + part * 32; *(LAS u32x4*)dst = o0; *(LAS u32x4*)(dst + 16) = o1; }
      if (ten == 1) {
#pragma unroll
        for (int e = 0; e < 16; ++e) RHS[t * 260 + 128 + 16 * part + e] = be * eG * y[e]; }
      if (ten == 2) {
#pragma unroll
        for (int e = 0; e < 16; ++e) RHS[t * 260 + 16 * part + e] = be * y[e]; }
    } }
  __syncthreads();
#pragma unroll
  for (int ti = 0; ti < 4; ++ti) { const int id = 4 * w + ti, isq = id >> 4, tm = (id >> 2) & 3, tn = id & 3; f32x4 acc = {0.f, 0.f, 0.f, 0.f};
#pragma unroll
    for (int kk = 0; kk < 4; ++kk) { const bf16x8 a = *(const LAS bf16x8*)(lds + (isq ? L_Q : L_K) + (16 * tm + c16) * 272 + (32 * kk + 8 * q4) * 2);
      const bf16x8 b = *(const LAS bf16x8*)(lds + L_K + (16 * tn + c16) * 272 + (32 * kk + 8 * q4) * 2);
      acc = __builtin_amdgcn_mfma_f32_16x16x32_bf16(a, b, acc, 0, 0, 0); }
    const int s = 16 * tn + c16; const float Gs = sc[s];
#pragma unroll
    for (int i = 0; i < 4; ++i) { const int t = 16 * tm + 4 * q4 + i; const float e = __expf(sc[t] - Gs);
      if (isq) QKf[t * 68 + s] = (s <= t) ? acc[i] * e : 0.f; else AM[t * 68 + s] = (s < t) ? sc[64 + t] * acc[i] * e : 0.f; } }
  __syncthreads();
  if (tid < 256) {
    float x[64]; int zero_ = 0; asm volatile("" : "+v"(zero_)); const LAS float* AMv = AM + zero_;
#pragma unroll
    for (int t = 0; t < 64; ++t) { float a = RHS[t * 260 + tid];
#pragma unroll
      for (int s4 = 0; s4 < (t + 3) / 4; ++s4) { const f32x4 am = *(const LAS f32x4*)(AMv + t * 68 + 4 * s4);
#pragma unroll
        for (int e = 0; e < 4; ++e) if (4 * s4 + e < t) a -= am[e] * x[4 * s4 + e]; }
      x[t] = a; if ((t & 3) == 3) __builtin_amdgcn_sched_barrier(0); }
    if (tid < 128) {
#pragma unroll
      for (int t8 = 0; t8 < 8; ++t8) { u32x4 o; o.x = cvtpk(x[8 * t8], x[8 * t8 + 1]); o.y = cvtpk(x[8 * t8 + 2], x[8 * t8 + 3]); o.z = cvtpk(x[8 * t8 + 4], x[8 * t8 + 5]); o.w = cvtpk(x[8 * t8 + 6], x[8 * t8 + 7]);
        *(u32x4*)(SL + GS_UT + tid * 64 + 8 * t8) = o; }
    } else {
#pragma unroll
      for (int t = 0; t < 64; ++t) SL[GS_NW + t * 128 + (tid - 128)] = f2bf(-x[t]);
    }
  } else {
    const int u = tid - 256; const float Glast = sc[63];
#pragma unroll
    for (int k = 0; k < 4; ++k) { const int ci = u + 256 * k, row = ci >> 4, c = ci & 15; const u32x4 v = *(const LAS u32x4*)(lds + L_Q + row * 272 + c * 16); const float e = __expf(sc[row]);
      u32x4 o; o.x = cvtpk(bflo(v.x) * e, bfhi(v.x) * e); o.y = cvtpk(bflo(v.y) * e, bfhi(v.y) * e); o.z = cvtpk(bflo(v.z) * e, bfhi(v.z) * e); o.w = cvtpk(bflo(v.w) * e, bfhi(v.w) * e);
      *(u32x4*)(SL + GS_QT + row * 128 + c * 8) = o; }
#pragma unroll
    for (int k = 0; k < 4; ++k) { const int id = u + 256 * k, d = id & 127, s8 = id >> 7; float kv[8];
#pragma unroll
      for (int j = 0; j < 8; ++j) { const int s = 8 * s8 + j; kv[j] = bf2f(*(const LAS bf16_t*)(lds + L_K + s * 272 + d * 2)) * __expf(Glast - sc[s]); }
      u32x4 o; o.x = cvtpk(kv[0], kv[1]); o.y = cvtpk(kv[2], kv[3]); o.z = cvtpk(kv[4], kv[5]); o.w = cvtpk(kv[6], kv[7]);
      *(u32x4*)(SL + GS_KTT + d * 64 + 8 * s8) = o; }
#pragma unroll
    for (int k = 0; k < 2; ++k) { const int ci = u + 256 * k, row = ci >> 3, c8 = ci & 7; const LAS float* qr = QKf + row * 68 + c8 * 8;
      u32x4 o; o.x = cvtpk(qr[0], qr[1]); o.y = cvtpk(qr[2], qr[3]); o.z = cvtpk(qr[4], qr[5]); o.w = cvtpk(qr[6], qr[7]);
      *(u32x4*)(SL + GS_QK + row * 64 + c8 * 8) = o; }
  }
  __syncthreads();
}

constexpr int SC_STAGE = 62464, SC_MISC = 2 * SC_STAGE;
__device__ __forceinline__ bf16x8 pack_acc2(const f32x4& a, const f32x4& b) { u32x4 o; o.x = cvtpk(a[0], a[1]); o.y = cvtpk(a[2], a[3]); o.z = cvtpk(b[0], b[1]); o.w = cvtpk(b[2], b[3]); return __builtin_bit_cast(bf16x8, o); }
__device__ __forceinline__ bf16x8 lda_perm(const LAS unsigned char* base) { const u32x2 lo = *(const LAS u32x2*)base, hi = *(const LAS u32x2*)(base + 32); u32x4 o = {lo.x, lo.y, hi.x, hi.y}; return __builtin_bit_cast(bf16x8, o); }

template <bool GDN>
__device__ __forceinline__ void scan_chain(LAS unsigned char* lds, const Params& p, int l, int chain  , int tid) {
  asm volatile("" : "+v"(tid));
  const int lane = tid & 63, w = tid >> 6, c16 = lane & 15, q4 = lane >> 4;
  const bool samp = chain >= 32; const int ch = samp ? chain - 32 : chain; const int b = ch >> 2, h = ch & 3;
  const int slot0 = samp ? 32 * 65 + ch : ch * 65, nch = samp ? 1 : 65;
  const unsigned char* slots = p.ws + (GDN ? WS_GSLOT : WS_MSLOT); constexpr int SLOT_B = GDN ? GSLOT_B : MSLOT_B;
  constexpr int NLD = GDN ? 7 : 5;
  bf16_t* OUT = (bf16_t*)(p.ws + (GDN ? WS_OG : WS_HM));
  LAS float* nvec = (LAS float*)(lds + SC_MISC); LAS float* c1 = nvec + 128; LAS float* c2 = nvec + 192;
  f32x4 S[8]; float mrun = 0.f;
  const int vcol = 16 * w + c16;
  if (!samp) {
#pragma unroll
    for (int i = 0; i < 8; ++i) S[i] = (f32x4){0.f, 0.f, 0.f, 0.f};
    if (!GDN && tid < 128) nvec[tid] = 0.f;
  } else if (GDN) {
    const float* S0 = p.in[7] + (((size_t)l * DB + b) * 4 + h) * 128 * 128;
#pragma unroll
    for (int i = 0; i < 8; ++i)
#pragma unroll
      for (int r = 0; r < 4; ++r) S[i][r] = S0[(size_t)(16 * i + 4 * q4 + r) * 128 + vcol];
  } else {
    const float* C0 = p.in[4] + (((size_t)l * DB + b) * 4 + h) * 128 * 128;
#pragma unroll
    for (int i = 0; i < 8; ++i) S[i] = *(const f32x4*)(C0 + (size_t)vcol * 128 + 16 * i + 4 * q4);
    if (tid < 128) nvec[tid] = p.in[5][(((size_t)l * DB + b) * 4 + h) * 128 + tid];
    mrun = p.in[6][((size_t)l * DB + b) * 4 + h];
  }
  auto lds_dst = [](int ci) -> int {
    if (GDN) { if (ci < 1024) return (ci >> 4) * 272 + (ci & 15) * 16; if (ci < 2048) { ci -= 1024; return 17408 + (ci >> 4) * 272 + (ci & 15) * 16; }
      if (ci < 2560) { ci -= 2048; return 34816 + (ci >> 3) * 144 + (ci & 7) * 16; } ci -= 2560; return 44032 + (ci >> 3) * 144 + (ci & 7) * 16; }
    else { if (ci < 1024) return (ci >> 4) * 272 + (ci & 15) * 16; if (ci < 1536) { ci -= 1024; return 17408 + (ci >> 3) * 144 + (ci & 7) * 16; }
      ci -= 1536; return 26624 + (ci >> 3) * 144 + (ci & 7) * 16; } };
  constexpr int L_A0 = 0;
  constexpr int L_QT = 17408;
  constexpr int L_QK = GDN ? 34816 : 17408;
  constexpr int L_KT = GDN ? 44032 : 26624;
  constexpr int L_SCAL = 45056;
  u32x4 st[NLD]; u32x4 stsc = {0u, 0u, 0u, 0u};
  { const u32x4* g = (const u32x4*)(slots + (size_t)slot0 * SLOT_B);
#pragma unroll
    for (int k = 0; k < NLD; ++k) st[k] = g[tid + 512 * k];
    if (!GDN && tid < 84) stsc = g[3584 + tid];
#pragma unroll
    for (int k = 0; k < NLD; ++k) *(LAS u32x4*)(lds + lds_dst(tid + 512 * k)) = st[k];
    if (!GDN && tid < 84) *(LAS u32x4*)(lds + L_SCAL + tid * 16) = stsc; }
  __syncthreads();
  for (int c = 0; c < nch; ++c) {
    const unsigned char* sl = slots + (size_t)(slot0 + c) * SLOT_B; const bf16_t* slb = (const bf16_t*)sl;
    LAS unsigned char* cur = lds + (c & 1) * SC_STAGE;
    const bool more = c + 1 < nch;
    if (more) { const u32x4* g = (const u32x4*)(sl + SLOT_B);
#pragma unroll
      for (int k = 0; k < NLD; ++k) st[k] = g[tid + 512 * k];
      if (!GDN && tid < 84) stsc = g[3584 + tid]; }
    const int nvalid = samp ? 16 : (c == 0 ? 16 : 64);
    const int row0 = samp ? ROW_S + 16 * b : (c == 0 ? ROW_M : b * SEQ + 64 * (c - 1));
    bf16x8 Sb[4];
#pragma unroll
    for (int kk = 0; kk < 4; ++kk) Sb[kk] = pack_acc2(S[2 * kk], S[2 * kk + 1]);
    f32x4 o[4];
    if (GDN) {
      f32x4 dl[4];
#pragma unroll
      for (int mt = 0; mt < 4; ++mt) { const u32x2 u = *(const u32x2*)(slb + GS_UT + vcol * 64 + 16 * mt + 4 * q4); dl[mt] = (f32x4){bflo(u.x), bfhi(u.x), bflo(u.y), bfhi(u.y)}; o[mt] = (f32x4){0.f, 0.f, 0.f, 0.f}; }
#pragma unroll
      for (int mt = 0; mt < 4; ++mt)
#pragma unroll
        for (int kk = 0; kk < 4; ++kk) {
          const bf16x8 aw = lda_perm(cur + L_A0 + (16 * mt + c16) * 272 + (32 * kk + 4 * q4) * 2);
          const bf16x8 aq = lda_perm(cur + L_QT + (16 * mt + c16) * 272 + (32 * kk + 4 * q4) * 2);
          dl[mt] = __builtin_amdgcn_mfma_f32_16x16x32_bf16(aw, Sb[kk], dl[mt], 0, 0, 0);
          o[mt] = __builtin_amdgcn_mfma_f32_16x16x32_bf16(aq, Sb[kk], o[mt], 0, 0, 0); }
      bf16x8 Db[2];
#pragma unroll
      for (int ks = 0; ks < 2; ++ks) Db[ks] = pack_acc2(dl[2 * ks], dl[2 * ks + 1]);
#pragma unroll
      for (int mt = 0; mt < 4; ++mt)
#pragma unroll
        for (int ks = 0; ks < 2; ++ks) { const bf16x8 a = lda_perm(cur + L_QK + (16 * mt + c16) * 144 + (32 * ks + 4 * q4) * 2);
          o[mt] = __builtin_amdgcn_mfma_f32_16x16x32_bf16(a, Db[ks], o[mt], 0, 0, 0); }
      const float gl = ((const float*)(sl + GS_SC_B))[0];
#pragma unroll
      for (int i = 0; i < 8; ++i) { S[i] *= gl;
#pragma unroll
        for (int ks = 0; ks < 2; ++ks) { const bf16x8 a = lda_perm(cur + L_KT + (16 * i + c16) * 144 + (32 * ks + 4 * q4) * 2);
          S[i] = __builtin_amdgcn_mfma_f32_16x16x32_bf16(a, Db[ks], S[i], 0, 0, 0); } }
    } else {
      const LAS float* scal = (const LAS float*)(cur + L_SCAL);
      bf16x8 bv[2];
#pragma unroll
      for (int ks = 0; ks < 2; ++ks) bv[ks] = *(const bf16x8*)(slb + MS_VT + vcol * 64 + 32 * ks + 8 * q4);
      { const int t = tid >> 3, part = tid & 7; const LAS unsigned char* qr = cur + L_A0 + t * 272 + part * 32; float a = 0.f;
        const u32x4 q0 = *(const LAS u32x4*)qr, q1 = *(const LAS u32x4*)(qr + 16); const LAS float* nn = nvec + 16 * part;
        a += bflo(q0.x) * nn[0] + bfhi(q0.x) * nn[1] + bflo(q0.y) * nn[2] + bfhi(q0.y) * nn[3] + bflo(q0.z) * nn[4] + bfhi(q0.z) * nn[5] + bflo(q0.w) * nn[6] + bfhi(q0.w) * nn[7];
        a += bflo(q1.x) * nn[8] + bfhi(q1.x) * nn[9] + bflo(q1.y) * nn[10] + bfhi(q1.y) * nn[11] + bflo(q1.z) * nn[12] + bfhi(q1.z) * nn[13] + bflo(q1.w) * nn[14] + bfhi(q1.w) * nn[15];
        a = sum8(a);
        if (part == 0) { const float inter = scal[MSC_B + t] + mrun, ml = scal[MSC_MLOC + t]; const float mt_ = fmaxf(inter, ml);
          const float w1 = __expf(inter - mt_), w2 = __expf(ml - mt_); const float den = w1 * a + w2 * scal[MSC_RS + t];
          const float sc_ = 1.f / fmaxf(fabsf(den), __expf(-mt_)); c1[t] = w1 * sc_; c2[t] = w2 * sc_; } }
      f32x4 a1[4], a2[4];
#pragma unroll
      for (int mt = 0; mt < 4; ++mt) { a1[mt] = (f32x4){0.f, 0.f, 0.f, 0.f}; a2[mt] = (f32x4){0.f, 0.f, 0.f, 0.f};
#pragma unroll
        for (int kk = 0; kk < 4; ++kk) { const bf16x8 aq = lda_perm(cur + L_A0 + (16 * mt + c16) * 272 + (32 * kk + 4 * q4) * 2);
          a1[mt] = __builtin_amdgcn_mfma_f32_16x16x32_bf16(aq, Sb[kk], a1[mt], 0, 0, 0); }
#pragma unroll
        for (int ks = 0; ks < 2; ++ks) { const bf16x8 a = *(const LAS bf16x8*)(cur + L_QK + (16 * mt + c16) * 144 + (32 * ks + 8 * q4) * 2);
          a2[mt] = __builtin_amdgcn_mfma_f32_16x16x32_bf16(a, bv[ks], a2[mt], 0, 0, 0); } }
      __syncthreads();
#pragma unroll
      for (int mt = 0; mt < 4; ++mt)
#pragma unroll
        for (int r = 0; r < 4; ++r) { const int t = 16 * mt + 4 * q4 + r; o[mt][r] = c1[t] * a1[mt][r] + c2[t] * a2[mt][r]; }
      const float A = scal[MSC_A], B = scal[MSC_BB]; const float mnew = fmaxf(B + mrun, A); const float alpha = __expf(B + mrun - mnew), beta = __expf(A - mnew);
#pragma unroll
      for (int i = 0; i < 8; ++i) { f32x4 X = {0.f, 0.f, 0.f, 0.f};
#pragma unroll
        for (int ks = 0; ks < 2; ++ks) { const bf16x8 a = *(const LAS bf16x8*)(cur + L_KT + (16 * i + c16) * 144 + (32 * ks + 8 * q4) * 2);
          X = __builtin_amdgcn_mfma_f32_16x16x32_bf16(a, bv[ks], X, 0, 0, 0); }
        S[i] = S[i] * alpha + X * beta; }
      if (tid < 128) nvec[tid] = alpha * nvec[tid] + beta * scal[MSC_DN + tid];
      mrun = mnew;
    }
#pragma unroll
    for (int mt = 0; mt < 4; ++mt)
#pragma unroll
      for (int r = 0; r < 4; ++r) { const int t = 16 * mt + 4 * q4 + r; if (t < nvalid) OUT[(size_t)(row0 + t) * 512 + h * 128 + vcol] = f2bf(o[mt][r]); }
    if (more) { LAS unsigned char* nb = lds + ((c + 1) & 1) * SC_STAGE;
#pragma unroll
      for (int k = 0; k < NLD; ++k) *(LAS u32x4*)(nb + lds_dst(tid + 512 * k)) = st[k];
      if (!GDN && tid < 84) *(LAS u32x4*)(nb + L_SCAL + tid * 16) = stsc; }
    __syncthreads();
  }
  if (GDN) { float* So = p.out + (samp ? O_SS + (((size_t)l * DB + b) * 4 + h) * 16384 : O_PS + (((size_t)l * NB + b) * 4 + h) * 16384);
#pragma unroll
    for (int i = 0; i < 8; ++i)
#pragma unroll
      for (int r = 0; r < 4; ++r) So[(size_t)(16 * i + 4 * q4 + r) * 128 + vcol] = S[i][r];
  } else { float* Co = p.out + (samp ? O_SC + (((size_t)l * DB + b) * 4 + h) * 16384 : O_PC + (((size_t)l * NB + b) * 4 + h) * 16384);
#pragma unroll
    for (int i = 0; i < 8; ++i) *(f32x4*)(Co + (size_t)vcol * 128 + 16 * i + 4 * q4) = S[i];
    if (tid < 128) (p.out + (samp ? O_SN + (((size_t)l * DB + b) * 4 + h) * 128 : O_PN + (((size_t)l * NB + b) * 4 + h) * 128))[tid] = nvec[tid];
    if (tid == 0) (p.out + (samp ? O_SM + ((size_t)l * DB + b) * 4 + h : O_PM + ((size_t)l * NB + b) * 4 + h))[0] = mrun;
  }
  __syncthreads();
}

constexpr int SA_KP = 592;
constexpr int SA_KT = 64 * SA_KP;
constexpr int SA_QOFF = SA_KT;
constexpr int SA_PART = 128 * 264;
constexpr size_t WS_SAPART = WS_END1;
constexpr size_t WS_END2 = al256(WS_SAPART + (size_t)256 * SA_PART * 4);

__device__ __forceinline__ void sattn_unit(LAS unsigned char* lds, const Params& p, int l, int b, int g, int tid) {
  asm volatile("" : "+v"(tid));
  const int lane = tid & 63, w = tid >> 6, c16 = lane & 15, q4 = lane >> 4;
  const bf16_t* QS = (const bf16_t*)(p.ws + WS_QS) + (size_t)b * 16 * 768;
  { const int h = w; const bf16_t* WK = (const bf16_t*)(p.ws + WS_WUKR) + (size_t)l * 256 * 512 + h * 64;
    bf16x8 a[2];
#pragma unroll
    for (int ks = 0; ks < 2; ++ks) a[ks] = *(const bf16x8*)(QS + (size_t)c16 * 768 + h * 96 + 32 * ks + 8 * q4);
#pragma unroll
    for (int nt = 0; nt < 16; ++nt) { f32x4 acc = {0.f, 0.f, 0.f, 0.f};
#pragma unroll
      for (int ks = 0; ks < 2; ++ks) { const bf16x8 bb = *(const bf16x8*)(WK + (size_t)(16 * nt + c16) * 512 + 32 * ks + 8 * q4);
        acc = __builtin_amdgcn_mfma_f32_16x16x32_bf16(a[ks], bb, acc, 0, 0, 0); }
#pragma unroll
      for (int r = 0; r < 4; ++r) { const int t = 4 * q4 + r; *(LAS bf16_t*)(lds + SA_QOFF + (t * 8 + h) * SA_KP + (16 * nt + c16) * 2) = f2bf(acc[r]); } }
    { const int row = tid >> 2, part = tid & 3, t = row >> 3, hh = row & 7;
      *(LAS u32x4*)(lds + SA_QOFF + row * SA_KP + 512 + part * 16) = *(const u32x4*)(QS + (size_t)t * 768 + hh * 96 + 64 + part * 8); } }
  const LAS unsigned char* qrow = lds + SA_QOFF + (16 * w + c16) * SA_KP + (8 * q4) * 2;
  const int tile0 = 8 * g, ntile = g == 7 ? 9 : 8;
  const float* CL = p.in[2] + ((size_t)l * DB + b) * NCACHE * 256; const float* CK = p.in[3] + ((size_t)l * DB + b) * NCACHE * 32;
  const float* NL = p.out + O_SLAT + ((size_t)l * DB + b) * DS * 256; const float* NK = p.out + O_SKR + ((size_t)l * DB + b) * DS * 32;
  f32x4 st[9];
  auto load_tile = [&](int tile) {
    int tj = tid; asm volatile("" : "+v"(tj));
#pragma unroll
    for (int k = 0; k < 9; ++k) { const int ci = tj + 512 * k, key = ci / 72, part = ci - key * 72; const int kg = tile * 64 + key;
      f32x4 v = {0.f, 0.f, 0.f, 0.f};
      if (kg < NCACHE) v = part < 64 ? *(const f32x4*)(CL + (size_t)kg * 256 + 4 * part) : *(const f32x4*)(CK + (size_t)kg * 32 + 4 * (part - 64));
      else if (kg < NCACHE + DS) v = part < 64 ? *(const f32x4*)(NL + (size_t)(kg - NCACHE) * 256 + 4 * part) : *(const f32x4*)(NK + (size_t)(kg - NCACHE) * 32 + 4 * (part - 64));
      st[k] = v; } };
  auto store_tile = [&](LAS unsigned char* dst) {
    int tj = tid; asm volatile("" : "+v"(tj));
#pragma unroll
    for (int k = 0; k < 9; ++k) { const int ci = tj + 512 * k, key = ci / 72, part = ci - key * 72; u32x2 o; o.x = cvtpk(st[k].x, st[k].y); o.y = cvtpk(st[k].z, st[k].w);
      *(LAS u32x2*)(dst + key * SA_KP + part * 8) = o; } };
  load_tile(tile0); store_tile(lds); __syncthreads();
  f32x4 O[16];
#pragma unroll
  for (int i = 0; i < 16; ++i) O[i] = (f32x4){0.f, 0.f, 0.f, 0.f};
  float mrun = -INFINITY, lrun = 0.f;
  for (int j = 0; j < ntile; ++j) {
    const bool more = j + 1 < ntile;
    if (more) load_tile(tile0 + j + 1);
    LAS unsigned char* kb = lds;
    f32x4 s[4];
#pragma unroll
    for (int mt = 0; mt < 4; ++mt) s[mt] = (f32x4){0.f, 0.f, 0.f, 0.f};
#pragma unroll
    for (int ks = 0; ks < 9; ++ks) { const bf16x8 qf = *(const LAS bf16x8*)(qrow + 64 * ks);
#pragma unroll
      for (int mt = 0; mt < 4; ++mt) { const bf16x8 a = *(const LAS bf16x8*)(kb + (16 * mt + c16) * SA_KP + (32 * ks + 8 * q4) * 2);
        s[mt] = __builtin_amdgcn_mfma_f32_16x16x32_bf16(a, qf, s[mt], 0, 0, 0); }
      if (ks & 1) __builtin_amdgcn_sched_barrier(0); }
    const int kbase = (tile0 + j) * 64;
    float tm = -INFINITY;
#pragma unroll
    for (int mt = 0; mt < 4; ++mt)
#pragma unroll
      for (int r = 0; r < 4; ++r) { if (kbase + 16 * mt + 4 * q4 + r >= NCACHE + DS) s[mt][r] = -INFINITY; tm = fmaxf(tm, s[mt][r]); }
    tm = fmaxf(tm, __shfl_xor(tm, 16)); tm = fmaxf(tm, __shfl_xor(tm, 32));
    const float mnew = fmaxf(mrun, tm); const float alpha = exp2f(mrun - mnew); mrun = mnew; float ps = 0.f;
#pragma unroll
    for (int mt = 0; mt < 4; ++mt)
#pragma unroll
      for (int r = 0; r < 4; ++r) { s[mt][r] = exp2f(s[mt][r] - mnew); ps += s[mt][r]; }
    lrun = lrun * alpha + ps;
    bf16x8 pb[2];
#pragma unroll
    for (int ks = 0; ks < 2; ++ks) pb[ks] = pack_acc2(s[2 * ks], s[2 * ks + 1]);
    const int vo = (4 * q4 + (c16 >> 2)) * SA_KP + (4 * (c16 & 3)) * 2;
#pragma unroll
    for (int nt = 0; nt < 16; ++nt) { O[nt] *= alpha;
#pragma unroll
      for (int ks = 0; ks < 2; ++ks) {
        const v4i16_t a0 = __builtin_amdgcn_ds_read_tr16_b64_v4i16((LAS v4i16_t*)(kb + vo + (32 * ks) * SA_KP + nt * 32));
        const v4i16_t a1 = __builtin_amdgcn_ds_read_tr16_b64_v4i16((LAS v4i16_t*)(kb + vo + (32 * ks + 16) * SA_KP + nt * 32));
        const bf16x8 va = {a0[0], a0[1], a0[2], a0[3], a1[0], a1[1], a1[2], a1[3]};
        O[nt] = __builtin_amdgcn_mfma_f32_16x16x32_bf16(va, pb[ks], O[nt], 0, 0, 0); }
      if ((nt & 3) == 3) __builtin_amdgcn_sched_barrier(0); }
    __syncthreads();
    if (more) { store_tile(lds); __syncthreads(); }
  }
  float* P = (float*)(p.ws + WS_SAPART) + (size_t)(b * 8 + g) * SA_PART + (size_t)(16 * w + c16) * 264;
#pragma unroll
  for (int nt = 0; nt < 16; ++nt) *(f32x4*)(P + 16 * nt + 4 * q4) = O[nt];
  lrun += __shfl_xor(lrun, 16); lrun += __shfl_xor(lrun, 32);
  if (q4 == 0) { P[256] = mrun; P[257] = lrun; }
  __syncthreads();
}

__device__ __forceinline__ void phase_finalize(const Params& p, int l, int gw, int NGW, int lane) {
  bf16_t* PROJ = (bf16_t*)(p.ws + WS_PROJ);
  const bf16_t* HM = (const bf16_t*)(p.ws + WS_HM); const bf16_t* OG = (const bf16_t*)(p.ws + WS_OG);
  const float* mnw = p.in[18] + (size_t)l * 512; const float* gnw = p.in[22] + (size_t)l * 128;
  for (int r = gw; r < MROWS; r += NGW) {
    bf16_t* pr = PROJ + (size_t)r * PJ;
#pragma unroll
    for (int h = 0; h < 4; ++h) {
      { const unsigned hv = *(const unsigned*)(HM + (size_t)r * 512 + h * 128 + 2 * lane), ov = *(const unsigned*)(pr + PC_MO + h * 128 + 2 * lane), zv = *(const unsigned*)(pr + PC_ZM + h * 128 + 2 * lane);
        const float a0 = bflo(hv) * sigmoidf_(bflo(ov)), a1 = bfhi(hv) * sigmoidf_(bfhi(ov));
        const float rs = rsqrtf(wave_sum(a0 * a0 + a1 * a1) * (1.f / 128.f) + EPS);
        *(unsigned*)(pr + PC_ZM + h * 128 + 2 * lane) = cvtpk(a0 * rs * mnw[h * 128 + 2 * lane] * siluf_(bflo(zv)), a1 * rs * mnw[h * 128 + 2 * lane + 1] * siluf_(bfhi(zv))); }
      { const unsigned gv = *(const unsigned*)(OG + (size_t)r * 512 + h * 128 + 2 * lane), zv = *(const unsigned*)(pr + PC_ZG + h * 128 + 2 * lane);
        const float a0 = bflo(gv), a1 = bfhi(gv);
        const float rs = rsqrtf(wave_sum(a0 * a0 + a1 * a1) * (1.f / 128.f) + EPS);
        *(unsigned*)(pr + PC_ZG + h * 128 + 2 * lane) = cvtpk(a0 * rs * gnw[2 * lane] * siluf_(bflo(zv)), a1 * rs * gnw[2 * lane + 1] * siluf_(bfhi(zv))); }
    }
  }
  const float* WV = p.in[16] + (size_t)l * 256 * 512;
  for (int rr = gw; rr < DB * 128; rr += NGW) {
    const int b = rr >> 7, q = rr & 127, t = q >> 3, h = q & 7;
    const float* P = (const float*)(p.ws + WS_SAPART) + (size_t)(b * 8) * SA_PART + (size_t)q * 264;
    float M = -INFINITY;
#pragma unroll
    for (int g = 0; g < 8; ++g) M = fmaxf(M, P[(size_t)g * SA_PART + 256]);
    float L = 0.f; f32x4 o = {0.f, 0.f, 0.f, 0.f};
#pragma unroll
    for (int g = 0; g < 8; ++g) { const float sc = exp2f(P[(size_t)g * SA_PART + 256] - M); L += P[(size_t)g * SA_PART + 257] * sc; o += *(const f32x4*)(P + (size_t)g * SA_PART + 4 * lane) * sc; }
    o *= 1.f / L;
    float acc = 0.f;
    for (int r4 = 0; r4 < 64; ++r4) { const float x0 = __shfl(o.x, r4), x1 = __shfl(o.y, r4), x2 = __shfl(o.z, r4), x3 = __shfl(o.w, r4); const float* wr = WV + (size_t)(4 * r4) * 512 + h * 64 + lane;
      acc += x0 * wr[0] + x1 * wr[512] + x2 * wr[1024] + x3 * wr[1536]; }
    bf16_t* zp = PROJ + (size_t)(ROW_S + b * 16 + t) * PJ + PC_ZA + h * 64 + lane;
    *zp = f2bf(acc * siluf_(bf2f(*zp)));
  }
}

struct EpiOut {
  const float* xp; const float* xs; const float* xm; float* out; float* xmeta; int l;
  __device__ __forceinline__ void operator()(const f32x4 (&acc)[2][2][4][2], int tm, int pn, int wr, int wc, int fr, int fq) const {
#pragma unroll
    for (int ai = 0; ai < 2; ++ai)
#pragma unroll
      for (int m = 0; m < 4; ++m) {
        int fr_ = fr; asm volatile("" : "+v"(fr_) :: "memory");
        const int r = tm * 256 + ai * 128 + wr * 64 + m * 16 + fr_;
        if (r >= MROWS) continue;
        float* xo = r < ROW_S ? out + O_YP + (size_t)r * D : (r < ROW_M ? out + O_YS + (size_t)(r - ROW_S) * D : xmeta + (size_t)(r - ROW_M) * D);
        const float* xi = l == 0 ? (r < ROW_S ? xp + (size_t)r * D : (r < ROW_M ? xs + (size_t)(r - ROW_S) * D : xm + (size_t)(r - ROW_M) * D)) : xo;
#pragma unroll
        for (int bj = 0; bj < 2; ++bj) { const int col0 = pn * 256 + bj * 128 + wc * 32 + 8 * fq;
          const f32x4 a = *(const f32x4*)(xi + col0), b = *(const f32x4*)(xi + col0 + 4);
          *(f32x4*)(xo + col0) = a + acc[ai][bj][m][0]; *(f32x4*)(xo + col0 + 4) = b + acc[ai][bj][m][1]; }
      }
  }
};

__device__ __forceinline__ void phase_final_norm(const Params& p, int gw, int NGW, int lane) {
  const f32x4* wr = (const f32x4*)p.in[24] + lane;
  for (int r = gw; r < ROW_M; r += NGW) {
    f32x4* xr = (f32x4*)xrow_out(p, r) + lane; f32x4 v[4]; float s = 0.f;
#pragma unroll
    for (int j = 0; j < 4; ++j) { v[j] = xr[64 * j]; s += (v[j].x * v[j].x + v[j].y * v[j].y) + (v[j].z * v[j].z + v[j].w * v[j].w); }
    const float rstd = rsqrtf(wave_sum(s) * (1.f / D) + EPS);
#pragma unroll
    for (int j = 0; j < 4; ++j) xr[64 * j] = v[j] * rstd * wr[64 * j];
  }
}

#ifndef PROBE_LEVEL
#define PROBE_LEVEL 0
#endif
#ifndef NLAYERS_RUN
#define NLAYERS_RUN DEPTH
#endif
__device__ __forceinline__ void probe_report(const Params& p, int stage, float err) {
  int mag = 0; if (err > 0.f) { float lg = log10f(err) + 5.f; mag = lg < 0.f ? 0 : (lg > 9.f ? 9 : (int)lg); }
  p.out[0] = (float)(10 * stage + mag) * 1000.f;
}
__device__ __forceinline__ unsigned hash_u(unsigned x) { x ^= x >> 16; x *= 0x7feb352du; x ^= x >> 15; x *= 0x846ca68bu; x ^= x >> 16; return x; }
__device__ __forceinline__ float nerr(float got, float want, float scale) { return fabsf(got - want) / (0.03f * fabsf(want) + 0.03f * scale + 1e-6f); }

__device__ __forceinline__ void probe_checks(const Params& p, int l, long long gt) {
  unsigned* ctl = (unsigned*)(p.ws + WS_CTL);
  const bf16_t* PROJ = (const bf16_t*)(p.ws + WS_PROJ);
  const float* RSTD = (const float*)(p.ws + WS_RSTD);
  const float* ct = (const float*)(p.ws + WS_ROPE); const float* st = ct + ROPE_N * 16;
  const bf16_t* KV = (const bf16_t*)(p.ws + WS_KV);
  const bf16_t* QATT = (const bf16_t*)(p.ws + WS_QATT); const bf16_t* QMETA = (const bf16_t*)(p.ws + WS_QMETA); const bf16_t* QS = (const bf16_t*)(p.ws + WS_QS);
  if (gt < 2048) {
    unsigned hh = hash_u((unsigned)gt + 77u); int r = (int)(hh % MROWS); if ((gt & 7) == 0) r = ROW_M + (int)(hh % 16); if ((gt & 7) == 1) r = ROW_S + (int)(hh % 512);
    hh = hash_u(hh); const int h = (int)(hh % 8); hh = hash_u(hh); const int d = (int)(hh % 96);
    const RowInfo ri = row_info(r); const bf16_t* pr = PROJ + (size_t)r * PJ + PC_CQ;
    float ss = 0.f; for (int k = 0; k < 384; ++k) { const float c = bf2f(pr[k]); ss += c * c; }
    const float rs = rsqrtf(ss / 384.f + EPS);
    auto raw = [&](int dd) { float a = 0.f; for (int k = 0; k < 384; ++k) a += bf2f(pr[k]) * p.in[12][l * 384 + k] * p.in[13][((size_t)l * 384 + k) * 768 + h * 96 + dd]; return a * rs * QSCALE; };
    float want;
    if (d < 64) want = raw(d);
    else { const int i = (d - 64) & 15; const float x1 = raw(64 + i), x2 = raw(80 + i), c = ct[ri.pos * 16 + i], s = st[ri.pos * 16 + i]; want = d < 80 ? x1 * c - x2 * s : x2 * c + x1 * s; }
    float got;
    if (ri.kind == 0) got = bf2f(QATT[((size_t)(ri.b * 8 + h) * SEQ + ri.t) * 96 + d]);
    else if (ri.kind == 1) got = bf2f(QS[(size_t)(r - ROW_S) * 768 + h * 96 + d]);
    else got = bf2f(QMETA[((size_t)h * 256 + ri.t) * 96 + d]);
    atomicMax(ctl + 66, __float_as_uint(nerr(got, want, 0.15f)));
  } else if (gt < 4096) {
    unsigned hh = hash_u((unsigned)gt + 99u); int r = (int)(hh % NP); if ((gt & 7) == 0) r = ROW_M + (int)(hh % 16);
    hh = hash_u(hh); const int col = (int)(hh % 1024); hh = hash_u(hh); const int bsel = (int)(hh % 8);
    const RowInfo ri = row_info(r); const bf16_t* pr = PROJ + (size_t)r * PJ + PC_CKV;
    float a = 0.f; const float* W = (col < 512 ? p.in[15] : p.in[16]) + (size_t)l * 256 * 512 + (col & 511);
    for (int k = 0; k < 256; ++k) a += bf2f(pr[k]) * p.in[14][l * 256 + k] * W[(size_t)k * 512];
    a *= RSTD[2 * r + 1];
    const int h = (col & 511) >> 6, d0 = (col & 63) + (col >= 512 ? 96 : 0);
    const int b = ri.kind == 0 ? ri.b : bsel; const int krow = ri.kind == 0 ? 64 + ri.t : ri.t;
    const bf16_t* kvr = KV + ((size_t)(b * 8 + h) * KVROWS + krow) * 160;
    float e = nerr(bf2f(kvr[d0]), a, 0.2f);
    const int i = col & 31; const float* okr = p.out + O_PKR + (((size_t)l * NB + b) * NCACHE + (ri.kind == 0 ? NMETA + ri.t : ri.t)) * 32;
    e = fmaxf(e, nerr(bf2f(kvr[64 + i]), okr[i], 0.2f));
    atomicMax(ctl + 67, __float_as_uint(e));
  } else if (gt < 4096 + 1536) {
    unsigned hh = hash_u((unsigned)gt + 1234u); const bool meta = (gt & 15) == 0;
    const int b = (int)(hh % 8); hh = hash_u(hh); const int h = (int)(hh % 8); hh = hash_u(hh); int t = (int)(hh % SEQ); if ((gt & 3) == 1) t &= 255; if (meta) t &= 15; hh = hash_u(hh); const int dv = (int)(hh % 64);
    const bf16_t* q = meta ? QMETA + ((size_t)h * 256 + t) * 96 : QATT + ((size_t)(b * 8 + h) * SEQ + t) * 96;
    const bf16_t* kvb = KV + (size_t)(b * 8 + h) * KVROWS * 160;
    const int nown = meta ? 0 : 64 * (t / 64 + 1);
    float mx = -INFINITY, lsum = 0.f, osum = 0.f;
    for (int pass = 0; pass < 2; ++pass)
      for (int k = 0; k < 16 + nown; ++k) { const bf16_t* kr = kvb + (size_t)(k < 16 ? k : 64 + (k - 16)) * 160;
        float s = 0.f; for (int d = 0; d < 96; ++d) s += bf2f(q[d]) * bf2f(kr[d]);
        if (pass == 0) mx = fmaxf(mx, s); else { const float pe = exp2f(s - mx); lsum += pe; osum += pe * bf2f(kr[96 + dv]); } }
    const int r = meta ? ROW_M + t : b * SEQ + t;
    const bf16_t* xn = (const bf16_t*)(p.ws + WS_XN) + (size_t)r * 1024; const bf16_t* wz = (const bf16_t*)(p.ws + WS_WIN) + ((size_t)l * PJ + PC_ZA + h * 64 + dv) * 1024;
    float z = 0.f; for (int k = 0; k < 1024; ++k) z += bf2f(xn[k]) * bf2f(wz[k]);
    const float want = osum / lsum * siluf_(z);
    const float got = bf2f(PROJ[(size_t)r * PJ + PC_ZA + h * 64 + dv]);
    atomicMax(ctl + 68, __float_as_uint(nerr(got, want, 0.02f)));
  }
}


__device__ __forceinline__ int queue_next(unsigned* ctr, LAS unsigned char* lds, int tid) {
  LAS int* slot = (LAS int*)(lds + 147440);
  if (tid == 0) *slot = (int)atomicAdd(ctr, 1u);
  __syncthreads();
  const int v = *slot;
  __syncthreads();
  return v;
}

#define OPQ_TID() int tq = threadIdx.x; asm volatile("" : "+v"(tq)); const Params& pq = p; int bq = blockIdx.x; asm volatile("" : "+s"(bq)); const int lq = tq & 63; const int gwq = blockIdx.x * NWAVES + (tq >> 6); (void)lq; (void)gwq
template <int l>
__device__ __forceinline__ void run_layer(const Params& p, LAS unsigned char* lds, cg::grid_group& grid) {
  const int NGW = gridDim.x * NWAVES; const int G = gridDim.x, bx = blockIdx.x;
  bf16_t* PROJ = (bf16_t*)(p.ws + WS_PROJ);
  unsigned* ctl = (unsigned*)(p.ws + WS_CTL);

    {
      asm volatile("" ::: "memory");
      pg8::Gemm g{(const bf16_t*)(p.ws + WS_XN), (const bf16_t*)(p.ws + WS_WIN) + (size_t)l * PJ * 1024, 1024, 1024, 1024};
      OrderAll S; S.init(MPAD / 256, PJ / 256, G, bx);
      EpiProj E{PROJ, PJ};
      pg8::gemm_phase(lds, g, S, E);
    }
    grid.sync();
    { OPQ_TID(); phase_rowpass(pq, l, gwq, NGW, lq);
      for (int u = bq; u < 2 * NSLOT; u += G) { if (u & 1) gdn_prep(lds, pq, l, u >> 1, tq); else mlstm_prep(lds, pq, l, u >> 1, tq); } }
    grid.sync();
    {
      const float* rstd = (const float*)(p.ws + WS_RSTD); const float* ct = (const float*)(p.ws + WS_ROPE);
      { pg8::Gemm g{PROJ + PC_CQ, (const bf16_t*)(p.ws + WS_WUQ) + (size_t)l * 768 * 384, PJ, 384, 384};
        OrderAll S; S.init(MPAD / 256, 3, G, bx);
        EpiQ E{rstd, ct, ct + ROPE_N * 16, (bf16_t*)(p.ws + WS_QATT), (bf16_t*)(p.ws + WS_QMETA), (bf16_t*)(p.ws + WS_QS)};
        pg8::gemm_phase(lds, g, S, E); }
      { pg8::Gemm g{PROJ + PC_CKV, (const bf16_t*)(p.ws + WS_WUKV) + (size_t)l * 1024 * 256, PJ, 256, 256};
        OrderKV S; S.init(129, 4, G, (bx + 137) % G);
        EpiKV E{rstd, (bf16_t*)(p.ws + WS_KV)};
        pg8::gemm_phase(lds, g, S, E); }
    }
    grid.sync();
    {
      OPQ_TID();
      if (bq < 32) { for (int k = 0; k < 5; ++k) scan_chain<false>(lds, pq, l, k == 0 ? bq : 32 + bq * 4 + k - 1, tq); }
      else if (bq < 64) { for (int k = 0; k < 5; ++k) scan_chain<true>(lds, pq, l, k == 0 ? bq - 32 : 32 + (bq - 32) * 4 + k - 1, tq); }
      else { for (int u = bq - 64; u < 256; u += G - 64) sattn_unit(lds, pq, l, u >> 3, u & 7, tq); }
      for (;;) {
        const int idx = queue_next(ctl + 8 + l, lds, tq);
        if (idx >= 1024 + 8) break;
        AttnUnit u;
        if (idx < 1024) { const int qb = 15 - (idx >> 6), bh = idx & 63;
          u.q = (const bf16_t*)(p.ws + WS_QATT) + ((size_t)bh * SEQ + 256 * qb) * 96; u.kv = (const bf16_t*)(p.ws + WS_KV) + (size_t)bh * KVROWS * 160;
          u.chunk0 = 4 * qb; u.ntiles = 4 * qb + 5; u.nq_valid = 256; u.out_row0 = (bh >> 3) * SEQ + 256 * qb; u.h = bh & 7; u.is_meta = 0; }
        else { const int h = idx - 1024;
          u.q = (const bf16_t*)(p.ws + WS_QMETA) + (size_t)h * 256 * 96; u.kv = (const bf16_t*)(p.ws + WS_KV) + (size_t)h * KVROWS * 160;
          u.chunk0 = 0; u.ntiles = 1; u.nq_valid = 16; u.out_row0 = ROW_M; u.h = h; u.is_meta = 1; }
        attn_unit(lds, u, PROJ, tq);
      }
    }
    grid.sync();
#if PROBE_LEVEL == 1
    if (l == 0) {
      probe_checks(p, l, (long long)bx * NTHREADS + tid);
      grid.sync();
      if (bx == 0 && tid == 0) {
        int stage = 9; float e = 0.f;
        for (int s = 8; s >= 2; --s) { const float es = __uint_as_float(ctl[64 + s]); if (es > 1.f) { stage = s; e = es; } }
        if (stage == 9) for (int s = 2; s <= 8; ++s) e = fmaxf(e, __uint_as_float(ctl[64 + s]));
        probe_report(p, stage, e); }
      return;
    }
#endif
    { OPQ_TID(); phase_finalize(pq, l, gwq, NGW, lq); }
    grid.sync();
    {
      pg8::Gemm g{PROJ + PC_ZA, (const bf16_t*)(p.ws + WS_WOUT) + (size_t)l * D * DMIX, PJ, DMIX, DMIX};
      OrderAll S; S.init(MPAD / 256, 4, G, bx);
      EpiOut E{p.in[0], p.in[1], p.in[9], p.out, (float*)(p.ws + WS_XMETA), l};
      pg8::gemm_phase(lds, g, S, E);
    }
    grid.sync();
    { OPQ_TID(); if (l + 1 < DEPTH) phase_norm_rows(pq, l + 1, gwq, NGW, lq); else phase_final_norm(pq, gwq, NGW, lq); }
    if (l + 1 < DEPTH) grid.sync();

}

__global__ void __launch_bounds__(NTHREADS, 2) mk_fwd(Params p) {
  extern __shared__ __attribute__((aligned(16))) unsigned char lds_raw[];
  LAS unsigned char* lds = (LAS unsigned char*)lds_raw;
  cg::grid_group grid = cg::this_grid();
  const int tid = threadIdx.x;
  const int lane = tid & 63, wave = tid >> 6;
  const int gw = blockIdx.x * NWAVES + wave, NGW = gridDim.x * NWAVES;
  const int G = gridDim.x, bx = blockIdx.x;
  bf16_t* PROJ = (bf16_t*)(p.ws + WS_PROJ);
  unsigned* ctl = (unsigned*)(p.ws + WS_CTL);

  phase0(p, lds, tid);
  grid.sync();
  run_layer<0>(p, lds, grid);
  if (NLAYERS_RUN > 1) run_layer<1>(p, lds, grid);
}

extern "C" void kernel_launch(void* const* d_in, const int* in_sizes, int n_in, void* d_out, int out_size,
                              void* d_ws, size_t ws_size, hipStream_t stream) {
  constexpr int LDS_BYTES = 144 * 1024;
  static int grid_blocks = 0;
  if (!grid_blocks) {
    int dev = 0, cus = 0, per_cu = 0;
    (void)hipGetDevice(&dev);
    (void)hipDeviceGetAttribute(&cus, hipDeviceAttributeMultiprocessorCount, dev);
    (void)hipFuncSetAttribute((const void*)mk_fwd, hipFuncAttributeMaxDynamicSharedMemorySize, LDS_BYTES);
    (void)hipOccupancyMaxActiveBlocksPerMultiprocessor(&per_cu, (const void*)mk_fwd, NTHREADS, LDS_BYTES);
    if (per_cu < 1) per_cu = 1;
    grid_blocks = cus * 1;
    if (n_in != 25 || (long long)out_size != O_END || ws_size < WS_END2) { fprintf(stderr, "kernel_launch: unexpected sizes n_in=%d out=%d ws=%zu (need %zu)\n", n_in, out_size, ws_size, (size_t)WS_END2); grid_blocks = -1; }
  }
  if (grid_blocks < 0) return;
  Params p{};
  for (int i = 0; i < 25; ++i) p.in[i] = (const float*)d_in[i];
  p.out = (float*)d_out; p.ws = (unsigned char*)d_ws; p.ph_lo = 0; p.ph_hi = 100; p.probe = 0; p.pad = 0;
  void* args[] = {&p};
  hipError_t e = hipLaunchCooperativeKernel((const void*)mk_fwd, dim3(grid_blocks), dim3(NTHREADS), args, LDS_BYTES, stream);
  if (e != hipSuccess) fprintf(stderr, "cooperative launch failed: %s (grid %d)\n", hipGetErrorString(e), grid_blocks);
}
```

```cpp
#define PROBE_LEVEL 0
#include <hip/hip_runtime.h>
#include <hip/hip_cooperative_groups.h>
#include <cstdio>
#include <cstdint>
namespace cg = cooperative_groups;

#define LAS __attribute__((address_space(3)))
typedef unsigned short bf16_t;
typedef short bf16x8 __attribute__((ext_vector_type(8)));
typedef short s16x4 __attribute__((ext_vector_type(4)));
typedef float f32x4 __attribute__((ext_vector_type(4)));
typedef float f32x2 __attribute__((ext_vector_type(2)));
typedef float f32x16 __attribute__((ext_vector_type(16)));
typedef unsigned u32x4 __attribute__((ext_vector_type(4)));
typedef unsigned u32x2 __attribute__((ext_vector_type(2)));
typedef __bf16 bf16x2_t __attribute__((ext_vector_type(2)));

__device__ __forceinline__ unsigned cvtpk(float lo, float hi) { f32x2 v = {lo, hi}; bf16x2_t b = __builtin_convertvector(v, bf16x2_t); return __builtin_bit_cast(unsigned, b); }
__device__ __forceinline__ bf16_t f2bf(float x) { return (bf16_t)(cvtpk(x, 0.f) & 0xffffu); }
__device__ __forceinline__ float bf2f(bf16_t x) { return __uint_as_float(((unsigned)x) << 16); }
__device__ __forceinline__ float bflo(unsigned w) { return __uint_as_float(w << 16); }
__device__ __forceinline__ float bfhi(unsigned w) { return __uint_as_float(w & 0xffff0000u); }

constexpr int D = 1024, NB = 8, SEQ = 4096, DEPTH = 2, DB = 32, DS = 16, NMETA = 16, NCACHE = 4112;
constexpr int NP = NB * SEQ;
constexpr int NS = DB * DS;
constexpr int ROW_S = NP, ROW_M = NP + NS, MROWS = ROW_M + NMETA, MPAD = 33536;
constexpr int INC = 5808;
constexpr int PJ = 5888;
constexpr int PJR = 2816;
constexpr int RC_MO = 704, RC_ZA = 1216, RC_ZM = 1728, RC_ZG = 2240;
constexpr int PC_CKV = 0, PC_CQ = 256, PC_KR = 640, PC_G16 = 672, PC_MQ = 704, PC_MK = 1216, PC_MV = 1728, PC_MO = 2240,
              PC_GQ = 2752, PC_GK = 3264, PC_GV = 3776, PC_ZA = 4288, PC_ZM = 4800, PC_ZG = 5312, PC_END = 5824;
constexpr int DMIX = 1536;
constexpr int NTHREADS = 512, NWAVES = 8;
constexpr float EPS = 1e-6f;
constexpr float QSCALE = 0.10206207261596575f * 1.4426950408889634f;

constexpr long long O_YP = 0;
constexpr long long O_YS = O_YP + (long long)NB * SEQ * D;
constexpr long long O_PLAT = O_YS + (long long)DB * DS * D;
constexpr long long O_PKR = O_PLAT + (long long)DEPTH * NB * NCACHE * 256;
constexpr long long O_PC = O_PKR + (long long)DEPTH * NB * NCACHE * 32;
constexpr long long O_PN = O_PC + (long long)DEPTH * NB * 4 * 128 * 128;
constexpr long long O_PM = O_PN + (long long)DEPTH * NB * 4 * 128;
constexpr long long O_PS = O_PM + (long long)DEPTH * NB * 4;
constexpr long long O_PCONV = O_PS + (long long)DEPTH * NB * 4 * 128 * 128;
constexpr long long O_SLAT = O_PCONV + (long long)DEPTH * NB * 3 * 1536;
constexpr long long O_SKR = O_SLAT + (long long)DEPTH * DB * DS * 256;
constexpr long long O_SC = O_SKR + (long long)DEPTH * DB * DS * 32;
constexpr long long O_SN = O_SC + (long long)DEPTH * DB * 4 * 128 * 128;
constexpr long long O_SM = O_SN + (long long)DEPTH * DB * 4 * 128;
constexpr long long O_SS = O_SM + (long long)DEPTH * DB * 4;
constexpr long long O_SCONV = O_SS + (long long)DEPTH * DB * 4 * 128 * 128;
constexpr long long O_END = O_SCONV + (long long)DEPTH * DB * 3 * 1536;

constexpr size_t al256(size_t x) { return (x + 255) & ~(size_t)255; }
constexpr size_t WS_CTL = 0;
constexpr size_t WS_BAR = 16384;
constexpr size_t WS_ZERO = WS_BAR + 14336;
constexpr size_t WS_ROPE = 32768;
constexpr size_t ROPE_N = 4160;
constexpr size_t WS_WIN = al256(WS_ROPE + ROPE_N * 16 * 4 * 2);
constexpr size_t WS_WUQ = al256(WS_WIN + (size_t)2 * PJ * 1024 * 2);
constexpr size_t WS_WUKV = al256(WS_WUQ + (size_t)2 * 768 * 384 * 2);
constexpr size_t WS_WOUT = al256(WS_WUKV + (size_t)2 * 1024 * 256 * 2);
constexpr size_t WS_WUKR = al256(WS_WOUT + (size_t)2 * 1024 * 1536 * 2);
constexpr size_t WS_WUVT = al256(WS_WUKR + (size_t)2 * 256 * 512 * 2);
constexpr size_t WS_XMETA = al256(WS_WUVT + (size_t)2 * 512 * 256 * 2);
constexpr size_t WS_RSTD = al256(WS_XMETA + 16 * 1024 * 4);
constexpr size_t SEG_B = (size_t)MPAD * 512 * 2;
constexpr size_t WS_OA = al256(WS_RSTD + (size_t)MPAD * 2 * 4);
constexpr size_t WS_XN = WS_OA + SEG_B;
constexpr size_t WS_PROJ = al256(WS_XN + (size_t)MPAD * 1024 * 2);
constexpr size_t WS_PROJH = WS_PROJ + (size_t)MPAD * PJR * 2;
constexpr size_t PH_T = (size_t)MPAD * 128;
constexpr size_t WS_GATES = al256(WS_PROJ + (size_t)MPAD * PJ * 2);
constexpr size_t WS_QATT = al256(WS_GATES + (size_t)MPAD * 16 * 4);
constexpr size_t WS_QMETA = al256(WS_QATT + (size_t)NB * 8 * SEQ * 96 * 2);
constexpr size_t WS_QS = al256(WS_QMETA + (size_t)8 * 256 * 96 * 2);
constexpr int KVROWS = 64 + SEQ;
constexpr size_t WS_KV = al256(WS_QS + (size_t)NS * 768 * 2);
constexpr size_t WS_END0 = al256(WS_KV + (size_t)NB * 8 * KVROWS * 160 * 2);

struct Params {
  const float* in[25];
  float* out;
  unsigned char* ws;
  int ph_lo, ph_hi;
  int probe, pad;
};

__device__ __forceinline__ float wave_sum(float v) {
#pragma unroll
  for (int o = 1; o < 64; o <<= 1) v += __shfl_xor(v, o);
  return v;
}
__device__ __forceinline__ float sigmoidf_(float x) { return __builtin_amdgcn_rcpf(1.f + __builtin_amdgcn_exp2f(-1.4426950408889634f * x)); }
__device__ __forceinline__ float siluf_(float x) { return x * __builtin_amdgcn_rcpf(1.f + __builtin_amdgcn_exp2f(-1.4426950408889634f * x)); }

__device__ __forceinline__ int orig_col(int pc, float& sc) {
  sc = 1.f;
  if (pc < 256) return 384 + pc;
  if (pc < 640) return pc - 256;
  if (pc < 672) return pc;
  if (pc < 688) { int g = pc - 672; return g < 8 ? 2720 + g : 5288 + (g - 8); }
  if (pc < 704) return -1;
  if (pc < 1216) return 1184 + (pc - 704);
  if (pc < 1728) { sc = 0.08838834764831845f; return 1696 + (pc - 1216); }
  if (pc < 2240) return 2208 + (pc - 1728);
  if (pc < 2752) return 2728 + (pc - 2240);
  if (pc < 4288) return 3752 + (pc - 2752);
  if (pc < 4800) return 672 + (pc - 4288);
  if (pc < 5312) return 3240 + (pc - 4800);
  if (pc < 5824) return 5296 + (pc - 5312);
  return -1;
}

template <class F>
__device__ __forceinline__ void transpose_item(F src, int K, bf16_t* WT, LAS float* scr, int kb, int nb, int lane) {
  const int k0 = 64 * kb, n0 = 32 * nb;
#pragma unroll 16
  for (int i = 0; i < 32; ++i) { const int kk = 2 * i + (lane >> 5); scr[kk * 33 + (lane & 31)] = src(k0 + kk, n0 + (lane & 31)); }
  asm volatile("s_waitcnt lgkmcnt(0)" ::: "memory");
  const int c = lane & 7;
#pragma unroll
  for (int j = 0; j < 4; ++j) {
    const int n = (lane >> 3) + 8 * j; const LAS float* s = scr + (8 * c) * 33 + n;
    u32x4 o; o.x = cvtpk(s[0 * 33], s[1 * 33]); o.y = cvtpk(s[2 * 33], s[3 * 33]); o.z = cvtpk(s[4 * 33], s[5 * 33]); o.w = cvtpk(s[6 * 33], s[7 * 33]);
    *(u32x4*)(WT + (size_t)(n0 + n) * K + k0 + 8 * c) = o;
  }
  asm volatile("s_waitcnt lgkmcnt(0)" ::: "memory");
}

template <class F4>
__device__ __forceinline__ void transpose_item4(F4 src4, int K, bf16_t* WT, LAS float* scr  , int kb, int nb, int lane) {
  const int k0 = 32 * kb, n0 = 128 * nb;
  f32x4 v[16];
#pragma unroll
  for (int i = 0; i < 16; ++i) v[i] = src4(k0 + 2 * i + (lane >> 5), n0 + 4 * (lane & 31));
#pragma unroll
  for (int i = 0; i < 16; ++i) *(LAS f32x4*)(scr + (2 * i + (lane >> 5)) * 132 + 4 * (lane & 31)) = v[i];
  asm volatile("s_waitcnt lgkmcnt(0)" ::: "memory");
  const int c = lane & 3;
#pragma unroll
  for (int j = 0; j < 8; ++j) {
    const int n = (lane >> 2) + 16 * j; const LAS float* s = scr + (8 * c) * 132 + n;
    u32x4 o; o.x = cvtpk(s[0 * 132], s[1 * 132]); o.y = cvtpk(s[2 * 132], s[3 * 132]); o.z = cvtpk(s[4 * 132], s[5 * 132]); o.w = cvtpk(s[6 * 132], s[7 * 132]);
    *(u32x4*)(WT + (size_t)(n0 + n) * K + k0 + 8 * c) = o;
  }
  asm volatile("s_waitcnt lgkmcnt(0)" ::: "memory");
}

__device__ __forceinline__ void rms_row_to_bf16(const float* xrow, const float* w, bf16_t* orow, int lane) {
  const f32x4* xr = (const f32x4*)xrow + lane; const f32x4* wr = (const f32x4*)w + lane;
  f32x4 v[4]; float s = 0.f;
#pragma unroll
  for (int j = 0; j < 4; ++j) { v[j] = xr[64 * j]; s += (v[j].x * v[j].x + v[j].y * v[j].y) + (v[j].z * v[j].z + v[j].w * v[j].w); }
  const float rstd = rsqrtf(wave_sum(s) * (1.f / D) + EPS);
  unsigned long long* o8 = (unsigned long long*)orow + lane;
#pragma unroll
  for (int j = 0; j < 4; ++j) { const f32x4 ww = wr[64 * j];
    o8[64 * j] = (unsigned long long)cvtpk(v[j].x * rstd * ww.x, v[j].y * rstd * ww.y) | ((unsigned long long)cvtpk(v[j].z * rstd * ww.z, v[j].w * rstd * ww.w) << 32); }
}

__device__ __forceinline__ const float* xrow_in(const Params& p, int l, int r) {
  if (l == 0) {
    if (r < ROW_S) return p.in[0] + (size_t)r * D;
    if (r < ROW_M) return p.in[1] + (size_t)(r - ROW_S) * D;
    return p.in[9] + (size_t)(r - ROW_M) * D;
  }
  if (r < ROW_S) return p.out + O_YP + (size_t)r * D;
  if (r < ROW_M) return p.out + O_YS + (size_t)(r - ROW_S) * D;
  return (const float*)(p.ws + WS_XMETA) + (size_t)(r - ROW_M) * D;
}
__device__ __forceinline__ float* xrow_out(const Params& p, int r) {
  if (r < ROW_S) return p.out + O_YP + (size_t)r * D;
  if (r < ROW_M) return p.out + O_YS + (size_t)(r - ROW_S) * D;
  return (float*)(p.ws + WS_XMETA) + (size_t)(r - ROW_M) * D;
}

__device__ __forceinline__ void phase_norm_rows(const Params& p, int l, int gw, int NGW, int lane, int rbeg = 0, int rend = MPAD) {
  bf16_t* XN = (bf16_t*)(p.ws + WS_XN);
  const f32x4* wr = (const f32x4*)(p.in[10] + (size_t)l * D) + lane;
  for (int r0 = rbeg + 4 * gw; r0 < rend; r0 += 4 * NGW) {
    f32x4 v[4][4]; float s[4];
#pragma unroll
    for (int i = 0; i < 4; ++i) { const int r = r0 + i;
      if (r < MROWS) { const f32x4* xr = (const f32x4*)xrow_in(p, l, r) + lane;
#pragma unroll
        for (int j = 0; j < 4; ++j) v[i][j] = xr[64 * j]; }
      else {
#pragma unroll
        for (int j = 0; j < 4; ++j) v[i][j] = (f32x4){0.f, 0.f, 0.f, 0.f}; } }
#pragma unroll
    for (int i = 0; i < 4; ++i) { s[i] = 0.f;
#pragma unroll
      for (int j = 0; j < 4; ++j) s[i] += (v[i][j].x * v[i][j].x + v[i][j].y * v[i][j].y) + (v[i][j].z * v[i][j].z + v[i][j].w * v[i][j].w); }
#pragma unroll
    for (int o = 1; o < 64; o <<= 1)
#pragma unroll
      for (int i = 0; i < 4; ++i) s[i] += __shfl_xor(s[i], o);
#pragma unroll
    for (int i = 0; i < 4; ++i) { const float rstd = rsqrtf(s[i] * (1.f / D) + EPS); unsigned long long* o8 = (unsigned long long*)(XN + (size_t)(r0 + i) * D) + lane;
#pragma unroll
      for (int j = 0; j < 4; ++j) { const f32x4 ww = wr[64 * j];
        o8[64 * j] = (unsigned long long)cvtpk(v[i][j].x * rstd * ww.x, v[i][j].y * rstd * ww.y) | ((unsigned long long)cvtpk(v[i][j].z * rstd * ww.z, v[i][j].w * rstd * ww.w) << 32); } }
  }
}

__device__ __forceinline__ void phase0(const Params& p, LAS unsigned char* lds, int tid) {
  const int lane = tid & 63, wave = tid >> 6;
  const int gw = blockIdx.x * NWAVES + wave, NGW = gridDim.x * NWAVES;
  LAS float* scr = (LAS float*)(lds + wave * 16896);
  if (blockIdx.x == 0 && tid < 1024 / 4) ((unsigned*)(p.ws + WS_CTL))[tid] = 0u;
  constexpr int I_WIN = 32 * (PJ / 128), I_WUQ = 12 * 6, I_WUKV = 8 * 8, I_WOUT = 48 * 8, I_WUVT = 8 * 4;
  constexpr int I_L = I_WIN + I_WUQ + I_WUKV + I_WOUT + I_WUVT, I_ALL = 2 * I_L;
  for (int it = gw; it < I_ALL; it += NGW) {
    const int l = it / I_L; int r = it % I_L;
    if (r < I_WIN) {
      const float* W = p.in[11] + (size_t)l * D * INC;
      transpose_item4([&](int k, int n) { float sc; const int oc = orig_col(n, sc); f32x4 v = {0.f, 0.f, 0.f, 0.f}; if (oc >= 0) { v = *(const f32x4*)(W + (size_t)k * INC + oc); v *= sc; } return v; },
                      1024, (bf16_t*)(p.ws + WS_WIN) + (size_t)l * PJ * 1024, scr, r % 32, r / 32, lane);
      continue; }
    r -= I_WIN;
    if (r < I_WUQ) {
      const float* W = p.in[13] + (size_t)l * 384 * 768; const float* qn = p.in[12] + (size_t)l * 384;
      transpose_item4([&](int k, int n) { f32x4 v = *(const f32x4*)(W + (size_t)k * 768 + n); v *= qn[k] * QSCALE; return v; }, 384, (bf16_t*)(p.ws + WS_WUQ) + (size_t)l * 768 * 384, scr, r % 12, r / 12, lane);
      continue; }
    r -= I_WUQ;
    if (r < I_WUKV) {
      const float* Wk = p.in[15] + (size_t)l * 256 * 512; const float* Wv = p.in[16] + (size_t)l * 256 * 512; const float* kn = p.in[14] + (size_t)l * 256;
      transpose_item4([&](int k, int n) { f32x4 v = n < 512 ? *(const f32x4*)(Wk + (size_t)k * 512 + n) : *(const f32x4*)(Wv + (size_t)k * 512 + n - 512); v *= kn[k]; return v; }, 256, (bf16_t*)(p.ws + WS_WUKV) + (size_t)l * 1024 * 256, scr, r % 8, r / 8, lane);
      continue; }
    r -= I_WUKV;
    if (r < I_WOUT) {
      const float* W = p.in[23] + (size_t)l * DMIX * D;
      transpose_item4([&](int k, int n) { return *(const f32x4*)(W + (size_t)k * D + n); }, DMIX, (bf16_t*)(p.ws + WS_WOUT) + (size_t)l * D * DMIX, scr, r % 48, r / 48, lane);
      continue; }
    r -= I_WOUT;
    { const float* Wv = p.in[16] + (size_t)l * 256 * 512;
      transpose_item4([&](int k, int n) { return *(const f32x4*)(Wv + (size_t)k * 512 + n); }, 256, (bf16_t*)(p.ws + WS_WUVT) + (size_t)l * 512 * 256, scr, r % 8, r / 8, lane); }
  }
  const long long gt = (long long)blockIdx.x * NTHREADS + tid, GT = (long long)gridDim.x * NTHREADS;
  { bf16_t* o = (bf16_t*)(p.ws + WS_WUKR); const float* W = p.in[15];
    for (long long i = gt; i < 2LL * 256 * 512; i += GT) o[i] = f2bf(W[i]); }
  { float* ct = (float*)(p.ws + WS_ROPE); float* st = ct + ROPE_N * 16;
    for (long long i = gt; i < (long long)ROPE_N * 16; i += GT) {
      const int pos = (int)(i >> 4), k = (int)(i & 15);
      const float freq = powf(10000.f, -(float)k / 16.f); const float ang = (float)pos * freq;
      float s, c; sincosf(ang, &s, &c); ct[i] = c; st[i] = s; } }
  phase_norm_rows(p, 0, gw, NGW, lane);
}

namespace pg8 {
constexpr int BM = 256, BK = 64, HALF = 128, HTB = HALF * BK * 2, STAGE_BYTES = 8 * HTB, NXCD = 8, WGM = 8;
__device__ __forceinline__ int lds_byte(int r, int c) { const int st = (r >> 4) * 2 + (c >> 5), rr = r & 15, cc = c & 31, ob = rr * 64 + cc * 2; return st * 1024 + (ob ^ (((ob >> 9) & 1) << 5)); }
__device__ __forceinline__ void stage_rc(int b, int& R, int& C) { const int st = b / 1024, sb = b % 1024, swz = sb ^ (((sb >> 9) & 1) << 5); R = (st >> 1) * 16 + swz / 64; C = (st & 1) * 32 + (swz % 64) / 2; }
__device__ __forceinline__ int perm32(int rho) { const int n = rho >> 4, i = rho & 15; return 8 * (i >> 2) + 4 * n + (i & 3); }
struct Unit { int pm, pn; };
struct Gemm { const bf16_t* A; const bf16_t* Bt; int lda, ldb, K; int kseg; size_t segstride; };
struct StaticOrder {
  int nM, nN, nwg, G, c;
  __device__ void init(int nM_, int nN_, int G_, int c_) { nM = nM_; nN = nN_; nwg = nM * nN; G = G_; c = c_; }
  __device__ bool next(int i, Unit& u) const {
    const long L = (long)i * G + c; if (L >= nwg) return false;
    int wgid = (int)L; { const int q = nwg / NXCD, r = nwg % NXCD, xcd = wgid % NXCD, off = wgid / NXCD; wgid = (xcd < r ? xcd * (q + 1) : r * (q + 1) + (xcd - r) * q) + off; }
    const int nig = WGM * nN, gid = wgid / nig, fm = gid * WGM, gsz = (nM - fm) < WGM ? (nM - fm) : WGM;
    u.pm = fm + ((wgid % nig) % gsz); u.pn = (wgid % nig) / gsz; return true;
  }
};
template <class Epi, class Sched>
__device__ __forceinline__ void gemm_phase(LAS unsigned char* lds, const Gemm g, const Sched& S, const Epi& E) {
  int tid = threadIdx.x; asm volatile("" : "+v"(tid)); const int wid = __builtin_amdgcn_readfirstlane(tid >> 6), lane = tid & 63, wr = wid >> 2, wc = wid & 3, fr = lane & 15, fq = lane >> 4;
  const int nt = g.K / BK;
  unsigned voffA[2], voffB[2];
#pragma unroll
  for (int i = 0; i < 2; ++i) { int R, C; stage_rc(tid * 16 + i * 8192, R, C); const int Rb = (R & ~31) + perm32(R & 31);
    voffA[i] = (unsigned)(R * g.lda + C) * 2u; voffB[i] = (unsigned)(Rb * g.ldb + C) * 2u; }
  const size_t kstep = (size_t)(BK * 2);
  const size_t hstepA = (size_t)HALF * g.lda * 2, hstepB = (size_t)HALF * g.ldb * 2;
  const size_t tstepA = 2 * hstepA, tstepB = 2 * hstepB;
  const unsigned ldsw = (unsigned)wid * 1024u;
  const int aoff = lds_byte(wr * 64 + fr, fq * 8), boff = lds_byte(wc * 32 + fr, fq * 8);
#define PG8_SA(b, h) (((b) * 2 + (h)) * HTB)
#define PG8_SB(b, h) ((4 + (b) * 2 + (h)) * HTB)
#define PG8_STAGE(bufoff, gbase, voff) do { _Pragma("unroll") for (int _i = 0; _i < 2; ++_i) \
    __builtin_amdgcn_global_load_lds((const unsigned*)((const char*)(gbase) + (voff)[_i]), (LAS unsigned*)(lds + (bufoff) + ldsw + _i * 8192), 16, 0, 0); } while (0)
#define PG8_LDA(dst, b, h) do { _Pragma("unroll") for (int m = 0; m < 4; ++m) _Pragma("unroll") for (int k = 0; k < 2; ++k) dst[m][k] = *(const LAS bf16x8*)(lds + PG8_SA(b, h) + aoff + m * 2048 + k * 1024); } while (0)
#define PG8_LDB(dst, b, h) do { _Pragma("unroll") for (int n = 0; n < 2; ++n) _Pragma("unroll") for (int k = 0; k < 2; ++k) dst[n][k] = *(const LAS bf16x8*)(lds + PG8_SB(b, h) + boff + n * 2048 + k * 1024); } while (0)
#define PG8_MMA(ai, bj, At, Bt) do { __builtin_amdgcn_s_setprio(1); _Pragma("unroll") for (int m = 0; m < 4; ++m) _Pragma("unroll") for (int n = 0; n < 2; ++n) _Pragma("unroll") for (int k = 0; k < 2; ++k) \
    acc[ai][bj][m][n] = __builtin_amdgcn_mfma_f32_16x16x32_bf16(Bt[n][k], At[m][k], acc[ai][bj][m][n], 0, 0, 0); __builtin_amdgcn_s_setprio(0); } while (0)
#define PG8_WAIT_V(n) asm volatile("s_waitcnt vmcnt(" #n ")" ::: "memory")
#define PG8_WAIT_L(n) asm volatile("s_waitcnt lgkmcnt(" #n ")" ::: "memory")
#define PG8_BAR __builtin_amdgcn_s_barrier()
#define PG8_SCHED __builtin_amdgcn_sched_barrier(0)
  Unit cur, nxt; int ui = 0;
  if (!S.next(0, cur)) return;
  f32x4 acc[2][2][4][2];
#pragma unroll
  for (int a = 0; a < 2; ++a)
#pragma unroll
    for (int b = 0; b < 2; ++b)
#pragma unroll
      for (int m = 0; m < 4; ++m)
#pragma unroll
        for (int n = 0; n < 2; ++n) acc[a][b][m][n] = (f32x4){0.f, 0.f, 0.f, 0.f};
  bf16x8 At[4][2], B0[2][2], B1[2][2];
  const char* cA = (const char*)g.A + (size_t)S.tile_m(cur.pm) * tstepA; const char* cB = (const char*)g.Bt + (size_t)cur.pn * tstepB;
  PG8_STAGE(PG8_SB(0, 0), cB, voffB); PG8_STAGE(PG8_SB(0, 1), cB + hstepB, voffB); PG8_STAGE(PG8_SA(0, 0), cA, voffA); PG8_STAGE(PG8_SA(0, 1), cA + hstepA, voffA);
  if (wr == 1) PG8_BAR;
  PG8_WAIT_V(2); PG8_BAR;
  PG8_STAGE(PG8_SB(1, 0), cB + kstep, voffB); PG8_STAGE(PG8_SA(1, 0), cA + kstep, voffA); PG8_STAGE(PG8_SB(1, 1), cB + hstepB + kstep, voffB);
  PG8_WAIT_V(6); PG8_BAR;
  for (;;) {
    const bool has_next = S.next(ui + 1, nxt);
    const char* nA = has_next ? (const char*)g.A + (size_t)S.tile_m(nxt.pm) * tstepA : cA; const char* nB = has_next ? (const char*)g.Bt + (size_t)nxt.pn * tstepB : cB;
#pragma unroll 1
    for (int t = 0; t < nt; t += 2) {
      const bool last = (t == nt - 2);
      const int sg1 = t / g.kseg, sg2 = (t + 2) / g.kseg;
      const char* a1 = cA + (size_t)sg1 * g.segstride + (size_t)(t + 1 - sg1 * g.kseg) * kstep;
      const char* a2 = last ? nA : cA + (size_t)sg2 * g.segstride + (size_t)(t + 2 - sg2 * g.kseg) * kstep; const char* b2 = last ? nB : cB + (size_t)(t + 2) * kstep;
      const char* a3 = a2 + kstep; const char* b3 = b2 + kstep;
      PG8_LDB(B0, 0, 0); PG8_LDB(B1, 0, 1); PG8_SCHED; PG8_LDA(At, 0, 0); PG8_STAGE(PG8_SA(1, 1), a1 + hstepA, voffA);
      PG8_WAIT_V(8); PG8_WAIT_L(0); PG8_BAR; PG8_MMA(0, 0, At, B0); PG8_MMA(0, 1, At, B1); PG8_BAR; PG8_SCHED;
      PG8_LDA(At, 0, 1); PG8_STAGE(PG8_SB(0, 0), b2, voffB); PG8_STAGE(PG8_SB(0, 1), b2 + hstepB, voffB); PG8_STAGE(PG8_SA(0, 0), a2, voffA);
      PG8_WAIT_V(8); PG8_WAIT_L(0); PG8_BAR; PG8_MMA(1, 0, At, B0); PG8_MMA(1, 1, At, B1); PG8_BAR; PG8_SCHED;
      PG8_LDB(B0, 1, 0); PG8_LDB(B1, 1, 1); PG8_SCHED; PG8_LDA(At, 1, 0); PG8_STAGE(PG8_SA(0, 1), a2 + hstepA, voffA);
      PG8_WAIT_V(8); PG8_WAIT_L(0); PG8_BAR; PG8_MMA(0, 0, At, B0); PG8_MMA(0, 1, At, B1); PG8_BAR; PG8_SCHED;
      PG8_LDA(At, 1, 1); PG8_STAGE(PG8_SB(1, 0), b3, voffB); PG8_STAGE(PG8_SB(1, 1), b3 + hstepB, voffB); PG8_STAGE(PG8_SA(1, 0), a3, voffA);
      PG8_WAIT_V(8); PG8_WAIT_L(0); PG8_BAR; PG8_MMA(1, 0, At, B0); PG8_MMA(1, 1, At, B1); PG8_BAR; PG8_SCHED;
    }
    if (wr == 0) PG8_BAR;
    E(acc, S.tile_m(cur.pm), cur.pn, wr, wc, fr, fq);
    if (!has_next) break;
#pragma unroll
    for (int a = 0; a < 2; ++a)
#pragma unroll
      for (int b = 0; b < 2; ++b)
#pragma unroll
        for (int m = 0; m < 4; ++m)
#pragma unroll
          for (int n = 0; n < 2; ++n) acc[a][b][m][n] = (f32x4){0.f, 0.f, 0.f, 0.f};
    cur = nxt; cA = nA; cB = nB; ++ui;
    if (wr == 1) PG8_BAR;
  }
  PG8_WAIT_V(0);
  PG8_BAR;
#undef PG8_SA
#undef PG8_SB
#undef PG8_STAGE
#undef PG8_LDA
#undef PG8_LDB
#undef PG8_MMA
#undef PG8_WAIT_V
#undef PG8_WAIT_L
#undef PG8_BAR
#undef PG8_SCHED
}
}

struct OrderAll : pg8::StaticOrder { __device__ __forceinline__ int tile_m(int pm) const { return pm; } };

struct EpiProj {
  bf16_t* O; bf16_t* OH;
  __device__ __forceinline__ static void dest(int c32, bf16_t* O, bf16_t* OH, bf16_t*& base, int& pitch) {
    if (c32 < PC_MQ) { base = O + c32; pitch = PJR; }
    else if (c32 >= PC_ZA) { base = O + (RC_ZA + c32 - PC_ZA); pitch = PJR; }
    else if (c32 >= PC_MO && c32 < PC_GQ) { base = O + (RC_MO + c32 - PC_MO); pitch = PJR; }
    else { const int rel = c32 < PC_MO ? c32 - PC_MQ : c32 - PC_GQ + 1536; base = OH + (size_t)(rel >> 7) * PH_T + (rel & 127); pitch = 128; }
  }
  __device__ __forceinline__ void operator()(const f32x4 (&acc)[2][2][4][2], int tm, int pn, int wr, int wc, int fr, int fq) const {
    const int row0 = tm * 256 + wr * 64 + fr;
    bf16_t* b0; bf16_t* b1; int p0, p1;
    dest(__builtin_amdgcn_readfirstlane(pn * 256 + wc * 32), O, OH, b0, p0); dest(__builtin_amdgcn_readfirstlane(pn * 256 + 128 + wc * 32), O, OH, b1, p1);
#pragma unroll
    for (int ai = 0; ai < 2; ++ai)
#pragma unroll
      for (int m = 0; m < 4; ++m) { int r_ = row0; asm volatile("" : "+v"(r_) :: "memory"); const int r = r_ + ai * 128 + m * 16;
#pragma unroll
        for (int bj = 0; bj < 2; ++bj) { const f32x4 v0 = acc[ai][bj][m][0], v1 = acc[ai][bj][m][1];
          u32x4 w; w.x = cvtpk(v0[0], v0[1]); w.y = cvtpk(v0[2], v0[3]); w.z = cvtpk(v1[0], v1[1]); w.w = cvtpk(v1[2], v1[3]);
          *(u32x4*)((bj ? b1 : b0) + (size_t)r * (bj ? p1 : p0) + 8 * fq) = w; } }
  }
};


struct RowInfo { int kind  , b, t, pos; };
__device__ __forceinline__ RowInfo row_info(int r) {
  RowInfo ri;
  if (r < ROW_S) { ri.kind = 0; ri.b = r >> 12; ri.t = r & 4095; ri.pos = NMETA + ri.t; }
  else if (r < ROW_M) { ri.kind = 1; ri.b = (r - ROW_S) >> 4; ri.t = (r - ROW_S) & 15; ri.pos = NCACHE + ri.t; }
  else if (r < MROWS) { ri.kind = 2; ri.b = 0; ri.t = r - ROW_M; ri.pos = ri.t; }
  else { ri.kind = 3; ri.b = 0; ri.t = 0; ri.pos = 0; }
  return ri;
}
__device__ __forceinline__ float softplusf_(float x) { return x > 20.f ? x : __logf(1.f + __expf(x)); }
__device__ __forceinline__ float logsigmoidf_(float x) { return x >= 0.f ? -__logf(1.f + __expf(-x)) : x - __logf(1.f + __expf(x)); }

__device__ __forceinline__ void phase_rowpass(const Params& p, int l, int gw, int NGW, int lane) {
  const bf16_t* PROJ = (const bf16_t*)(p.ws + WS_PROJ);
  float* RSTD = (float*)(p.ws + WS_RSTD);
  const float* ct = (const float*)(p.ws + WS_ROPE); const float* st = ct + ROPE_N * 16;
  bf16_t* KV = (bf16_t*)(p.ws + WS_KV);
  const f32x4 kn = *(const f32x4*)(p.in[14] + (size_t)l * 256 + 4 * lane);
  for (int r0 = 2 * gw; r0 < MROWS; r0 += 2 * NGW) {
    u32x2 ck[2]; unsigned cq[2][3]; unsigned short krv[2][2]; float skv[2], sq[2];
#pragma unroll
    for (int i = 0; i < 2; ++i) { const bf16_t* pr = PROJ + (size_t)(r0 + i) * PJR;
      ck[i] = *(const u32x2*)(pr + PC_CKV + 4 * lane);
      const unsigned* cqp = (const unsigned*)(pr + PC_CQ + 6 * lane); cq[i][0] = cqp[0]; cq[i][1] = cqp[1]; cq[i][2] = cqp[2];
      krv[i][0] = pr[PC_KR + (lane & 15)]; krv[i][1] = pr[PC_KR + 16 + (lane & 15)]; }
#pragma unroll
    for (int i = 0; i < 2; ++i) { const float c0 = bflo(ck[i].x), c1 = bfhi(ck[i].x), c2 = bflo(ck[i].y), c3 = bfhi(ck[i].y); skv[i] = c0 * c0 + c1 * c1 + c2 * c2 + c3 * c3; sq[i] = 0.f;
#pragma unroll
      for (int j = 0; j < 3; ++j) { const float a = bflo(cq[i][j]), b = bfhi(cq[i][j]); sq[i] += a * a + b * b; } }
#pragma unroll
    for (int o = 1; o < 64; o <<= 1)
#pragma unroll
      for (int i = 0; i < 2; ++i) { skv[i] += __shfl_xor(skv[i], o); sq[i] += __shfl_xor(sq[i], o); }
#pragma unroll
    for (int i = 0; i < 2; ++i) {
      const int r = r0 + i; const RowInfo ri = row_info(r); const bf16_t* pr = PROJ + (size_t)r * PJR;
      const float rs_kv = rsqrtf(skv[i] * (1.f / 256.f) + EPS), rs_q = rsqrtf(sq[i] * (1.f / 384.f) + EPS);
      const f32x4 lat = {bflo(ck[i].x) * rs_kv * kn.x, bfhi(ck[i].x) * rs_kv * kn.y, bflo(ck[i].y) * rs_kv * kn.z, bfhi(ck[i].y) * rs_kv * kn.w};
      if (lane == 0) { RSTD[2 * r] = rs_q; RSTD[2 * r + 1] = rs_kv; }
      float o1 = 0.f, o2 = 0.f;
      if (lane < 16) { const float x1 = bf2f(krv[i][0]), x2 = bf2f(krv[i][1]); const float c = ct[ri.pos * 16 + lane], s = st[ri.pos * 16 + lane]; o1 = x1 * c - x2 * s; o2 = x2 * c + x1 * s; }
      if (ri.kind == 0) {
        float* ol = p.out + O_PLAT + (((size_t)l * NB + ri.b) * NCACHE + NMETA + ri.t) * 256; *(f32x4*)(ol + 4 * lane) = lat;
        if (lane < 16) { float* ok = p.out + O_PKR + (((size_t)l * NB + ri.b) * NCACHE + NMETA + ri.t) * 32; ok[lane] = o1; ok[16 + lane] = o2; }
        {
          const int k0 = 4 * (lane & 7), src = k0 & 15; float v4[4];
#pragma unroll
          for (int e = 0; e < 4; ++e) { const float a1 = __shfl(o1, src + e), a2 = __shfl(o2, src + e); v4[e] = k0 < 16 ? a1 : a2; }
          u32x2 w; w.x = cvtpk(v4[0], v4[1]); w.y = cvtpk(v4[2], v4[3]);
          *(u32x2*)(KV + ((size_t)(ri.b * 8 + (lane >> 3)) * KVROWS + 64 + ri.t) * 160 + 64 + k0) = w; }
      } else if (ri.kind == 1) {
        float* ol = p.out + O_SLAT + (((size_t)l * DB + ri.b) * DS + ri.t) * 256; *(f32x4*)(ol + 4 * lane) = lat;
        if (lane < 16) { float* ok = p.out + O_SKR + (((size_t)l * DB + ri.b) * DS + ri.t) * 32; ok[lane] = o1; ok[16 + lane] = o2; }
      } else {
        for (int b = 0; b < NB; ++b) {
          float* ol = p.out + O_PLAT + (((size_t)l * NB + b) * NCACHE + ri.t) * 256; *(f32x4*)(ol + 4 * lane) = lat;
          if (lane < 16) { float* ok = p.out + O_PKR + (((size_t)l * NB + b) * NCACHE + ri.t) * 32; ok[lane] = o1; ok[16 + lane] = o2;
#pragma unroll
            for (int h = 0; h < 8; ++h) { bf16_t* kd = KV + ((size_t)(b * 8 + h) * KVROWS + ri.t) * 160 + 64; kd[lane] = f2bf(o1); kd[16 + lane] = f2bf(o2); } }
        }
      }
      float* co = nullptr;
      if (ri.kind == 0 && ri.t >= SEQ - 3) co = p.out + O_PCONV + (((size_t)l * NB + ri.b) * 3 + (ri.t - (SEQ - 3))) * 1536;
      if (ri.kind == 1 && ri.t >= DS - 3) co = p.out + O_SCONV + (((size_t)l * DB + ri.b) * 3 + (ri.t - (DS - 3))) * 1536;
      if (co) { const bf16_t* ph = (const bf16_t*)(p.ws + WS_PROJH) + (size_t)(12 + (lane >> 4)) * PH_T + (size_t)r * 128 + 8 * (lane & 15);
        for (int c = lane * 8; c < 1536; c += 512) { const u32x4 w = *(const u32x4*)(ph + (size_t)(c >> 9) * 4 * PH_T);
          *(f32x4*)(co + c) = (f32x4){bflo(w.x), bfhi(w.x), bflo(w.y), bfhi(w.y)}; *(f32x4*)(co + c + 4) = (f32x4){bflo(w.z), bfhi(w.z), bflo(w.w), bfhi(w.w)}; } }
    }
  }
}

struct OrderTail : pg8::StaticOrder { __device__ __forceinline__ int tile_m(int pm) const { return 128 + pm; } };
struct OrderKV : pg8::StaticOrder { __device__ __forceinline__ int tile_m(int pm) const { return pm < 128 ? pm : 130; } };

struct EpiQ {
  const float* rstd; const float* ct; const float* st; bf16_t* QATT; bf16_t* QMETA; bf16_t* QS;
  __device__ __forceinline__ void operator()(const f32x4 (&acc)[2][2][4][2], int tm, int pn, int wr, int wc, int fr, int fq) const {
    float rsv[2][4];
#pragma unroll
    for (int ai = 0; ai < 2; ++ai)
#pragma unroll
      for (int m = 0; m < 4; ++m) { const int r = tm * 256 + ai * 128 + wr * 64 + m * 16 + fr; rsv[ai][m] = r < MROWS ? rstd[2 * r] : 0.f; }
#pragma unroll
    for (int ai = 0; ai < 2; ++ai)
#pragma unroll
      for (int m = 0; m < 4; ++m) {
        int fr_ = fr; asm volatile("" : "+v"(fr_) :: "memory");
        const int r = tm * 256 + ai * 128 + wr * 64 + m * 16 + fr_; const RowInfo ri = row_info(r);
        const float rs = rsv[ai][m];
        bf16_t* dst; int hstride;
        if (ri.kind == 0) { dst = QATT + ((size_t)(ri.b * 8) * SEQ + ri.t) * 96; hstride = SEQ * 96; }
        else if (ri.kind == 1) { dst = QS + (size_t)(r - ROW_S) * 768; hstride = 96; }
        else { dst = QMETA + (size_t)ri.t * 96; hstride = 256 * 96; }
#pragma unroll
        for (int bj = 0; bj < 2; ++bj) {
          const int gb = pn * 256 + bj * 128 + wc * 32; const int h = gb / 96, gm = gb - h * 96;
          float v[8];
#pragma unroll
          for (int j = 0; j < 4; ++j) { v[j] = acc[ai][bj][m][0][j] * rs; v[4 + j] = acc[ai][bj][m][1][j] * rs; }
          if (gm == 64) {
            const float* cp = ct + ri.pos * 16 + 8 * (fq & 1); const float* sp = st + ri.pos * 16 + 8 * (fq & 1);
            const f32x4 c0 = *(const f32x4*)cp, c1 = *(const f32x4*)(cp + 4), s0 = *(const f32x4*)sp, s1 = *(const f32x4*)(sp + 4);
            const float sg = fq < 2 ? -1.f : 1.f;
#pragma unroll
            for (int j = 0; j < 8; ++j) { const float pv = __shfl_xor(v[j], 32); const float c = j < 4 ? c0[j & 3] : c1[j & 3], s = j < 4 ? s0[j & 3] : s1[j & 3];
              v[j] = v[j] * c + sg * pv * s; }
          }
          u32x4 w; w.x = cvtpk(v[0], v[1]); w.y = cvtpk(v[2], v[3]); w.z = cvtpk(v[4], v[5]); w.w = cvtpk(v[6], v[7]);
          if (ri.kind != 3) *(u32x4*)(dst + (size_t)h * hstride + gm + 8 * fq) = w;
        }
      }
  }
};

struct EpiKV {
  const float* rstd; bf16_t* KV;
  __device__ __forceinline__ void operator()(const f32x4 (&acc)[2][2][4][2], int tm, int pn, int wr, int wc, int fr, int fq) const {
#pragma unroll
    for (int ai = 0; ai < 2; ++ai)
#pragma unroll
      for (int m = 0; m < 4; ++m) {
        int fr_ = fr; asm volatile("" : "+v"(fr_) :: "memory");
        const int r = tm * 256 + ai * 128 + wr * 64 + m * 16 + fr_; const RowInfo ri = row_info(r);
        if (ri.kind != 0 && ri.kind != 2) continue;
        const float rs = rstd[2 * r + 1];
#pragma unroll
        for (int bj = 0; bj < 2; ++bj) {
          const int col0 = pn * 256 + bj * 128 + wc * 32 + 8 * fq; const int isv = col0 >= 512; const int cc = col0 & 511; const int h = cc >> 6, d0 = (cc & 63) + (isv ? 96 : 0);
          const f32x4 v0 = acc[ai][bj][m][0] * rs, v1 = acc[ai][bj][m][1] * rs;
          u32x4 w; w.x = cvtpk(v0[0], v0[1]); w.y = cvtpk(v0[2], v0[3]); w.z = cvtpk(v1[0], v1[1]); w.w = cvtpk(v1[2], v1[3]);
          if (ri.kind == 0) *(u32x4*)(KV + ((size_t)(ri.b * 8 + h) * KVROWS + 64 + ri.t) * 160 + d0) = w;
          else for (int b = 0; b < NB; ++b) *(u32x4*)(KV + ((size_t)(b * 8 + h) * KVROWS + ri.t) * 160 + d0) = w;
        }
        asm volatile("" ::: "memory");
      }
  }
};

struct AttnUnit { const bf16_t* q; const bf16_t* kv; int ntiles, chunk0, nq_valid, out_row0, h, is_meta; };
constexpr int AT_KP = 208, AT_VP = 192, AT_KB = 64 * AT_KP, AT_STAGE = AT_KB + 64 * AT_VP;
typedef short v4i16_t __attribute__((ext_vector_type(4)));

__device__ __forceinline__ void attn_unit(LAS unsigned char* lds, const AttnUnit u, const bf16_t* PROJ, bf16_t* OA, int tid, unsigned char* p_ws_probe = nullptr) {
  asm volatile("" : "+v"(tid));
  const int lane = tid & 63, w = tid >> 6, r32 = lane & 31, hi = lane >> 5;
  const int jmax = u.is_meta ? 0 : (1 + u.chunk0 + (w >> 1));
  bf16x8 qf[6];
  { const bf16_t* qp = u.q + (size_t)(32 * w + r32) * 96 + 8 * hi;
#pragma unroll
    for (int s = 0; s < 6; ++s) qf[s] = *(const bf16x8*)(qp + 16 * s); }
  f32x16 o0, o1;
#pragma unroll
  for (int i = 0; i < 16; ++i) { o0[i] = 0.f; o1[i] = 0.f; }
  float mrun = -INFINITY, lrun = 0.f;
  u32x4 sA0, sA1, sA2, sB0, sB1, sB2; sA2 = (u32x4){0u, 0u, 0u, 0u}; sB2 = sA2;
  auto lds_off = [](int c) { const int row = c / 20, cc = c - row * 20; return cc < 12 ? row * AT_KP + cc * 16 : AT_KB + row * AT_VP + (cc - 12) * 16; };
  const int off0 = lds_off(tid), off1 = lds_off(tid + 512), off2 = lds_off(tid < 256 ? tid + 1024 : 0);
#define AT_LOAD(S0, S1, S2, TILE) do { const u32x4* g_ = (const u32x4*)(u.kv + (size_t)(TILE) * 64 * 160); S0 = g_[tid]; S1 = g_[tid + 512]; if (tid < 256) S2 = g_[tid + 1024]; } while (0)
#define AT_STORE(S0, S1, S2, STG) do { LAS unsigned char* nb_ = lds + (STG) * AT_STAGE; *(LAS u32x4*)(nb_ + off0) = S0; *(LAS u32x4*)(nb_ + off1) = S1; if (tid < 256) *(LAS u32x4*)(nb_ + off2) = S2; } while (0)
  AT_LOAD(sB0, sB1, sB2, 0); AT_STORE(sB0, sB1, sB2, 0);
  if (u.ntiles > 1) AT_LOAD(sA0, sA1, sA2, 1);
  if (u.ntiles > 2) AT_LOAD(sB0, sB1, sB2, 2);
  __syncthreads();
  const int koff = r32 * AT_KP + 16 * hi;
  const int l16 = lane & 15, cg = (lane >> 4) & 1;
  const int voff = AT_KB + (4 * hi + (l16 >> 2)) * AT_VP + (16 * cg + 4 * (l16 & 3)) * 2;
#if PROBE_LEVEL == 2
  unsigned long long tl_ = __builtin_amdgcn_s_memrealtime(), aa_[4] = {0ull, 0ull, 0ull, 0ull};
#define AA_T(i) do { const unsigned long long t_ = __builtin_amdgcn_s_memrealtime(); aa_[i] += t_ - tl_; tl_ = t_; } while (0)
#else
#define AA_T(i) do {} while (0)
#endif
  auto compute_tile = [&](int j) {
    LAS unsigned char* sb = lds + (j & 1) * AT_STAGE;
    AA_T(3);
    if (j <= jmax) {
      const float mref = mrun > -1e30f ? mrun : 0.f;
      f32x16 p0, p1;
#pragma unroll
      for (int i = 0; i < 16; ++i) { p0[i] = -mref; p1[i] = -mref; }
      bf16x8 kf0[6], kf1[6];
#pragma unroll
      for (int s = 0; s < 6; ++s) { kf0[s] = *(const LAS bf16x8*)(sb + koff + s * 32); kf1[s] = *(const LAS bf16x8*)(sb + koff + 32 * AT_KP + s * 32); }
      v4i16_t va0[4], va1[4], vb0[4], vb1[4];
#pragma unroll
      for (int ks = 0; ks < 4; ++ks) {
        va0[ks] = __builtin_amdgcn_ds_read_tr16_b64_v4i16((LAS v4i16_t*)(sb + voff + ks * 16 * AT_VP));
        va1[ks] = __builtin_amdgcn_ds_read_tr16_b64_v4i16((LAS v4i16_t*)(sb + voff + ks * 16 * AT_VP + 8 * AT_VP));
        vb0[ks] = __builtin_amdgcn_ds_read_tr16_b64_v4i16((LAS v4i16_t*)(sb + voff + ks * 16 * AT_VP + 64));
        vb1[ks] = __builtin_amdgcn_ds_read_tr16_b64_v4i16((LAS v4i16_t*)(sb + voff + ks * 16 * AT_VP + 8 * AT_VP + 64)); }
      __builtin_amdgcn_sched_barrier(0);
#pragma unroll
      for (int s = 0; s < 6; ++s) {
        p0 = __builtin_amdgcn_mfma_f32_32x32x16_bf16(kf0[s], qf[s], p0, 0, 0, 0);
        p1 = __builtin_amdgcn_mfma_f32_32x32x16_bf16(kf1[s], qf[s], p1, 0, 0, 0);
      }
      asm volatile("" :: "v"(p0), "v"(p1)); AA_T(0);
      if (j == 0) {
#pragma unroll
        for (int i = 8; i < 16; ++i) p0[i] = -INFINITY;
#pragma unroll
        for (int i = 0; i < 16; ++i) p1[i] = -INFINITY;
      }
      float tm = p0[0];
#pragma unroll
      for (int i = 1; i < 16; ++i) tm = fmaxf(tm, p0[i]);
#pragma unroll
      for (int i = 0; i < 16; ++i) tm = fmaxf(tm, p1[i]);
      tm = fmaxf(tm, __shfl_xor(tm, 32));
      if (!__all(tm + (mref - mrun) <= 6.0f)) {
        const float mnew = fmaxf(mrun, tm + mref); const float alpha = __builtin_amdgcn_exp2f(mrun - mnew); mrun = mnew; lrun *= alpha;
        const float shift = mnew - mref;
#pragma unroll
        for (int i = 0; i < 16; ++i) { o0[i] *= alpha; o1[i] *= alpha; p0[i] -= shift; p1[i] -= shift; }
      }
      float ps = 0.f;
#pragma unroll
      for (int i = 0; i < 16; ++i) { p0[i] = __builtin_amdgcn_exp2f(p0[i]); p1[i] = __builtin_amdgcn_exp2f(p1[i]); ps += p0[i] + p1[i]; }
      lrun += ps;
      AA_T(1);
      bf16x8 pb[4];
#pragma unroll
      for (int s = 0; s < 2; ++s) {
        u32x4 a, b;
        a.x = cvtpk(p0[8 * s + 0], p0[8 * s + 1]); a.y = cvtpk(p0[8 * s + 2], p0[8 * s + 3]); a.z = cvtpk(p0[8 * s + 4], p0[8 * s + 5]); a.w = cvtpk(p0[8 * s + 6], p0[8 * s + 7]);
        b.x = cvtpk(p1[8 * s + 0], p1[8 * s + 1]); b.y = cvtpk(p1[8 * s + 2], p1[8 * s + 3]); b.z = cvtpk(p1[8 * s + 4], p1[8 * s + 5]); b.w = cvtpk(p1[8 * s + 6], p1[8 * s + 7]);
        pb[s] = __builtin_bit_cast(bf16x8, a); pb[2 + s] = __builtin_bit_cast(bf16x8, b);
      }
#pragma unroll
      for (int ks = 0; ks < 4; ++ks) {
        const bf16x8 va = {va0[ks][0], va0[ks][1], va0[ks][2], va0[ks][3], va1[ks][0], va1[ks][1], va1[ks][2], va1[ks][3]};
        const bf16x8 vb = {vb0[ks][0], vb0[ks][1], vb0[ks][2], vb0[ks][3], vb1[ks][0], vb1[ks][1], vb1[ks][2], vb1[ks][3]};
        o0 = __builtin_amdgcn_mfma_f32_32x32x16_bf16(va, pb[ks], o0, 0, 0, 0);
        o1 = __builtin_amdgcn_mfma_f32_32x32x16_bf16(vb, pb[ks], o1, 0, 0, 0);
      }
      asm volatile("" :: "v"(o0), "v"(o1)); AA_T(2);
    }
  };
  for (int j = 0; j < u.ntiles; j += 2) {
    compute_tile(j);
    if (j + 1 < u.ntiles) AT_STORE(sA0, sA1, sA2, (j + 1) & 1);
    if (j + 3 < u.ntiles) AT_LOAD(sA0, sA1, sA2, j + 3);
    __syncthreads();
    if (j + 1 >= u.ntiles) break;
    compute_tile(j + 1);
    if (j + 2 < u.ntiles) AT_STORE(sB0, sB1, sB2, j & 1);
    if (j + 4 < u.ntiles) AT_LOAD(sB0, sB1, sB2, j + 4);
    __syncthreads();
  }
#undef AT_LOAD
#undef AT_STORE
#if PROBE_LEVEL == 2
  if (tid == 448 && blockIdx.x == 200) { for (int i = 0; i < 4; ++i) ((unsigned long long*)(p_ws_probe + WS_CTL + 2048))[4 + i] += aa_[i]; }
#endif
  const float ltot = lrun + __shfl_xor(lrun, 32); const float inv = 1.f / ltot;
  const int qi = 32 * w + r32;
  if (qi < u.nq_valid) {
    const bf16_t* zr = PROJ + (size_t)(u.out_row0 + qi) * PJR + RC_ZA + u.h * 64; bf16_t* orow = OA + (size_t)(u.out_row0 + qi) * 512 + u.h * 64;
#pragma unroll
    for (int dvt = 0; dvt < 2; ++dvt)
#pragma unroll
      for (int g = 0; g < 4; ++g) {
        const int dv0 = 32 * dvt + 8 * g + 4 * hi; u32x2 z = *(const u32x2*)(zr + dv0);
        float v[4];
#pragma unroll
        for (int e = 0; e < 4; ++e) v[e] = (dvt ? o1[4 * g + e] : o0[4 * g + e]) * inv;
        z.x = cvtpk(v[0] * siluf_(bflo(z.x)), v[1] * siluf_(bfhi(z.x))); z.y = cvtpk(v[2] * siluf_(bflo(z.y)), v[3] * siluf_(bfhi(z.y)));
        *(u32x2*)(orow + dv0) = z;
      }
  }
  __syncthreads();
}

constexpr int NSLOT = 32 * 65 + 128;
constexpr int MSLOT_B = 57344 + 2048;
constexpr int GSLOT_B = 73728 + 256;
constexpr int MS_Q = 0, MS_QK = 8192, MS_KHT = 12288, MS_VT = 20480, MS_SC_B = 57344;
constexpr int MSC_B = 0, MSC_MLOC = 64, MSC_RS = 128, MSC_DN = 192, MSC_A = 320, MSC_BB = 321;
constexpr int GS_NW = 0, GS_QT = 8192, GS_QK = 16384, GS_KTT = 20480, GS_UT = 28672, GS_SC_B = 73728;
constexpr size_t WS_MSLOT = WS_END0;
constexpr size_t WS_GSLOT = al256(WS_MSLOT + (size_t)NSLOT * MSLOT_B);
constexpr size_t WS_HM = WS_XN;
constexpr size_t WS_OG = WS_XN + SEG_B;
constexpr size_t WS_END1 = al256(WS_GSLOT + (size_t)NSLOT * GSLOT_B);

struct ChunkDesc { int row0, nvalid, kind  , b, h, tok0; };
__device__ __forceinline__ ChunkDesc chunk_of_slot(int slot) {
  ChunkDesc c;
  if (slot < 32 * 65) { const int ch = slot / 65, ci = slot - ch * 65; c.b = ch >> 2; c.h = ch & 3;
    if (ci == 0) { c.kind = 2; c.row0 = ROW_M; c.nvalid = 16; c.tok0 = 0; } else { c.kind = 0; c.row0 = c.b * SEQ + 64 * (ci - 1); c.nvalid = 64; c.tok0 = 64 * (ci - 1); } }
  else { const int ch = slot - 32 * 65; c.b = ch >> 2; c.h = ch & 3; c.kind = 1; c.row0 = ROW_S + 16 * c.b; c.nvalid = 16; c.tok0 = 0; }
  return c;
}
#define SCAN_DPP(old, src, ctrl, rmask) __int_as_float(__builtin_amdgcn_update_dpp(__float_as_int(old), __float_as_int(src), ctrl, rmask, 0xF, false))
__device__ __forceinline__ float scan_add(float v, int lane) {
  (void)lane;
  v += SCAN_DPP(0.f, v, 0x111, 0xF); v += SCAN_DPP(0.f, v, 0x112, 0xF); v += SCAN_DPP(0.f, v, 0x114, 0xF); v += SCAN_DPP(0.f, v, 0x118, 0xF);
  v += SCAN_DPP(0.f, v, 0x142, 0xA); v += SCAN_DPP(0.f, v, 0x143, 0xC);
  return v;
}
__device__ __forceinline__ float scan_max(float v, int lane) {
  (void)lane;
  v = fmaxf(v, SCAN_DPP(-INFINITY, v, 0x111, 0xF)); v = fmaxf(v, SCAN_DPP(-INFINITY, v, 0x112, 0xF)); v = fmaxf(v, SCAN_DPP(-INFINITY, v, 0x114, 0xF)); v = fmaxf(v, SCAN_DPP(-INFINITY, v, 0x118, 0xF));
  v = fmaxf(v, SCAN_DPP(-INFINITY, v, 0x142, 0xA)); v = fmaxf(v, SCAN_DPP(-INFINITY, v, 0x143, 0xC));
  return v;
}
__device__ __forceinline__ float wave_max(float v) { return __int_as_float(__builtin_amdgcn_readlane(__float_as_int(scan_max(v, 0)), 63)); }
__device__ __forceinline__ int kperm_pos(int k) { return (k & ~31) | (((k >> 2) & 3) << 3) | (((k >> 4) & 1) << 2) | (k & 3); }
__device__ __forceinline__ void store_perm8(bf16_t* rowbase, int k0, const u32x4& o) { u32x2 lo = {o.x, o.y}, hi = {o.z, o.w}; const int p0 = kperm_pos(k0); *(u32x2*)(rowbase + p0) = lo; *(u32x2*)(rowbase + p0 + 8) = hi; }
__device__ __forceinline__ float sum8(float v) { v += __shfl_xor(v, 1); v += __shfl_xor(v, 2); v += __shfl_xor(v, 4); return v; }

__device__ __forceinline__ void lds_barrier() { asm volatile("s_waitcnt lgkmcnt(0)\n\ts_barrier" ::: "memory"); }
#if PROBE_LEVEL == 2
#define PP_INIT() unsigned long long tl_ = __builtin_amdgcn_s_memrealtime()
#define PP_T(blk, i) do { lds_barrier(); if (tid == 0 && blockIdx.x == (blk)) { const unsigned long long t_ = __builtin_amdgcn_s_memrealtime(); ((unsigned long long*)(p.ws + WS_CTL + 2048))[(i)] += t_ - tl_; tl_ = t_; } } while (0)
#else
#define PP_INIT() do {} while (0)
#define PP_T(blk, i) do {} while (0)
#endif
constexpr int MP_IMG = 52224, MP_QK = 2 * MP_IMG, MP_SC = MP_QK + 17408, MP_G = MP_SC + 1536;
__device__ __forceinline__ bool prep_slot_skipped(int slot) { return slot < 32 * 65 && slot % 65 == 0 && slot >= 4 * 65; }
__device__ __forceinline__ int prep_next_slot(int slot, int G) { for (slot += G; slot < NSLOT; slot += G) if (!prep_slot_skipped(slot)) return slot; return NSLOT; }
__device__ __forceinline__ void mlstm_issue(LAS unsigned char* lds, const Params& p, int slot, int buf, int tid) {
  const ChunkDesc cd = chunk_of_slot(slot);
  const bf16_t* PROJ = (const bf16_t*)(p.ws + WS_PROJ); const bf16_t* PROJH = (const bf16_t*)(p.ws + WS_PROJH);
  const unsigned char* zero = p.ws + WS_ZERO;
  const int wu = __builtin_amdgcn_readfirstlane(tid >> 6), lane = tid & 63;
#pragma unroll
  for (int it = 0; it < 7; ++it) { const int k = wu + 8 * it;
    if (k < 51) { const int ten = k / 17, i = k - 17 * ten; const int o = i * 1024 + lane * 16, row = o / 272, col = o - row * 272;
      const unsigned char* src = (row < cd.nvalid && col < 256) ? (const unsigned char*)(PROJH + (size_t)(ten * 4 + cd.h) * PH_T + (size_t)(cd.row0 + row) * 128) + col : zero;
      __builtin_amdgcn_global_load_lds((const unsigned*)src, (LAS unsigned*)(lds + buf * MP_IMG + ten * 17408 + i * 1024), 16, 0, 0); } }
  if (wu == 3) { const unsigned char* src = lane < cd.nvalid ? (const unsigned char*)(PROJ + (size_t)(cd.row0 + lane) * PJR + PC_G16) : zero;
    __builtin_amdgcn_global_load_lds((const unsigned*)src, (LAS unsigned*)(lds + MP_G + buf * 1024), 16, 0, 0); }
}
__device__ __forceinline__ void mlstm_prep(LAS unsigned char* lds, const Params& p, int l, int slot, int buf, float bias_i, float bias_f, int tid) {
  asm volatile("" : "+v"(tid));
  PP_INIT();
  const ChunkDesc cd = chunk_of_slot(slot);
  bf16_t* SL = (bf16_t*)(p.ws + WS_MSLOT + (size_t)slot * MSLOT_B); float* SC = (float*)(p.ws + WS_MSLOT + (size_t)slot * MSLOT_B + MS_SC_B);
  const int lane = tid & 63, w = tid >> 6, c16 = lane & 15, q4 = lane >> 4;
  const int L_Q = buf * MP_IMG, L_K = L_Q + 17408, L_V = L_Q + 34816; constexpr int L_QK = MP_QK, L_SC = MP_SC;
  LAS float* sc = (LAS float*)(lds + L_SC);
  if (w == 0) {
    float ig = -INFINITY, fg = 0.f;
    if (lane < cd.nvalid) { const LAS bf16_t* gr = (const LAS bf16_t*)(lds + MP_G + buf * 1024 + lane * 16);
      ig = bf2f(gr[cd.h]) + bias_i; fg = logsigmoidf_(bf2f(gr[4 + cd.h]) + bias_f); }
    const float b = scan_add(fg, lane); const float g = ig - b; const float cm = scan_max(g, lane); const float gmax = __int_as_float(__builtin_amdgcn_readlane(__float_as_int(cm), 63)); const float blast = __int_as_float(__builtin_amdgcn_readlane(__float_as_int(b), 63));
    sc[lane] = b; sc[64 + lane] = g; sc[128 + lane] = b + cm; sc[192 + lane] = __expf(g - gmax);
    SC[MSC_B + lane] = b; SC[MSC_MLOC + lane] = b + cm;
    if (lane == 0) { SC[MSC_A] = blast + gmax; SC[MSC_BB] = blast; }
  }
  if (tid >= 64 && tid < 192) sc[256 + tid - 64] = 0.f;
  lds_barrier();
  PP_T(0, 8);
#pragma unroll
  for (int ti = 0; ti < 2; ++ti) { const int id = 2 * w + ti, tm = id >> 2, tn = id & 3; f32x4 acc = {0.f, 0.f, 0.f, 0.f};
#pragma unroll
    for (int kk = 0; kk < 4; ++kk) { const bf16x8 a = *(const LAS bf16x8*)(lds + L_Q + (16 * tm + c16) * 272 + (32 * kk + 8 * q4) * 2);
      const bf16x8 b = *(const LAS bf16x8*)(lds + L_K + (16 * tn + c16) * 272 + (32 * kk + 8 * q4) * 2);
      acc = __builtin_amdgcn_mfma_f32_16x16x32_bf16(a, b, acc, 0, 0, 0); }
    const int s = 16 * tn + c16; const float gs = sc[64 + s];
#pragma unroll
    for (int i = 0; i < 4; ++i) { const int t = 16 * tm + 4 * q4 + i; const float e = (s <= t) ? __expf(sc[t] + gs - sc[128 + t]) : 0.f;
      ((LAS float*)(lds + L_QK))[t * 68 + s] = (s <= t) ? acc[i] * e : 0.f; } }
  asm volatile("s_waitcnt vmcnt(0)" ::: "memory");
  lds_barrier();
  PP_T(0, 9);
  { const int row = tid >> 3, c8 = tid & 7; const LAS float* qr = (const LAS float*)(lds + L_QK) + row * 68 + c8 * 8; float v[8]; float rs = 0.f;
#pragma unroll
    for (int j = 0; j < 8; ++j) { v[j] = qr[j]; rs += v[j]; }
    u32x4 o; o.x = cvtpk(v[0], v[1]); o.y = cvtpk(v[2], v[3]); o.z = cvtpk(v[4], v[5]); o.w = cvtpk(v[6], v[7]);
    *(u32x4*)(SL + MS_QK + row * 64 + c8 * 8) = o; rs = sum8(rs); if (c8 == 0) SC[MSC_RS + row] = rs; }
#pragma unroll
  for (int k = 0; k < 2; ++k) { const int ci = tid + 512 * k, row = ci >> 4, c = ci & 15; const u32x4 qv = *(const LAS u32x4*)(lds + L_Q + row * 272 + c * 16); store_perm8(SL + MS_Q + row * 128, c * 8, qv); }
#pragma unroll
  for (int k = 0; k < 2; ++k) { const int id = tid + 512 * k, d = id & 127, s8 = id >> 7; float kv[8], vv[8]; float dsum = 0.f;
#pragma unroll
    for (int j = 0; j < 8; ++j) { const int s = 8 * s8 + j; kv[j] = bf2f(*(const LAS bf16_t*)(lds + L_K + s * 272 + d * 2)) * sc[192 + s]; vv[j] = bf2f(*(const LAS bf16_t*)(lds + L_V + s * 272 + d * 2)); }
    u32x4 o; o.x = cvtpk(kv[0], kv[1]); o.y = cvtpk(kv[2], kv[3]); o.z = cvtpk(kv[4], kv[5]); o.w = cvtpk(kv[6], kv[7]);
    dsum = bflo(o.x) + bfhi(o.x) + bflo(o.y) + bfhi(o.y) + bflo(o.z) + bfhi(o.z) + bflo(o.w) + bfhi(o.w);
    *(u32x4*)(SL + MS_KHT + d * 64 + 8 * s8) = o; atomicAdd((float*)(sc + 256 + d), dsum);
    u32x4 ov; ov.x = cvtpk(vv[0], vv[1]); ov.y = cvtpk(vv[2], vv[3]); ov.z = cvtpk(vv[4], vv[5]); ov.w = cvtpk(vv[6], vv[7]);
    *(u32x4*)(SL + MS_VT + d * 64 + 8 * s8) = ov; }
  lds_barrier();
  if (tid < 128) SC[MSC_DN + tid] = sc[256 + tid];
  PP_T(0, 10);
}

__device__ __forceinline__ void gdn_conv_taps(const Params& p, int l, const ChunkDesc& cd, int t, int col  , float (&x)[4][8]) {
  const bf16_t* PROJ = (const bf16_t*)(p.ws + WS_PROJ);
#pragma unroll
  for (int j = 0; j < 4; ++j) {
    const int T = cd.tok0 + t - 3 + j; int row = -1; const float* fsrc = nullptr;
    if (T >= 0) row = (cd.kind == 0 ? cd.b * SEQ : (cd.kind == 1 ? ROW_S + 16 * cd.b : ROW_M)) + T;
    else if (cd.kind == 0) row = ROW_M + 16 + T;
    else if (cd.kind == 1) fsrc = p.in[8] + (((size_t)l * DB + cd.b) * 3 + (3 + T)) * 1536 + col;
    if (row >= 0) { const u32x4 w = *(const u32x4*)((const bf16_t*)(p.ws + WS_PROJH) + (size_t)(12 + (col >> 7)) * PH_T + (size_t)row * 128 + (col & 127));
      x[j][0] = bflo(w.x); x[j][1] = bfhi(w.x); x[j][2] = bflo(w.y); x[j][3] = bfhi(w.y); x[j][4] = bflo(w.z); x[j][5] = bfhi(w.z); x[j][6] = bflo(w.w); x[j][7] = bfhi(w.w); }
    else if (fsrc) { const f32x4 a = *(const f32x4*)fsrc, b = *(const f32x4*)(fsrc + 4); x[j][0] = a.x; x[j][1] = a.y; x[j][2] = a.z; x[j][3] = a.w; x[j][4] = b.x; x[j][5] = b.y; x[j][6] = b.z; x[j][7] = b.w; }
    else {
#pragma unroll
      for (int e = 0; e < 8; ++e) x[j][e] = 0.f; }
  }
}

constexpr int GP_IMG_T = 67 * 272, GP_IMG = 54 * 1024;
__device__ __forceinline__ int gdn_queue_slot(int idx) {
  if (idx < 260) return idx;
  if (idx < 2052) { const int r = idx - 260; return 65 * (4 + (r >> 6)) + 1 + (r & 63); }
  if (idx < 2180) return 2080 + (idx - 2052);
  return NSLOT;
}
__device__ __forceinline__ bool gdn_slot_interior(int slot) { return slot < 32 * 65 && (slot % 65) >= 2; }
__device__ __forceinline__ void gdn_issue(LAS unsigned char* lds, const Params& p, int slot, int tid) {
  const ChunkDesc cd = chunk_of_slot(slot);
  const unsigned char* zero = p.ws + WS_ZERO;
  const unsigned char* src0 = (const unsigned char*)((const bf16_t*)(p.ws + WS_PROJH) + (size_t)(12 + cd.h) * PH_T + (size_t)(cd.b * SEQ + cd.tok0 - 3) * 128);
  const int wu = __builtin_amdgcn_readfirstlane(tid >> 6), lane = tid & 63;
#pragma unroll
  for (int it = 0; it < 7; ++it) { const int k = wu + 8 * it;
    if (k < 54) { const int o = k * 1024 + lane * 16, ten = o / GP_IMG_T, rem = o - ten * GP_IMG_T, row = rem / 272, col = rem - row * 272;
      const unsigned char* src = (ten < 3 && col < 256) ? src0 + (size_t)ten * (4 * PH_T * 2) + row * 256 + col : zero;
      __builtin_amdgcn_global_load_lds((const unsigned*)src, (LAS unsigned*)(lds + k * 1024), 16, 0, 0); } }
}
__device__ __forceinline__ void gdn_prep(LAS unsigned char* lds, const Params& p, int l, int slot, bool have_img, int next_slot, int tid) {
  asm volatile("" : "+v"(tid));
  PP_INIT();
  const ChunkDesc cd = chunk_of_slot(slot);
  const bf16_t* PROJ = (const bf16_t*)(p.ws + WS_PROJ);
  bf16_t* SL = (bf16_t*)(p.ws + WS_GSLOT + (size_t)slot * GSLOT_B); float* SC = (float*)(p.ws + WS_GSLOT + (size_t)slot * GSLOT_B + GS_SC_B);
  const int lane = tid & 63, w = tid >> 6, c16 = lane & 15, q4 = lane >> 4;
  constexpr int RT_P = 528; constexpr int L_Q = 0, L_K = 17408, L_QK = 34816, L_RT = 55296  , L_AM = 89088, L_T = 106496, L_TB = 123904, L_CW = 133120, L_SC = 139264, L_M = 139776;
  LAS float* sc = (LAS float*)(lds + L_SC);
  LAS float* AM = (LAS float*)(lds + L_AM); LAS float* QKf = (LAS float*)(lds + L_QK); LAS float* T = (LAS float*)(lds + L_T);
  LAS float* CW = (LAS float*)(lds + L_CW); LAS float* MB = (LAS float*)(lds + L_M);
  const int t = tid >> 3, part = tid & 7;
  u32x4 xin[3][2][4];
  if (cd.kind == 0 && cd.tok0 > 0) {
    if (!have_img) { gdn_issue(lds, p, slot, tid); asm volatile("s_waitcnt vmcnt(0)" ::: "memory"); }
    lds_barrier();
    const LAS unsigned char* ib = lds + t * 272 + part * 32;
#pragma unroll
    for (int j = 0; j < 4; ++j)
#pragma unroll
      for (int ten = 0; ten < 3; ++ten)
#pragma unroll
        for (int hh = 0; hh < 2; ++hh) xin[ten][hh][j] = *(const LAS u32x4*)(ib + ten * GP_IMG_T + j * 272 + 16 * hh);
  } else {
#pragma unroll
    for (int j = 0; j < 4; ++j) {
      const int Tt = cd.tok0 + t - 3 + j; int row = -1; const float* fsrc = nullptr;
      if (Tt >= 0) row = (cd.kind == 0 ? cd.b * SEQ : (cd.kind == 1 ? ROW_S + 16 * cd.b : ROW_M)) + Tt;
      else if (cd.kind == 0) row = ROW_M + 16 + Tt;
      else if (cd.kind == 1) fsrc = p.in[8] + (((size_t)l * DB + cd.b) * 3 + (3 + Tt)) * 1536;
#pragma unroll
      for (int ten = 0; ten < 3; ++ten)
#pragma unroll
        for (int hh = 0; hh < 2; ++hh) { const int col = ten * 512 + cd.h * 128 + 16 * part + 8 * hh; u32x4 v = {0u, 0u, 0u, 0u};
          if (row >= 0) v = *(const u32x4*)((const bf16_t*)(p.ws + WS_PROJH) + (size_t)(12 + (col >> 7)) * PH_T + (size_t)row * 128 + (col & 127));
          else if (fsrc) { const f32x4 a = *(const f32x4*)(fsrc + col), b = *(const f32x4*)(fsrc + col + 4); v.x = cvtpk(a.x, a.y); v.y = cvtpk(a.z, a.w); v.z = cvtpk(b.x, b.y); v.w = cvtpk(b.z, b.w); }
          xin[ten][hh][j] = v; }
    }
  }
  if (w == 0) {
    float ld = 0.f, be = 0.f;
    if (lane < cd.nvalid) { const bf16_t* pr = PROJ + (size_t)(cd.row0 + lane) * PJR + PC_G16;
      ld = -__expf(p.in[20][l * 4 + cd.h]) * softplusf_(bf2f(pr[8 + cd.h]) + p.in[21][l * 4 + cd.h]); be = sigmoidf_(bf2f(pr[12 + cd.h])); }
    const float G = scan_add(ld, lane); sc[lane] = G; sc[64 + lane] = be;
    if (lane == 63) SC[0] = __expf(G);
  } else if (tid < 64 + 384) { const int i = tid - 64, ten = i >> 7, j = (i >> 5) & 3, c4 = i & 31;
    *(LAS f32x4*)(CW + (ten * 4 + j) * 128 + 4 * c4) = *(const f32x4*)(p.in[19] + ((size_t)l * 4 + j) * 1536 + ten * 512 + cd.h * 128 + 4 * c4); }
  lds_barrier();
  PP_T(1, 0);
  { const float G = sc[t], be = sc[64 + t], eG = __expf(G);
#pragma unroll
    for (int ten = 0; ten < 3; ++ten) {
      float y[16];
#pragma unroll
      for (int hh = 0; hh < 2; ++hh) {
        float a[8];
#pragma unroll
        for (int e = 0; e < 8; ++e) a[e] = 0.f;
#pragma unroll
        for (int j = 0; j < 4; ++j) { const u32x4 v = xin[ten][hh][j]; const LAS float* cw = CW + (ten * 4 + j) * 128 + 16 * part + 8 * hh; const f32x4 w0 = *(const LAS f32x4*)cw, w1 = *(const LAS f32x4*)(cw + 4);
          a[0] += bflo(v.x) * w0.x; a[1] += bfhi(v.x) * w0.y; a[2] += bflo(v.y) * w0.z; a[3] += bfhi(v.y) * w0.w; a[4] += bflo(v.z) * w1.x; a[5] += bfhi(v.z) * w1.y; a[6] += bflo(v.w) * w1.z; a[7] += bfhi(v.w) * w1.w; }
#pragma unroll
        for (int e = 0; e < 8; ++e) y[8 * hh + e] = siluf_(a[e]); }
      if (ten < 2) { float ss = 0.f;
#pragma unroll
        for (int e = 0; e < 16; ++e) ss += y[e] * y[e];
        ss = sum8(ss); const float rn = rsqrtf(ss + EPS) * (ten == 0 ? 0.08838834764831845f : 1.f);
#pragma unroll
        for (int e = 0; e < 16; ++e) y[e] *= rn; }
      if (t >= cd.nvalid) {
#pragma unroll
        for (int e = 0; e < 16; ++e) y[e] = 0.f; }
      if (ten < 2) { u32x4 o0, o1; o0.x = cvtpk(y[0], y[1]); o0.y = cvtpk(y[2], y[3]); o0.z = cvtpk(y[4], y[5]); o0.w = cvtpk(y[6], y[7]);
        o1.x = cvtpk(y[8], y[9]); o1.y = cvtpk(y[10], y[11]); o1.z = cvtpk(y[12], y[13]); o1.w = cvtpk(y[14], y[15]);
        LAS unsigned char* dst = lds + (ten == 0 ? L_Q : L_K) + t * 272 + part * 32; *(LAS u32x4*)dst = o0; *(LAS u32x4*)(dst + 16) = o1; }
      if (ten >= 1) { const float scl = ten == 1 ? be * eG : be; const int cb = ten == 1 ? 128 : 0;
        u32x4 o0, o1; o0.x = cvtpk(scl * y[0], scl * y[1]); o0.y = cvtpk(scl * y[2], scl * y[3]); o0.z = cvtpk(scl * y[4], scl * y[5]); o0.w = cvtpk(scl * y[6], scl * y[7]);
        o1.x = cvtpk(scl * y[8], scl * y[9]); o1.y = cvtpk(scl * y[10], scl * y[11]); o1.z = cvtpk(scl * y[12], scl * y[13]); o1.w = cvtpk(scl * y[14], scl * y[15]);
        LAS unsigned char* dst = lds + L_RT + t * RT_P + (cb + 16 * part) * 2; *(LAS u32x4*)dst = o0; *(LAS u32x4*)(dst + 16) = o1; }
    } }
  lds_barrier();
  PP_T(1, 1);
#pragma unroll
  for (int ti = 0; ti < 4; ++ti) { const int id = 4 * w + ti, isq = id >> 4, tm = (id >> 2) & 3, tn = id & 3; f32x4 acc = {0.f, 0.f, 0.f, 0.f};
#pragma unroll
    for (int kk = 0; kk < 4; ++kk) { const bf16x8 a = *(const LAS bf16x8*)(lds + (isq ? L_Q : L_K) + (16 * tm + c16) * 272 + (32 * kk + 8 * q4) * 2);
      const bf16x8 b = *(const LAS bf16x8*)(lds + L_K + (16 * tn + c16) * 272 + (32 * kk + 8 * q4) * 2);
      acc = __builtin_amdgcn_mfma_f32_16x16x32_bf16(a, b, acc, 0, 0, 0); }
    const int s = 16 * tn + c16; const float Gs = sc[s];
#pragma unroll
    for (int i = 0; i < 4; ++i) { const int tt = 16 * tm + 4 * q4 + i; const float e = __expf(sc[tt] - Gs);
      if (isq) QKf[tt * 68 + s] = (s <= tt) ? acc[i] * e : 0.f; else AM[tt * 68 + s] = (s < tt) ? sc[64 + tt] * acc[i] * e : 0.f; } }
  lds_barrier();
  PP_T(1, 2);
  if (tid < 64) { const int bi = tid >> 4, cc = tid & 15; float x[16];
#pragma unroll
    for (int r = 0; r < 16; ++r) { float a = (r == cc) ? 1.f : 0.f;
#pragma unroll
      for (int s = 0; s < r; ++s) a -= AM[(16 * bi + r) * 68 + 16 * bi + s] * x[s];
      x[r] = a; T[(16 * bi + r) * 68 + 16 * bi + cc] = a; }
  } else {
    const int u = tid - 64; const float Glast = sc[63];
    for (int ci = u; ci < 1024; ci += 448) { const int row = ci >> 4, cq = ci & 15; const u32x4 v = *(const LAS u32x4*)(lds + L_Q + row * 272 + cq * 16); const float e = __expf(sc[row]);
      u32x4 o; o.x = cvtpk(bflo(v.x) * e, bfhi(v.x) * e); o.y = cvtpk(bflo(v.y) * e, bfhi(v.y) * e); o.z = cvtpk(bflo(v.z) * e, bfhi(v.z) * e); o.w = cvtpk(bflo(v.w) * e, bfhi(v.w) * e);
      store_perm8(SL + GS_QT + row * 128, cq * 8, o); }
    for (int id = u; id < 1024; id += 448) { const int d = id & 127, s8 = id >> 7; float kv[8];
#pragma unroll
      for (int j = 0; j < 8; ++j) { const int s = 8 * s8 + j; kv[j] = bf2f(*(const LAS bf16_t*)(lds + L_K + s * 272 + d * 2)) * __expf(Glast - sc[s]); }
      u32x4 o; o.x = cvtpk(kv[0], kv[1]); o.y = cvtpk(kv[2], kv[3]); o.z = cvtpk(kv[4], kv[5]); o.w = cvtpk(kv[6], kv[7]);
      store_perm8(SL + GS_KTT + d * 64, 8 * s8, o); }
    for (int ci = u; ci < 512; ci += 448) { const int row = ci >> 3, c8 = ci & 7; const LAS float* qr = QKf + row * 68 + c8 * 8;
      u32x4 o; o.x = cvtpk(qr[0], qr[1]); o.y = cvtpk(qr[2], qr[3]); o.z = cvtpk(qr[4], qr[5]); o.w = cvtpk(qr[6], qr[7]);
      store_perm8(SL + GS_QK + row * 64, c8 * 8, o); }
    for (int e = u; e < 6 * 256; e += 448) { const int bp = e >> 8, r = (e >> 4) & 15, cc = e & 15;
      const int bi = bp < 3 ? 0 : (bp < 5 ? 1 : 2), bj = bp < 3 ? bp + 1 : (bp < 5 ? bp - 1 : 3); T[(16 * bi + r) * 68 + 16 * bj + cc] = 0.f; }
  }
  lds_barrier();
  if (next_slot < NSLOT && gdn_slot_interior(next_slot)) gdn_issue(lds, p, next_slot, tid);
  PP_T(1, 3);
  { auto split4 = [](const f32x4& x, v4i16_t& hi, v4i16_t& lo) {
#pragma unroll
      for (int i = 0; i < 4; ++i) { const bf16_t h = f2bf(x[i]); hi[i] = (short)h; lo[i] = (short)f2bf(x[i] - bf2f(h)); } };
#pragma unroll
    for (int bi = 1; bi < 4; ++bi) {
      if (w < bi) { const int bj = w; f32x4 m = {0.f, 0.f, 0.f, 0.f};
        for (int kb = bj; kb < bi; ++kb) {
          const f32x4 av = *(const LAS f32x4*)(AM + (16 * bi + c16) * 68 + 16 * kb + 4 * q4);
          f32x4 tv;
#pragma unroll
          for (int i = 0; i < 4; ++i) tv[i] = T[(16 * kb + 4 * q4 + i) * 68 + 16 * bj + c16];
          v4i16_t ah, al, th, tl; split4(av, ah, al); split4(tv, th, tl);
          m = __builtin_amdgcn_mfma_f32_16x16x16bf16_1k(ah, th, m, 0, 0, 0); m = __builtin_amdgcn_mfma_f32_16x16x16bf16_1k(ah, tl, m, 0, 0, 0); m = __builtin_amdgcn_mfma_f32_16x16x16bf16_1k(al, th, m, 0, 0, 0); }
        const f32x4 dv = *(const LAS f32x4*)(T + (16 * bi + c16) * 68 + 16 * bi + 4 * q4);
        v4i16_t dh, dl, mh, ml; split4(dv, dh, dl); split4(m, mh, ml);
        f32x4 r = {0.f, 0.f, 0.f, 0.f};
        r = __builtin_amdgcn_mfma_f32_16x16x16bf16_1k(dh, mh, r, 0, 0, 0); r = __builtin_amdgcn_mfma_f32_16x16x16bf16_1k(dh, ml, r, 0, 0, 0); r = __builtin_amdgcn_mfma_f32_16x16x16bf16_1k(dl, mh, r, 0, 0, 0);
#pragma unroll
        for (int i = 0; i < 4; ++i) T[(16 * bi + 4 * q4 + i) * 68 + 16 * bj + c16] = -r[i]; }
      lds_barrier();
    } }
  { const int row = tid >> 3, c8 = tid & 7; const LAS float* tr = T + row * 68 + c8 * 8;
    u32x4 o; o.x = cvtpk(tr[0], tr[1]); o.y = cvtpk(tr[2], tr[3]); o.z = cvtpk(tr[4], tr[5]); o.w = cvtpk(tr[6], tr[7]);
    *(LAS u32x4*)(lds + L_TB + row * 144 + c8 * 16) = o; }
  asm volatile("s_waitcnt vmcnt(0)" ::: "memory");
  lds_barrier();
  PP_T(1, 4);
  { const int l16 = lane & 15; const int troff = (8 * q4 + (l16 >> 2)) * RT_P + (4 * (l16 & 3)) * 2;
#pragma unroll
  for (int ti = 0; ti < 8; ++ti) { const int id = 8 * w + ti; f32x4 acc = {0.f, 0.f, 0.f, 0.f};
    if (id < 32) { const int mt = id >> 3, nt = id & 7;
#pragma unroll
      for (int ks = 0; ks < 2; ++ks) { const bf16x8 a = *(const LAS bf16x8*)(lds + L_TB + (16 * mt + c16) * 144 + (32 * ks + 8 * q4) * 2);
        const v4i16_t b0 = __builtin_amdgcn_ds_read_tr16_b64_v4i16((LAS v4i16_t*)(lds + L_RT + troff + (32 * ks) * RT_P + (16 * nt) * 2));
        const v4i16_t b1 = __builtin_amdgcn_ds_read_tr16_b64_v4i16((LAS v4i16_t*)(lds + L_RT + troff + (32 * ks + 4) * RT_P + (16 * nt) * 2));
        const bf16x8 b = {b0[0], b0[1], b0[2], b0[3], b1[0], b1[1], b1[2], b1[3]};
        acc = __builtin_amdgcn_mfma_f32_16x16x32_bf16(a, b, acc, 0, 0, 0); }
      u32x2 o; o.x = cvtpk(acc[0], acc[1]); o.y = cvtpk(acc[2], acc[3]);
      *(u32x2*)(SL + GS_UT + (16 * nt + c16) * 64 + 16 * mt + 4 * q4) = o;
    } else { const int mt = (id - 32) >> 2, nt = (id - 32) & 3;
#pragma unroll
      for (int ks = 0; ks < 2; ++ks) {
        const v4i16_t a0 = __builtin_amdgcn_ds_read_tr16_b64_v4i16((LAS v4i16_t*)(lds + L_RT + troff + (32 * ks) * RT_P + (128 + 16 * mt) * 2));
        const v4i16_t a1 = __builtin_amdgcn_ds_read_tr16_b64_v4i16((LAS v4i16_t*)(lds + L_RT + troff + (32 * ks + 4) * RT_P + (128 + 16 * mt) * 2));
        const bf16x8 a = {a0[0], a0[1], a0[2], a0[3], a1[0], a1[1], a1[2], a1[3]};
        const bf16x8 b = *(const LAS bf16x8*)(lds + L_TB + (16 * nt + c16) * 144 + (32 * ks + 8 * q4) * 2);
        acc = __builtin_amdgcn_mfma_f32_16x16x32_bf16(a, b, acc, 0, 0, 0); }
      u32x2 o; o.x = cvtpk(-acc[0], -acc[1]); o.y = cvtpk(-acc[2], -acc[3]);
      *(u32x2*)(SL + GS_NW + (16 * nt + c16) * 128 + 32 * (mt >> 1) + 8 * q4 + 4 * (mt & 1)) = o;
    } } }
  lds_barrier();
  PP_T(1, 5);
}

constexpr int SC_STAGE = 62464, SC_MISC = 2 * SC_STAGE;
__device__ __forceinline__ bf16x8 pack_acc2(const f32x4& a, const f32x4& b) { u32x4 o; o.x = cvtpk(a[0], a[1]); o.y = cvtpk(a[2], a[3]); o.z = cvtpk(b[0], b[1]); o.w = cvtpk(b[2], b[3]); return __builtin_bit_cast(bf16x8, o); }
__device__ __forceinline__ bf16x8 lda_perm(const LAS unsigned char* base) { return *(const LAS bf16x8*)base; }

template <bool GDN>
__device__ __forceinline__ void scan_chain(LAS unsigned char* lds, const Params& p, int l, int chain  , int tid) {
  asm volatile("" : "+v"(tid));
  const int lane = tid & 63, w = tid >> 6, c16 = lane & 15, q4 = lane >> 4;
  const bool samp = chain >= 32; const int ch = samp ? chain - 32 : chain; const int b = ch >> 2, h = ch & 3;
  const int slot0 = samp ? 32 * 65 + ch : ch * 65, nch = samp ? 1 : 65;
  const unsigned char* slots = p.ws + (GDN ? WS_GSLOT : WS_MSLOT); constexpr int SLOT_B = GDN ? GSLOT_B : MSLOT_B;
  constexpr int NLD = GDN ? 7 : 5;
  bf16_t* OUT = (bf16_t*)(p.ws + (GDN ? WS_OG : WS_HM));
  LAS float* nvec = (LAS float*)(lds + SC_MISC); LAS float* c1 = nvec + 128; LAS float* c2 = nvec + 192;
  f32x4 S[8]; float mrun = 0.f;
  const int vcol = 16 * w + c16;
  if (!samp) {
#pragma unroll
    for (int i = 0; i < 8; ++i) S[i] = (f32x4){0.f, 0.f, 0.f, 0.f};
    if (!GDN && tid < 128) nvec[tid] = 0.f;
  } else if (GDN) {
    const float* S0 = p.in[7] + (((size_t)l * DB + b) * 4 + h) * 128 * 128;
#pragma unroll
    for (int i = 0; i < 8; ++i)
#pragma unroll
      for (int r = 0; r < 4; ++r) S[i][r] = S0[(size_t)(16 * i + 4 * q4 + r) * 128 + vcol];
  } else {
    const float* C0 = p.in[4] + (((size_t)l * DB + b) * 4 + h) * 128 * 128;
#pragma unroll
    for (int i = 0; i < 8; ++i) S[i] = *(const f32x4*)(C0 + (size_t)vcol * 128 + 16 * i + 4 * q4);
    if (tid < 128) nvec[tid] = p.in[5][(((size_t)l * DB + b) * 4 + h) * 128 + tid];
    mrun = p.in[6][((size_t)l * DB + b) * 4 + h];
  }
  auto lds_dst = [](int ci) -> int {
    if (GDN) { if (ci < 1024) return (ci >> 4) * 272 + (ci & 15) * 16; if (ci < 2048) { ci -= 1024; return 17408 + (ci >> 4) * 272 + (ci & 15) * 16; }
      if (ci < 2560) { ci -= 2048; return 34816 + (ci >> 3) * 144 + (ci & 7) * 16; } ci -= 2560; return 44032 + (ci >> 3) * 144 + (ci & 7) * 16; }
    else { if (ci < 1024) return (ci >> 4) * 272 + (ci & 15) * 16; if (ci < 1536) { ci -= 1024; return 17408 + (ci >> 3) * 144 + (ci & 7) * 16; }
      ci -= 1536; return 26624 + (ci >> 3) * 144 + (ci & 7) * 16; } };
  constexpr int L_A0 = 0;
  constexpr int L_QT = 17408;
  constexpr int L_QK = GDN ? 34816 : 17408;
  constexpr int L_KT = GDN ? 44032 : 26624;
  constexpr int L_SCAL = 45056;
  u32x4 stA[NLD], stB[NLD]; u32x4 scA = {0u, 0u, 0u, 0u}; u32x2 utA[4], utB[4]; float glA = 1.f, glB = 1.f; bf16x8 bvA[2];
  u32x2 utc[4]; float glc = 1.f; bf16x8 bvc[2];
#define SC_LOAD(ST, UT, GL, CH) do { const unsigned char* s_ = slots + (size_t)((!samp && (CH) == 0) ? h * 65 : slot0 + (CH)) * SLOT_B;     const u32x4* g_ = (const u32x4*)s_; const bf16_t* sb_ = (const bf16_t*)s_; \
    _Pragma("unroll") for (int k = 0; k < NLD; ++k) ST[k] = g_[tid + 512 * k]; \
    if (GDN) { _Pragma("unroll") for (int mt = 0; mt < 4; ++mt) UT[mt] = *(const u32x2*)(sb_ + GS_UT + vcol * 64 + 16 * mt + 4 * q4); GL = ((const float*)(s_ + GS_SC_B))[0]; } \
    else { if (tid < 84) scA = g_[3584 + tid]; _Pragma("unroll") for (int ks = 0; ks < 2; ++ks) bvA[ks] = *(const bf16x8*)(sb_ + MS_VT + vcol * 64 + 32 * ks + 8 * q4); } } while (0)
#define SC_STORE(ST, UT, GL, STG) do { LAS unsigned char* nb_ = lds + (STG) * SC_STAGE; \
    _Pragma("unroll") for (int k = 0; k < NLD; ++k) *(LAS u32x4*)(nb_ + lds_dst(tid + 512 * k)) = ST[k]; \
    if (GDN) { _Pragma("unroll") for (int mt = 0; mt < 4; ++mt) utc[mt] = UT[mt]; glc = GL; } \
    else { if (tid < 84) *(LAS u32x4*)(nb_ + L_SCAL + tid * 16) = scA; bvc[0] = bvA[0]; bvc[1] = bvA[1]; } } while (0)
#if PROBE_LEVEL == 2
#define SS_T(i) do { if (GDN) { const unsigned long long t_ = __builtin_amdgcn_s_memrealtime(); sacc_[(i)] += t_ - tl_; tl_ = t_; } } while (0)
  unsigned long long tl_ = __builtin_amdgcn_s_memrealtime(); unsigned long long sacc_[4] = {0ull, 0ull, 0ull, 0ull};
#else
#define SS_T(i) do {} while (0)
#endif
  f32x4 o[4];
  auto step = [&](const int c) {
    LAS unsigned char* cur = lds + (c & 1) * SC_STAGE;
    SS_T(3);
    bf16x8 Sb[4];
#pragma unroll
    for (int kk = 0; kk < 4; ++kk) Sb[kk] = pack_acc2(S[2 * kk], S[2 * kk + 1]);
    if (GDN) {
      f32x4 dl[4];
#pragma unroll
      for (int mt = 0; mt < 4; ++mt) { const u32x2 u = utc[mt]; dl[mt] = (f32x4){bflo(u.x), bfhi(u.x), bflo(u.y), bfhi(u.y)}; o[mt] = (f32x4){0.f, 0.f, 0.f, 0.f}; }
#pragma unroll
      for (int mt = 0; mt < 4; ++mt)
#pragma unroll
        for (int kk = 0; kk < 4; ++kk) {
          const bf16x8 aw = lda_perm(cur + L_A0 + (16 * mt + c16) * 272 + (32 * kk + 8 * q4) * 2);
          const bf16x8 aq = lda_perm(cur + L_QT + (16 * mt + c16) * 272 + (32 * kk + 8 * q4) * 2);
          dl[mt] = __builtin_amdgcn_mfma_f32_16x16x32_bf16(aw, Sb[kk], dl[mt], 0, 0, 0);
          o[mt] = __builtin_amdgcn_mfma_f32_16x16x32_bf16(aq, Sb[kk], o[mt], 0, 0, 0); }
      bf16x8 Db[2];
#pragma unroll
      for (int ks = 0; ks < 2; ++ks) Db[ks] = pack_acc2(dl[2 * ks], dl[2 * ks + 1]);
      asm volatile("" :: "v"(Db[0]), "v"(Db[1])); SS_T(0);
#pragma unroll
      for (int mt = 0; mt < 4; ++mt)
#pragma unroll
        for (int ks = 0; ks < 2; ++ks) { const bf16x8 a = lda_perm(cur + L_QK + (16 * mt + c16) * 144 + (32 * ks + 8 * q4) * 2);
          o[mt] = __builtin_amdgcn_mfma_f32_16x16x32_bf16(a, Db[ks], o[mt], 0, 0, 0); }
      const float gl = glc;
#pragma unroll
      for (int i = 0; i < 8; ++i) { S[i] *= gl;
#pragma unroll
        for (int ks = 0; ks < 2; ++ks) { const bf16x8 a = lda_perm(cur + L_KT + (16 * i + c16) * 144 + (32 * ks + 8 * q4) * 2);
          S[i] = __builtin_amdgcn_mfma_f32_16x16x32_bf16(a, Db[ks], S[i], 0, 0, 0); } }
    } else {
      const LAS float* scal = (const LAS float*)(cur + L_SCAL);
      bf16x8 bv[2];
#pragma unroll
      for (int ks = 0; ks < 2; ++ks) bv[ks] = bvc[ks];
      { const int t = tid >> 3, part = tid & 7; const LAS unsigned char* qr = cur + L_A0 + t * 272 + part * 32; float a = 0.f;
        const u32x4 q0 = *(const LAS u32x4*)qr, q1 = *(const LAS u32x4*)(qr + 16);
        const LAS float* n0 = nvec + 32 * (part >> 1) + 8 * (part & 1); const LAS float* n1 = n0 + 16;
        a += bflo(q0.x) * n0[0] + bfhi(q0.x) * n0[1] + bflo(q0.y) * n0[2] + bfhi(q0.y) * n0[3] + bflo(q0.z) * n1[0] + bfhi(q0.z) * n1[1] + bflo(q0.w) * n1[2] + bfhi(q0.w) * n1[3];
        a += bflo(q1.x) * n0[4] + bfhi(q1.x) * n0[5] + bflo(q1.y) * n0[6] + bfhi(q1.y) * n0[7] + bflo(q1.z) * n1[4] + bfhi(q1.z) * n1[5] + bflo(q1.w) * n1[6] + bfhi(q1.w) * n1[7];
        a = sum8(a);
        if (part == 0) { const float inter = scal[MSC_B + t] + mrun, ml = scal[MSC_MLOC + t]; const float mt_ = fmaxf(inter, ml);
          const float w1 = __expf(inter - mt_), w2 = __expf(ml - mt_); const float den = w1 * a + w2 * scal[MSC_RS + t];
          const float sc_ = 1.f / fmaxf(fabsf(den), __expf(-mt_)); c1[t] = w1 * sc_; c2[t] = w2 * sc_; } }
      f32x4 a1[4], a2[4];
#pragma unroll
      for (int mt = 0; mt < 4; ++mt) { a1[mt] = (f32x4){0.f, 0.f, 0.f, 0.f}; a2[mt] = (f32x4){0.f, 0.f, 0.f, 0.f};
#pragma unroll
        for (int kk = 0; kk < 4; ++kk) { const bf16x8 aq = lda_perm(cur + L_A0 + (16 * mt + c16) * 272 + (32 * kk + 8 * q4) * 2);
          a1[mt] = __builtin_amdgcn_mfma_f32_16x16x32_bf16(aq, Sb[kk], a1[mt], 0, 0, 0); }
#pragma unroll
        for (int ks = 0; ks < 2; ++ks) { const bf16x8 a = *(const LAS bf16x8*)(cur + L_QK + (16 * mt + c16) * 144 + (32 * ks + 8 * q4) * 2);
          a2[mt] = __builtin_amdgcn_mfma_f32_16x16x32_bf16(a, bv[ks], a2[mt], 0, 0, 0); } }
      lds_barrier();
#pragma unroll
      for (int mt = 0; mt < 4; ++mt)
#pragma unroll
        for (int r = 0; r < 4; ++r) { const int t = 16 * mt + 4 * q4 + r; o[mt][r] = c1[t] * a1[mt][r] + c2[t] * a2[mt][r]; }
      const float A = scal[MSC_A], B = scal[MSC_BB]; const float mnew = fmaxf(B + mrun, A); const float alpha = __expf(B + mrun - mnew), beta = __expf(A - mnew);
#pragma unroll
      for (int i = 0; i < 8; ++i) { f32x4 X = {0.f, 0.f, 0.f, 0.f};
#pragma unroll
        for (int ks = 0; ks < 2; ++ks) { const bf16x8 a = *(const LAS bf16x8*)(cur + L_KT + (16 * i + c16) * 144 + (32 * ks + 8 * q4) * 2);
          X = __builtin_amdgcn_mfma_f32_16x16x32_bf16(a, bv[ks], X, 0, 0, 0); }
        S[i] = S[i] * alpha + X * beta; }
      if (tid < 128) nvec[tid] = alpha * nvec[tid] + beta * scal[MSC_DN + tid];
      mrun = mnew;
    }
    asm volatile("" :: "v"(S[0]), "v"(S[7])); SS_T(1);
  };
  auto emit = [&](const int c) {
    const int nvalid = samp ? 16 : (c == 0 ? 16 : 64);
    const int row0 = samp ? ROW_S + 16 * b : (c == 0 ? ROW_M : b * SEQ + 64 * (c - 1));
    { bf16_t* op = OUT + (size_t)(row0 + 4 * q4) * 512 + h * 128 + vcol;
#pragma unroll
      for (int mt = 0; mt < 4; ++mt) if (16 * mt < nvalid) {
#pragma unroll
        for (int r = 0; r < 4; ++r) op[(16 * mt + r) * 512] = f2bf(o[mt][r]); } }
    SS_T(2);
  };
  if (GDN) {
    SC_LOAD(stB, utB, glB, 0); SC_STORE(stB, utB, glB, 0);
    if (nch > 1) SC_LOAD(stA, utA, glA, 1);
    lds_barrier();
    for (int c = 0; c < nch; c += 2) {
      if (c + 2 < nch) SC_LOAD(stB, utB, glB, c + 2);
      step(c);
      if (c + 1 < nch) SC_STORE(stA, utA, glA, 1);
      emit(c);
      lds_barrier();
      if (c + 1 >= nch) break;
      if (c + 3 < nch) SC_LOAD(stA, utA, glA, c + 3);
      step(c + 1);
      if (c + 2 < nch) SC_STORE(stB, utB, glB, 0);
      emit(c + 1);
      lds_barrier();
    }
  } else {
    SC_LOAD(stA, utA, glA, 0); SC_STORE(stA, utA, glA, 0);
    lds_barrier();
    for (int c = 0; c < nch; ++c) {
      if (c + 1 < nch) SC_LOAD(stA, utA, glA, c + 1);
      step(c);
      if (c + 1 < nch) SC_STORE(stA, utA, glA, (c + 1) & 1);
      emit(c);
      lds_barrier();
    }
  }
#undef SC_LOAD
#undef SC_STORE
#if PROBE_LEVEL == 2
  if (GDN && tid == 0 && blockIdx.x == 32 && !samp) { for (int i = 0; i < 4; ++i) ((unsigned long long*)(p.ws + WS_CTL + 2048))[i] += sacc_[i]; }
#endif
  if (GDN) { float* So = p.out + (samp ? O_SS + (((size_t)l * DB + b) * 4 + h) * 16384 : O_PS + (((size_t)l * NB + b) * 4 + h) * 16384);
#pragma unroll
    for (int i = 0; i < 8; ++i)
#pragma unroll
      for (int r = 0; r < 4; ++r) So[(size_t)(16 * i + 4 * q4 + r) * 128 + vcol] = S[i][r];
  } else { float* Co = p.out + (samp ? O_SC + (((size_t)l * DB + b) * 4 + h) * 16384 : O_PC + (((size_t)l * NB + b) * 4 + h) * 16384);
#pragma unroll
    for (int i = 0; i < 8; ++i) *(f32x4*)(Co + (size_t)vcol * 128 + 16 * i + 4 * q4) = S[i];
    if (tid < 128) (p.out + (samp ? O_SN + (((size_t)l * DB + b) * 4 + h) * 128 : O_PN + (((size_t)l * NB + b) * 4 + h) * 128))[tid] = nvec[tid];
    if (tid == 0) (p.out + (samp ? O_SM + ((size_t)l * DB + b) * 4 + h : O_PM + ((size_t)l * NB + b) * 4 + h))[0] = mrun;
  }
  __syncthreads();
}


constexpr int SA_KP = 592;
constexpr int SA_KT = 64 * SA_KP;
constexpr int SA_QOFF = SA_KT;
constexpr int SA_NG = 2;
constexpr int SA_PART = 128 * 264;
constexpr size_t WS_SAPART = WS_END1;
constexpr size_t WS_TPART = al256(WS_SAPART + (size_t)DB * SA_NG * SA_PART * 4);
constexpr size_t WS_X1B = al256(WS_TPART + (size_t)3 * 768 * 1024 * 4);
constexpr size_t WS_END2 = al256(WS_X1B + (size_t)NP * D * 2);

__device__ __forceinline__ void sattn_unit(LAS unsigned char* lds, const Params& p, int l, int b, int g, int tid) {
  asm volatile("" : "+v"(tid));
  const int lane = tid & 63, w = tid >> 6, c16 = lane & 15, q4 = lane >> 4;
  const bf16_t* QS = (const bf16_t*)(p.ws + WS_QS) + (size_t)b * 16 * 768;
  { const int h = w; const bf16_t* WK = (const bf16_t*)(p.ws + WS_WUKR) + (size_t)l * 256 * 512 + h * 64;
    bf16x8 a[2];
#pragma unroll
    for (int ks = 0; ks < 2; ++ks) a[ks] = *(const bf16x8*)(QS + (size_t)c16 * 768 + h * 96 + 32 * ks + 8 * q4);
#pragma unroll
    for (int nt = 0; nt < 16; ++nt) { f32x4 acc = {0.f, 0.f, 0.f, 0.f};
#pragma unroll
      for (int ks = 0; ks < 2; ++ks) { const bf16x8 bb = *(const bf16x8*)(WK + (size_t)(16 * nt + c16) * 512 + 32 * ks + 8 * q4);
        acc = __builtin_amdgcn_mfma_f32_16x16x32_bf16(a[ks], bb, acc, 0, 0, 0); }
#pragma unroll
      for (int r = 0; r < 4; ++r) { const int t = 4 * q4 + r; *(LAS bf16_t*)(lds + SA_QOFF + (t * 8 + h) * SA_KP + (16 * nt + c16) * 2) = f2bf(acc[r]); } }
    { const int row = tid >> 2, part = tid & 3, t = row >> 3, hh = row & 7;
      *(LAS u32x4*)(lds + SA_QOFF + row * SA_KP + 512 + part * 16) = *(const u32x4*)(QS + (size_t)t * 768 + hh * 96 + 64 + part * 8); } }
  const LAS unsigned char* qrow = lds + SA_QOFF + (16 * w + c16) * SA_KP + (8 * q4) * 2;
  const int tile0 = (64 / SA_NG) * g, ntile = g == SA_NG - 1 ? 64 / SA_NG + 1 : 64 / SA_NG;
  const float* CL = p.in[2] + ((size_t)l * DB + b) * NCACHE * 256; const float* CK = p.in[3] + ((size_t)l * DB + b) * NCACHE * 32;
  const float* NL = p.out + O_SLAT + ((size_t)l * DB + b) * DS * 256; const float* NK = p.out + O_SKR + ((size_t)l * DB + b) * DS * 32;
  f32x4 stA[9], stB[9];
#define SA_LOAD(ST, TILE) do { const int tl_ = (TILE); int tj = tid; asm volatile("" : "+v"(tj)); \
    if (tl_ < NCACHE / 64) { const f32x4* cl_ = (const f32x4*)(CL + (size_t)tl_ * 64 * 256) + tj; \
      _Pragma("unroll") for (int k = 0; k < 8; ++k) ST[k] = cl_[512 * k]; \
      ST[8] = ((const f32x4*)(CK + (size_t)tl_ * 64 * 32))[tj]; } \
    else { \
      _Pragma("unroll") for (int k = 0; k < 8; ++k) { const int kg = tl_ * 64 + (tj >> 6) + 8 * k, part = tj & 63; f32x4 v = {0.f, 0.f, 0.f, 0.f}; \
        if (kg < NCACHE) v = *(const f32x4*)(CL + (size_t)kg * 256 + 4 * part); else if (kg < NCACHE + DS) v = *(const f32x4*)(NL + (size_t)(kg - NCACHE) * 256 + 4 * part); ST[k] = v; } \
      { const int kg = tl_ * 64 + (tj >> 3), part = tj & 7; f32x4 v = {0.f, 0.f, 0.f, 0.f}; \
        if (kg < NCACHE) v = *(const f32x4*)(CK + (size_t)kg * 32 + 4 * part); else if (kg < NCACHE + DS) v = *(const f32x4*)(NK + (size_t)(kg - NCACHE) * 32 + 4 * part); ST[8] = v; } } } while (0)
#define SA_STORE(ST) do { int tj = tid; asm volatile("" : "+v"(tj)); \
    _Pragma("unroll") for (int k = 0; k < 8; ++k) { u32x2 o; o.x = cvtpk(ST[k].x, ST[k].y); o.y = cvtpk(ST[k].z, ST[k].w); \
      *(LAS u32x2*)(lds + ((tj >> 6) + 8 * k) * SA_KP + (tj & 63) * 8) = o; } \
    { u32x2 o; o.x = cvtpk(ST[8].x, ST[8].y); o.y = cvtpk(ST[8].z, ST[8].w); *(LAS u32x2*)(lds + (tj >> 3) * SA_KP + 512 + (tj & 7) * 8) = o; } } while (0)
  SA_LOAD(stB, tile0); SA_STORE(stB);
  if (ntile > 1) SA_LOAD(stA, tile0 + 1);
  if (ntile > 2) SA_LOAD(stB, tile0 + 2);
  __syncthreads();
  f32x4 O[16];
#pragma unroll
  for (int i = 0; i < 16; ++i) O[i] = (f32x4){0.f, 0.f, 0.f, 0.f};
  float mrun = -INFINITY, lrun = 0.f;
  auto compute_tile = [&](int j) {
    LAS unsigned char* kb = lds;
    f32x4 s[4];
#pragma unroll
    for (int mt = 0; mt < 4; ++mt) s[mt] = (f32x4){0.f, 0.f, 0.f, 0.f};
#pragma unroll
    for (int ks = 0; ks < 9; ++ks) { const bf16x8 qf = *(const LAS bf16x8*)(qrow + 64 * ks);
#pragma unroll
      for (int mt = 0; mt < 4; ++mt) { const bf16x8 a = *(const LAS bf16x8*)(kb + (16 * mt + c16) * SA_KP + (32 * ks + 8 * q4) * 2);
        s[mt] = __builtin_amdgcn_mfma_f32_16x16x32_bf16(a, qf, s[mt], 0, 0, 0); }
      if (ks % 3 == 2) __builtin_amdgcn_sched_barrier(0); }
    const int kbase = (tile0 + j) * 64;
    float tm = -INFINITY;
#pragma unroll
    for (int mt = 0; mt < 4; ++mt)
#pragma unroll
      for (int r = 0; r < 4; ++r) { if (kbase + 16 * mt + 4 * q4 + r >= NCACHE + DS) s[mt][r] = -INFINITY; tm = fmaxf(tm, s[mt][r]); }
    tm = fmaxf(tm, __shfl_xor(tm, 16)); tm = fmaxf(tm, __shfl_xor(tm, 32));
    const float mnew = fmaxf(mrun, tm); const float alpha = __builtin_amdgcn_exp2f(mrun - mnew); mrun = mnew; float ps = 0.f;
#pragma unroll
    for (int mt = 0; mt < 4; ++mt)
#pragma unroll
      for (int r = 0; r < 4; ++r) { s[mt][r] = __builtin_amdgcn_exp2f(s[mt][r] - mnew); ps += s[mt][r]; }
    lrun = lrun * alpha + ps;
    bf16x8 pb[2];
#pragma unroll
    for (int ks = 0; ks < 2; ++ks) pb[ks] = pack_acc2(s[2 * ks], s[2 * ks + 1]);
    const int vo = (4 * q4 + (c16 >> 2)) * SA_KP + (4 * (c16 & 3)) * 2;
#pragma unroll
    for (int nt = 0; nt < 16; ++nt) { O[nt] *= alpha;
#pragma unroll
      for (int ks = 0; ks < 2; ++ks) {
        const v4i16_t a0 = __builtin_amdgcn_ds_read_tr16_b64_v4i16((LAS v4i16_t*)(kb + vo + (32 * ks) * SA_KP + nt * 32));
        const v4i16_t a1 = __builtin_amdgcn_ds_read_tr16_b64_v4i16((LAS v4i16_t*)(kb + vo + (32 * ks + 16) * SA_KP + nt * 32));
        const bf16x8 va = {a0[0], a0[1], a0[2], a0[3], a1[0], a1[1], a1[2], a1[3]};
        O[nt] = __builtin_amdgcn_mfma_f32_16x16x32_bf16(va, pb[ks], O[nt], 0, 0, 0); }
      if ((nt & 7) == 7) __builtin_amdgcn_sched_barrier(0); }
  };
  for (int j = 0; j < ntile; j += 2) {
    compute_tile(j);
    __syncthreads();
    if (j + 1 < ntile) SA_STORE(stA);
    __syncthreads();
    if (j + 3 < ntile) SA_LOAD(stA, tile0 + j + 3);
    if (j + 1 >= ntile) break;
    compute_tile(j + 1);
    __syncthreads();
    if (j + 2 < ntile) SA_STORE(stB);
    __syncthreads();
    if (j + 4 < ntile) SA_LOAD(stB, tile0 + j + 4);
  }
#undef SA_LOAD
#undef SA_STORE
  float* P = (float*)(p.ws + WS_SAPART) + (size_t)(b * SA_NG + g) * SA_PART + (size_t)(16 * w + c16) * 264;
#pragma unroll
  for (int nt = 0; nt < 16; ++nt) *(f32x4*)(P + 16 * nt + 4 * q4) = O[nt];
  lrun += __shfl_xor(lrun, 16); lrun += __shfl_xor(lrun, 32);
  if (q4 == 0) { P[256] = mrun; P[257] = lrun; }
  __syncthreads();
}

__device__ __forceinline__ void phase_finalize(LAS unsigned char* lds, const Params& p, int l, int gw, int NGW, int lane) {
  const bf16_t* PROJ = (const bf16_t*)(p.ws + WS_PROJ);
  bf16_t* HM = (bf16_t*)(p.ws + WS_HM); bf16_t* OG = (bf16_t*)(p.ws + WS_OG); bf16_t* OA = (bf16_t*)(p.ws + WS_OA);
  const float* mnw = p.in[18] + (size_t)l * 512; const float* gnw = p.in[22] + (size_t)l * 128;
  { const int un = gw >> 3, wv = gw & 7;
    if (un < DB * 8) {
      const int b = un >> 3, h = un & 7, c16 = lane & 15, q4 = lane >> 4;
      const float* P = (const float*)(p.ws + WS_SAPART) + (size_t)(b * SA_NG) * SA_PART + (size_t)(c16 * 8 + h) * 264;
      float mg[SA_NG], M = -INFINITY;
#pragma unroll
      for (int g = 0; g < SA_NG; ++g) { mg[g] = P[(size_t)g * SA_PART + 256]; M = fmaxf(M, mg[g]); }
      float L = 0.f;
#pragma unroll
      for (int g = 0; g < SA_NG; ++g) { mg[g] = __builtin_amdgcn_exp2f(mg[g] - M); L += P[(size_t)g * SA_PART + 257] * mg[g]; }
      const float invL = 1.f / L;
      const bf16_t* WT = (const bf16_t*)(p.ws + WS_WUVT) + (size_t)l * 512 * 256 + (size_t)(h * 64) * 256;
      const int ks = wv;
      f32x4 v0 = {0.f, 0.f, 0.f, 0.f}, v1 = {0.f, 0.f, 0.f, 0.f};
#pragma unroll
      for (int g = 0; g < SA_NG; ++g) { const float* pg = P + (size_t)g * SA_PART + 32 * ks + 8 * q4; v0 += *(const f32x4*)pg * mg[g]; v1 += *(const f32x4*)(pg + 4) * mg[g]; }
      v0 *= invL; v1 *= invL;
      u32x4 aw; aw.x = cvtpk(v0[0], v0[1]); aw.y = cvtpk(v0[2], v0[3]); aw.z = cvtpk(v1[0], v1[1]); aw.w = cvtpk(v1[2], v1[3]);
      const bf16x8 af = __builtin_bit_cast(bf16x8, aw);
      LAS f32x4* red = (LAS f32x4*)lds;
#pragma unroll
      for (int nt = 0; nt < 4; ++nt) { const bf16x8 bf = *(const bf16x8*)(WT + (size_t)(16 * nt + c16) * 256 + 32 * ks + 8 * q4);
        const f32x4 acc = __builtin_amdgcn_mfma_f32_16x16x32_bf16(af, bf, (f32x4){0.f, 0.f, 0.f, 0.f}, 0, 0, 0);
        red[(wv * 4 + nt) * 64 + lane] = acc; }
      __syncthreads();
      if (wv < 4) { const int nt = wv; f32x4 s = red[nt * 64 + lane];
#pragma unroll
        for (int w2 = 1; w2 < 8; ++w2) s += red[(w2 * 4 + nt) * 64 + lane];
#pragma unroll
        for (int r = 0; r < 4; ++r) { const int t = 4 * q4 + r, row = ROW_S + b * 16 + t, col = h * 64 + 16 * nt + c16;
          OA[(size_t)row * 512 + col] = f2bf(s[r] * siluf_(bf2f(PROJ[(size_t)row * PJR + RC_ZA + col]))); } }
      __syncthreads();
    } }
  { const int hh = lane >> 4, c8 = (lane & 15) * 8, col = hh * 128 + c8;
    const f32x4 mn0 = *(const f32x4*)(mnw + col), mn1 = *(const f32x4*)(mnw + col + 4), gn0 = *(const f32x4*)(gnw + c8), gn1 = *(const f32x4*)(gnw + c8 + 4);
    for (int r0 = 2 * gw; r0 < MROWS; r0 += 2 * NGW) {
      u32x4 hv[2], ov[2], zm[2], gv[2], zg[2];
#pragma unroll
      for (int i = 0; i < 2; ++i) { const int r = r0 + i; const bf16_t* pr = PROJ + (size_t)r * PJR;
        hv[i] = *(const u32x4*)(HM + (size_t)r * 512 + col); ov[i] = *(const u32x4*)(pr + RC_MO + col); zm[i] = *(const u32x4*)(pr + RC_ZM + col);
        gv[i] = *(const u32x4*)(OG + (size_t)r * 512 + col); zg[i] = *(const u32x4*)(pr + RC_ZG + col); }
      float a[2][8], g[2][8], sm[2], sg[2];
#pragma unroll
      for (int i = 0; i < 2; ++i) {
        const unsigned hw[4] = {hv[i].x, hv[i].y, hv[i].z, hv[i].w}, ow[4] = {ov[i].x, ov[i].y, ov[i].z, ov[i].w}, gw4[4] = {gv[i].x, gv[i].y, gv[i].z, gv[i].w};
        sm[i] = 0.f; sg[i] = 0.f;
#pragma unroll
        for (int e = 0; e < 4; ++e) { a[i][2 * e] = bflo(hw[e]) * sigmoidf_(bflo(ow[e])); a[i][2 * e + 1] = bfhi(hw[e]) * sigmoidf_(bfhi(ow[e])); g[i][2 * e] = bflo(gw4[e]); g[i][2 * e + 1] = bfhi(gw4[e]);
          sm[i] += a[i][2 * e] * a[i][2 * e] + a[i][2 * e + 1] * a[i][2 * e + 1]; sg[i] += g[i][2 * e] * g[i][2 * e] + g[i][2 * e + 1] * g[i][2 * e + 1]; } }
#pragma unroll
      for (int o = 1; o < 16; o <<= 1)
#pragma unroll
        for (int i = 0; i < 2; ++i) { sm[i] += __shfl_xor(sm[i], o); sg[i] += __shfl_xor(sg[i], o); }
#pragma unroll
      for (int i = 0; i < 2; ++i) { const int r = r0 + i; const float rm = rsqrtf(sm[i] * (1.f / 128.f) + EPS), rg = rsqrtf(sg[i] * (1.f / 128.f) + EPS);
        const unsigned zw[4] = {zm[i].x, zm[i].y, zm[i].z, zm[i].w}, yw[4] = {zg[i].x, zg[i].y, zg[i].z, zg[i].w};
        const float mnv[8] = {mn0.x, mn0.y, mn0.z, mn0.w, mn1.x, mn1.y, mn1.z, mn1.w}, gnv[8] = {gn0.x, gn0.y, gn0.z, gn0.w, gn1.x, gn1.y, gn1.z, gn1.w};
        unsigned om[4], og[4];
#pragma unroll
        for (int e = 0; e < 4; ++e) { om[e] = cvtpk(a[i][2 * e] * rm * mnv[2 * e] * siluf_(bflo(zw[e])), a[i][2 * e + 1] * rm * mnv[2 * e + 1] * siluf_(bfhi(zw[e])));
          og[e] = cvtpk(g[i][2 * e] * rg * gnv[2 * e] * siluf_(bflo(yw[e])), g[i][2 * e + 1] * rg * gnv[2 * e + 1] * siluf_(bfhi(yw[e]))); }
        *(u32x4*)(HM + (size_t)r * 512 + col) = (u32x4){om[0], om[1], om[2], om[3]}; *(u32x4*)(OG + (size_t)r * 512 + col) = (u32x4){og[0], og[1], og[2], og[3]}; }
    } }
#if PROBE_LEVEL == 2
  if (gw == 7 && lane == 0) ((unsigned long long*)(p.ws + WS_CTL + 1024))[52 + l] = __builtin_amdgcn_s_memrealtime();
  if (gw == 807 && lane == 0) ((unsigned long long*)(p.ws + WS_CTL + 1024))[54 + l] = __builtin_amdgcn_s_memrealtime();
#endif
}

struct EpiOut {
  const float* xp; bf16_t* xb; int l;
  __device__ __forceinline__ void operator()(const f32x4 (&acc)[2][2][4][2], int tm, int pn, int wr, int wc, int fr, int fq) const {
#pragma unroll
    for (int ai = 0; ai < 2; ++ai) {
      int fr_ = fr; asm volatile("" : "+v"(fr_) :: "memory");
      f32x4 xa[4][2][2];
#pragma unroll
      for (int m = 0; m < 4; ++m) { const int r = tm * 256 + ai * 128 + wr * 64 + m * 16 + fr_;
#pragma unroll
        for (int bj = 0; bj < 2; ++bj) { const int col0 = pn * 256 + bj * 128 + wc * 32 + 8 * fq;
          if (l == 0) { const float* xi = xp + (size_t)r * D + col0; xa[m][bj][0] = *(const f32x4*)xi; xa[m][bj][1] = *(const f32x4*)(xi + 4); }
          else { const u32x4 w = *(const u32x4*)(xb + (size_t)r * D + col0); xa[m][bj][0] = (f32x4){bflo(w.x), bfhi(w.x), bflo(w.y), bfhi(w.y)}; xa[m][bj][1] = (f32x4){bflo(w.z), bfhi(w.z), bflo(w.w), bfhi(w.w)}; } } }
#pragma unroll
      for (int m = 0; m < 4; ++m) { const int r = tm * 256 + ai * 128 + wr * 64 + m * 16 + fr_;
#pragma unroll
        for (int bj = 0; bj < 2; ++bj) { const int col0 = pn * 256 + bj * 128 + wc * 32 + 8 * fq;
          const f32x4 y0 = xa[m][bj][0] + acc[ai][bj][m][0], y1 = xa[m][bj][1] + acc[ai][bj][m][1];
          u32x4 w; w.x = cvtpk(y0.x, y0.y); w.y = cvtpk(y0.z, y0.w); w.z = cvtpk(y1.x, y1.y); w.w = cvtpk(y1.z, y1.w);
          *(u32x4*)(xb + (size_t)r * D + col0) = w; } }
    }
  }
};

__device__ __forceinline__ void phase_norm_rows_b(const Params& p, int lnext, int gw, int NGW, int lane, int rbeg, int rend) {
  const bf16_t* XB = (const bf16_t*)(p.ws + WS_X1B); bf16_t* XN = (bf16_t*)(p.ws + WS_XN);
  const float* nw = p.in[10] + (size_t)lnext * D + 16 * lane;
  const f32x4 w0 = *(const f32x4*)nw, w1 = *(const f32x4*)(nw + 4), w2 = *(const f32x4*)(nw + 8), w3 = *(const f32x4*)(nw + 12);
  for (int r0 = rbeg + 4 * gw; r0 < rend; r0 += 4 * NGW) {
    u32x4 v[4][2]; float s[4];
#pragma unroll
    for (int i = 0; i < 4; ++i) { const u32x4* xr = (const u32x4*)(XB + (size_t)(r0 + i) * D + 16 * lane); v[i][0] = xr[0]; v[i][1] = xr[1]; }
    float f[4][16];
#pragma unroll
    for (int i = 0; i < 4; ++i) { const unsigned ww[8] = {v[i][0].x, v[i][0].y, v[i][0].z, v[i][0].w, v[i][1].x, v[i][1].y, v[i][1].z, v[i][1].w}; s[i] = 0.f;
#pragma unroll
      for (int e = 0; e < 8; ++e) { f[i][2 * e] = bflo(ww[e]); f[i][2 * e + 1] = bfhi(ww[e]); s[i] += f[i][2 * e] * f[i][2 * e] + f[i][2 * e + 1] * f[i][2 * e + 1]; } }
#pragma unroll
    for (int o = 1; o < 64; o <<= 1)
#pragma unroll
      for (int i = 0; i < 4; ++i) s[i] += __shfl_xor(s[i], o);
#pragma unroll
    for (int i = 0; i < 4; ++i) { const float rstd = rsqrtf(s[i] * (1.f / D) + EPS); const float wv[16] = {w0.x, w0.y, w0.z, w0.w, w1.x, w1.y, w1.z, w1.w, w2.x, w2.y, w2.z, w2.w, w3.x, w3.y, w3.z, w3.w};
      u32x4 o0, o1; unsigned ow[8];
#pragma unroll
      for (int e = 0; e < 8; ++e) ow[e] = cvtpk(f[i][2 * e] * rstd * wv[2 * e], f[i][2 * e + 1] * rstd * wv[2 * e + 1]);
      o0 = (u32x4){ow[0], ow[1], ow[2], ow[3]}; o1 = (u32x4){ow[4], ow[5], ow[6], ow[7]};
      u32x4* xo = (u32x4*)(XN + (size_t)(r0 + i) * D + 16 * lane); xo[0] = o0; xo[1] = o1; }
  }
}
__device__ __forceinline__ void phase_final_norm_b(const Params& p, int gw, int NGW, int lane, int rbeg, int rend) {
  const bf16_t* XB = (const bf16_t*)(p.ws + WS_X1B);
  const float* nw = p.in[24] + 16 * lane;
  const f32x4 w0 = *(const f32x4*)nw, w1 = *(const f32x4*)(nw + 4), w2 = *(const f32x4*)(nw + 8), w3 = *(const f32x4*)(nw + 12);
  for (int r0 = rbeg + 4 * gw; r0 < rend; r0 += 4 * NGW) {
    u32x4 v[4][2]; float s[4];
#pragma unroll
    for (int i = 0; i < 4; ++i) { const u32x4* xr = (const u32x4*)(XB + (size_t)(r0 + i) * D + 16 * lane); v[i][0] = xr[0]; v[i][1] = xr[1]; }
    float f[4][16];
#pragma unroll
    for (int i = 0; i < 4; ++i) { const unsigned ww[8] = {v[i][0].x, v[i][0].y, v[i][0].z, v[i][0].w, v[i][1].x, v[i][1].y, v[i][1].z, v[i][1].w}; s[i] = 0.f;
#pragma unroll
      for (int e = 0; e < 8; ++e) { f[i][2 * e] = bflo(ww[e]); f[i][2 * e + 1] = bfhi(ww[e]); s[i] += f[i][2 * e] * f[i][2 * e] + f[i][2 * e + 1] * f[i][2 * e + 1]; } }
#pragma unroll
    for (int o = 1; o < 64; o <<= 1)
#pragma unroll
      for (int i = 0; i < 4; ++i) s[i] += __shfl_xor(s[i], o);
#pragma unroll
    for (int i = 0; i < 4; ++i) { const float rstd = rsqrtf(s[i] * (1.f / D) + EPS);
      f32x4* yo = (f32x4*)(p.out + O_YP + (size_t)(r0 + i) * D + 16 * lane);
      yo[0] = (f32x4){f[i][0] * rstd * w0.x, f[i][1] * rstd * w0.y, f[i][2] * rstd * w0.z, f[i][3] * rstd * w0.w};
      yo[1] = (f32x4){f[i][4] * rstd * w1.x, f[i][5] * rstd * w1.y, f[i][6] * rstd * w1.z, f[i][7] * rstd * w1.w};
      yo[2] = (f32x4){f[i][8] * rstd * w2.x, f[i][9] * rstd * w2.y, f[i][10] * rstd * w2.z, f[i][11] * rstd * w2.w};
      yo[3] = (f32x4){f[i][12] * rstd * w3.x, f[i][13] * rstd * w3.y, f[i][14] * rstd * w3.z, f[i][15] * rstd * w3.w}; }
  }
}

__device__ __forceinline__ void phase_final_norm(const Params& p, int gw, int NGW, int lane, int rbeg, int rend) {
  const f32x4* wr = (const f32x4*)p.in[24] + lane;
  for (int r0 = rbeg + 4 * gw; r0 < rend; r0 += 4 * NGW) {
    f32x4 v[4][4]; float s[4];
#pragma unroll
    for (int i = 0; i < 4; ++i) { const f32x4* xr = (const f32x4*)xrow_out(p, r0 + i) + lane;
#pragma unroll
      for (int j = 0; j < 4; ++j) v[i][j] = xr[64 * j]; }
#pragma unroll
    for (int i = 0; i < 4; ++i) { s[i] = 0.f;
#pragma unroll
      for (int j = 0; j < 4; ++j) s[i] += (v[i][j].x * v[i][j].x + v[i][j].y * v[i][j].y) + (v[i][j].z * v[i][j].z + v[i][j].w * v[i][j].w); }
#pragma unroll
    for (int o = 1; o < 64; o <<= 1)
#pragma unroll
      for (int i = 0; i < 4; ++i) s[i] += __shfl_xor(s[i], o);
#pragma unroll
    for (int i = 0; i < 4; ++i) { const float rstd = rsqrtf(s[i] * (1.f / D) + EPS); f32x4* xr = (f32x4*)xrow_out(p, r0 + i) + lane;
#pragma unroll
      for (int j = 0; j < 4; ++j) xr[64 * j] = v[i][j] * rstd * wr[64 * j]; }
  }
}


struct EpiPart {
  float* part;
  __device__ __forceinline__ void operator()(const f32x4 (&acc)[2][2][4][2], int tm, int pn, int wr, int wc, int fr, int fq) const {
#pragma unroll
    for (int ai = 0; ai < 2; ++ai)
#pragma unroll
      for (int m = 0; m < 4; ++m) {
        int fr_ = fr; asm volatile("" : "+v"(fr_) :: "memory");
        const int rr = (tm - 128) * 256 + ai * 128 + wr * 64 + m * 16 + fr_; float* pr = part + (size_t)rr * D;
#pragma unroll
        for (int bj = 0; bj < 2; ++bj) { const int col0 = pn * 256 + bj * 128 + wc * 32 + 8 * fq; *(f32x4*)(pr + col0) = acc[ai][bj][m][0]; *(f32x4*)(pr + col0 + 4) = acc[ai][bj][m][1]; }
      }
  }
};
__device__ __forceinline__ void phase_tail_rows(const Params& p, int l, int gw, int NGW, int lane) {
  const float* TP = (const float*)(p.ws + WS_TPART);
  bf16_t* XN = (bf16_t*)(p.ws + WS_XN);
  const int rend = (l + 1 < DEPTH) ? MPAD : ROW_M;
  for (int r = ROW_S + gw; r < rend; r += NGW) {
    if (r >= MROWS) { u32x4 z = {0u, 0u, 0u, 0u}; ((u32x4*)(XN + (size_t)r * D))[lane] = z; ((u32x4*)(XN + (size_t)r * D))[lane + 64] = z; continue; }
    const f32x4* xi = (const f32x4*)xrow_in(p, l, r) + lane; f32x4 v[4]; float s = 0.f;
#pragma unroll
    for (int j = 0; j < 4; ++j) { v[j] = xi[64 * j];
#pragma unroll
      for (int sl = 0; sl < 3; ++sl) v[j] += ((const f32x4*)(TP + ((size_t)sl * 768 + (r - ROW_S)) * D))[lane + 64 * j];
      s += (v[j].x * v[j].x + v[j].y * v[j].y) + (v[j].z * v[j].z + v[j].w * v[j].w); }
    const float rstd = rsqrtf(wave_sum(s) * (1.f / D) + EPS);
    if (l + 1 < DEPTH) {
      f32x4* xo = (f32x4*)xrow_out(p, r) + lane; const f32x4* wr = (const f32x4*)(p.in[10] + (size_t)(l + 1) * D) + lane; unsigned long long* o8 = (unsigned long long*)(XN + (size_t)r * D) + lane;
#pragma unroll
      for (int j = 0; j < 4; ++j) { xo[64 * j] = v[j]; const f32x4 ww = wr[64 * j];
        o8[64 * j] = (unsigned long long)cvtpk(v[j].x * rstd * ww.x, v[j].y * rstd * ww.y) | ((unsigned long long)cvtpk(v[j].z * rstd * ww.z, v[j].w * rstd * ww.w) << 32); }
    } else {
      f32x4* xo = (f32x4*)xrow_out(p, r) + lane; const f32x4* wr = (const f32x4*)p.in[24] + lane;
#pragma unroll
      for (int j = 0; j < 4; ++j) xo[64 * j] = v[j] * rstd * wr[64 * j];
    }
  }
}
#ifndef NLAYERS_RUN
#define NLAYERS_RUN DEPTH
#endif
__device__ __forceinline__ void probe_report(const Params& p, int stage, float err) {
  int mag = 0; if (err > 0.f) { float lg = log10f(err) + 5.f; mag = lg < 0.f ? 0 : (lg > 9.f ? 9 : (int)lg); }
  p.out[0] = (float)(10 * stage + mag) * 1000.f;
}
__device__ __forceinline__ unsigned hash_u(unsigned x) { x ^= x >> 16; x *= 0x7feb352du; x ^= x >> 15; x *= 0x846ca68bu; x ^= x >> 16; return x; }
__device__ __forceinline__ float nerr(float got, float want, float scale) { return fabsf(got - want) / (0.03f * fabsf(want) + 0.03f * scale + 1e-6f); }

__device__ __forceinline__ void probe_checks(const Params& p, int l, long long gt) {
  unsigned* ctl = (unsigned*)(p.ws + WS_CTL);
  const bf16_t* PROJ = (const bf16_t*)(p.ws + WS_PROJ);
  const float* RSTD = (const float*)(p.ws + WS_RSTD);
  const float* ct = (const float*)(p.ws + WS_ROPE); const float* st = ct + ROPE_N * 16;
  const bf16_t* KV = (const bf16_t*)(p.ws + WS_KV);
  const bf16_t* QATT = (const bf16_t*)(p.ws + WS_QATT); const bf16_t* QMETA = (const bf16_t*)(p.ws + WS_QMETA); const bf16_t* QS = (const bf16_t*)(p.ws + WS_QS);
  if (gt < 2048) {
    unsigned hh = hash_u((unsigned)gt + 77u); int r = (int)(hh % MROWS); if ((gt & 7) == 0) r = ROW_M + (int)(hh % 16); if ((gt & 7) == 1) r = ROW_S + (int)(hh % 512);
    hh = hash_u(hh); const int h = (int)(hh % 8); hh = hash_u(hh); const int d = (int)(hh % 96);
    const RowInfo ri = row_info(r); const bf16_t* pr = PROJ + (size_t)r * PJR + PC_CQ;
    float ss = 0.f; for (int k = 0; k < 384; ++k) { const float c = bf2f(pr[k]); ss += c * c; }
    const float rs = rsqrtf(ss / 384.f + EPS);
    auto raw = [&](int dd) { float a = 0.f; for (int k = 0; k < 384; ++k) a += bf2f(pr[k]) * p.in[12][l * 384 + k] * p.in[13][((size_t)l * 384 + k) * 768 + h * 96 + dd]; return a * rs * QSCALE; };
    float want;
    if (d < 64) want = raw(d);
    else { const int i = (d - 64) & 15; const float x1 = raw(64 + i), x2 = raw(80 + i), c = ct[ri.pos * 16 + i], s = st[ri.pos * 16 + i]; want = d < 80 ? x1 * c - x2 * s : x2 * c + x1 * s; }
    float got;
    if (ri.kind == 0) got = bf2f(QATT[((size_t)(ri.b * 8 + h) * SEQ + ri.t) * 96 + d]);
    else if (ri.kind == 1) got = bf2f(QS[(size_t)(r - ROW_S) * 768 + h * 96 + d]);
    else got = bf2f(QMETA[((size_t)h * 256 + ri.t) * 96 + d]);
    atomicMax(ctl + 66, __float_as_uint(nerr(got, want, 0.15f)));
  } else if (gt < 4096) {
    unsigned hh = hash_u((unsigned)gt + 99u); int r = (int)(hh % NP); if ((gt & 7) == 0) r = ROW_M + (int)(hh % 16);
    hh = hash_u(hh); const int col = (int)(hh % 1024); hh = hash_u(hh); const int bsel = (int)(hh % 8);
    const RowInfo ri = row_info(r); const bf16_t* pr = PROJ + (size_t)r * PJR + PC_CKV;
    float a = 0.f; const float* W = (col < 512 ? p.in[15] : p.in[16]) + (size_t)l * 256 * 512 + (col & 511);
    for (int k = 0; k < 256; ++k) a += bf2f(pr[k]) * p.in[14][l * 256 + k] * W[(size_t)k * 512];
    a *= RSTD[2 * r + 1];
    const int h = (col & 511) >> 6, d0 = (col & 63) + (col >= 512 ? 96 : 0);
    const int b = ri.kind == 0 ? ri.b : bsel; const int krow = ri.kind == 0 ? 64 + ri.t : ri.t;
    const bf16_t* kvr = KV + ((size_t)(b * 8 + h) * KVROWS + krow) * 160;
    float e = nerr(bf2f(kvr[d0]), a, 0.2f);
    const int i = col & 31; const float* okr = p.out + O_PKR + (((size_t)l * NB + b) * NCACHE + (ri.kind == 0 ? NMETA + ri.t : ri.t)) * 32;
    e = fmaxf(e, nerr(bf2f(kvr[64 + i]), okr[i], 0.2f));
    atomicMax(ctl + 67, __float_as_uint(e));
  } else if (gt < 4096 + 1536) {
    unsigned hh = hash_u((unsigned)gt + 1234u); const bool meta = (gt & 15) == 0;
    const int b = (int)(hh % 8); hh = hash_u(hh); const int h = (int)(hh % 8); hh = hash_u(hh); int t = (int)(hh % SEQ); if ((gt & 3) == 1) t &= 255; if (meta) t &= 15; hh = hash_u(hh); const int dv = (int)(hh % 64);
    const bf16_t* q = meta ? QMETA + ((size_t)h * 256 + t) * 96 : QATT + ((size_t)(b * 8 + h) * SEQ + t) * 96;
    const bf16_t* kvb = KV + (size_t)(b * 8 + h) * KVROWS * 160;
    const int nown = meta ? 0 : 64 * (t / 64 + 1);
    float mx = -INFINITY, lsum = 0.f, osum = 0.f;
    for (int pass = 0; pass < 2; ++pass)
      for (int k = 0; k < 16 + nown; ++k) { const bf16_t* kr = kvb + (size_t)(k < 16 ? k : 64 + (k - 16)) * 160;
        float s = 0.f; for (int d = 0; d < 96; ++d) s += bf2f(q[d]) * bf2f(kr[d]);
        if (pass == 0) mx = fmaxf(mx, s); else { const float pe = exp2f(s - mx); lsum += pe; osum += pe * bf2f(kr[96 + dv]); } }
    const int r = meta ? ROW_M + t : b * SEQ + t;
    const bf16_t* xn = (const bf16_t*)(p.ws + WS_XN) + (size_t)r * 1024; const bf16_t* wz = (const bf16_t*)(p.ws + WS_WIN) + ((size_t)l * PJ + PC_ZA + h * 64 + dv) * 1024;
    float z = 0.f; for (int k = 0; k < 1024; ++k) z += bf2f(xn[k]) * bf2f(wz[k]);
    const float want = osum / lsum * siluf_(z);
    const float got = bf2f(PROJ[(size_t)r * PJR + RC_ZA + h * 64 + dv]);
    atomicMax(ctl + 68, __float_as_uint(nerr(got, want, 0.02f)));
  }
}


__device__ __forceinline__ int queue_next(unsigned* ctr, LAS unsigned char* lds, int tid) {
  LAS int* slot = (LAS int*)(lds + 147440);
  if (tid == 0) *slot = (int)atomicAdd(ctr, 1u);
  __syncthreads();
  const int v = *slot;
  __syncthreads();
  return v;
}

#define OPQ_TID() int tq = threadIdx.x; asm volatile("" : "+v"(tq)); const Params& pq = p; int bq = blockIdx.x; asm volatile("" : "+s"(bq)); const int lq = tq & 63; const int gwq = blockIdx.x * NWAVES + (tq >> 6); (void)lq; (void)gwq

#define XB_TMO      128
#define XB_XCNT(j)  (256  + 64 * (j))
#define XB_XSUB(j)  (1280 + 64 * (j))
#define XB_XGEN(j)  (2304 + 64 * (j))
#define XB_TOP      3328
#define XB_TOPGEN   3392
#define XCD_BAR_WORDS 3456
#define XB_SPIN_CAP (1u << 22)
__device__ __forceinline__ unsigned xb_ld(unsigned* p)              { return __hip_atomic_load(p, __ATOMIC_RELAXED, __HIP_MEMORY_SCOPE_AGENT); }
__device__ __forceinline__ unsigned xb_add(unsigned* p, unsigned v) { return __hip_atomic_fetch_add(p, v, __ATOMIC_RELAXED, __HIP_MEMORY_SCOPE_AGENT); }
__device__ __forceinline__ unsigned xb_xcc_id() { return (unsigned)__builtin_amdgcn_s_getreg((3 << 11) | 20) & 0xFu; }
#define XB_SPIN(cond, bar) do { unsigned _sp = 0; while (cond) { __builtin_amdgcn_s_sleep(1); \
    if ((++_sp & 255u) == 0u) { if (xb_ld(&(bar)[XB_TMO])) break; if (_sp > XB_SPIN_CAP) { atomicAdd(&(bar)[XB_TMO], 1u); break; } } } } while (0)
struct XcdBarrier { unsigned* bar; unsigned x; volatile LAS unsigned* st; };
__device__ __forceinline__ XcdBarrier xcd_barrier_post(unsigned* bar, volatile LAS unsigned* st) {
  XcdBarrier b; b.bar = bar; b.x = xb_xcc_id(); b.st = st;
  if (threadIdx.x == 0) (void)xb_add(&bar[XB_XCNT(b.x)], 1u);
  return b;
}
__device__ __forceinline__ void xcd_barrier_complete(unsigned* bar, unsigned x, unsigned& nloc, unsigned& nx) {
  const unsigned G = gridDim.x * gridDim.y * gridDim.z;
  unsigned sum, cnt, mine, sp = 0u;
  for (;;) {
    sum = 0u; cnt = 0u; mine = 0u;
#pragma unroll
    for (unsigned j = 0; j < 16; ++j) { const unsigned c = xb_ld(&bar[XB_XCNT(j)]); sum += c; cnt += (c > 0u) ? 1u : 0u; mine = (j == x) ? c : mine; }
    if (sum == G) break;
    __builtin_amdgcn_s_sleep(1);
    if ((++sp & 255u) == 0u) { if (xb_ld(&bar[XB_TMO])) break; if (sp > XB_SPIN_CAP) { atomicAdd(&bar[XB_TMO], 1u); break; } }
  }
  nloc = mine > 0u ? mine : 1u; nx = cnt > 0u ? cnt : 1u;
}
__device__ __forceinline__ void xcd_barrier(const XcdBarrier& b) {
  asm volatile("s_waitcnt vmcnt(0)" ::: "memory");
  __syncthreads();
  if (threadIdx.x == 0) {
    unsigned* bar = b.bar;
    __builtin_amdgcn_s_waitcnt(0);
    unsigned nloc = b.st[0], nx = b.st[1];
    if (nloc == 0u) { xcd_barrier_complete(bar, b.x, nloc, nx); b.st[0] = nloc; b.st[1] = nx; }
    const unsigned old = xb_add(&bar[XB_XSUB(b.x)], 1u);
    const unsigned gen = old / nloc;
    if (old + 1u == (gen + 1u) * nloc) {
      __builtin_amdgcn_fence(__ATOMIC_RELEASE, "agent");
      asm volatile("s_waitcnt vmcnt(0)" ::: "memory");
      const unsigned og = xb_add(&bar[XB_TOP], 1u);
      const unsigned tg = og / nx;
      if (og + 1u == (tg + 1u) * nx) xb_add(&bar[XB_TOPGEN], 1u);
      else XB_SPIN(xb_ld(&bar[XB_TOPGEN]) == tg, bar);
      __builtin_amdgcn_fence(__ATOMIC_ACQUIRE, "agent");
      xb_add(&bar[XB_XGEN(b.x)], 1u);
      asm volatile("s_waitcnt vmcnt(0)" ::: "memory");
    } else {
      XB_SPIN(xb_ld(&bar[XB_XGEN(b.x)]) == gen, bar);
      __builtin_amdgcn_fence(__ATOMIC_ACQUIRE, "agent");
      asm volatile("s_waitcnt vmcnt(0)" ::: "memory");
    }
  }
  __syncthreads();
}

#if PROBE_LEVEL == 2
#define STAMP(i) do { if (blockIdx.x == 0 && threadIdx.x == 0) ((unsigned long long*)(p.ws + WS_CTL + 1024))[i] = __builtin_amdgcn_s_memrealtime(); } while (0)
#define BSTAMP(blk, i) do { if (blockIdx.x == (blk) && threadIdx.x == 0) ((unsigned long long*)(p.ws + WS_CTL + 1024))[i] = __builtin_amdgcn_s_memrealtime(); } while (0)
#else
#define STAMP(i) do {} while (0)
#define BSTAMP(blk, i) do {} while (0)
#endif
template <int l>
__device__ __forceinline__ void run_layer(const Params& p, LAS unsigned char* lds, const XcdBarrier& gbar) {
  const int NGW = gridDim.x * NWAVES; const int G = gridDim.x, bx = blockIdx.x;
  bf16_t* PROJ = (bf16_t*)(p.ws + WS_PROJ);
  unsigned* ctl = (unsigned*)(p.ws + WS_CTL);

    {
      asm volatile("" ::: "memory");
      pg8::Gemm g{(const bf16_t*)(p.ws + WS_XN), (const bf16_t*)(p.ws + WS_WIN) + (size_t)l * PJ * 1024, 1024, 1024, 1024, 1 << 20, 0};
      OrderAll S; S.init(MPAD / 256, PJ / 256, G, bx);
      EpiProj E{PROJ, (bf16_t*)(p.ws + WS_PROJH)};
      pg8::gemm_phase(lds, g, S, E);
    }
    xcd_barrier(gbar); STAMP(1 + 7 * l + 1);
    { OPQ_TID(); phase_rowpass(pq, l, gwq, NGW, lq);
#if PROBE_LEVEL == 2
      BSTAMP(0, 46 + l);
      {
        int slot = prep_next_slot(bq - G, G), buf = 0;
        const float* gb_ = pq.in[17] + l * 8; const float gb0 = gb_[0], gb1 = gb_[1], gb2 = gb_[2], gb3 = gb_[3], gb4 = gb_[4], gb5 = gb_[5], gb6 = gb_[6], gb7 = gb_[7];
        __syncthreads();
        if (slot < NSLOT) { mlstm_issue(lds, pq, slot, 0, tq); asm volatile("s_waitcnt vmcnt(0)" ::: "memory"); }
        while (slot < NSLOT) {
          const int nslot = prep_next_slot(slot, G);
#if PROBE_LEVEL == 2
          const unsigned long long tw0_ = __builtin_amdgcn_s_memrealtime();
#endif
          lds_barrier();
#if PROBE_LEVEL == 2
          if (tq == 0 && bq == 0) ((unsigned long long*)(pq.ws + WS_CTL + 2048))[11] += __builtin_amdgcn_s_memrealtime() - tw0_;
#endif
          if (nslot < NSLOT) mlstm_issue(lds, pq, nslot, buf ^ 1, tq);
          { const int hh = (slot < 32 * 65 ? slot / 65 : slot - 32 * 65) & 3;
            mlstm_prep(lds, pq, l, slot, buf, hh == 0 ? gb0 : (hh == 1 ? gb1 : (hh == 2 ? gb2 : gb3)), hh == 0 ? gb4 : (hh == 1 ? gb5 : (hh == 2 ? gb6 : gb7)), tq); }
          slot = nslot; buf ^= 1; }
        __syncthreads();
#if PROBE_LEVEL == 2
        const unsigned long long tg0_ = __builtin_amdgcn_s_memrealtime();
#endif
        {
          unsigned* gq = ctl + 16 + l; LAS int* qs_ = (LAS int*)(lds + 147440);
          if (tq == 0) { qs_[0] = (int)atomicAdd(gq, 1u); qs_[1] = (int)atomicAdd(gq, 1u); }
          __syncthreads();
          int cur = gdn_queue_slot(__builtin_amdgcn_readfirstlane(qs_[0])), nxt = gdn_queue_slot(__builtin_amdgcn_readfirstlane(qs_[1]));
          __syncthreads();
          bool have = false;
          while (cur < NSLOT) {
            unsigned pend = 0u; if (tq == 0) pend = atomicAdd(gq, 1u);
            gdn_prep(lds, pq, l, cur, have, nxt, tq);
            have = nxt < NSLOT && gdn_slot_interior(nxt);
            if (tq == 0) qs_[0] = (int)pend;
            lds_barrier();
            cur = nxt; nxt = gdn_queue_slot(__builtin_amdgcn_readfirstlane(qs_[0]));
            lds_barrier();
          }
        }
#if PROBE_LEVEL == 2
        __syncthreads(); if (tq == 0 && bq == 0) ((unsigned long long*)(pq.ws + WS_CTL + 2048))[12] += __builtin_amdgcn_s_memrealtime() - tg0_;
#endif
      }
#else
      {
        int slot = prep_next_slot(bq - G, G), buf = 0;
        const float* gb_ = pq.in[17] + l * 8; const float gb0 = gb_[0], gb1 = gb_[1], gb2 = gb_[2], gb3 = gb_[3], gb4 = gb_[4], gb5 = gb_[5], gb6 = gb_[6], gb7 = gb_[7];
        __syncthreads();
        if (slot < NSLOT) { mlstm_issue(lds, pq, slot, 0, tq); asm volatile("s_waitcnt vmcnt(0)" ::: "memory"); }
        while (slot < NSLOT) {
          const int nslot = prep_next_slot(slot, G);
#if PROBE_LEVEL == 2
          const unsigned long long tw0_ = __builtin_amdgcn_s_memrealtime();
#endif
          lds_barrier();
#if PROBE_LEVEL == 2
          if (tq == 0 && bq == 0) ((unsigned long long*)(pq.ws + WS_CTL + 2048))[11] += __builtin_amdgcn_s_memrealtime() - tw0_;
#endif
          if (nslot < NSLOT) mlstm_issue(lds, pq, nslot, buf ^ 1, tq);
          { const int hh = (slot < 32 * 65 ? slot / 65 : slot - 32 * 65) & 3;
            mlstm_prep(lds, pq, l, slot, buf, hh == 0 ? gb0 : (hh == 1 ? gb1 : (hh == 2 ? gb2 : gb3)), hh == 0 ? gb4 : (hh == 1 ? gb5 : (hh == 2 ? gb6 : gb7)), tq); }
          slot = nslot; buf ^= 1; }
        __syncthreads();
#if PROBE_LEVEL == 2
        const unsigned long long tg0_ = __builtin_amdgcn_s_memrealtime();
#endif
        {
          unsigned* gq = ctl + 16 + l; LAS int* qs_ = (LAS int*)(lds + 147440);
          if (tq == 0) { qs_[0] = (int)atomicAdd(gq, 1u); qs_[1] = (int)atomicAdd(gq, 1u); }
          __syncthreads();
          int cur = gdn_queue_slot(__builtin_amdgcn_readfirstlane(qs_[0])), nxt = gdn_queue_slot(__builtin_amdgcn_readfirstlane(qs_[1]));
          __syncthreads();
          bool have = false;
          while (cur < NSLOT) {
            unsigned pend = 0u; if (tq == 0) pend = atomicAdd(gq, 1u);
            gdn_prep(lds, pq, l, cur, have, nxt, tq);
            have = nxt < NSLOT && gdn_slot_interior(nxt);
            if (tq == 0) qs_[0] = (int)pend;
            lds_barrier();
            cur = nxt; nxt = gdn_queue_slot(__builtin_amdgcn_readfirstlane(qs_[0]));
            lds_barrier();
          }
        }
#if PROBE_LEVEL == 2
        __syncthreads(); if (tq == 0 && bq == 0) ((unsigned long long*)(pq.ws + WS_CTL + 2048))[12] += __builtin_amdgcn_s_memrealtime() - tg0_;
#endif
      }
#endif
    }
    xcd_barrier(gbar); STAMP(1 + 7 * l + 2);
    {
      const float* rstd = (const float*)(p.ws + WS_RSTD); const float* ct = (const float*)(p.ws + WS_ROPE);
      { pg8::Gemm g{PROJ + PC_CQ, (const bf16_t*)(p.ws + WS_WUQ) + (size_t)l * 768 * 384, PJR, 384, 384, 1 << 20, 0};
        OrderAll S; S.init(MPAD / 256, 3, G, bx);
        EpiQ E{rstd, ct, ct + ROPE_N * 16, (bf16_t*)(p.ws + WS_QATT), (bf16_t*)(p.ws + WS_QMETA), (bf16_t*)(p.ws + WS_QS)};
        pg8::gemm_phase(lds, g, S, E); }
      { pg8::Gemm g{PROJ + PC_CKV, (const bf16_t*)(p.ws + WS_WUKV) + (size_t)l * 1024 * 256, PJR, 256, 256, 1 << 20, 0};
        OrderKV S; S.init(129, 4, G, (bx + 119) % G);
        EpiKV E{rstd, (bf16_t*)(p.ws + WS_KV)};
        pg8::gemm_phase(lds, g, S, E); }
    }
    xcd_barrier(gbar); STAMP(1 + 7 * l + 3);
    {
      OPQ_TID();
      if (bq < 32) { for (int k = 0; k < 5; ++k) scan_chain<false>(lds, pq, l, k == 0 ? bq : 32 + bq * 4 + k - 1, tq); }
      else if (bq < 64) { for (int k = 0; k < 5; ++k) scan_chain<true>(lds, pq, l, k == 0 ? bq - 32 : 32 + (bq - 32) * 4 + k - 1, tq); }
      else { for (int u = bq - 64; u < DB * SA_NG; u += G - 64) sattn_unit(lds, pq, l, u / SA_NG, u % SA_NG, tq); }
      BSTAMP(0, 40 + l); BSTAMP(32, 42 + l); BSTAMP(64, 44 + l);
      for (;;) {
        const int idx = queue_next(ctl + 8 + l, lds, tq);
        if (idx >= 1024 + 8) break;
        AttnUnit u;
        if (idx < 1024) { const int qb = 15 - (idx >> 6), bh = idx & 63;
          u.q = (const bf16_t*)(p.ws + WS_QATT) + ((size_t)bh * SEQ + 256 * qb) * 96; u.kv = (const bf16_t*)(p.ws + WS_KV) + (size_t)bh * KVROWS * 160;
          u.chunk0 = 4 * qb; u.ntiles = 4 * qb + 5; u.nq_valid = 256; u.out_row0 = (bh >> 3) * SEQ + 256 * qb; u.h = bh & 7; u.is_meta = 0; }
        else { const int h = idx - 1024;
          u.q = (const bf16_t*)(p.ws + WS_QMETA) + (size_t)h * 256 * 96; u.kv = (const bf16_t*)(p.ws + WS_KV) + (size_t)h * KVROWS * 160;
          u.chunk0 = 0; u.ntiles = 1; u.nq_valid = 16; u.out_row0 = ROW_M; u.h = h; u.is_meta = 1; }
        attn_unit(lds, u, PROJ, (bf16_t*)(p.ws + WS_OA), tq, p.ws);
      }
    }
    xcd_barrier(gbar); STAMP(1 + 7 * l + 4);
#if PROBE_LEVEL == 1
    if (l == 0) {
      probe_checks(p, l, (long long)bx * NTHREADS + tid);
      xcd_barrier(gbar);
      if (bx == 0 && tid == 0) {
        int stage = 9; float e = 0.f;
        for (int s = 8; s >= 2; --s) { const float es = __uint_as_float(ctl[64 + s]); if (es > 1.f) { stage = s; e = es; } }
        if (stage == 9) for (int s = 2; s <= 8; ++s) e = fmaxf(e, __uint_as_float(ctl[64 + s]));
        probe_report(p, stage, e); }
      return;
    }
#endif
    { OPQ_TID(); phase_finalize(lds, pq, l, gwq, NGW, lq); }
    xcd_barrier(gbar); STAMP(1 + 7 * l + 5);
    {
      pg8::Gemm g{(const bf16_t*)(p.ws + WS_OA), (const bf16_t*)(p.ws + WS_WOUT) + (size_t)l * D * DMIX, 512, DMIX, DMIX, 8, SEG_B};
      OrderAll S; S.init(128, 4, G, bx);
      EpiOut E{p.in[0], (bf16_t*)(p.ws + WS_X1B), l};
      pg8::gemm_phase(lds, g, S, E);
    }
    xcd_barrier(gbar); STAMP(1 + 7 * l + 6);
    { OPQ_TID();
      constexpr int NX = (l + 1 < DEPTH) ? 12 : 8;
      if (bq < 3 * NX) {
        const int sl = bq / NX, uu = bq - sl * NX;
        pg8::Gemm g{(const bf16_t*)(p.ws + WS_OA + (size_t)sl * SEG_B), (const bf16_t*)(p.ws + WS_WOUT) + (size_t)l * D * DMIX + sl * 512, 512, DMIX, 512, 1 << 20, 0};
        OrderTail S; S.init(NX / 4, 4, NX, uu);
        EpiPart E{(float*)(p.ws + WS_TPART) + (size_t)sl * 768 * D};
        pg8::gemm_phase(lds, g, S, E);
        BSTAMP(0, 56 + l);
      } else {
        const int gw2 = (bq - 3 * NX) * NWAVES + (tq >> 6), NGW2 = (G - 3 * NX) * NWAVES;
        if (l + 1 < DEPTH) { phase_norm_rows_b(pq, l + 1, gw2, NGW2, lq, 0, 16384); phase_norm_rows_b(pq, l + 1, gw2, NGW2, lq, 16768, ROW_S); }
        else phase_final_norm_b(pq, gw2, NGW2, lq, 0, ROW_S);
        BSTAMP(100, 58 + l);
      }
    }
    xcd_barrier(gbar);
    { OPQ_TID(); phase_tail_rows(pq, l, gwq, NGW, lq); if (l + 1 < DEPTH) phase_norm_rows_b(pq, l + 1, gwq, NGW, lq, 16384, 16768); }
    if (l + 1 < DEPTH) { xcd_barrier(gbar); STAMP(1 + 7 * l + 7); }

}

__global__ void __launch_bounds__(NTHREADS, 2) mk_fwd(Params p) {
  extern __shared__ __attribute__((aligned(16))) unsigned char lds_raw[];
  LAS unsigned char* lds = (LAS unsigned char*)lds_raw;
  cg::grid_group grid = cg::this_grid();
  const int tid = threadIdx.x;
  const int lane = tid & 63, wave = tid >> 6;
  const int gw = blockIdx.x * NWAVES + wave, NGW = gridDim.x * NWAVES;
  const int G = gridDim.x, bx = blockIdx.x;
  bf16_t* PROJ = (bf16_t*)(p.ws + WS_PROJ);
  unsigned* ctl = (unsigned*)(p.ws + WS_CTL);

  if (threadIdx.x < 2) ((LAS unsigned*)(lds + 147424))[threadIdx.x] = 0u;
  __syncthreads();
  const XcdBarrier gbar = xcd_barrier_post((unsigned*)(p.ws + WS_BAR), (volatile LAS unsigned*)(lds + 147424));
  STAMP(0);
#if PROBE_LEVEL == 2
  if (threadIdx.x < 16 && blockIdx.x == 200) ((unsigned long long*)(p.ws + WS_CTL + 2048))[threadIdx.x] = 0ull;
#endif
  phase0(p, lds, tid);
  grid.sync(); STAMP(1);
  run_layer<0>(p, lds, gbar);
  if (NLAYERS_RUN > 1) run_layer<1>(p, lds, gbar);
#if PROBE_LEVEL == 2
  STAMP(15);
  grid.sync();
  if (blockIdx.x == 0) {
    const unsigned long long* ts = (const unsigned long long*)(p.ws + WS_CTL + 1024);
    const long long offs[13] = {O_YP, O_YS, O_PLAT, O_PKR, O_PC, O_PN, O_PM, O_PS, O_PCONV, O_SLAT, O_SKR, O_SC, O_SN};
    unsigned d[13];
    for (int k = 0; k < 6; ++k) d[k] = (unsigned)((ts[k + 1] - ts[k]) / 100);
    for (int k = 0; k < 6; ++k) d[k] = (unsigned)((ts[k + 1] - ts[k]) / 100);
    d[6] = 1; d[7] = (unsigned)((ts[7] - ts[6]) / 100); d[8] = (unsigned)((ts[8] - ts[7]) / 100);
    d[9] = (unsigned)((ts[50] - ts[5]) / 100); d[10] = (unsigned)((ts[52] - ts[5]) / 100); d[11] = (unsigned)((ts[56] - ts[7]) / 100); d[12] = (unsigned)((ts[58] - ts[7]) / 100);
    d[3] = (unsigned)((ts[54] - ts[5]) / 100);
    for (int k = 0; k < 13; ++k) { unsigned n = d[k]; if (k == 6 && n > 64) n = 64; if (k == 5 && n > 8192) n = 8192; if (n > 30000) n = 30000;
      for (unsigned i = threadIdx.x; i < n; i += NTHREADS) p.out[offs[k] + i] = __uint_as_float(0xAAAAAAAAu); }
  }
#endif
}

extern "C" void kernel_launch(void* const* d_in, const int* in_sizes, int n_in, void* d_out, int out_size,
                              void* d_ws, size_t ws_size, hipStream_t stream) {
  constexpr int LDS_BYTES = 144 * 1024;
  static int grid_blocks = 0;
  if (!grid_blocks) {
    int dev = 0, cus = 0, per_cu = 0;
    (void)hipGetDevice(&dev);
    (void)hipDeviceGetAttribute(&cus, hipDeviceAttributeMultiprocessorCount, dev);
    (void)hipFuncSetAttribute((const void*)mk_fwd, hipFuncAttributeMaxDynamicSharedMemorySize, LDS_BYTES);
    (void)hipOccupancyMaxActiveBlocksPerMultiprocessor(&per_cu, (const void*)mk_fwd, NTHREADS, LDS_BYTES);
    if (per_cu < 1) per_cu = 1;
    grid_blocks = cus * 1;
    if (n_in != 25 || (long long)out_size != O_END || ws_size < WS_END2) { fprintf(stderr, "kernel_launch: unexpected sizes n_in=%d out=%d ws=%zu (need %zu)\n", n_in, out_size, ws_size, (size_t)WS_END2); grid_blocks = -1; }
  }
  if (grid_blocks < 0) return;
  (void)hipMemsetAsync((unsigned char*)d_ws + WS_BAR, 0, 14336 + 256, stream);
  Params p{};
  for (int i = 0; i < 25; ++i) p.in[i] = (const float*)d_in[i];
  p.out = (float*)d_out; p.ws = (unsigned char*)d_ws; p.ph_lo = 0; p.ph_hi = 100; p.probe = 0; p.pad = 0;
  void* args[] = {&p};
  hipError_t e = hipLaunchCooperativeKernel((const void*)mk_fwd, dim3(grid_blocks), dim3(NTHREADS), args, LDS_BYTES, stream);
  if (e != hipSuccess) fprintf(stderr, "cooperative launch failed: %s (grid %d)\n", hipGetErrorString(e), grid_blocks);
}
```

```cpp
#define PROBE_LEVEL 0
#include <hip/hip_runtime.h>
#include <hip/hip_cooperative_groups.h>
#include <cstdio>
#include <cstdint>
namespace cg = cooperative_groups;

#define LAS __attribute__((address_space(3)))
typedef unsigned short bf16_t;
typedef short bf16x8 __attribute__((ext_vector_type(8)));
typedef short s16x4 __attribute__((ext_vector_type(4)));
typedef float f32x4 __attribute__((ext_vector_type(4)));
typedef float f32x2 __attribute__((ext_vector_type(2)));
typedef float f32x16 __attribute__((ext_vector_type(16)));
typedef unsigned u32x4 __attribute__((ext_vector_type(4)));
typedef unsigned u32x2 __attribute__((ext_vector_type(2)));
typedef __bf16 bf16x2_t __attribute__((ext_vector_type(2)));

__device__ __forceinline__ unsigned cvtpk(float lo, float hi) { f32x2 v = {lo, hi}; bf16x2_t b = __builtin_convertvector(v, bf16x2_t); return __builtin_bit_cast(unsigned, b); }
__device__ __forceinline__ bf16_t f2bf(float x) { return (bf16_t)(cvtpk(x, 0.f) & 0xffffu); }
__device__ __forceinline__ float bf2f(bf16_t x) { return __uint_as_float(((unsigned)x) << 16); }
__device__ __forceinline__ float bflo(unsigned w) { return __uint_as_float(w << 16); }
__device__ __forceinline__ float bfhi(unsigned w) { return __uint_as_float(w & 0xffff0000u); }

constexpr int D = 1024, NB = 8, SEQ = 4096, DEPTH = 2, DB = 32, DS = 16, NMETA = 16, NCACHE = 4112;
constexpr int NP = NB * SEQ;
constexpr int NS = DB * DS;
constexpr int ROW_S = NP, ROW_M = NP + NS, MROWS = ROW_M + NMETA, MPAD = 33536;
constexpr int INC = 5808;
constexpr int PJ = 5888;
constexpr int PJR = 2816;
constexpr int RC_MO = 704, RC_ZA = 1216, RC_ZM = 1728, RC_ZG = 2240;
constexpr int PC_CKV = 0, PC_CQ = 256, PC_KR = 640, PC_G16 = 672, PC_MQ = 704, PC_MK = 1216, PC_MV = 1728, PC_MO = 2240,
              PC_GQ = 2752, PC_GK = 3264, PC_GV = 3776, PC_ZA = 4288, PC_ZM = 4800, PC_ZG = 5312, PC_END = 5824;
constexpr int DMIX = 1536;
constexpr int NTHREADS = 512, NWAVES = 8;
constexpr float EPS = 1e-6f;
constexpr float QSCALE = 0.10206207261596575f * 1.4426950408889634f;

constexpr long long O_YP = 0;
constexpr long long O_YS = O_YP + (long long)NB * SEQ * D;
constexpr long long O_PLAT = O_YS + (long long)DB * DS * D;
constexpr long long O_PKR = O_PLAT + (long long)DEPTH * NB * NCACHE * 256;
constexpr long long O_PC = O_PKR + (long long)DEPTH * NB * NCACHE * 32;
constexpr long long O_PN = O_PC + (long long)DEPTH * NB * 4 * 128 * 128;
constexpr long long O_PM = O_PN + (long long)DEPTH * NB * 4 * 128;
constexpr long long O_PS = O_PM + (long long)DEPTH * NB * 4;
constexpr long long O_PCONV = O_PS + (long long)DEPTH * NB * 4 * 128 * 128;
constexpr long long O_SLAT = O_PCONV + (long long)DEPTH * NB * 3 * 1536;
constexpr long long O_SKR = O_SLAT + (long long)DEPTH * DB * DS * 256;
constexpr long long O_SC = O_SKR + (long long)DEPTH * DB * DS * 32;
constexpr long long O_SN = O_SC + (long long)DEPTH * DB * 4 * 128 * 128;
constexpr long long O_SM = O_SN + (long long)DEPTH * DB * 4 * 128;
constexpr long long O_SS = O_SM + (long long)DEPTH * DB * 4;
constexpr long long O_SCONV = O_SS + (long long)DEPTH * DB * 4 * 128 * 128;
constexpr long long O_END = O_SCONV + (long long)DEPTH * DB * 3 * 1536;

constexpr size_t al256(size_t x) { return (x + 255) & ~(size_t)255; }
constexpr size_t WS_CTL = 0;
constexpr size_t WS_BAR = 16384;
constexpr size_t WS_ZERO = WS_BAR + 14336;
constexpr size_t WS_WQ = WS_ZERO + 256;
constexpr size_t WS_ROPE = 32768;
constexpr size_t ROPE_N = 4160;
constexpr size_t WS_WIN = al256(WS_ROPE + ROPE_N * 16 * 4 * 2);
constexpr size_t WS_WUQ = al256(WS_WIN + (size_t)2 * PJ * 1024 * 2);
constexpr size_t WS_WUKV = al256(WS_WUQ + (size_t)2 * 768 * 384 * 2);
constexpr size_t WS_WOUT = al256(WS_WUKV + (size_t)2 * 1024 * 256 * 2);
constexpr size_t WS_WUKR = al256(WS_WOUT + (size_t)2 * 1024 * 1536 * 2);
constexpr size_t WS_WUVT = al256(WS_WUKR + (size_t)2 * 256 * 512 * 2);
constexpr size_t WS_XMETA = al256(WS_WUVT + (size_t)2 * 512 * 256 * 2);
constexpr size_t WS_RSTD = al256(WS_XMETA + 16 * 1024 * 4);
constexpr size_t SEG_B = (size_t)MPAD * 512 * 2;
constexpr size_t WS_OA = al256(WS_RSTD + (size_t)MPAD * 2 * 4);
constexpr size_t WS_XN = WS_OA + SEG_B;
constexpr size_t WS_PROJ = al256(WS_XN + (size_t)MPAD * 1024 * 2);
constexpr size_t WS_PROJH = WS_PROJ + (size_t)MPAD * PJR * 2;
constexpr size_t PH_T = (size_t)MPAD * 128;
constexpr size_t WS_GATES = al256(WS_PROJ + (size_t)MPAD * PJ * 2);
constexpr size_t WS_QATT = al256(WS_GATES + (size_t)MPAD * 16 * 4);
constexpr size_t WS_QMETA = al256(WS_QATT + (size_t)NB * 8 * SEQ * 96 * 2);
constexpr size_t WS_QS = al256(WS_QMETA + (size_t)8 * 256 * 96 * 2);
constexpr int KVROWS = 64 + SEQ;
constexpr size_t WS_KV = al256(WS_QS + (size_t)NS * 768 * 2);
constexpr size_t WS_END0 = al256(WS_KV + (size_t)NB * 8 * KVROWS * 160 * 2);

struct Params {
  const float* in[25];
  float* out;
  unsigned char* ws;
  int ph_lo, ph_hi;
  int probe, pad;
};

__device__ __forceinline__ float wave_sum(float v) {
#pragma unroll
  for (int o = 1; o < 64; o <<= 1) v += __shfl_xor(v, o);
  return v;
}
__device__ __forceinline__ float sigmoidf_(float x) { return __builtin_amdgcn_rcpf(1.f + __builtin_amdgcn_exp2f(-1.4426950408889634f * x)); }
__device__ __forceinline__ float siluf_(float x) { return x * __builtin_amdgcn_rcpf(1.f + __builtin_amdgcn_exp2f(-1.4426950408889634f * x)); }

__device__ __forceinline__ int orig_col(int pc, float& sc) {
  sc = 1.f;
  if (pc < 256) return 384 + pc;
  if (pc < 640) return pc - 256;
  if (pc < 672) return pc;
  if (pc < 688) { int g = pc - 672; return g < 8 ? 2720 + g : 5288 + (g - 8); }
  if (pc < 704) return -1;
  if (pc < 1216) return 1184 + (pc - 704);
  if (pc < 1728) { sc = 0.08838834764831845f; return 1696 + (pc - 1216); }
  if (pc < 2240) return 2208 + (pc - 1728);
  if (pc < 2752) return 2728 + (pc - 2240);
  if (pc < 4288) return 3752 + (pc - 2752);
  if (pc < 4800) return 672 + (pc - 4288);
  if (pc < 5312) return 3240 + (pc - 4800);
  if (pc < 5824) return 5296 + (pc - 5312);
  return -1;
}

template <class F>
__device__ __forceinline__ void transpose_item(F src, int K, bf16_t* WT, LAS float* scr, int kb, int nb, int lane) {
  const int k0 = 64 * kb, n0 = 32 * nb;
#pragma unroll 16
  for (int i = 0; i < 32; ++i) { const int kk = 2 * i + (lane >> 5); scr[kk * 33 + (lane & 31)] = src(k0 + kk, n0 + (lane & 31)); }
  asm volatile("s_waitcnt lgkmcnt(0)" ::: "memory");
  const int c = lane & 7;
#pragma unroll
  for (int j = 0; j < 4; ++j) {
    const int n = (lane >> 3) + 8 * j; const LAS float* s = scr + (8 * c) * 33 + n;
    u32x4 o; o.x = cvtpk(s[0 * 33], s[1 * 33]); o.y = cvtpk(s[2 * 33], s[3 * 33]); o.z = cvtpk(s[4 * 33], s[5 * 33]); o.w = cvtpk(s[6 * 33], s[7 * 33]);
    *(u32x4*)(WT + (size_t)(n0 + n) * K + k0 + 8 * c) = o;
  }
  asm volatile("s_waitcnt lgkmcnt(0)" ::: "memory");
}

template <class F4>
__device__ __forceinline__ void transpose_item4(F4 src4, int K, bf16_t* WT, LAS float* scr  , int kb, int nb, int lane) {
  const int k0 = 32 * kb, n0 = 128 * nb;
  f32x4 v[16];
#pragma unroll
  for (int i = 0; i < 16; ++i) v[i] = src4(k0 + 2 * i + (lane >> 5), n0 + 4 * (lane & 31));
#pragma unroll
  for (int i = 0; i < 16; ++i) *(LAS f32x4*)(scr + (2 * i + (lane >> 5)) * 132 + 4 * (lane & 31)) = v[i];
  asm volatile("s_waitcnt lgkmcnt(0)" ::: "memory");
  const int c = lane & 3;
#pragma unroll
  for (int j = 0; j < 8; ++j) {
    const int n = (lane >> 2) + 16 * j; const LAS float* s = scr + (8 * c) * 132 + n;
    u32x4 o; o.x = cvtpk(s[0 * 132], s[1 * 132]); o.y = cvtpk(s[2 * 132], s[3 * 132]); o.z = cvtpk(s[4 * 132], s[5 * 132]); o.w = cvtpk(s[6 * 132], s[7 * 132]);
    *(u32x4*)(WT + (size_t)(n0 + n) * K + k0 + 8 * c) = o;
  }
  asm volatile("s_waitcnt lgkmcnt(0)" ::: "memory");
}

__device__ __forceinline__ void rms_row_to_bf16(const float* xrow, const float* w, bf16_t* orow, int lane) {
  const f32x4* xr = (const f32x4*)xrow + lane; const f32x4* wr = (const f32x4*)w + lane;
  f32x4 v[4]; float s = 0.f;
#pragma unroll
  for (int j = 0; j < 4; ++j) { v[j] = xr[64 * j]; s += (v[j].x * v[j].x + v[j].y * v[j].y) + (v[j].z * v[j].z + v[j].w * v[j].w); }
  const float rstd = rsqrtf(wave_sum(s) * (1.f / D) + EPS);
  unsigned long long* o8 = (unsigned long long*)orow + lane;
#pragma unroll
  for (int j = 0; j < 4; ++j) { const f32x4 ww = wr[64 * j];
    o8[64 * j] = (unsigned long long)cvtpk(v[j].x * rstd * ww.x, v[j].y * rstd * ww.y) | ((unsigned long long)cvtpk(v[j].z * rstd * ww.z, v[j].w * rstd * ww.w) << 32); }
}

__device__ __forceinline__ const float* xrow_in(const Params& p, int l, int r) {
  if (l == 0) {
    if (r < ROW_S) return p.in[0] + (size_t)r * D;
    if (r < ROW_M) return p.in[1] + (size_t)(r - ROW_S) * D;
    return p.in[9] + (size_t)(r - ROW_M) * D;
  }
  if (r < ROW_S) return p.out + O_YP + (size_t)r * D;
  if (r < ROW_M) return p.out + O_YS + (size_t)(r - ROW_S) * D;
  return (const float*)(p.ws + WS_XMETA) + (size_t)(r - ROW_M) * D;
}
__device__ __forceinline__ float* xrow_out(const Params& p, int r) {
  if (r < ROW_S) return p.out + O_YP + (size_t)r * D;
  if (r < ROW_M) return p.out + O_YS + (size_t)(r - ROW_S) * D;
  return (float*)(p.ws + WS_XMETA) + (size_t)(r - ROW_M) * D;
}

__device__ __forceinline__ void phase_norm_rows(const Params& p, int l, int gw, int NGW, int lane, int rbeg = 0, int rend = MPAD) {
  bf16_t* XN = (bf16_t*)(p.ws + WS_XN);
  const f32x4* wr = (const f32x4*)(p.in[10] + (size_t)l * D) + lane;
  for (int r0 = rbeg + 4 * gw; r0 < rend; r0 += 4 * NGW) {
    f32x4 v[4][4]; float s[4];
#pragma unroll
    for (int i = 0; i < 4; ++i) { const int r = r0 + i;
      if (r < MROWS) { const f32x4* xr = (const f32x4*)xrow_in(p, l, r) + lane;
#pragma unroll
        for (int j = 0; j < 4; ++j) v[i][j] = xr[64 * j]; }
      else {
#pragma unroll
        for (int j = 0; j < 4; ++j) v[i][j] = (f32x4){0.f, 0.f, 0.f, 0.f}; } }
#pragma unroll
    for (int i = 0; i < 4; ++i) { s[i] = 0.f;
#pragma unroll
      for (int j = 0; j < 4; ++j) s[i] += (v[i][j].x * v[i][j].x + v[i][j].y * v[i][j].y) + (v[i][j].z * v[i][j].z + v[i][j].w * v[i][j].w); }
#pragma unroll
    for (int o = 1; o < 64; o <<= 1)
#pragma unroll
      for (int i = 0; i < 4; ++i) s[i] += __shfl_xor(s[i], o);
#pragma unroll
    for (int i = 0; i < 4; ++i) { const float rstd = rsqrtf(s[i] * (1.f / D) + EPS); unsigned long long* o8 = (unsigned long long*)(XN + (size_t)(r0 + i) * D) + lane;
#pragma unroll
      for (int j = 0; j < 4; ++j) { const f32x4 ww = wr[64 * j];
        o8[64 * j] = (unsigned long long)cvtpk(v[i][j].x * rstd * ww.x, v[i][j].y * rstd * ww.y) | ((unsigned long long)cvtpk(v[i][j].z * rstd * ww.z, v[i][j].w * rstd * ww.w) << 32); } }
  }
}

__device__ __forceinline__ void phase0(const Params& p, LAS unsigned char* lds, int tid) {
  const int lane = tid & 63, wave = tid >> 6;
  const int gw = blockIdx.x * NWAVES + wave, NGW = gridDim.x * NWAVES;
  LAS float* scr = (LAS float*)(lds + wave * 16896);
  if (blockIdx.x == 0 && tid < 1024 / 4) ((unsigned*)(p.ws + WS_CTL))[tid] = 0u;
  constexpr int I_WIN = 32 * (PJ / 128), I_WUQ = 12 * 6, I_WUKV = 8 * 8, I_WOUT = 48 * 8, I_WUVT = 8 * 4;
  constexpr int I_L = I_WIN + I_WUQ + I_WUKV + I_WOUT + I_WUVT, I_ALL = 2 * I_L;
  auto do_item = [&](const int it) {
    const int l = it / I_L; int r = it % I_L;
    if (r < I_WIN) {
      const float* W = p.in[11] + (size_t)l * D * INC;
      transpose_item4([&](int k, int n) { float sc; const int oc = orig_col(n, sc); f32x4 v = {0.f, 0.f, 0.f, 0.f}; if (oc >= 0) { v = *(const f32x4*)(W + (size_t)k * INC + oc); v *= sc; } return v; },
                      1024, (bf16_t*)(p.ws + WS_WIN) + (size_t)l * PJ * 1024, scr, r % 32, r / 32, lane);
      return; }
    r -= I_WIN;
    if (r < I_WUQ) {
      const float* W = p.in[13] + (size_t)l * 384 * 768; const float* qn = p.in[12] + (size_t)l * 384;
      transpose_item4([&](int k, int n) { f32x4 v = *(const f32x4*)(W + (size_t)k * 768 + n); v *= qn[k] * QSCALE; return v; }, 384, (bf16_t*)(p.ws + WS_WUQ) + (size_t)l * 768 * 384, scr, r % 12, r / 12, lane);
      return; }
    r -= I_WUQ;
    if (r < I_WUKV) {
      const float* Wk = p.in[15] + (size_t)l * 256 * 512; const float* Wv = p.in[16] + (size_t)l * 256 * 512; const float* kn = p.in[14] + (size_t)l * 256;
      transpose_item4([&](int k, int n) { f32x4 v = n < 512 ? *(const f32x4*)(Wk + (size_t)k * 512 + n) : *(const f32x4*)(Wv + (size_t)k * 512 + n - 512); v *= kn[k]; return v; }, 256, (bf16_t*)(p.ws + WS_WUKV) + (size_t)l * 1024 * 256, scr, r % 8, r / 8, lane);
      return; }
    r -= I_WUKV;
    if (r < I_WOUT) {
      const float* W = p.in[23] + (size_t)l * DMIX * D;
      transpose_item4([&](int k, int n) { return *(const f32x4*)(W + (size_t)k * D + n); }, DMIX, (bf16_t*)(p.ws + WS_WOUT) + (size_t)l * D * DMIX, scr, r % 48, r / 48, lane);
      return; }
    r -= I_WOUT;
    { const float* Wv = p.in[16] + (size_t)l * 256 * 512;
      transpose_item4([&](int k, int n) { return *(const f32x4*)(Wv + (size_t)k * 512 + n); }, 256, (bf16_t*)(p.ws + WS_WUVT) + (size_t)l * 512 * 256, scr, r % 8, r / 8, lane); }
  };
  const long long gt = (long long)blockIdx.x * NTHREADS + tid, GT = (long long)gridDim.x * NTHREADS;
  { bf16_t* o = (bf16_t*)(p.ws + WS_WUKR); const float* W = p.in[15];
    for (long long i = gt; i < 2LL * 256 * 512; i += GT) o[i] = f2bf(W[i]); }
  { float* ct = (float*)(p.ws + WS_ROPE); float* st = ct + ROPE_N * 16;
    for (long long i = gt; i < (long long)ROPE_N * 16; i += GT) {
      const int pos = (int)(i >> 4), k = (int)(i & 15);
      const float freq = powf(10000.f, -(float)k / 16.f); const float ang = (float)pos * freq;
      float s, c; sincosf(ang, &s, &c); ct[i] = c; st[i] = s; } }
  phase_norm_rows(p, 0, gw, NGW, lane);
  { LAS int* qs = (LAS int*)(lds + 147440); unsigned* wq = (unsigned*)(p.ws + WS_WQ);
    for (;;) {
      __syncthreads();
      if (tid == 0) *qs = (int)atomicAdd(wq, 8u);
      __syncthreads();
      const int base = *qs;
      if (base >= I_ALL) break;
      if (base + wave < I_ALL) do_item(base + wave);
    }
    __syncthreads(); }
}

namespace pg8 {
constexpr int BM = 256, BK = 64, HALF = 128, HTB = HALF * BK * 2, STAGE_BYTES = 8 * HTB, NXCD = 8, WGM = 8;
__device__ __forceinline__ int lds_byte(int r, int c) { const int st = (r >> 4) * 2 + (c >> 5), rr = r & 15, cc = c & 31, ob = rr * 64 + cc * 2; return st * 1024 + (ob ^ (((ob >> 9) & 1) << 5)); }
__device__ __forceinline__ void stage_rc(int b, int& R, int& C) { const int st = b / 1024, sb = b % 1024, swz = sb ^ (((sb >> 9) & 1) << 5); R = (st >> 1) * 16 + swz / 64; C = (st & 1) * 32 + (swz % 64) / 2; }
__device__ __forceinline__ int perm32(int rho) { const int n = rho >> 4, i = rho & 15; return 8 * (i >> 2) + 4 * n + (i & 3); }
struct Unit { int pm, pn; };
struct Gemm { const bf16_t* A; const bf16_t* Bt; int lda, ldb, K; int kseg; size_t segstride; };
struct StaticOrder {
  int nM, nN, nwg, G, c;
  __device__ void init(int nM_, int nN_, int G_, int c_) { nM = nM_; nN = nN_; nwg = nM * nN; G = G_; c = c_; }
  __device__ bool next(int i, Unit& u) const {
    const long L = (long)i * G + c; if (L >= nwg) return false;
    int wgid = (int)L; { const int q = nwg / NXCD, r = nwg % NXCD, xcd = wgid % NXCD, off = wgid / NXCD; wgid = (xcd < r ? xcd * (q + 1) : r * (q + 1) + (xcd - r) * q) + off; }
    const int nig = WGM * nN, gid = wgid / nig, fm = gid * WGM, gsz = (nM - fm) < WGM ? (nM - fm) : WGM;
    u.pm = fm + ((wgid % nig) % gsz); u.pn = (wgid % nig) / gsz; return true;
  }
};
template <class Epi, class Sched>
__device__ __forceinline__ void gemm_phase(LAS unsigned char* lds, const Gemm g, const Sched& S, const Epi& E) {
  int tid = threadIdx.x; asm volatile("" : "+v"(tid)); const int wid = __builtin_amdgcn_readfirstlane(tid >> 6), lane = tid & 63, wr = wid >> 2, wc = wid & 3, fr = lane & 15, fq = lane >> 4;
  const int nt = g.K / BK;
  unsigned voffA[2], voffB[2];
#pragma unroll
  for (int i = 0; i < 2; ++i) { int R, C; stage_rc(tid * 16 + i * 8192, R, C); const int Rb = (R & ~31) + perm32(R & 31);
    voffA[i] = (unsigned)(R * g.lda + C) * 2u; voffB[i] = (unsigned)(Rb * g.ldb + C) * 2u; }
  const size_t kstep = (size_t)(BK * 2);
  const size_t hstepA = (size_t)HALF * g.lda * 2, hstepB = (size_t)HALF * g.ldb * 2;
  const size_t tstepA = 2 * hstepA, tstepB = 2 * hstepB;
  const unsigned ldsw = (unsigned)wid * 1024u;
  const int aoff = lds_byte(wr * 64 + fr, fq * 8), boff = lds_byte(wc * 32 + fr, fq * 8);
#define PG8_SA(b, h) (((b) * 2 + (h)) * HTB)
#define PG8_SB(b, h) ((4 + (b) * 2 + (h)) * HTB)
#define PG8_STAGE(bufoff, gbase, voff) do { _Pragma("unroll") for (int _i = 0; _i < 2; ++_i) \
    __builtin_amdgcn_global_load_lds((const unsigned*)((const char*)(gbase) + (voff)[_i]), (LAS unsigned*)(lds + (bufoff) + ldsw + _i * 8192), 16, 0, 0); } while (0)
#define PG8_LDA(dst, b, h) do { _Pragma("unroll") for (int m = 0; m < 4; ++m) _Pragma("unroll") for (int k = 0; k < 2; ++k) dst[m][k] = *(const LAS bf16x8*)(lds + PG8_SA(b, h) + aoff + m * 2048 + k * 1024); } while (0)
#define PG8_LDB(dst, b, h) do { _Pragma("unroll") for (int n = 0; n < 2; ++n) _Pragma("unroll") for (int k = 0; k < 2; ++k) dst[n][k] = *(const LAS bf16x8*)(lds + PG8_SB(b, h) + boff + n * 2048 + k * 1024); } while (0)
#define PG8_MMA(ai, bj, At, Bt) do { __builtin_amdgcn_s_setprio(1); _Pragma("unroll") for (int m = 0; m < 4; ++m) _Pragma("unroll") for (int n = 0; n < 2; ++n) _Pragma("unroll") for (int k = 0; k < 2; ++k) \
    acc[ai][bj][m][n] = __builtin_amdgcn_mfma_f32_16x16x32_bf16(Bt[n][k], At[m][k], acc[ai][bj][m][n], 0, 0, 0); __builtin_amdgcn_s_setprio(0); } while (0)
#define PG8_WAIT_V(n) asm volatile("s_waitcnt vmcnt(" #n ")" ::: "memory")
#define PG8_WAIT_L(n) asm volatile("s_waitcnt lgkmcnt(" #n ")" ::: "memory")
#define PG8_BAR __builtin_amdgcn_s_barrier()
#define PG8_SCHED __builtin_amdgcn_sched_barrier(0)
  Unit cur, nxt; int ui = 0;
  if (!S.next(0, cur)) return;
  f32x4 acc[2][2][4][2];
#pragma unroll
  for (int a = 0; a < 2; ++a)
#pragma unroll
    for (int b = 0; b < 2; ++b)
#pragma unroll
      for (int m = 0; m < 4; ++m)
#pragma unroll
        for (int n = 0; n < 2; ++n) acc[a][b][m][n] = (f32x4){0.f, 0.f, 0.f, 0.f};
  bf16x8 At[4][2], B0[2][2], B1[2][2];
  const char* cA = (const char*)g.A + (size_t)S.tile_m(cur.pm) * tstepA; const char* cB = (const char*)g.Bt + (size_t)cur.pn * tstepB;
  PG8_STAGE(PG8_SB(0, 0), cB, voffB); PG8_STAGE(PG8_SB(0, 1), cB + hstepB, voffB); PG8_STAGE(PG8_SA(0, 0), cA, voffA); PG8_STAGE(PG8_SA(0, 1), cA + hstepA, voffA);
  if (wr == 1) PG8_BAR;
  PG8_WAIT_V(2); PG8_BAR;
  PG8_STAGE(PG8_SB(1, 0), cB + kstep, voffB); PG8_STAGE(PG8_SA(1, 0), cA + kstep, voffA); PG8_STAGE(PG8_SB(1, 1), cB + hstepB + kstep, voffB);
  PG8_WAIT_V(6); PG8_BAR;
  for (;;) {
    const bool has_next = S.next(ui + 1, nxt);
    const char* nA = has_next ? (const char*)g.A + (size_t)S.tile_m(nxt.pm) * tstepA : cA; const char* nB = has_next ? (const char*)g.Bt + (size_t)nxt.pn * tstepB : cB;
#pragma unroll 1
    for (int t = 0; t < nt; t += 2) {
      const bool last = (t == nt - 2);
      const int sg1 = t / g.kseg, sg2 = (t + 2) / g.kseg;
      const char* a1 = cA + (size_t)sg1 * g.segstride + (size_t)(t + 1 - sg1 * g.kseg) * kstep;
      const char* a2 = last ? nA : cA + (size_t)sg2 * g.segstride + (size_t)(t + 2 - sg2 * g.kseg) * kstep; const char* b2 = last ? nB : cB + (size_t)(t + 2) * kstep;
      const char* a3 = a2 + kstep; const char* b3 = b2 + kstep;
      PG8_LDB(B0, 0, 0); PG8_LDB(B1, 0, 1); PG8_SCHED; PG8_LDA(At, 0, 0); PG8_STAGE(PG8_SA(1, 1), a1 + hstepA, voffA);
      PG8_WAIT_V(8); PG8_WAIT_L(0); PG8_BAR; PG8_MMA(0, 0, At, B0); PG8_MMA(0, 1, At, B1); PG8_BAR; PG8_SCHED;
      PG8_LDA(At, 0, 1); PG8_STAGE(PG8_SB(0, 0), b2, voffB); PG8_STAGE(PG8_SB(0, 1), b2 + hstepB, voffB); PG8_STAGE(PG8_SA(0, 0), a2, voffA);
      PG8_WAIT_V(8); PG8_WAIT_L(0); PG8_BAR; PG8_MMA(1, 0, At, B0); PG8_MMA(1, 1, At, B1); PG8_BAR; PG8_SCHED;
      PG8_LDB(B0, 1, 0); PG8_LDB(B1, 1, 1); PG8_SCHED; PG8_LDA(At, 1, 0); PG8_STAGE(PG8_SA(0, 1), a2 + hstepA, voffA);
      PG8_WAIT_V(8); PG8_WAIT_L(0); PG8_BAR; PG8_MMA(0, 0, At, B0); PG8_MMA(0, 1, At, B1); PG8_BAR; PG8_SCHED;
      PG8_LDA(At, 1, 1); PG8_STAGE(PG8_SB(1, 0), b3, voffB); PG8_STAGE(PG8_SB(1, 1), b3 + hstepB, voffB); PG8_STAGE(PG8_SA(1, 0), a3, voffA);
      PG8_WAIT_V(8); PG8_WAIT_L(0); PG8_BAR; PG8_MMA(1, 0, At, B0); PG8_MMA(1, 1, At, B1); PG8_BAR; PG8_SCHED;
    }
    if (wr == 0) PG8_BAR;
    E(acc, S.tile_m(cur.pm), cur.pn, wr, wc, fr, fq);
    if (!has_next) break;
#pragma unroll
    for (int a = 0; a < 2; ++a)
#pragma unroll
      for (int b = 0; b < 2; ++b)
#pragma unroll
        for (int m = 0; m < 4; ++m)
#pragma unroll
          for (int n = 0; n < 2; ++n) acc[a][b][m][n] = (f32x4){0.f, 0.f, 0.f, 0.f};
    cur = nxt; cA = nA; cB = nB; ++ui;
    if (wr == 1) PG8_BAR;
  }
  PG8_WAIT_V(0);
  PG8_BAR;
#undef PG8_SA
#undef PG8_SB
#undef PG8_STAGE
#undef PG8_LDA
#undef PG8_LDB
#undef PG8_MMA
#undef PG8_WAIT_V
#undef PG8_WAIT_L
#undef PG8_BAR
#undef PG8_SCHED
}
}

struct OrderAll : pg8::StaticOrder { __device__ __forceinline__ int tile_m(int pm) const { return pm; } };

struct EpiProj {
  bf16_t* O; bf16_t* OH;
  __device__ __forceinline__ static void dest(int c32, bf16_t* O, bf16_t* OH, bf16_t*& base, int& pitch) {
    if (c32 < PC_MQ) { base = O + c32; pitch = PJR; }
    else if (c32 >= PC_ZA) { base = O + (RC_ZA + c32 - PC_ZA); pitch = PJR; }
    else if (c32 >= PC_MO && c32 < PC_GQ) { base = O + (RC_MO + c32 - PC_MO); pitch = PJR; }
    else { const int rel = c32 < PC_MO ? c32 - PC_MQ : c32 - PC_GQ + 1536; base = OH + (size_t)(rel >> 7) * PH_T + (rel & 127); pitch = 128; }
  }
  __device__ __forceinline__ void operator()(const f32x4 (&acc)[2][2][4][2], int tm, int pn, int wr, int wc, int fr, int fq) const {
    const int row0 = tm * 256 + wr * 64 + fr;
    bf16_t* b0; bf16_t* b1; int p0, p1;
    dest(__builtin_amdgcn_readfirstlane(pn * 256 + wc * 32), O, OH, b0, p0); dest(__builtin_amdgcn_readfirstlane(pn * 256 + 128 + wc * 32), O, OH, b1, p1);
#pragma unroll
    for (int ai = 0; ai < 2; ++ai)
#pragma unroll
      for (int m = 0; m < 4; ++m) { int r_ = row0; asm volatile("" : "+v"(r_) :: "memory"); const int r = r_ + ai * 128 + m * 16;
#pragma unroll
        for (int bj = 0; bj < 2; ++bj) { const f32x4 v0 = acc[ai][bj][m][0], v1 = acc[ai][bj][m][1];
          u32x4 w; w.x = cvtpk(v0[0], v0[1]); w.y = cvtpk(v0[2], v0[3]); w.z = cvtpk(v1[0], v1[1]); w.w = cvtpk(v1[2], v1[3]);
          *(u32x4*)((bj ? b1 : b0) + (size_t)r * (bj ? p1 : p0) + 8 * fq) = w; } }
  }
};


struct RowInfo { int kind  , b, t, pos; };
__device__ __forceinline__ RowInfo row_info(int r) {
  RowInfo ri;
  if (r < ROW_S) { ri.kind = 0; ri.b = r >> 12; ri.t = r & 4095; ri.pos = NMETA + ri.t; }
  else if (r < ROW_M) { ri.kind = 1; ri.b = (r - ROW_S) >> 4; ri.t = (r - ROW_S) & 15; ri.pos = NCACHE + ri.t; }
  else if (r < MROWS) { ri.kind = 2; ri.b = 0; ri.t = r - ROW_M; ri.pos = ri.t; }
  else { ri.kind = 3; ri.b = 0; ri.t = 0; ri.pos = 0; }
  return ri;
}
__device__ __forceinline__ float softplusf_(float x) { return x > 20.f ? x : __logf(1.f + __expf(x)); }
__device__ __forceinline__ float logsigmoidf_(float x) { return x >= 0.f ? -__logf(1.f + __expf(-x)) : x - __logf(1.f + __expf(x)); }

__device__ __forceinline__ void phase_rowpass(const Params& p, int l, int gw, int NGW, int lane) {
  const bf16_t* PROJ = (const bf16_t*)(p.ws + WS_PROJ);
  float* RSTD = (float*)(p.ws + WS_RSTD);
  const float* ct = (const float*)(p.ws + WS_ROPE); const float* st = ct + ROPE_N * 16;
  bf16_t* KV = (bf16_t*)(p.ws + WS_KV);
  const f32x4 kn = *(const f32x4*)(p.in[14] + (size_t)l * 256 + 4 * lane);
  for (int r0 = 2 * gw; r0 < MROWS; r0 += 2 * NGW) {
    u32x2 ck[2]; unsigned cq[2][3]; unsigned short krv[2][2]; float skv[2], sq[2];
#pragma unroll
    for (int i = 0; i < 2; ++i) { const bf16_t* pr = PROJ + (size_t)(r0 + i) * PJR;
      ck[i] = *(const u32x2*)(pr + PC_CKV + 4 * lane);
      const unsigned* cqp = (const unsigned*)(pr + PC_CQ + 6 * lane); cq[i][0] = cqp[0]; cq[i][1] = cqp[1]; cq[i][2] = cqp[2];
      krv[i][0] = pr[PC_KR + (lane & 15)]; krv[i][1] = pr[PC_KR + 16 + (lane & 15)]; }
#pragma unroll
    for (int i = 0; i < 2; ++i) { const float c0 = bflo(ck[i].x), c1 = bfhi(ck[i].x), c2 = bflo(ck[i].y), c3 = bfhi(ck[i].y); skv[i] = c0 * c0 + c1 * c1 + c2 * c2 + c3 * c3; sq[i] = 0.f;
#pragma unroll
      for (int j = 0; j < 3; ++j) { const float a = bflo(cq[i][j]), b = bfhi(cq[i][j]); sq[i] += a * a + b * b; } }
#pragma unroll
    for (int o = 1; o < 64; o <<= 1)
#pragma unroll
      for (int i = 0; i < 2; ++i) { skv[i] += __shfl_xor(skv[i], o); sq[i] += __shfl_xor(sq[i], o); }
#pragma unroll
    for (int i = 0; i < 2; ++i) {
      const int r = r0 + i; const RowInfo ri = row_info(r); const bf16_t* pr = PROJ + (size_t)r * PJR;
      const float rs_kv = rsqrtf(skv[i] * (1.f / 256.f) + EPS), rs_q = rsqrtf(sq[i] * (1.f / 384.f) + EPS);
      const f32x4 lat = {bflo(ck[i].x) * rs_kv * kn.x, bfhi(ck[i].x) * rs_kv * kn.y, bflo(ck[i].y) * rs_kv * kn.z, bfhi(ck[i].y) * rs_kv * kn.w};
      if (lane == 0) { RSTD[2 * r] = rs_q; RSTD[2 * r + 1] = rs_kv; }
      float o1 = 0.f, o2 = 0.f;
      if (lane < 16) { const float x1 = bf2f(krv[i][0]), x2 = bf2f(krv[i][1]); const float c = ct[ri.pos * 16 + lane], s = st[ri.pos * 16 + lane]; o1 = x1 * c - x2 * s; o2 = x2 * c + x1 * s; }
      if (ri.kind == 0) {
        float* ol = p.out + O_PLAT + (((size_t)l * NB + ri.b) * NCACHE + NMETA + ri.t) * 256; *(f32x4*)(ol + 4 * lane) = lat;
        if (lane < 16) { float* ok = p.out + O_PKR + (((size_t)l * NB + ri.b) * NCACHE + NMETA + ri.t) * 32; ok[lane] = o1; ok[16 + lane] = o2; }
        {
          const int k0 = 4 * (lane & 7), src = k0 & 15; float v4[4];
#pragma unroll
          for (int e = 0; e < 4; ++e) { const float a1 = __shfl(o1, src + e), a2 = __shfl(o2, src + e); v4[e] = k0 < 16 ? a1 : a2; }
          u32x2 w; w.x = cvtpk(v4[0], v4[1]); w.y = cvtpk(v4[2], v4[3]);
          *(u32x2*)(KV + ((size_t)(ri.b * 8 + (lane >> 3)) * KVROWS + 64 + ri.t) * 160 + 64 + k0) = w; }
      } else if (ri.kind == 1) {
        float* ol = p.out + O_SLAT + (((size_t)l * DB + ri.b) * DS + ri.t) * 256; *(f32x4*)(ol + 4 * lane) = lat;
        if (lane < 16) { float* ok = p.out + O_SKR + (((size_t)l * DB + ri.b) * DS + ri.t) * 32; ok[lane] = o1; ok[16 + lane] = o2; }
      } else {
        for (int b = 0; b < NB; ++b) {
          float* ol = p.out + O_PLAT + (((size_t)l * NB + b) * NCACHE + ri.t) * 256; *(f32x4*)(ol + 4 * lane) = lat;
          if (lane < 16) { float* ok = p.out + O_PKR + (((size_t)l * NB + b) * NCACHE + ri.t) * 32; ok[lane] = o1; ok[16 + lane] = o2;
#pragma unroll
            for (int h = 0; h < 8; ++h) { bf16_t* kd = KV + ((size_t)(b * 8 + h) * KVROWS + ri.t) * 160 + 64; kd[lane] = f2bf(o1); kd[16 + lane] = f2bf(o2); } }
        }
      }
      float* co = nullptr;
      if (ri.kind == 0 && ri.t >= SEQ - 3) co = p.out + O_PCONV + (((size_t)l * NB + ri.b) * 3 + (ri.t - (SEQ - 3))) * 1536;
      if (ri.kind == 1 && ri.t >= DS - 3) co = p.out + O_SCONV + (((size_t)l * DB + ri.b) * 3 + (ri.t - (DS - 3))) * 1536;
      if (co) { const bf16_t* ph = (const bf16_t*)(p.ws + WS_PROJH) + (size_t)(12 + (lane >> 4)) * PH_T + (size_t)r * 128 + 8 * (lane & 15);
        for (int c = lane * 8; c < 1536; c += 512) { const u32x4 w = *(const u32x4*)(ph + (size_t)(c >> 9) * 4 * PH_T);
          *(f32x4*)(co + c) = (f32x4){bflo(w.x), bfhi(w.x), bflo(w.y), bfhi(w.y)}; *(f32x4*)(co + c + 4) = (f32x4){bflo(w.z), bfhi(w.z), bflo(w.w), bfhi(w.w)}; } }
    }
  }
}

struct OrderTail : pg8::StaticOrder { __device__ __forceinline__ int tile_m(int pm) const { return 128 + pm; } };
struct OrderKV : pg8::StaticOrder { __device__ __forceinline__ int tile_m(int pm) const { return pm < 128 ? pm : 130; } };

struct EpiQ {
  const float* rstd; const float* ct; const float* st; bf16_t* QATT; bf16_t* QMETA; bf16_t* QS;
  __device__ __forceinline__ void operator()(const f32x4 (&acc)[2][2][4][2], int tm, int pn, int wr, int wc, int fr, int fq) const {
    float rsv[2][4];
#pragma unroll
    for (int ai = 0; ai < 2; ++ai)
#pragma unroll
      for (int m = 0; m < 4; ++m) { const int r = tm * 256 + ai * 128 + wr * 64 + m * 16 + fr; rsv[ai][m] = r < MROWS ? rstd[2 * r] : 0.f; }
#pragma unroll
    for (int ai = 0; ai < 2; ++ai)
#pragma unroll
      for (int m = 0; m < 4; ++m) {
        int fr_ = fr; asm volatile("" : "+v"(fr_) :: "memory");
        const int r = tm * 256 + ai * 128 + wr * 64 + m * 16 + fr_; const RowInfo ri = row_info(r);
        const float rs = rsv[ai][m];
        bf16_t* dst; int hstride;
        if (ri.kind == 0) { dst = QATT + ((size_t)(ri.b * 8) * SEQ + ri.t) * 96; hstride = SEQ * 96; }
        else if (ri.kind == 1) { dst = QS + (size_t)(r - ROW_S) * 768; hstride = 96; }
        else { dst = QMETA + (size_t)ri.t * 96; hstride = 256 * 96; }
#pragma unroll
        for (int bj = 0; bj < 2; ++bj) {
          const int gb = pn * 256 + bj * 128 + wc * 32; const int h = gb / 96, gm = gb - h * 96;
          float v[8];
#pragma unroll
          for (int j = 0; j < 4; ++j) { v[j] = acc[ai][bj][m][0][j] * rs; v[4 + j] = acc[ai][bj][m][1][j] * rs; }
          if (gm == 64) {
            const float* cp = ct + ri.pos * 16 + 8 * (fq & 1); const float* sp = st + ri.pos * 16 + 8 * (fq & 1);
            const f32x4 c0 = *(const f32x4*)cp, c1 = *(const f32x4*)(cp + 4), s0 = *(const f32x4*)sp, s1 = *(const f32x4*)(sp + 4);
            const float sg = fq < 2 ? -1.f : 1.f;
#pragma unroll
            for (int j = 0; j < 8; ++j) { const float pv = __shfl_xor(v[j], 32); const float c = j < 4 ? c0[j & 3] : c1[j & 3], s = j < 4 ? s0[j & 3] : s1[j & 3];
              v[j] = v[j] * c + sg * pv * s; }
          }
          u32x4 w; w.x = cvtpk(v[0], v[1]); w.y = cvtpk(v[2], v[3]); w.z = cvtpk(v[4], v[5]); w.w = cvtpk(v[6], v[7]);
          if (ri.kind != 3) *(u32x4*)(dst + (size_t)h * hstride + gm + 8 * fq) = w;
        }
      }
  }
};

struct EpiKV {
  const float* rstd; bf16_t* KV;
  __device__ __forceinline__ void operator()(const f32x4 (&acc)[2][2][4][2], int tm, int pn, int wr, int wc, int fr, int fq) const {
#pragma unroll
    for (int ai = 0; ai < 2; ++ai)
#pragma unroll
      for (int m = 0; m < 4; ++m) {
        int fr_ = fr; asm volatile("" : "+v"(fr_) :: "memory");
        const int r = tm * 256 + ai * 128 + wr * 64 + m * 16 + fr_; const RowInfo ri = row_info(r);
        if (ri.kind != 0 && ri.kind != 2) continue;
        const float rs = rstd[2 * r + 1];
#pragma unroll
        for (int bj = 0; bj < 2; ++bj) {
          const int col0 = pn * 256 + bj * 128 + wc * 32 + 8 * fq; const int isv = col0 >= 512; const int cc = col0 & 511; const int h = cc >> 6, d0 = (cc & 63) + (isv ? 96 : 0);
          const f32x4 v0 = acc[ai][bj][m][0] * rs, v1 = acc[ai][bj][m][1] * rs;
          u32x4 w; w.x = cvtpk(v0[0], v0[1]); w.y = cvtpk(v0[2], v0[3]); w.z = cvtpk(v1[0], v1[1]); w.w = cvtpk(v1[2], v1[3]);
          if (ri.kind == 0) *(u32x4*)(KV + ((size_t)(ri.b * 8 + h) * KVROWS + 64 + ri.t) * 160 + d0) = w;
          else for (int b = 0; b < NB; ++b) *(u32x4*)(KV + ((size_t)(b * 8 + h) * KVROWS + ri.t) * 160 + d0) = w;
        }
        asm volatile("" ::: "memory");
      }
  }
};

struct AttnUnit { const bf16_t* q; const bf16_t* kv; int ntiles, chunk0, nq_valid, out_row0, h, is_meta; };
constexpr int AT_KP = 208, AT_VP = 192, AT_KB = 64 * AT_KP, AT_STAGE = AT_KB + 64 * AT_VP;
typedef short v4i16_t __attribute__((ext_vector_type(4)));

__device__ __forceinline__ void attn_unit(LAS unsigned char* lds, const AttnUnit u, const bf16_t* PROJ, bf16_t* OA, int tid, unsigned char* p_ws_probe = nullptr) {
  asm volatile("" : "+v"(tid));
  const int lane = tid & 63, w = tid >> 6, r32 = lane & 31, hi = lane >> 5;
  const int jmax = u.is_meta ? 0 : (1 + u.chunk0 + (w >> 1));
  bf16x8 qf[6];
  { const bf16_t* qp = u.q + (size_t)(32 * w + r32) * 96 + 8 * hi;
#pragma unroll
    for (int s = 0; s < 6; ++s) qf[s] = *(const bf16x8*)(qp + 16 * s); }
  f32x16 o0, o1;
#pragma unroll
  for (int i = 0; i < 16; ++i) { o0[i] = 0.f; o1[i] = 0.f; }
  float mrun = -INFINITY, lrun = 0.f;
  u32x4 sA0, sA1, sA2, sB0, sB1, sB2; sA2 = (u32x4){0u, 0u, 0u, 0u}; sB2 = sA2;
  auto lds_off = [](int c) { const int row = c / 20, cc = c - row * 20; return cc < 12 ? row * AT_KP + cc * 16 : AT_KB + row * AT_VP + (cc - 12) * 16; };
  const int off0 = lds_off(tid), off1 = lds_off(tid + 512), off2 = lds_off(tid < 256 ? tid + 1024 : 0);
#define AT_LOAD(S0, S1, S2, TILE) do { const u32x4* g_ = (const u32x4*)(u.kv + (size_t)(TILE) * 64 * 160); S0 = g_[tid]; S1 = g_[tid + 512]; if (tid < 256) S2 = g_[tid + 1024]; } while (0)
#define AT_STORE(S0, S1, S2, STG) do { LAS unsigned char* nb_ = lds + (STG) * AT_STAGE; *(LAS u32x4*)(nb_ + off0) = S0; *(LAS u32x4*)(nb_ + off1) = S1; if (tid < 256) *(LAS u32x4*)(nb_ + off2) = S2; } while (0)
  AT_LOAD(sB0, sB1, sB2, 0); AT_STORE(sB0, sB1, sB2, 0);
  if (u.ntiles > 1) AT_LOAD(sA0, sA1, sA2, 1);
  if (u.ntiles > 2) AT_LOAD(sB0, sB1, sB2, 2);
  __syncthreads();
  const int koff = r32 * AT_KP + 16 * hi;
  const int l16 = lane & 15, cg = (lane >> 4) & 1;
  const int voff = AT_KB + (4 * hi + (l16 >> 2)) * AT_VP + (16 * cg + 4 * (l16 & 3)) * 2;
#if PROBE_LEVEL == 2
  unsigned long long tl_ = __builtin_amdgcn_s_memrealtime(), aa_[4] = {0ull, 0ull, 0ull, 0ull};
#define AA_T(i) do { const unsigned long long t_ = __builtin_amdgcn_s_memrealtime(); aa_[i] += t_ - tl_; tl_ = t_; } while (0)
#else
#define AA_T(i) do {} while (0)
#endif
  auto compute_tile = [&](int j) {
    LAS unsigned char* sb = lds + (j & 1) * AT_STAGE;
    AA_T(3);
    if (j <= jmax) {
      const float mref = mrun > -1e30f ? mrun : 0.f;
      f32x16 p0, p1;
#pragma unroll
      for (int i = 0; i < 16; ++i) { p0[i] = -mref; p1[i] = -mref; }
      bf16x8 kf0[6], kf1[6];
#pragma unroll
      for (int s = 0; s < 6; ++s) { kf0[s] = *(const LAS bf16x8*)(sb + koff + s * 32); kf1[s] = *(const LAS bf16x8*)(sb + koff + 32 * AT_KP + s * 32); }
      v4i16_t va0[4], va1[4], vb0[4], vb1[4];
#pragma unroll
      for (int ks = 0; ks < 4; ++ks) {
        va0[ks] = __builtin_amdgcn_ds_read_tr16_b64_v4i16((LAS v4i16_t*)(sb + voff + ks * 16 * AT_VP));
        va1[ks] = __builtin_amdgcn_ds_read_tr16_b64_v4i16((LAS v4i16_t*)(sb + voff + ks * 16 * AT_VP + 8 * AT_VP));
        vb0[ks] = __builtin_amdgcn_ds_read_tr16_b64_v4i16((LAS v4i16_t*)(sb + voff + ks * 16 * AT_VP + 64));
        vb1[ks] = __builtin_amdgcn_ds_read_tr16_b64_v4i16((LAS v4i16_t*)(sb + voff + ks * 16 * AT_VP + 8 * AT_VP + 64)); }
      __builtin_amdgcn_sched_barrier(0);
#pragma unroll
      for (int s = 0; s < 6; ++s) {
        p0 = __builtin_amdgcn_mfma_f32_32x32x16_bf16(kf0[s], qf[s], p0, 0, 0, 0);
        p1 = __builtin_amdgcn_mfma_f32_32x32x16_bf16(kf1[s], qf[s], p1, 0, 0, 0);
      }
      asm volatile("" :: "v"(p0), "v"(p1)); AA_T(0);
      if (j == 0) {
#pragma unroll
        for (int i = 8; i < 16; ++i) p0[i] = -INFINITY;
#pragma unroll
        for (int i = 0; i < 16; ++i) p1[i] = -INFINITY;
      }
      float tm = p0[0];
#pragma unroll
      for (int i = 1; i < 16; ++i) tm = fmaxf(tm, p0[i]);
#pragma unroll
      for (int i = 0; i < 16; ++i) tm = fmaxf(tm, p1[i]);
      tm = fmaxf(tm, __shfl_xor(tm, 32));
      if (!__all(tm + (mref - mrun) <= 6.0f)) {
        const float mnew = fmaxf(mrun, tm + mref); const float alpha = __builtin_amdgcn_exp2f(mrun - mnew); mrun = mnew; lrun *= alpha;
        const float shift = mnew - mref;
#pragma unroll
        for (int i = 0; i < 16; ++i) { o0[i] *= alpha; o1[i] *= alpha; p0[i] -= shift; p1[i] -= shift; }
      }
      float ps = 0.f;
#pragma unroll
      for (int i = 0; i < 16; ++i) { p0[i] = __builtin_amdgcn_exp2f(p0[i]); p1[i] = __builtin_amdgcn_exp2f(p1[i]); ps += p0[i] + p1[i]; }
      lrun += ps;
      AA_T(1);
      bf16x8 pb[4];
#pragma unroll
      for (int s = 0; s < 2; ++s) {
        u32x4 a, b;
        a.x = cvtpk(p0[8 * s + 0], p0[8 * s + 1]); a.y = cvtpk(p0[8 * s + 2], p0[8 * s + 3]); a.z = cvtpk(p0[8 * s + 4], p0[8 * s + 5]); a.w = cvtpk(p0[8 * s + 6], p0[8 * s + 7]);
        b.x = cvtpk(p1[8 * s + 0], p1[8 * s + 1]); b.y = cvtpk(p1[8 * s + 2], p1[8 * s + 3]); b.z = cvtpk(p1[8 * s + 4], p1[8 * s + 5]); b.w = cvtpk(p1[8 * s + 6], p1[8 * s + 7]);
        pb[s] = __builtin_bit_cast(bf16x8, a); pb[2 + s] = __builtin_bit_cast(bf16x8, b);
      }
#pragma unroll
      for (int ks = 0; ks < 4; ++ks) {
        const bf16x8 va = {va0[ks][0], va0[ks][1], va0[ks][2], va0[ks][3], va1[ks][0], va1[ks][1], va1[ks][2], va1[ks][3]};
        const bf16x8 vb = {vb0[ks][0], vb0[ks][1], vb0[ks][2], vb0[ks][3], vb1[ks][0], vb1[ks][1], vb1[ks][2], vb1[ks][3]};
        o0 = __builtin_amdgcn_mfma_f32_32x32x16_bf16(va, pb[ks], o0, 0, 0, 0);
        o1 = __builtin_amdgcn_mfma_f32_32x32x16_bf16(vb, pb[ks], o1, 0, 0, 0);
      }
      asm volatile("" :: "v"(o0), "v"(o1)); AA_T(2);
    }
  };
  for (int j = 0; j < u.ntiles; j += 2) {
    compute_tile(j);
    if (j + 1 < u.ntiles) AT_STORE(sA0, sA1, sA2, (j + 1) & 1);
    if (j + 3 < u.ntiles) AT_LOAD(sA0, sA1, sA2, j + 3);
    __syncthreads();
    if (j + 1 >= u.ntiles) break;
    compute_tile(j + 1);
    if (j + 2 < u.ntiles) AT_STORE(sB0, sB1, sB2, j & 1);
    if (j + 4 < u.ntiles) AT_LOAD(sB0, sB1, sB2, j + 4);
    __syncthreads();
  }
#undef AT_LOAD
#undef AT_STORE
#if PROBE_LEVEL == 2
  if (tid == 448 && blockIdx.x == 200) { for (int i = 0; i < 4; ++i) ((unsigned long long*)(p_ws_probe + WS_CTL + 2048))[4 + i] += aa_[i]; }
#endif
  const float ltot = lrun + __shfl_xor(lrun, 32); const float inv = 1.f / ltot;
  const int qi = 32 * w + r32;
  if (qi < u.nq_valid) {
    const bf16_t* zr = PROJ + (size_t)(u.out_row0 + qi) * PJR + RC_ZA + u.h * 64; bf16_t* orow = OA + (size_t)(u.out_row0 + qi) * 512 + u.h * 64;
#pragma unroll
    for (int dvt = 0; dvt < 2; ++dvt)
#pragma unroll
      for (int g = 0; g < 4; ++g) {
        const int dv0 = 32 * dvt + 8 * g + 4 * hi; u32x2 z = *(const u32x2*)(zr + dv0);
        float v[4];
#pragma unroll
        for (int e = 0; e < 4; ++e) v[e] = (dvt ? o1[4 * g + e] : o0[4 * g + e]) * inv;
        z.x = cvtpk(v[0] * siluf_(bflo(z.x)), v[1] * siluf_(bfhi(z.x))); z.y = cvtpk(v[2] * siluf_(bflo(z.y)), v[3] * siluf_(bfhi(z.y)));
        *(u32x2*)(orow + dv0) = z;
      }
  }
  __syncthreads();
}

constexpr int NSLOT = 32 * 65 + 128;
constexpr int MSLOT_B = 57344 + 2048;
constexpr int GSLOT_B = 73728 + 256;
constexpr int MS_Q = 0, MS_QK = 8192, MS_KHT = 12288, MS_VT = 20480, MS_SC_B = 57344;
constexpr int MSC_B = 0, MSC_MLOC = 64, MSC_RS = 128, MSC_DN = 192, MSC_A = 320, MSC_BB = 321;
constexpr int GS_NW = 0, GS_QT = 8192, GS_QK = 16384, GS_KTT = 20480, GS_UT = 28672, GS_SC_B = 73728;
constexpr size_t WS_MSLOT = WS_END0;
constexpr size_t WS_GSLOT = al256(WS_MSLOT + (size_t)NSLOT * MSLOT_B);
constexpr size_t WS_HM = WS_XN;
constexpr size_t WS_OG = WS_XN + SEG_B;
constexpr size_t WS_END1 = al256(WS_GSLOT + (size_t)NSLOT * GSLOT_B);

struct ChunkDesc { int row0, nvalid, kind  , b, h, tok0; };
__device__ __forceinline__ ChunkDesc chunk_of_slot(int slot) {
  ChunkDesc c;
  if (slot < 32 * 65) { const int ch = slot / 65, ci = slot - ch * 65; c.b = ch >> 2; c.h = ch & 3;
    if (ci == 0) { c.kind = 2; c.row0 = ROW_M; c.nvalid = 16; c.tok0 = 0; } else { c.kind = 0; c.row0 = c.b * SEQ + 64 * (ci - 1); c.nvalid = 64; c.tok0 = 64 * (ci - 1); } }
  else { const int ch = slot - 32 * 65; c.b = ch >> 2; c.h = ch & 3; c.kind = 1; c.row0 = ROW_S + 16 * c.b; c.nvalid = 16; c.tok0 = 0; }
  return c;
}
#define SCAN_DPP(old, src, ctrl, rmask) __int_as_float(__builtin_amdgcn_update_dpp(__float_as_int(old), __float_as_int(src), ctrl, rmask, 0xF, false))
__device__ __forceinline__ float scan_add(float v, int lane) {
  (void)lane;
  v += SCAN_DPP(0.f, v, 0x111, 0xF); v += SCAN_DPP(0.f, v, 0x112, 0xF); v += SCAN_DPP(0.f, v, 0x114, 0xF); v += SCAN_DPP(0.f, v, 0x118, 0xF);
  v += SCAN_DPP(0.f, v, 0x142, 0xA); v += SCAN_DPP(0.f, v, 0x143, 0xC);
  return v;
}
__device__ __forceinline__ float scan_max(float v, int lane) {
  (void)lane;
  v = fmaxf(v, SCAN_DPP(-INFINITY, v, 0x111, 0xF)); v = fmaxf(v, SCAN_DPP(-INFINITY, v, 0x112, 0xF)); v = fmaxf(v, SCAN_DPP(-INFINITY, v, 0x114, 0xF)); v = fmaxf(v, SCAN_DPP(-INFINITY, v, 0x118, 0xF));
  v = fmaxf(v, SCAN_DPP(-INFINITY, v, 0x142, 0xA)); v = fmaxf(v, SCAN_DPP(-INFINITY, v, 0x143, 0xC));
  return v;
}
__device__ __forceinline__ float wave_max(float v) { return __int_as_float(__builtin_amdgcn_readlane(__float_as_int(scan_max(v, 0)), 63)); }
__device__ __forceinline__ int kperm_pos(int k) { return (k & ~31) | (((k >> 2) & 3) << 3) | (((k >> 4) & 1) << 2) | (k & 3); }
__device__ __forceinline__ void store_perm8(bf16_t* rowbase, int k0, const u32x4& o) { u32x2 lo = {o.x, o.y}, hi = {o.z, o.w}; const int p0 = kperm_pos(k0); *(u32x2*)(rowbase + p0) = lo; *(u32x2*)(rowbase + p0 + 8) = hi; }
__device__ __forceinline__ float sum8(float v) { v += __shfl_xor(v, 1); v += __shfl_xor(v, 2); v += __shfl_xor(v, 4); return v; }

__device__ __forceinline__ void lds_barrier() { asm volatile("s_waitcnt lgkmcnt(0)\n\ts_barrier" ::: "memory"); }
#if PROBE_LEVEL == 2
#define PP_INIT() unsigned long long tl_ = __builtin_amdgcn_s_memrealtime()
#define PP_T(blk, i) do { lds_barrier(); if (tid == 0 && blockIdx.x == (blk)) { const unsigned long long t_ = __builtin_amdgcn_s_memrealtime(); ((unsigned long long*)(p.ws + WS_CTL + 2048))[(i)] += t_ - tl_; tl_ = t_; } } while (0)
#else
#define PP_INIT() do {} while (0)
#define PP_T(blk, i) do {} while (0)
#endif
constexpr int MP_IMG = 52224, MP_QK = 2 * MP_IMG, MP_SC = MP_QK + 17408, MP_G = MP_SC + 1536;
__device__ __forceinline__ bool prep_slot_skipped(int slot) { return slot < 32 * 65 && slot % 65 == 0 && slot >= 4 * 65; }
__device__ __forceinline__ int prep_next_slot(int slot, int G) { for (slot += G; slot < NSLOT; slot += G) if (!prep_slot_skipped(slot)) return slot; return NSLOT; }
__device__ __forceinline__ void mlstm_issue(LAS unsigned char* lds, const Params& p, int slot, int buf, int tid) {
  const ChunkDesc cd = chunk_of_slot(slot);
  const bf16_t* PROJ = (const bf16_t*)(p.ws + WS_PROJ); const bf16_t* PROJH = (const bf16_t*)(p.ws + WS_PROJH);
  const unsigned char* zero = p.ws + WS_ZERO;
  const int wu = __builtin_amdgcn_readfirstlane(tid >> 6), lane = tid & 63;
#pragma unroll
  for (int it = 0; it < 7; ++it) { const int k = wu + 8 * it;
    if (k < 51) { const int ten = k / 17, i = k - 17 * ten; const int o = i * 1024 + lane * 16, row = o / 272, col = o - row * 272;
      const unsigned char* src = (row < cd.nvalid && col < 256) ? (const unsigned char*)(PROJH + (size_t)(ten * 4 + cd.h) * PH_T + (size_t)(cd.row0 + row) * 128) + col : zero;
      __builtin_amdgcn_global_load_lds((const unsigned*)src, (LAS unsigned*)(lds + buf * MP_IMG + ten * 17408 + i * 1024), 16, 0, 0); } }
  if (wu == 3) { const unsigned char* src = lane < cd.nvalid ? (const unsigned char*)(PROJ + (size_t)(cd.row0 + lane) * PJR + PC_G16) : zero;
    __builtin_amdgcn_global_load_lds((const unsigned*)src, (LAS unsigned*)(lds + MP_G + buf * 1024), 16, 0, 0); }
}
__device__ __forceinline__ void mlstm_prep(LAS unsigned char* lds, const Params& p, int l, int slot, int buf, float bias_i, float bias_f, int tid) {
  asm volatile("" : "+v"(tid));
  PP_INIT();
  const ChunkDesc cd = chunk_of_slot(slot);
  bf16_t* SL = (bf16_t*)(p.ws + WS_MSLOT + (size_t)slot * MSLOT_B); float* SC = (float*)(p.ws + WS_MSLOT + (size_t)slot * MSLOT_B + MS_SC_B);
  const int lane = tid & 63, w = tid >> 6, c16 = lane & 15, q4 = lane >> 4;
  const int L_Q = buf * MP_IMG, L_K = L_Q + 17408, L_V = L_Q + 34816; constexpr int L_QK = MP_QK, L_SC = MP_SC;
  LAS float* sc = (LAS float*)(lds + L_SC);
  if (w == 0) {
    float ig = -INFINITY, fg = 0.f;
    if (lane < cd.nvalid) { const LAS bf16_t* gr = (const LAS bf16_t*)(lds + MP_G + buf * 1024 + lane * 16);
      ig = bf2f(gr[cd.h]) + bias_i; fg = logsigmoidf_(bf2f(gr[4 + cd.h]) + bias_f); }
    const float b = scan_add(fg, lane); const float g = ig - b; const float cm = scan_max(g, lane); const float gmax = __int_as_float(__builtin_amdgcn_readlane(__float_as_int(cm), 63)); const float blast = __int_as_float(__builtin_amdgcn_readlane(__float_as_int(b), 63));
    sc[lane] = b; sc[64 + lane] = g; sc[128 + lane] = b + cm; sc[192 + lane] = __expf(g - gmax);
    SC[MSC_B + lane] = b; SC[MSC_MLOC + lane] = b + cm;
    if (lane == 0) { SC[MSC_A] = blast + gmax; SC[MSC_BB] = blast; }
  }
  if (tid >= 64 && tid < 192) sc[256 + tid - 64] = 0.f;
  lds_barrier();
  PP_T(0, 8);
#pragma unroll
  for (int ti = 0; ti < 2; ++ti) { const int id = 2 * w + ti, tm = id >> 2, tn = id & 3; f32x4 acc = {0.f, 0.f, 0.f, 0.f};
#pragma unroll
    for (int kk = 0; kk < 4; ++kk) { const bf16x8 a = *(const LAS bf16x8*)(lds + L_Q + (16 * tm + c16) * 272 + (32 * kk + 8 * q4) * 2);
      const bf16x8 b = *(const LAS bf16x8*)(lds + L_K + (16 * tn + c16) * 272 + (32 * kk + 8 * q4) * 2);
      acc = __builtin_amdgcn_mfma_f32_16x16x32_bf16(a, b, acc, 0, 0, 0); }
    const int s = 16 * tn + c16; const float gs = sc[64 + s];
#pragma unroll
    for (int i = 0; i < 4; ++i) { const int t = 16 * tm + 4 * q4 + i; const float e = (s <= t) ? __expf(sc[t] + gs - sc[128 + t]) : 0.f;
      ((LAS float*)(lds + L_QK))[t * 68 + s] = (s <= t) ? acc[i] * e : 0.f; } }
  asm volatile("s_waitcnt vmcnt(0)" ::: "memory");
  lds_barrier();
  PP_T(0, 9);
  { const int row = tid >> 3, c8 = tid & 7; const LAS float* qr = (const LAS float*)(lds + L_QK) + row * 68 + c8 * 8; float v[8]; float rs = 0.f;
#pragma unroll
    for (int j = 0; j < 8; ++j) { v[j] = qr[j]; rs += v[j]; }
    u32x4 o; o.x = cvtpk(v[0], v[1]); o.y = cvtpk(v[2], v[3]); o.z = cvtpk(v[4], v[5]); o.w = cvtpk(v[6], v[7]);
    *(u32x4*)(SL + MS_QK + row * 64 + c8 * 8) = o; rs = sum8(rs); if (c8 == 0) SC[MSC_RS + row] = rs; }
#pragma unroll
  for (int k = 0; k < 2; ++k) { const int ci = tid + 512 * k, row = ci >> 4, c = ci & 15; const u32x4 qv = *(const LAS u32x4*)(lds + L_Q + row * 272 + c * 16); store_perm8(SL + MS_Q + row * 128, c * 8, qv); }
#pragma unroll
  for (int k = 0; k < 2; ++k) { const int id = tid + 512 * k, d = id & 127, s8 = id >> 7; float kv[8], vv[8]; float dsum = 0.f;
#pragma unroll
    for (int j = 0; j < 8; ++j) { const int s = 8 * s8 + j; kv[j] = bf2f(*(const LAS bf16_t*)(lds + L_K + s * 272 + d * 2)) * sc[192 + s]; vv[j] = bf2f(*(const LAS bf16_t*)(lds + L_V + s * 272 + d * 2)); }
    u32x4 o; o.x = cvtpk(kv[0], kv[1]); o.y = cvtpk(kv[2], kv[3]); o.z = cvtpk(kv[4], kv[5]); o.w = cvtpk(kv[6], kv[7]);
    dsum = bflo(o.x) + bfhi(o.x) + bflo(o.y) + bfhi(o.y) + bflo(o.z) + bfhi(o.z) + bflo(o.w) + bfhi(o.w);
    *(u32x4*)(SL + MS_KHT + d * 64 + 8 * s8) = o; atomicAdd((float*)(sc + 256 + d), dsum);
    u32x4 ov; ov.x = cvtpk(vv[0], vv[1]); ov.y = cvtpk(vv[2], vv[3]); ov.z = cvtpk(vv[4], vv[5]); ov.w = cvtpk(vv[6], vv[7]);
    *(u32x4*)(SL + MS_VT + d * 64 + 8 * s8) = ov; }
  lds_barrier();
  if (tid < 128) SC[MSC_DN + tid] = sc[256 + tid];
  PP_T(0, 10);
}

__device__ __forceinline__ void gdn_conv_taps(const Params& p, int l, const ChunkDesc& cd, int t, int col  , float (&x)[4][8]) {
  const bf16_t* PROJ = (const bf16_t*)(p.ws + WS_PROJ);
#pragma unroll
  for (int j = 0; j < 4; ++j) {
    const int T = cd.tok0 + t - 3 + j; int row = -1; const float* fsrc = nullptr;
    if (T >= 0) row = (cd.kind == 0 ? cd.b * SEQ : (cd.kind == 1 ? ROW_S + 16 * cd.b : ROW_M)) + T;
    else if (cd.kind == 0) row = ROW_M + 16 + T;
    else if (cd.kind == 1) fsrc = p.in[8] + (((size_t)l * DB + cd.b) * 3 + (3 + T)) * 1536 + col;
    if (row >= 0) { const u32x4 w = *(const u32x4*)((const bf16_t*)(p.ws + WS_PROJH) + (size_t)(12 + (col >> 7)) * PH_T + (size_t)row * 128 + (col & 127));
      x[j][0] = bflo(w.x); x[j][1] = bfhi(w.x); x[j][2] = bflo(w.y); x[j][3] = bfhi(w.y); x[j][4] = bflo(w.z); x[j][5] = bfhi(w.z); x[j][6] = bflo(w.w); x[j][7] = bfhi(w.w); }
    else if (fsrc) { const f32x4 a = *(const f32x4*)fsrc, b = *(const f32x4*)(fsrc + 4); x[j][0] = a.x; x[j][1] = a.y; x[j][2] = a.z; x[j][3] = a.w; x[j][4] = b.x; x[j][5] = b.y; x[j][6] = b.z; x[j][7] = b.w; }
    else {
#pragma unroll
      for (int e = 0; e < 8; ++e) x[j][e] = 0.f; }
  }
}

constexpr int GP_IMG_T = 67 * 272, GP_IMG = 54 * 1024;
__device__ __forceinline__ int gdn_queue_slot(int idx) {
  if (idx < 260) return idx;
  if (idx < 2052) { const int r = idx - 260; return 65 * (4 + (r >> 6)) + 1 + (r & 63); }
  if (idx < 2180) return 2080 + (idx - 2052);
  return NSLOT;
}
__device__ __forceinline__ bool gdn_slot_interior(int slot) { return slot < 32 * 65 && (slot % 65) >= 2; }
__device__ __forceinline__ void gdn_issue(LAS unsigned char* lds, const Params& p, int slot, int tid) {
  const ChunkDesc cd = chunk_of_slot(slot);
  const unsigned char* zero = p.ws + WS_ZERO;
  const unsigned char* src0 = (const unsigned char*)((const bf16_t*)(p.ws + WS_PROJH) + (size_t)(12 + cd.h) * PH_T + (size_t)(cd.b * SEQ + cd.tok0 - 3) * 128);
  const int wu = __builtin_amdgcn_readfirstlane(tid >> 6), lane = tid & 63;
#pragma unroll
  for (int it = 0; it < 7; ++it) { const int k = wu + 8 * it;
    if (k < 54) { const int o = k * 1024 + lane * 16, ten = o / GP_IMG_T, rem = o - ten * GP_IMG_T, row = rem / 272, col = rem - row * 272;
      const unsigned char* src = (ten < 3 && col < 256) ? src0 + (size_t)ten * (4 * PH_T * 2) + row * 256 + col : zero;
      __builtin_amdgcn_global_load_lds((const unsigned*)src, (LAS unsigned*)(lds + k * 1024), 16, 0, 0); } }
}
__device__ __forceinline__ void gdn_prep(LAS unsigned char* lds, const Params& p, int l, int slot, bool have_img, int next_slot, int tid) {
  asm volatile("" : "+v"(tid));
  PP_INIT();
  const ChunkDesc cd = chunk_of_slot(slot);
  const bf16_t* PROJ = (const bf16_t*)(p.ws + WS_PROJ);
  bf16_t* SL = (bf16_t*)(p.ws + WS_GSLOT + (size_t)slot * GSLOT_B); float* SC = (float*)(p.ws + WS_GSLOT + (size_t)slot * GSLOT_B + GS_SC_B);
  const int lane = tid & 63, w = tid >> 6, c16 = lane & 15, q4 = lane >> 4;
  constexpr int RT_P = 528; constexpr int L_Q = 0, L_K = 17408, L_QK = 34816, L_RT = 55296  , L_AM = 89088, L_T = 106496, L_TB = 123904, L_CW = 133120, L_SC = 139264, L_M = 139776;
  LAS float* sc = (LAS float*)(lds + L_SC);
  LAS float* AM = (LAS float*)(lds + L_AM); LAS float* QKf = (LAS float*)(lds + L_QK); LAS float* T = (LAS float*)(lds + L_T);
  LAS float* CW = (LAS float*)(lds + L_CW); LAS float* MB = (LAS float*)(lds + L_M);
  const int t = tid >> 3, part = tid & 7;
  u32x4 xin[3][2][4];
  if (cd.kind == 0 && cd.tok0 > 0) {
    if (!have_img) { gdn_issue(lds, p, slot, tid); asm volatile("s_waitcnt vmcnt(0)" ::: "memory"); }
    lds_barrier();
    const LAS unsigned char* ib = lds + t * 272 + part * 32;
#pragma unroll
    for (int j = 0; j < 4; ++j)
#pragma unroll
      for (int ten = 0; ten < 3; ++ten)
#pragma unroll
        for (int hh = 0; hh < 2; ++hh) xin[ten][hh][j] = *(const LAS u32x4*)(ib + ten * GP_IMG_T + j * 272 + 16 * hh);
  } else {
#pragma unroll
    for (int j = 0; j < 4; ++j) {
      const int Tt = cd.tok0 + t - 3 + j; int row = -1; const float* fsrc = nullptr;
      if (Tt >= 0) row = (cd.kind == 0 ? cd.b * SEQ : (cd.kind == 1 ? ROW_S + 16 * cd.b : ROW_M)) + Tt;
      else if (cd.kind == 0) row = ROW_M + 16 + Tt;
      else if (cd.kind == 1) fsrc = p.in[8] + (((size_t)l * DB + cd.b) * 3 + (3 + Tt)) * 1536;
#pragma unroll
      for (int ten = 0; ten < 3; ++ten)
#pragma unroll
        for (int hh = 0; hh < 2; ++hh) { const int col = ten * 512 + cd.h * 128 + 16 * part + 8 * hh; u32x4 v = {0u, 0u, 0u, 0u};
          if (row >= 0) v = *(const u32x4*)((const bf16_t*)(p.ws + WS_PROJH) + (size_t)(12 + (col >> 7)) * PH_T + (size_t)row * 128 + (col & 127));
          else if (fsrc) { const f32x4 a = *(const f32x4*)(fsrc + col), b = *(const f32x4*)(fsrc + col + 4); v.x = cvtpk(a.x, a.y); v.y = cvtpk(a.z, a.w); v.z = cvtpk(b.x, b.y); v.w = cvtpk(b.z, b.w); }
          xin[ten][hh][j] = v; }
    }
  }
  if (w == 0) {
    float ld = 0.f, be = 0.f;
    if (lane < cd.nvalid) { const bf16_t* pr = PROJ + (size_t)(cd.row0 + lane) * PJR + PC_G16;
      ld = -__expf(p.in[20][l * 4 + cd.h]) * softplusf_(bf2f(pr[8 + cd.h]) + p.in[21][l * 4 + cd.h]); be = sigmoidf_(bf2f(pr[12 + cd.h])); }
    const float G = scan_add(ld, lane); sc[lane] = G; sc[64 + lane] = be;
    if (lane == 63) SC[0] = __expf(G);
  } else if (tid < 64 + 384) { const int i = tid - 64, ten = i >> 7, j = (i >> 5) & 3, c4 = i & 31;
    *(LAS f32x4*)(CW + (ten * 4 + j) * 128 + 4 * c4) = *(const f32x4*)(p.in[19] + ((size_t)l * 4 + j) * 1536 + ten * 512 + cd.h * 128 + 4 * c4); }
  lds_barrier();
  PP_T(1, 0);
  { const float G = sc[t], be = sc[64 + t], eG = __expf(G);
#pragma unroll
    for (int ten = 0; ten < 3; ++ten) {
      float y[16];
#pragma unroll
      for (int hh = 0; hh < 2; ++hh) {
        float a[8];
#pragma unroll
        for (int e = 0; e < 8; ++e) a[e] = 0.f;
#pragma unroll
        for (int j = 0; j < 4; ++j) { const u32x4 v = xin[ten][hh][j]; const LAS float* cw = CW + (ten * 4 + j) * 128 + 16 * part + 8 * hh; const f32x4 w0 = *(const LAS f32x4*)cw, w1 = *(const LAS f32x4*)(cw + 4);
          a[0] += bflo(v.x) * w0.x; a[1] += bfhi(v.x) * w0.y; a[2] += bflo(v.y) * w0.z; a[3] += bfhi(v.y) * w0.w; a[4] += bflo(v.z) * w1.x; a[5] += bfhi(v.z) * w1.y; a[6] += bflo(v.w) * w1.z; a[7] += bfhi(v.w) * w1.w; }
#pragma unroll
        for (int e = 0; e < 8; ++e) y[8 * hh + e] = siluf_(a[e]); }
      if (ten < 2) { float ss = 0.f;
#pragma unroll
        for (int e = 0; e < 16; ++e) ss += y[e] * y[e];
        ss = sum8(ss); const float rn = rsqrtf(ss + EPS) * (ten == 0 ? 0.08838834764831845f : 1.f);
#pragma unroll
        for (int e = 0; e < 16; ++e) y[e] *= rn; }
      if (t >= cd.nvalid) {
#pragma unroll
        for (int e = 0; e < 16; ++e) y[e] = 0.f; }
      if (ten < 2) { u32x4 o0, o1; o0.x = cvtpk(y[0], y[1]); o0.y = cvtpk(y[2], y[3]); o0.z = cvtpk(y[4], y[5]); o0.w = cvtpk(y[6], y[7]);
        o1.x = cvtpk(y[8], y[9]); o1.y = cvtpk(y[10], y[11]); o1.z = cvtpk(y[12], y[13]); o1.w = cvtpk(y[14], y[15]);
        LAS unsigned char* dst = lds + (ten == 0 ? L_Q : L_K) + t * 272 + part * 32; *(LAS u32x4*)dst = o0; *(LAS u32x4*)(dst + 16) = o1; }
      if (ten >= 1) { const float scl = ten == 1 ? be * eG : be; const int cb = ten == 1 ? 128 : 0;
        u32x4 o0, o1; o0.x = cvtpk(scl * y[0], scl * y[1]); o0.y = cvtpk(scl * y[2], scl * y[3]); o0.z = cvtpk(scl * y[4], scl * y[5]); o0.w = cvtpk(scl * y[6], scl * y[7]);
        o1.x = cvtpk(scl * y[8], scl * y[9]); o1.y = cvtpk(scl * y[10], scl * y[11]); o1.z = cvtpk(scl * y[12], scl * y[13]); o1.w = cvtpk(scl * y[14], scl * y[15]);
        LAS unsigned char* dst = lds + L_RT + t * RT_P + (cb + 16 * part) * 2; *(LAS u32x4*)dst = o0; *(LAS u32x4*)(dst + 16) = o1; }
    } }
  lds_barrier();
  PP_T(1, 1);
#pragma unroll
  for (int ti = 0; ti < 4; ++ti) { const int id = 4 * w + ti, isq = id >> 4, tm = (id >> 2) & 3, tn = id & 3; f32x4 acc = {0.f, 0.f, 0.f, 0.f};
#pragma unroll
    for (int kk = 0; kk < 4; ++kk) { const bf16x8 a = *(const LAS bf16x8*)(lds + (isq ? L_Q : L_K) + (16 * tm + c16) * 272 + (32 * kk + 8 * q4) * 2);
      const bf16x8 b = *(const LAS bf16x8*)(lds + L_K + (16 * tn + c16) * 272 + (32 * kk + 8 * q4) * 2);
      acc = __builtin_amdgcn_mfma_f32_16x16x32_bf16(a, b, acc, 0, 0, 0); }
    const int s = 16 * tn + c16; const float Gs = sc[s];
#pragma unroll
    for (int i = 0; i < 4; ++i) { const int tt = 16 * tm + 4 * q4 + i; const float e = __expf(sc[tt] - Gs);
      if (isq) QKf[tt * 68 + s] = (s <= tt) ? acc[i] * e : 0.f; else AM[tt * 68 + s] = (s < tt) ? sc[64 + tt] * acc[i] * e : 0.f; } }
  lds_barrier();
  PP_T(1, 2);
  if (tid < 64) { const int bi = tid >> 4, cc = tid & 15; float x[16];
#pragma unroll
    for (int r = 0; r < 16; ++r) { float a = (r == cc) ? 1.f : 0.f;
#pragma unroll
      for (int s = 0; s < r; ++s) a -= AM[(16 * bi + r) * 68 + 16 * bi + s] * x[s];
      x[r] = a; T[(16 * bi + r) * 68 + 16 * bi + cc] = a; }
  } else {
    const int u = tid - 64; const float Glast = sc[63];
    for (int ci = u; ci < 1024; ci += 448) { const int row = ci >> 4, cq = ci & 15; const u32x4 v = *(const LAS u32x4*)(lds + L_Q + row * 272 + cq * 16); const float e = __expf(sc[row]);
      u32x4 o; o.x = cvtpk(bflo(v.x) * e, bfhi(v.x) * e); o.y = cvtpk(bflo(v.y) * e, bfhi(v.y) * e); o.z = cvtpk(bflo(v.z) * e, bfhi(v.z) * e); o.w = cvtpk(bflo(v.w) * e, bfhi(v.w) * e);
      store_perm8(SL + GS_QT + row * 128, cq * 8, o); }
    for (int id = u; id < 1024; id += 448) { const int d = id & 127, s8 = id >> 7; float kv[8];
#pragma unroll
      for (int j = 0; j < 8; ++j) { const int s = 8 * s8 + j; kv[j] = bf2f(*(const LAS bf16_t*)(lds + L_K + s * 272 + d * 2)) * __expf(Glast - sc[s]); }
      u32x4 o; o.x = cvtpk(kv[0], kv[1]); o.y = cvtpk(kv[2], kv[3]); o.z = cvtpk(kv[4], kv[5]); o.w = cvtpk(kv[6], kv[7]);
      store_perm8(SL + GS_KTT + d * 64, 8 * s8, o); }
    for (int ci = u; ci < 512; ci += 448) { const int row = ci >> 3, c8 = ci & 7; const LAS float* qr = QKf + row * 68 + c8 * 8;
      u32x4 o; o.x = cvtpk(qr[0], qr[1]); o.y = cvtpk(qr[2], qr[3]); o.z = cvtpk(qr[4], qr[5]); o.w = cvtpk(qr[6], qr[7]);
      store_perm8(SL + GS_QK + row * 64, c8 * 8, o); }
    for (int e = u; e < 6 * 256; e += 448) { const int bp = e >> 8, r = (e >> 4) & 15, cc = e & 15;
      const int bi = bp < 3 ? 0 : (bp < 5 ? 1 : 2), bj = bp < 3 ? bp + 1 : (bp < 5 ? bp - 1 : 3); T[(16 * bi + r) * 68 + 16 * bj + cc] = 0.f; }
  }
  lds_barrier();
  if (next_slot < NSLOT && gdn_slot_interior(next_slot)) gdn_issue(lds, p, next_slot, tid);
  PP_T(1, 3);
  { auto split4 = [](const f32x4& x, v4i16_t& hi, v4i16_t& lo) {
#pragma unroll
      for (int i = 0; i < 4; ++i) { const bf16_t h = f2bf(x[i]); hi[i] = (short)h; lo[i] = (short)f2bf(x[i] - bf2f(h)); } };
#pragma unroll
    for (int bi = 1; bi < 4; ++bi) {
      if (w < bi) { const int bj = w; f32x4 m = {0.f, 0.f, 0.f, 0.f};
        for (int kb = bj; kb < bi; ++kb) {
          const f32x4 av = *(const LAS f32x4*)(AM + (16 * bi + c16) * 68 + 16 * kb + 4 * q4);
          f32x4 tv;
#pragma unroll
          for (int i = 0; i < 4; ++i) tv[i] = T[(16 * kb + 4 * q4 + i) * 68 + 16 * bj + c16];
          v4i16_t ah, al, th, tl; split4(av, ah, al); split4(tv, th, tl);
          m = __builtin_amdgcn_mfma_f32_16x16x16bf16_1k(ah, th, m, 0, 0, 0); m = __builtin_amdgcn_mfma_f32_16x16x16bf16_1k(ah, tl, m, 0, 0, 0); m = __builtin_amdgcn_mfma_f32_16x16x16bf16_1k(al, th, m, 0, 0, 0); }
        const f32x4 dv = *(const LAS f32x4*)(T + (16 * bi + c16) * 68 + 16 * bi + 4 * q4);
        v4i16_t dh, dl, mh, ml; split4(dv, dh, dl); split4(m, mh, ml);
        f32x4 r = {0.f, 0.f, 0.f, 0.f};
        r = __builtin_amdgcn_mfma_f32_16x16x16bf16_1k(dh, mh, r, 0, 0, 0); r = __builtin_amdgcn_mfma_f32_16x16x16bf16_1k(dh, ml, r, 0, 0, 0); r = __builtin_amdgcn_mfma_f32_16x16x16bf16_1k(dl, mh, r, 0, 0, 0);
#pragma unroll
        for (int i = 0; i < 4; ++i) T[(16 * bi + 4 * q4 + i) * 68 + 16 * bj + c16] = -r[i]; }
      lds_barrier();
    } }
  { const int row = tid >> 3, c8 = tid & 7; const LAS float* tr = T + row * 68 + c8 * 8;
    u32x4 o; o.x = cvtpk(tr[0], tr[1]); o.y = cvtpk(tr[2], tr[3]); o.z = cvtpk(tr[4], tr[5]); o.w = cvtpk(tr[6], tr[7]);
    *(LAS u32x4*)(lds + L_TB + row * 144 + c8 * 16) = o; }
  asm volatile("s_waitcnt vmcnt(0)" ::: "memory");
  lds_barrier();
  PP_T(1, 4);
  { const int l16 = lane & 15; const int troff = (8 * q4 + (l16 >> 2)) * RT_P + (4 * (l16 & 3)) * 2;
#pragma unroll
  for (int ti = 0; ti < 8; ++ti) { const int id = 8 * w + ti; f32x4 acc = {0.f, 0.f, 0.f, 0.f};
    if (id < 32) { const int mt = id >> 3, nt = id & 7;
#pragma unroll
      for (int ks = 0; ks < 2; ++ks) { const bf16x8 a = *(const LAS bf16x8*)(lds + L_TB + (16 * mt + c16) * 144 + (32 * ks + 8 * q4) * 2);
        const v4i16_t b0 = __builtin_amdgcn_ds_read_tr16_b64_v4i16((LAS v4i16_t*)(lds + L_RT + troff + (32 * ks) * RT_P + (16 * nt) * 2));
        const v4i16_t b1 = __builtin_amdgcn_ds_read_tr16_b64_v4i16((LAS v4i16_t*)(lds + L_RT + troff + (32 * ks + 4) * RT_P + (16 * nt) * 2));
        const bf16x8 b = {b0[0], b0[1], b0[2], b0[3], b1[0], b1[1], b1[2], b1[3]};
        acc = __builtin_amdgcn_mfma_f32_16x16x32_bf16(a, b, acc, 0, 0, 0); }
      u32x2 o; o.x = cvtpk(acc[0], acc[1]); o.y = cvtpk(acc[2], acc[3]);
      *(u32x2*)(SL + GS_UT + (16 * nt + c16) * 64 + 16 * mt + 4 * q4) = o;
    } else { const int mt = (id - 32) >> 2, nt = (id - 32) & 3;
#pragma unroll
      for (int ks = 0; ks < 2; ++ks) {
        const v4i16_t a0 = __builtin_amdgcn_ds_read_tr16_b64_v4i16((LAS v4i16_t*)(lds + L_RT + troff + (32 * ks) * RT_P + (128 + 16 * mt) * 2));
        const v4i16_t a1 = __builtin_amdgcn_ds_read_tr16_b64_v4i16((LAS v4i16_t*)(lds + L_RT + troff + (32 * ks + 4) * RT_P + (128 + 16 * mt) * 2));
        const bf16x8 a = {a0[0], a0[1], a0[2], a0[3], a1[0], a1[1], a1[2], a1[3]};
        const bf16x8 b = *(const LAS bf16x8*)(lds + L_TB + (16 * nt + c16) * 144 + (32 * ks + 8 * q4) * 2);
        acc = __builtin_amdgcn_mfma_f32_16x16x32_bf16(a, b, acc, 0, 0, 0); }
      u32x2 o; o.x = cvtpk(-acc[0], -acc[1]); o.y = cvtpk(-acc[2], -acc[3]);
      *(u32x2*)(SL + GS_NW + (16 * nt + c16) * 128 + 32 * (mt >> 1) + 8 * q4 + 4 * (mt & 1)) = o;
    } } }
  lds_barrier();
  PP_T(1, 5);
}

constexpr int SC_STAGE = 62464, SC_MISC = 2 * SC_STAGE;
__device__ __forceinline__ bf16x8 pack_acc2(const f32x4& a, const f32x4& b) { u32x4 o; o.x = cvtpk(a[0], a[1]); o.y = cvtpk(a[2], a[3]); o.z = cvtpk(b[0], b[1]); o.w = cvtpk(b[2], b[3]); return __builtin_bit_cast(bf16x8, o); }
__device__ __forceinline__ bf16x8 lda_perm(const LAS unsigned char* base) { return *(const LAS bf16x8*)base; }

template <bool GDN>
__device__ __forceinline__ void scan_chain(LAS unsigned char* lds, const Params& p, int l, int chain  , int tid) {
  asm volatile("" : "+v"(tid));
  const int lane = tid & 63, w = tid >> 6, c16 = lane & 15, q4 = lane >> 4;
  const bool samp = chain >= 32; const int ch = samp ? chain - 32 : chain; const int b = ch >> 2, h = ch & 3;
  const int slot0 = samp ? 32 * 65 + ch : ch * 65, nch = samp ? 1 : 65;
  const unsigned char* slots = p.ws + (GDN ? WS_GSLOT : WS_MSLOT); constexpr int SLOT_B = GDN ? GSLOT_B : MSLOT_B;
  constexpr int NLD = GDN ? 7 : 5;
  bf16_t* OUT = (bf16_t*)(p.ws + (GDN ? WS_OG : WS_HM));
  LAS float* nvec = (LAS float*)(lds + SC_MISC); LAS float* c1 = nvec + 128; LAS float* c2 = nvec + 192;
  f32x4 S[8]; float mrun = 0.f;
  const int vcol = 16 * w + c16;
  if (!samp) {
#pragma unroll
    for (int i = 0; i < 8; ++i) S[i] = (f32x4){0.f, 0.f, 0.f, 0.f};
    if (!GDN && tid < 128) nvec[tid] = 0.f;
  } else if (GDN) {
    const float* S0 = p.in[7] + (((size_t)l * DB + b) * 4 + h) * 128 * 128;
#pragma unroll
    for (int i = 0; i < 8; ++i)
#pragma unroll
      for (int r = 0; r < 4; ++r) S[i][r] = S0[(size_t)(16 * i + 4 * q4 + r) * 128 + vcol];
  } else {
    const float* C0 = p.in[4] + (((size_t)l * DB + b) * 4 + h) * 128 * 128;
#pragma unroll
    for (int i = 0; i < 8; ++i) S[i] = *(const f32x4*)(C0 + (size_t)vcol * 128 + 16 * i + 4 * q4);
    if (tid < 128) nvec[tid] = p.in[5][(((size_t)l * DB + b) * 4 + h) * 128 + tid];
    mrun = p.in[6][((size_t)l * DB + b) * 4 + h];
  }
  auto lds_dst = [](int ci) -> int {
    if (GDN) { if (ci < 1024) return (ci >> 4) * 272 + (ci & 15) * 16; if (ci < 2048) { ci -= 1024; return 17408 + (ci >> 4) * 272 + (ci & 15) * 16; }
      if (ci < 2560) { ci -= 2048; return 34816 + (ci >> 3) * 144 + (ci & 7) * 16; } ci -= 2560; return 44032 + (ci >> 3) * 144 + (ci & 7) * 16; }
    else { if (ci < 1024) return (ci >> 4) * 272 + (ci & 15) * 16; if (ci < 1536) { ci -= 1024; return 17408 + (ci >> 3) * 144 + (ci & 7) * 16; }
      ci -= 1536; return 26624 + (ci >> 3) * 144 + (ci & 7) * 16; } };
  constexpr int L_A0 = 0;
  constexpr int L_QT = 17408;
  constexpr int L_QK = GDN ? 34816 : 17408;
  constexpr int L_KT = GDN ? 44032 : 26624;
  constexpr int L_SCAL = 45056;
  u32x4 stA[NLD], stB[NLD]; u32x4 scA = {0u, 0u, 0u, 0u}; u32x2 utA[4], utB[4]; float glA = 1.f, glB = 1.f; bf16x8 bvA[2];
  u32x2 utc[4]; float glc = 1.f; bf16x8 bvc[2];
#define SC_LOAD(ST, UT, GL, CH) do { const unsigned char* s_ = slots + (size_t)((!samp && (CH) == 0) ? h * 65 : slot0 + (CH)) * SLOT_B;     const u32x4* g_ = (const u32x4*)s_; const bf16_t* sb_ = (const bf16_t*)s_; \
    _Pragma("unroll") for (int k = 0; k < NLD; ++k) ST[k] = g_[tid + 512 * k]; \
    if (GDN) { _Pragma("unroll") for (int mt = 0; mt < 4; ++mt) UT[mt] = *(const u32x2*)(sb_ + GS_UT + vcol * 64 + 16 * mt + 4 * q4); GL = ((const float*)(s_ + GS_SC_B))[0]; } \
    else { if (tid < 84) scA = g_[3584 + tid]; _Pragma("unroll") for (int ks = 0; ks < 2; ++ks) bvA[ks] = *(const bf16x8*)(sb_ + MS_VT + vcol * 64 + 32 * ks + 8 * q4); } } while (0)
#define SC_STORE(ST, UT, GL, STG) do { LAS unsigned char* nb_ = lds + (STG) * SC_STAGE; \
    _Pragma("unroll") for (int k = 0; k < NLD; ++k) *(LAS u32x4*)(nb_ + lds_dst(tid + 512 * k)) = ST[k]; \
    if (GDN) { _Pragma("unroll") for (int mt = 0; mt < 4; ++mt) utc[mt] = UT[mt]; glc = GL; } \
    else { if (tid < 84) *(LAS u32x4*)(nb_ + L_SCAL + tid * 16) = scA; bvc[0] = bvA[0]; bvc[1] = bvA[1]; } } while (0)
#if PROBE_LEVEL == 2
#define SS_T(i) do { if (GDN) { const unsigned long long t_ = __builtin_amdgcn_s_memrealtime(); sacc_[(i)] += t_ - tl_; tl_ = t_; } } while (0)
  unsigned long long tl_ = __builtin_amdgcn_s_memrealtime(); unsigned long long sacc_[4] = {0ull, 0ull, 0ull, 0ull};
#else
#define SS_T(i) do {} while (0)
#endif
  f32x4 o[4];
  auto step = [&](const int c) {
    LAS unsigned char* cur = lds + (c & 1) * SC_STAGE;
    SS_T(3);
    bf16x8 Sb[4];
#pragma unroll
    for (int kk = 0; kk < 4; ++kk) Sb[kk] = pack_acc2(S[2 * kk], S[2 * kk + 1]);
    if (GDN) {
      f32x4 dl[4];
#pragma unroll
      for (int mt = 0; mt < 4; ++mt) { const u32x2 u = utc[mt]; dl[mt] = (f32x4){bflo(u.x), bfhi(u.x), bflo(u.y), bfhi(u.y)}; o[mt] = (f32x4){0.f, 0.f, 0.f, 0.f}; }
#pragma unroll
      for (int mt = 0; mt < 4; ++mt)
#pragma unroll
        for (int kk = 0; kk < 4; ++kk) {
          const bf16x8 aw = lda_perm(cur + L_A0 + (16 * mt + c16) * 272 + (32 * kk + 8 * q4) * 2);
          const bf16x8 aq = lda_perm(cur + L_QT + (16 * mt + c16) * 272 + (32 * kk + 8 * q4) * 2);
          dl[mt] = __builtin_amdgcn_mfma_f32_16x16x32_bf16(aw, Sb[kk], dl[mt], 0, 0, 0);
          o[mt] = __builtin_amdgcn_mfma_f32_16x16x32_bf16(aq, Sb[kk], o[mt], 0, 0, 0); }
      bf16x8 Db[2];
#pragma unroll
      for (int ks = 0; ks < 2; ++ks) Db[ks] = pack_acc2(dl[2 * ks], dl[2 * ks + 1]);
      asm volatile("" :: "v"(Db[0]), "v"(Db[1])); SS_T(0);
#pragma unroll
      for (int mt = 0; mt < 4; ++mt)
#pragma unroll
        for (int ks = 0; ks < 2; ++ks) { const bf16x8 a = lda_perm(cur + L_QK + (16 * mt + c16) * 144 + (32 * ks + 8 * q4) * 2);
          o[mt] = __builtin_amdgcn_mfma_f32_16x16x32_bf16(a, Db[ks], o[mt], 0, 0, 0); }
      const float gl = glc;
#pragma unroll
      for (int i = 0; i < 8; ++i) { S[i] *= gl;
#pragma unroll
        for (int ks = 0; ks < 2; ++ks) { const bf16x8 a = lda_perm(cur + L_KT + (16 * i + c16) * 144 + (32 * ks + 8 * q4) * 2);
          S[i] = __builtin_amdgcn_mfma_f32_16x16x32_bf16(a, Db[ks], S[i], 0, 0, 0); } }
    } else {
      const LAS float* scal = (const LAS float*)(cur + L_SCAL);
      bf16x8 bv[2];
#pragma unroll
      for (int ks = 0; ks < 2; ++ks) bv[ks] = bvc[ks];
      { const int t = tid >> 3, part = tid & 7; const LAS unsigned char* qr = cur + L_A0 + t * 272 + part * 32; float a = 0.f;
        const u32x4 q0 = *(const LAS u32x4*)qr, q1 = *(const LAS u32x4*)(qr + 16);
        const LAS float* n0 = nvec + 32 * (part >> 1) + 8 * (part & 1); const LAS float* n1 = n0 + 16;
        a += bflo(q0.x) * n0[0] + bfhi(q0.x) * n0[1] + bflo(q0.y) * n0[2] + bfhi(q0.y) * n0[3] + bflo(q0.z) * n1[0] + bfhi(q0.z) * n1[1] + bflo(q0.w) * n1[2] + bfhi(q0.w) * n1[3];
        a += bflo(q1.x) * n0[4] + bfhi(q1.x) * n0[5] + bflo(q1.y) * n0[6] + bfhi(q1.y) * n0[7] + bflo(q1.z) * n1[4] + bfhi(q1.z) * n1[5] + bflo(q1.w) * n1[6] + bfhi(q1.w) * n1[7];
        a = sum8(a);
        if (part == 0) { const float inter = scal[MSC_B + t] + mrun, ml = scal[MSC_MLOC + t]; const float mt_ = fmaxf(inter, ml);
          const float w1 = __expf(inter - mt_), w2 = __expf(ml - mt_); const float den = w1 * a + w2 * scal[MSC_RS + t];
          const float sc_ = 1.f / fmaxf(fabsf(den), __expf(-mt_)); c1[t] = w1 * sc_; c2[t] = w2 * sc_; } }
      f32x4 a1[4], a2[4];
#pragma unroll
      for (int mt = 0; mt < 4; ++mt) { a1[mt] = (f32x4){0.f, 0.f, 0.f, 0.f}; a2[mt] = (f32x4){0.f, 0.f, 0.f, 0.f};
#pragma unroll
        for (int kk = 0; kk < 4; ++kk) { const bf16x8 aq = lda_perm(cur + L_A0 + (16 * mt + c16) * 272 + (32 * kk + 8 * q4) * 2);
          a1[mt] = __builtin_amdgcn_mfma_f32_16x16x32_bf16(aq, Sb[kk], a1[mt], 0, 0, 0); }
#pragma unroll
        for (int ks = 0; ks < 2; ++ks) { const bf16x8 a = *(const LAS bf16x8*)(cur + L_QK + (16 * mt + c16) * 144 + (32 * ks + 8 * q4) * 2);
          a2[mt] = __builtin_amdgcn_mfma_f32_16x16x32_bf16(a, bv[ks], a2[mt], 0, 0, 0); } }
      lds_barrier();
#pragma unroll
      for (int mt = 0; mt < 4; ++mt)
#pragma unroll
        for (int r = 0; r < 4; ++r) { const int t = 16 * mt + 4 * q4 + r; o[mt][r] = c1[t] * a1[mt][r] + c2[t] * a2[mt][r]; }
      const float A = scal[MSC_A], B = scal[MSC_BB]; const float mnew = fmaxf(B + mrun, A); const float alpha = __expf(B + mrun - mnew), beta = __expf(A - mnew);
#pragma unroll
      for (int i = 0; i < 8; ++i) { f32x4 X = {0.f, 0.f, 0.f, 0.f};
#pragma unroll
        for (int ks = 0; ks < 2; ++ks) { const bf16x8 a = *(const LAS bf16x8*)(cur + L_KT + (16 * i + c16) * 144 + (32 * ks + 8 * q4) * 2);
          X = __builtin_amdgcn_mfma_f32_16x16x32_bf16(a, bv[ks], X, 0, 0, 0); }
        S[i] = S[i] * alpha + X * beta; }
      if (tid < 128) nvec[tid] = alpha * nvec[tid] + beta * scal[MSC_DN + tid];
      mrun = mnew;
    }
    asm volatile("" :: "v"(S[0]), "v"(S[7])); SS_T(1);
  };
  auto emit = [&](const int c) {
    const int nvalid = samp ? 16 : (c == 0 ? 16 : 64);
    const int row0 = samp ? ROW_S + 16 * b : (c == 0 ? ROW_M : b * SEQ + 64 * (c - 1));
    { bf16_t* op = OUT + (size_t)(row0 + 4 * q4) * 512 + h * 128 + vcol;
#pragma unroll
      for (int mt = 0; mt < 4; ++mt) if (16 * mt < nvalid) {
#pragma unroll
        for (int r = 0; r < 4; ++r) op[(16 * mt + r) * 512] = f2bf(o[mt][r]); } }
    SS_T(2);
  };
  if (GDN) {
    SC_LOAD(stB, utB, glB, 0); SC_STORE(stB, utB, glB, 0);
    if (nch > 1) SC_LOAD(stA, utA, glA, 1);
    lds_barrier();
    for (int c = 0; c < nch; c += 2) {
      if (c + 2 < nch) SC_LOAD(stB, utB, glB, c + 2);
      step(c);
      if (c + 1 < nch) SC_STORE(stA, utA, glA, 1);
      emit(c);
      lds_barrier();
      if (c + 1 >= nch) break;
      if (c + 3 < nch) SC_LOAD(stA, utA, glA, c + 3);
      step(c + 1);
      if (c + 2 < nch) SC_STORE(stB, utB, glB, 0);
      emit(c + 1);
      lds_barrier();
    }
  } else {
    SC_LOAD(stA, utA, glA, 0); SC_STORE(stA, utA, glA, 0);
    lds_barrier();
    for (int c = 0; c < nch; ++c) {
      if (c + 1 < nch) SC_LOAD(stA, utA, glA, c + 1);
      step(c);
      if (c + 1 < nch) SC_STORE(stA, utA, glA, (c + 1) & 1);
      emit(c);
      lds_barrier();
    }
  }
#undef SC_LOAD
#undef SC_STORE
#if PROBE_LEVEL == 2
  if (GDN && tid == 0 && blockIdx.x == 32 && !samp) { for (int i = 0; i < 4; ++i) ((unsigned long long*)(p.ws + WS_CTL + 2048))[i] += sacc_[i]; }
#endif
  if (GDN) { float* So = p.out + (samp ? O_SS + (((size_t)l * DB + b) * 4 + h) * 16384 : O_PS + (((size_t)l * NB + b) * 4 + h) * 16384);
#pragma unroll
    for (int i = 0; i < 8; ++i)
#pragma unroll
      for (int r = 0; r < 4; ++r) So[(size_t)(16 * i + 4 * q4 + r) * 128 + vcol] = S[i][r];
  } else { float* Co = p.out + (samp ? O_SC + (((size_t)l * DB + b) * 4 + h) * 16384 : O_PC + (((size_t)l * NB + b) * 4 + h) * 16384);
#pragma unroll
    for (int i = 0; i < 8; ++i) *(f32x4*)(Co + (size_t)vcol * 128 + 16 * i + 4 * q4) = S[i];
    if (tid < 128) (p.out + (samp ? O_SN + (((size_t)l * DB + b) * 4 + h) * 128 : O_PN + (((size_t)l * NB + b) * 4 + h) * 128))[tid] = nvec[tid];
    if (tid == 0) (p.out + (samp ? O_SM + ((size_t)l * DB + b) * 4 + h : O_PM + ((size_t)l * NB + b) * 4 + h))[0] = mrun;
  }
  __syncthreads();
}


constexpr int SA_KP = 592;
constexpr int SA_KT = 64 * SA_KP;
constexpr int SA_QOFF = SA_KT;
constexpr int SA_NG = 2;
constexpr int SA_PART = 128 * 264;
constexpr size_t WS_SAPART = WS_END1;
constexpr size_t WS_TPART = al256(WS_SAPART + (size_t)DB * SA_NG * SA_PART * 4);
constexpr size_t WS_X1B = al256(WS_TPART + (size_t)3 * 768 * 1024 * 4);
constexpr size_t WS_END2 = al256(WS_X1B + (size_t)NP * D * 2);

__device__ __forceinline__ void sattn_unit(LAS unsigned char* lds, const Params& p, int l, int b, int g, int tid) {
  asm volatile("" : "+v"(tid));
  const int lane = tid & 63, w = tid >> 6, c16 = lane & 15, q4 = lane >> 4;
  const bf16_t* QS = (const bf16_t*)(p.ws + WS_QS) + (size_t)b * 16 * 768;
  { const int h = w; const bf16_t* WK = (const bf16_t*)(p.ws + WS_WUKR) + (size_t)l * 256 * 512 + h * 64;
    bf16x8 a[2];
#pragma unroll
    for (int ks = 0; ks < 2; ++ks) a[ks] = *(const bf16x8*)(QS + (size_t)c16 * 768 + h * 96 + 32 * ks + 8 * q4);
#pragma unroll
    for (int nt = 0; nt < 16; ++nt) { f32x4 acc = {0.f, 0.f, 0.f, 0.f};
#pragma unroll
      for (int ks = 0; ks < 2; ++ks) { const bf16x8 bb = *(const bf16x8*)(WK + (size_t)(16 * nt + c16) * 512 + 32 * ks + 8 * q4);
        acc = __builtin_amdgcn_mfma_f32_16x16x32_bf16(a[ks], bb, acc, 0, 0, 0); }
#pragma unroll
      for (int r = 0; r < 4; ++r) { const int t = 4 * q4 + r; *(LAS bf16_t*)(lds + SA_QOFF + (t * 8 + h) * SA_KP + (16 * nt + c16) * 2) = f2bf(acc[r]); } }
    { const int row = tid >> 2, part = tid & 3, t = row >> 3, hh = row & 7;
      *(LAS u32x4*)(lds + SA_QOFF + row * SA_KP + 512 + part * 16) = *(const u32x4*)(QS + (size_t)t * 768 + hh * 96 + 64 + part * 8); } }
  const LAS unsigned char* qrow = lds + SA_QOFF + (16 * w + c16) * SA_KP + (8 * q4) * 2;
  const int tile0 = (64 / SA_NG) * g, ntile = g == SA_NG - 1 ? 64 / SA_NG + 1 : 64 / SA_NG;
  const float* CL = p.in[2] + ((size_t)l * DB + b) * NCACHE * 256; const float* CK = p.in[3] + ((size_t)l * DB + b) * NCACHE * 32;
  const float* NL = p.out + O_SLAT + ((size_t)l * DB + b) * DS * 256; const float* NK = p.out + O_SKR + ((size_t)l * DB + b) * DS * 32;
  f32x4 stA[9], stB[9];
#define SA_LOAD(ST, TILE) do { const int tl_ = (TILE); int tj = tid; asm volatile("" : "+v"(tj)); \
    if (tl_ < NCACHE / 64) { const f32x4* cl_ = (const f32x4*)(CL + (size_t)tl_ * 64 * 256) + tj; \
      _Pragma("unroll") for (int k = 0; k < 8; ++k) ST[k] = cl_[512 * k]; \
      ST[8] = ((const f32x4*)(CK + (size_t)tl_ * 64 * 32))[tj]; } \
    else { \
      _Pragma("unroll") for (int k = 0; k < 8; ++k) { const int kg = tl_ * 64 + (tj >> 6) + 8 * k, part = tj & 63; f32x4 v = {0.f, 0.f, 0.f, 0.f}; \
        if (kg < NCACHE) v = *(const f32x4*)(CL + (size_t)kg * 256 + 4 * part); else if (kg < NCACHE + DS) v = *(const f32x4*)(NL + (size_t)(kg - NCACHE) * 256 + 4 * part); ST[k] = v; } \
      { const int kg = tl_ * 64 + (tj >> 3), part = tj & 7; f32x4 v = {0.f, 0.f, 0.f, 0.f}; \
        if (kg < NCACHE) v = *(const f32x4*)(CK + (size_t)kg * 32 + 4 * part); else if (kg < NCACHE + DS) v = *(const f32x4*)(NK + (size_t)(kg - NCACHE) * 32 + 4 * part); ST[8] = v; } } } while (0)
#define SA_STORE(ST) do { int tj = tid; asm volatile("" : "+v"(tj)); \
    _Pragma("unroll") for (int k = 0; k < 8; ++k) { u32x2 o; o.x = cvtpk(ST[k].x, ST[k].y); o.y = cvtpk(ST[k].z, ST[k].w); \
      *(LAS u32x2*)(lds + ((tj >> 6) + 8 * k) * SA_KP + (tj & 63) * 8) = o; } \
    { u32x2 o; o.x = cvtpk(ST[8].x, ST[8].y); o.y = cvtpk(ST[8].z, ST[8].w); *(LAS u32x2*)(lds + (tj >> 3) * SA_KP + 512 + (tj & 7) * 8) = o; } } while (0)
  SA_LOAD(stB, tile0); SA_STORE(stB);
  if (ntile > 1) SA_LOAD(stA, tile0 + 1);
  if (ntile > 2) SA_LOAD(stB, tile0 + 2);
  __syncthreads();
  f32x4 O[16];
#pragma unroll
  for (int i = 0; i < 16; ++i) O[i] = (f32x4){0.f, 0.f, 0.f, 0.f};
  float mrun = -INFINITY, lrun = 0.f;
  auto compute_tile = [&](int j) {
    LAS unsigned char* kb = lds;
    f32x4 s[4];
#pragma unroll
    for (int mt = 0; mt < 4; ++mt) s[mt] = (f32x4){0.f, 0.f, 0.f, 0.f};
#pragma unroll
    for (int ks = 0; ks < 9; ++ks) { const bf16x8 qf = *(const LAS bf16x8*)(qrow + 64 * ks);
#pragma unroll
      for (int mt = 0; mt < 4; ++mt) { const bf16x8 a = *(const LAS bf16x8*)(kb + (16 * mt + c16) * SA_KP + (32 * ks + 8 * q4) * 2);
        s[mt] = __builtin_amdgcn_mfma_f32_16x16x32_bf16(a, qf, s[mt], 0, 0, 0); }
      if (ks % 3 == 2) __builtin_amdgcn_sched_barrier(0); }
    const int kbase = (tile0 + j) * 64;
    float tm = -INFINITY;
#pragma unroll
    for (int mt = 0; mt < 4; ++mt)
#pragma unroll
      for (int r = 0; r < 4; ++r) { if (kbase + 16 * mt + 4 * q4 + r >= NCACHE + DS) s[mt][r] = -INFINITY; tm = fmaxf(tm, s[mt][r]); }
    tm = fmaxf(tm, __shfl_xor(tm, 16)); tm = fmaxf(tm, __shfl_xor(tm, 32));
    const float mnew = fmaxf(mrun, tm); const float alpha = __builtin_amdgcn_exp2f(mrun - mnew); mrun = mnew; float ps = 0.f;
#pragma unroll
    for (int mt = 0; mt < 4; ++mt)
#pragma unroll
      for (int r = 0; r < 4; ++r) { s[mt][r] = __builtin_amdgcn_exp2f(s[mt][r] - mnew); ps += s[mt][r]; }
    lrun = lrun * alpha + ps;
    bf16x8 pb[2];
#pragma unroll
    for (int ks = 0; ks < 2; ++ks) pb[ks] = pack_acc2(s[2 * ks], s[2 * ks + 1]);
    const int vo = (4 * q4 + (c16 >> 2)) * SA_KP + (4 * (c16 & 3)) * 2;
#pragma unroll
    for (int nt = 0; nt < 16; ++nt) { O[nt] *= alpha;
#pragma unroll
      for (int ks = 0; ks < 2; ++ks) {
        const v4i16_t a0 = __builtin_amdgcn_ds_read_tr16_b64_v4i16((LAS v4i16_t*)(kb + vo + (32 * ks) * SA_KP + nt * 32));
        const v4i16_t a1 = __builtin_amdgcn_ds_read_tr16_b64_v4i16((LAS v4i16_t*)(kb + vo + (32 * ks + 16) * SA_KP + nt * 32));
        const bf16x8 va = {a0[0], a0[1], a0[2], a0[3], a1[0], a1[1], a1[2], a1[3]};
        O[nt] = __builtin_amdgcn_mfma_f32_16x16x32_bf16(va, pb[ks], O[nt], 0, 0, 0); }
      if ((nt & 7) == 7) __builtin_amdgcn_sched_barrier(0); }
  };
  for (int j = 0; j < ntile; j += 2) {
    compute_tile(j);
    __syncthreads();
    if (j + 1 < ntile) SA_STORE(stA);
    __syncthreads();
    if (j + 3 < ntile) SA_LOAD(stA, tile0 + j + 3);
    if (j + 1 >= ntile) break;
    compute_tile(j + 1);
    __syncthreads();
    if (j + 2 < ntile) SA_STORE(stB);
    __syncthreads();
    if (j + 4 < ntile) SA_LOAD(stB, tile0 + j + 4);
  }
#undef SA_LOAD
#undef SA_STORE
  float* P = (float*)(p.ws + WS_SAPART) + (size_t)(b * SA_NG + g) * SA_PART + (size_t)(16 * w + c16) * 264;
#pragma unroll
  for (int nt = 0; nt < 16; ++nt) *(f32x4*)(P + 16 * nt + 4 * q4) = O[nt];
  lrun += __shfl_xor(lrun, 16); lrun += __shfl_xor(lrun, 32);
  if (q4 == 0) { P[256] = mrun; P[257] = lrun; }
  __syncthreads();
}

__device__ __forceinline__ void phase_finalize(LAS unsigned char* lds, const Params& p, int l, int gw, int NGW, int lane) {
  const bf16_t* PROJ = (const bf16_t*)(p.ws + WS_PROJ);
  bf16_t* HM = (bf16_t*)(p.ws + WS_HM); bf16_t* OG = (bf16_t*)(p.ws + WS_OG); bf16_t* OA = (bf16_t*)(p.ws + WS_OA);
  const float* mnw = p.in[18] + (size_t)l * 512; const float* gnw = p.in[22] + (size_t)l * 128;
  { const int un = gw >> 3, wv = gw & 7;
    if (un < DB * 8) {
      const int b = un >> 3, h = un & 7, c16 = lane & 15, q4 = lane >> 4;
      const float* P = (const float*)(p.ws + WS_SAPART) + (size_t)(b * SA_NG) * SA_PART + (size_t)(c16 * 8 + h) * 264;
      float mg[SA_NG], M = -INFINITY;
#pragma unroll
      for (int g = 0; g < SA_NG; ++g) { mg[g] = P[(size_t)g * SA_PART + 256]; M = fmaxf(M, mg[g]); }
      float L = 0.f;
#pragma unroll
      for (int g = 0; g < SA_NG; ++g) { mg[g] = __builtin_amdgcn_exp2f(mg[g] - M); L += P[(size_t)g * SA_PART + 257] * mg[g]; }
      const float invL = 1.f / L;
      const bf16_t* WT = (const bf16_t*)(p.ws + WS_WUVT) + (size_t)l * 512 * 256 + (size_t)(h * 64) * 256;
      const int ks = wv;
      f32x4 v0 = {0.f, 0.f, 0.f, 0.f}, v1 = {0.f, 0.f, 0.f, 0.f};
#pragma unroll
      for (int g = 0; g < SA_NG; ++g) { const float* pg = P + (size_t)g * SA_PART + 32 * ks + 8 * q4; v0 += *(const f32x4*)pg * mg[g]; v1 += *(const f32x4*)(pg + 4) * mg[g]; }
      v0 *= invL; v1 *= invL;
      u32x4 aw; aw.x = cvtpk(v0[0], v0[1]); aw.y = cvtpk(v0[2], v0[3]); aw.z = cvtpk(v1[0], v1[1]); aw.w = cvtpk(v1[2], v1[3]);
      const bf16x8 af = __builtin_bit_cast(bf16x8, aw);
      LAS f32x4* red = (LAS f32x4*)lds;
#pragma unroll
      for (int nt = 0; nt < 4; ++nt) { const bf16x8 bf = *(const bf16x8*)(WT + (size_t)(16 * nt + c16) * 256 + 32 * ks + 8 * q4);
        const f32x4 acc = __builtin_amdgcn_mfma_f32_16x16x32_bf16(af, bf, (f32x4){0.f, 0.f, 0.f, 0.f}, 0, 0, 0);
        red[(wv * 4 + nt) * 64 + lane] = acc; }
      __syncthreads();
      if (wv < 4) { const int nt = wv; f32x4 s = red[nt * 64 + lane];
#pragma unroll
        for (int w2 = 1; w2 < 8; ++w2) s += red[(w2 * 4 + nt) * 64 + lane];
#pragma unroll
        for (int r = 0; r < 4; ++r) { const int t = 4 * q4 + r, row = ROW_S + b * 16 + t, col = h * 64 + 16 * nt + c16;
          OA[(size_t)row * 512 + col] = f2bf(s[r] * siluf_(bf2f(PROJ[(size_t)row * PJR + RC_ZA + col]))); } }
      __syncthreads();
    } }
  { const int hh = lane >> 4, c8 = (lane & 15) * 8, col = hh * 128 + c8;
    const f32x4 mn0 = *(const f32x4*)(mnw + col), mn1 = *(const f32x4*)(mnw + col + 4), gn0 = *(const f32x4*)(gnw + c8), gn1 = *(const f32x4*)(gnw + c8 + 4);
    for (int r0 = 2 * gw; r0 < MROWS; r0 += 2 * NGW) {
      u32x4 hv[2], ov[2], zm[2], gv[2], zg[2];
#pragma unroll
      for (int i = 0; i < 2; ++i) { const int r = r0 + i; const bf16_t* pr = PROJ + (size_t)r * PJR;
        hv[i] = *(const u32x4*)(HM + (size_t)r * 512 + col); ov[i] = *(const u32x4*)(pr + RC_MO + col); zm[i] = *(const u32x4*)(pr + RC_ZM + col);
        gv[i] = *(const u32x4*)(OG + (size_t)r * 512 + col); zg[i] = *(const u32x4*)(pr + RC_ZG + col); }
      float a[2][8], g[2][8], sm[2], sg[2];
#pragma unroll
      for (int i = 0; i < 2; ++i) {
        const unsigned hw[4] = {hv[i].x, hv[i].y, hv[i].z, hv[i].w}, ow[4] = {ov[i].x, ov[i].y, ov[i].z, ov[i].w}, gw4[4] = {gv[i].x, gv[i].y, gv[i].z, gv[i].w};
        sm[i] = 0.f; sg[i] = 0.f;
#pragma unroll
        for (int e = 0; e < 4; ++e) { a[i][2 * e] = bflo(hw[e]) * sigmoidf_(bflo(ow[e])); a[i][2 * e + 1] = bfhi(hw[e]) * sigmoidf_(bfhi(ow[e])); g[i][2 * e] = bflo(gw4[e]); g[i][2 * e + 1] = bfhi(gw4[e]);
          sm[i] += a[i][2 * e] * a[i][2 * e] + a[i][2 * e + 1] * a[i][2 * e + 1]; sg[i] += g[i][2 * e] * g[i][2 * e] + g[i][2 * e + 1] * g[i][2 * e + 1]; } }
#pragma unroll
      for (int o = 1; o < 16; o <<= 1)
#pragma unroll
        for (int i = 0; i < 2; ++i) { sm[i] += __shfl_xor(sm[i], o); sg[i] += __shfl_xor(sg[i], o); }
#pragma unroll
      for (int i = 0; i < 2; ++i) { const int r = r0 + i; const float rm = rsqrtf(sm[i] * (1.f / 128.f) + EPS), rg = rsqrtf(sg[i] * (1.f / 128.f) + EPS);
        const unsigned zw[4] = {zm[i].x, zm[i].y, zm[i].z, zm[i].w}, yw[4] = {zg[i].x, zg[i].y, zg[i].z, zg[i].w};
        const float mnv[8] = {mn0.x, mn0.y, mn0.z, mn0.w, mn1.x, mn1.y, mn1.z, mn1.w}, gnv[8] = {gn0.x, gn0.y, gn0.z, gn0.w, gn1.x, gn1.y, gn1.z, gn1.w};
        unsigned om[4], og[4];
#pragma unroll
        for (int e = 0; e < 4; ++e) { om[e] = cvtpk(a[i][2 * e] * rm * mnv[2 * e] * siluf_(bflo(zw[e])), a[i][2 * e + 1] * rm * mnv[2 * e + 1] * siluf_(bfhi(zw[e])));
          og[e] = cvtpk(g[i][2 * e] * rg * gnv[2 * e] * siluf_(bflo(yw[e])), g[i][2 * e + 1] * rg * gnv[2 * e + 1] * siluf_(bfhi(yw[e]))); }
        *(u32x4*)(HM + (size_t)r * 512 + col) = (u32x4){om[0], om[1], om[2], om[3]}; *(u32x4*)(OG + (size_t)r * 512 + col) = (u32x4){og[0], og[1], og[2], og[3]}; }
    } }
#if PROBE_LEVEL == 2
  if (gw == 7 && lane == 0) ((unsigned long long*)(p.ws + WS_CTL + 1024))[52 + l] = __builtin_amdgcn_s_memrealtime();
  if (gw == 807 && lane == 0) ((unsigned long long*)(p.ws + WS_CTL + 1024))[54 + l] = __builtin_amdgcn_s_memrealtime();
#endif
}

struct EpiOut {
  const float* xp; bf16_t* xb; int l;
  __device__ __forceinline__ void operator()(const f32x4 (&acc)[2][2][4][2], int tm, int pn, int wr, int wc, int fr, int fq) const {
#pragma unroll
    for (int ai = 0; ai < 2; ++ai) {
      int fr_ = fr; asm volatile("" : "+v"(fr_) :: "memory");
      f32x4 xa[4][2][2];
#pragma unroll
      for (int m = 0; m < 4; ++m) { const int r = tm * 256 + ai * 128 + wr * 64 + m * 16 + fr_;
#pragma unroll
        for (int bj = 0; bj < 2; ++bj) { const int col0 = pn * 256 + bj * 128 + wc * 32 + 8 * fq;
          if (l == 0) { const float* xi = xp + (size_t)r * D + col0; xa[m][bj][0] = *(const f32x4*)xi; xa[m][bj][1] = *(const f32x4*)(xi + 4); }
          else { const u32x4 w = *(const u32x4*)(xb + (size_t)r * D + col0); xa[m][bj][0] = (f32x4){bflo(w.x), bfhi(w.x), bflo(w.y), bfhi(w.y)}; xa[m][bj][1] = (f32x4){bflo(w.z), bfhi(w.z), bflo(w.w), bfhi(w.w)}; } } }
#pragma unroll
      for (int m = 0; m < 4; ++m) { const int r = tm * 256 + ai * 128 + wr * 64 + m * 16 + fr_;
#pragma unroll
        for (int bj = 0; bj < 2; ++bj) { const int col0 = pn * 256 + bj * 128 + wc * 32 + 8 * fq;
          const f32x4 y0 = xa[m][bj][0] + acc[ai][bj][m][0], y1 = xa[m][bj][1] + acc[ai][bj][m][1];
          u32x4 w; w.x = cvtpk(y0.x, y0.y); w.y = cvtpk(y0.z, y0.w); w.z = cvtpk(y1.x, y1.y); w.w = cvtpk(y1.z, y1.w);
          *(u32x4*)(xb + (size_t)r * D + col0) = w; } }
    }
  }
};

__device__ __forceinline__ void phase_norm_rows_b(const Params& p, int lnext, int gw, int NGW, int lane, int rbeg, int rend) {
  const bf16_t* XB = (const bf16_t*)(p.ws + WS_X1B); bf16_t* XN = (bf16_t*)(p.ws + WS_XN);
  const float* nw = p.in[10] + (size_t)lnext * D + 16 * lane;
  const f32x4 w0 = *(const f32x4*)nw, w1 = *(const f32x4*)(nw + 4), w2 = *(const f32x4*)(nw + 8), w3 = *(const f32x4*)(nw + 12);
  for (int r0 = rbeg + 4 * gw; r0 < rend; r0 += 4 * NGW) {
    u32x4 v[4][2]; float s[4];
#pragma unroll
    for (int i = 0; i < 4; ++i) { const u32x4* xr = (const u32x4*)(XB + (size_t)(r0 + i) * D + 16 * lane); v[i][0] = xr[0]; v[i][1] = xr[1]; }
    float f[4][16];
#pragma unroll
    for (int i = 0; i < 4; ++i) { const unsigned ww[8] = {v[i][0].x, v[i][0].y, v[i][0].z, v[i][0].w, v[i][1].x, v[i][1].y, v[i][1].z, v[i][1].w}; s[i] = 0.f;
#pragma unroll
      for (int e = 0; e < 8; ++e) { f[i][2 * e] = bflo(ww[e]); f[i][2 * e + 1] = bfhi(ww[e]); s[i] += f[i][2 * e] * f[i][2 * e] + f[i][2 * e + 1] * f[i][2 * e + 1]; } }
#pragma unroll
    for (int o = 1; o < 64; o <<= 1)
#pragma unroll
      for (int i = 0; i < 4; ++i) s[i] += __shfl_xor(s[i], o);
#pragma unroll
    for (int i = 0; i < 4; ++i) { const float rstd = rsqrtf(s[i] * (1.f / D) + EPS); const float wv[16] = {w0.x, w0.y, w0.z, w0.w, w1.x, w1.y, w1.z, w1.w, w2.x, w2.y, w2.z, w2.w, w3.x, w3.y, w3.z, w3.w};
      u32x4 o0, o1; unsigned ow[8];
#pragma unroll
      for (int e = 0; e < 8; ++e) ow[e] = cvtpk(f[i][2 * e] * rstd * wv[2 * e], f[i][2 * e + 1] * rstd * wv[2 * e + 1]);
      o0 = (u32x4){ow[0], ow[1], ow[2], ow[3]}; o1 = (u32x4){ow[4], ow[5], ow[6], ow[7]};
      u32x4* xo = (u32x4*)(XN + (size_t)(r0 + i) * D + 16 * lane); xo[0] = o0; xo[1] = o1; }
  }
}
__device__ __forceinline__ void phase_final_norm_b(const Params& p, int gw, int NGW, int lane, int rbeg, int rend) {
  const bf16_t* XB = (const bf16_t*)(p.ws + WS_X1B);
  const float* nw = p.in[24] + 16 * lane;
  const f32x4 w0 = *(const f32x4*)nw, w1 = *(const f32x4*)(nw + 4), w2 = *(const f32x4*)(nw + 8), w3 = *(const f32x4*)(nw + 12);
  for (int r0 = rbeg + 4 * gw; r0 < rend; r0 += 4 * NGW) {
    u32x4 v[4][2]; float s[4];
#pragma unroll
    for (int i = 0; i < 4; ++i) { const u32x4* xr = (const u32x4*)(XB + (size_t)(r0 + i) * D + 16 * lane); v[i][0] = xr[0]; v[i][1] = xr[1]; }
    float f[4][16];
#pragma unroll
    for (int i = 0; i < 4; ++i) { const unsigned ww[8] = {v[i][0].x, v[i][0].y, v[i][0].z, v[i][0].w, v[i][1].x, v[i][1].y, v[i][1].z, v[i][1].w}; s[i] = 0.f;
#pragma unroll
      for (int e = 0; e < 8; ++e) { f[i][2 * e] = bflo(ww[e]); f[i][2 * e + 1] = bfhi(ww[e]); s[i] += f[i][2 * e] * f[i][2 * e] + f[i][2 * e + 1] * f[i][2 * e + 1]; } }
#pragma unroll
    for (int o = 1; o < 64; o <<= 1)
#pragma unroll
      for (int i = 0; i < 4; ++i) s[i] += __shfl_xor(s[i], o);
#pragma unroll
    for (int i = 0; i < 4; ++i) { const float rstd = rsqrtf(s[i] * (1.f / D) + EPS);
      f32x4* yo = (f32x4*)(p.out + O_YP + (size_t)(r0 + i) * D + 16 * lane);
      yo[0] = (f32x4){f[i][0] * rstd * w0.x, f[i][1] * rstd * w0.y, f[i][2] * rstd * w0.z, f[i][3] * rstd * w0.w};
      yo[1] = (f32x4){f[i][4] * rstd * w1.x, f[i][5] * rstd * w1.y, f[i][6] * rstd * w1.z, f[i][7] * rstd * w1.w};
      yo[2] = (f32x4){f[i][8] * rstd * w2.x, f[i][9] * rstd * w2.y, f[i][10] * rstd * w2.z, f[i][11] * rstd * w2.w};
      yo[3] = (f32x4){f[i][12] * rstd * w3.x, f[i][13] * rstd * w3.y, f[i][14] * rstd * w3.z, f[i][15] * rstd * w3.w}; }
  }
}

__device__ __forceinline__ void phase_final_norm(const Params& p, int gw, int NGW, int lane, int rbeg, int rend) {
  const f32x4* wr = (const f32x4*)p.in[24] + lane;
  for (int r0 = rbeg + 4 * gw; r0 < rend; r0 += 4 * NGW) {
    f32x4 v[4][4]; float s[4];
#pragma unroll
    for (int i = 0; i < 4; ++i) { const f32x4* xr = (const f32x4*)xrow_out(p, r0 + i) + lane;
#pragma unroll
      for (int j = 0; j < 4; ++j) v[i][j] = xr[64 * j]; }
#pragma unroll
    for (int i = 0; i < 4; ++i) { s[i] = 0.f;
#pragma unroll
      for (int j = 0; j < 4; ++j) s[i] += (v[i][j].x * v[i][j].x + v[i][j].y * v[i][j].y) + (v[i][j].z * v[i][j].z + v[i][j].w * v[i][j].w); }
#pragma unroll
    for (int o = 1; o < 64; o <<= 1)
#pragma unroll
      for (int i = 0; i < 4; ++i) s[i] += __shfl_xor(s[i], o);
#pragma unroll
    for (int i = 0; i < 4; ++i) { const float rstd = rsqrtf(s[i] * (1.f / D) + EPS); f32x4* xr = (f32x4*)xrow_out(p, r0 + i) + lane;
#pragma unroll
      for (int j = 0; j < 4; ++j) xr[64 * j] = v[i][j] * rstd * wr[64 * j]; }
  }
}


struct EpiPart {
  float* part;
  __device__ __forceinline__ void operator()(const f32x4 (&acc)[2][2][4][2], int tm, int pn, int wr, int wc, int fr, int fq) const {
#pragma unroll
    for (int ai = 0; ai < 2; ++ai)
#pragma unroll
      for (int m = 0; m < 4; ++m) {
        int fr_ = fr; asm volatile("" : "+v"(fr_) :: "memory");
        const int rr = (tm - 128) * 256 + ai * 128 + wr * 64 + m * 16 + fr_; float* pr = part + (size_t)rr * D;
#pragma unroll
        for (int bj = 0; bj < 2; ++bj) { const int col0 = pn * 256 + bj * 128 + wc * 32 + 8 * fq; *(f32x4*)(pr + col0) = acc[ai][bj][m][0]; *(f32x4*)(pr + col0 + 4) = acc[ai][bj][m][1]; }
      }
  }
};
__device__ __forceinline__ void phase_tail_rows(const Params& p, int l, int gw, int NGW, int lane) {
  const float* TP = (const float*)(p.ws + WS_TPART);
  bf16_t* XN = (bf16_t*)(p.ws + WS_XN);
  const int rend = (l + 1 < DEPTH) ? MPAD : ROW_M;
  for (int r = ROW_S + gw; r < rend; r += NGW) {
    if (r >= MROWS) { u32x4 z = {0u, 0u, 0u, 0u}; ((u32x4*)(XN + (size_t)r * D))[lane] = z; ((u32x4*)(XN + (size_t)r * D))[lane + 64] = z; continue; }
    const f32x4* xi = (const f32x4*)xrow_in(p, l, r) + lane; f32x4 v[4]; float s = 0.f;
#pragma unroll
    for (int j = 0; j < 4; ++j) { v[j] = xi[64 * j];
#pragma unroll
      for (int sl = 0; sl < 3; ++sl) v[j] += ((const f32x4*)(TP + ((size_t)sl * 768 + (r - ROW_S)) * D))[lane + 64 * j];
      s += (v[j].x * v[j].x + v[j].y * v[j].y) + (v[j].z * v[j].z + v[j].w * v[j].w); }
    const float rstd = rsqrtf(wave_sum(s) * (1.f / D) + EPS);
    if (l + 1 < DEPTH) {
      f32x4* xo = (f32x4*)xrow_out(p, r) + lane; const f32x4* wr = (const f32x4*)(p.in[10] + (size_t)(l + 1) * D) + lane; unsigned long long* o8 = (unsigned long long*)(XN + (size_t)r * D) + lane;
#pragma unroll
      for (int j = 0; j < 4; ++j) { xo[64 * j] = v[j]; const f32x4 ww = wr[64 * j];
        o8[64 * j] = (unsigned long long)cvtpk(v[j].x * rstd * ww.x, v[j].y * rstd * ww.y) | ((unsigned long long)cvtpk(v[j].z * rstd * ww.z, v[j].w * rstd * ww.w) << 32); }
    } else {
      f32x4* xo = (f32x4*)xrow_out(p, r) + lane; const f32x4* wr = (const f32x4*)p.in[24] + lane;
#pragma unroll
      for (int j = 0; j < 4; ++j) xo[64 * j] = v[j] * rstd * wr[64 * j];
    }
  }
}
#ifndef NLAYERS_RUN
#define NLAYERS_RUN DEPTH
#endif
__device__ __forceinline__ void probe_report(const Params& p, int stage, float err) {
  int mag = 0; if (err > 0.f) { float lg = log10f(err) + 5.f; mag = lg < 0.f ? 0 : (lg > 9.f ? 9 : (int)lg); }
  p.out[0] = (float)(10 * stage + mag) * 1000.f;
}
__device__ __forceinline__ unsigned hash_u(unsigned x) { x ^= x >> 16; x *= 0x7feb352du; x ^= x >> 15; x *= 0x846ca68bu; x ^= x >> 16; return x; }
__device__ __forceinline__ float nerr(float got, float want, float scale) { return fabsf(got - want) / (0.03f * fabsf(want) + 0.03f * scale + 1e-6f); }

__device__ __forceinline__ void probe_checks(const Params& p, int l, long long gt) {
  unsigned* ctl = (unsigned*)(p.ws + WS_CTL);
  const bf16_t* PROJ = (const bf16_t*)(p.ws + WS_PROJ);
  const float* RSTD = (const float*)(p.ws + WS_RSTD);
  const float* ct = (const float*)(p.ws + WS_ROPE); const float* st = ct + ROPE_N * 16;
  const bf16_t* KV = (const bf16_t*)(p.ws + WS_KV);
  const bf16_t* QATT = (const bf16_t*)(p.ws + WS_QATT); const bf16_t* QMETA = (const bf16_t*)(p.ws + WS_QMETA); const bf16_t* QS = (const bf16_t*)(p.ws + WS_QS);
  if (gt < 2048) {
    unsigned hh = hash_u((unsigned)gt + 77u); int r = (int)(hh % MROWS); if ((gt & 7) == 0) r = ROW_M + (int)(hh % 16); if ((gt & 7) == 1) r = ROW_S + (int)(hh % 512);
    hh = hash_u(hh); const int h = (int)(hh % 8); hh = hash_u(hh); const int d = (int)(hh % 96);
    const RowInfo ri = row_info(r); const bf16_t* pr = PROJ + (size_t)r * PJR + PC_CQ;
    float ss = 0.f; for (int k = 0; k < 384; ++k) { const float c = bf2f(pr[k]); ss += c * c; }
    const float rs = rsqrtf(ss / 384.f + EPS);
    auto raw = [&](int dd) { float a = 0.f; for (int k = 0; k < 384; ++k) a += bf2f(pr[k]) * p.in[12][l * 384 + k] * p.in[13][((size_t)l * 384 + k) * 768 + h * 96 + dd]; return a * rs * QSCALE; };
    float want;
    if (d < 64) want = raw(d);
    else { const int i = (d - 64) & 15; const float x1 = raw(64 + i), x2 = raw(80 + i), c = ct[ri.pos * 16 + i], s = st[ri.pos * 16 + i]; want = d < 80 ? x1 * c - x2 * s : x2 * c + x1 * s; }
    float got;
    if (ri.kind == 0) got = bf2f(QATT[((size_t)(ri.b * 8 + h) * SEQ + ri.t) * 96 + d]);
    else if (ri.kind == 1) got = bf2f(QS[(size_t)(r - ROW_S) * 768 + h * 96 + d]);
    else got = bf2f(QMETA[((size_t)h * 256 + ri.t) * 96 + d]);
    atomicMax(ctl + 66, __float_as_uint(nerr(got, want, 0.15f)));
  } else if (gt < 4096) {
    unsigned hh = hash_u((unsigned)gt + 99u); int r = (int)(hh % NP); if ((gt & 7) == 0) r = ROW_M + (int)(hh % 16);
    hh = hash_u(hh); const int col = (int)(hh % 1024); hh = hash_u(hh); const int bsel = (int)(hh % 8);
    const RowInfo ri = row_info(r); const bf16_t* pr = PROJ + (size_t)r * PJR + PC_CKV;
    float a = 0.f; const float* W = (col < 512 ? p.in[15] : p.in[16]) + (size_t)l * 256 * 512 + (col & 511);
    for (int k = 0; k < 256; ++k) a += bf2f(pr[k]) * p.in[14][l * 256 + k] * W[(size_t)k * 512];
    a *= RSTD[2 * r + 1];
    const int h = (col & 511) >> 6, d0 = (col & 63) + (col >= 512 ? 96 : 0);
    const int b = ri.kind == 0 ? ri.b : bsel; const int krow = ri.kind == 0 ? 64 + ri.t : ri.t;
    const bf16_t* kvr = KV + ((size_t)(b * 8 + h) * KVROWS + krow) * 160;
    float e = nerr(bf2f(kvr[d0]), a, 0.2f);
    const int i = col & 31; const float* okr = p.out + O_PKR + (((size_t)l * NB + b) * NCACHE + (ri.kind == 0 ? NMETA + ri.t : ri.t)) * 32;
    e = fmaxf(e, nerr(bf2f(kvr[64 + i]), okr[i], 0.2f));
    atomicMax(ctl + 67, __float_as_uint(e));
  } else if (gt < 4096 + 1536) {
    unsigned hh = hash_u((unsigned)gt + 1234u); const bool meta = (gt & 15) == 0;
    const int b = (int)(hh % 8); hh = hash_u(hh); const int h = (int)(hh % 8); hh = hash_u(hh); int t = (int)(hh % SEQ); if ((gt & 3) == 1) t &= 255; if (meta) t &= 15; hh = hash_u(hh); const int dv = (int)(hh % 64);
    const bf16_t* q = meta ? QMETA + ((size_t)h * 256 + t) * 96 : QATT + ((size_t)(b * 8 + h) * SEQ + t) * 96;
    const bf16_t* kvb = KV + (size_t)(b * 8 + h) * KVROWS * 160;
    const int nown = meta ? 0 : 64 * (t / 64 + 1);
    float mx = -INFINITY, lsum = 0.f, osum = 0.f;
    for (int pass = 0; pass < 2; ++pass)
      for (int k = 0; k < 16 + nown; ++k) { const bf16_t* kr = kvb + (size_t)(k < 16 ? k : 64 + (k - 16)) * 160;
        float s = 0.f; for (int d = 0; d < 96; ++d) s += bf2f(q[d]) * bf2f(kr[d]);
        if (pass == 0) mx = fmaxf(mx, s); else { const float pe = exp2f(s - mx); lsum += pe; osum += pe * bf2f(kr[96 + dv]); } }
    const int r = meta ? ROW_M + t : b * SEQ + t;
    const bf16_t* xn = (const bf16_t*)(p.ws + WS_XN) + (size_t)r * 1024; const bf16_t* wz = (const bf16_t*)(p.ws + WS_WIN) + ((size_t)l * PJ + PC_ZA + h * 64 + dv) * 1024;
    float z = 0.f; for (int k = 0; k < 1024; ++k) z += bf2f(xn[k]) * bf2f(wz[k]);
    const float want = osum / lsum * siluf_(z);
    const float got = bf2f(PROJ[(size_t)r * PJR + RC_ZA + h * 64 + dv]);
    atomicMax(ctl + 68, __float_as_uint(nerr(got, want, 0.02f)));
  }
}


__device__ __forceinline__ int queue_next(unsigned* ctr, LAS unsigned char* lds, int tid) {
  LAS int* slot = (LAS int*)(lds + 147440);
  if (tid == 0) *slot = (int)atomicAdd(ctr, 1u);
  __syncthreads();
  const int v = *slot;
  __syncthreads();
  return v;
}

#define OPQ_TID() int tq = threadIdx.x; asm volatile("" : "+v"(tq)); const Params& pq = p; int bq = blockIdx.x; asm volatile("" : "+s"(bq)); const int lq = tq & 63; const int gwq = blockIdx.x * NWAVES + (tq >> 6); (void)lq; (void)gwq

#define XB_TMO      128
#define XB_XCNT(j)  (256  + 64 * (j))
#define XB_XSUB(j)  (1280 + 64 * (j))
#define XB_XGEN(j)  (2304 + 64 * (j))
#define XB_TOP      3328
#define XB_TOPGEN   3392
#define XCD_BAR_WORDS 3456
#define XB_SPIN_CAP (1u << 22)
__device__ __forceinline__ unsigned xb_ld(unsigned* p)              { return __hip_atomic_load(p, __ATOMIC_RELAXED, __HIP_MEMORY_SCOPE_AGENT); }
__device__ __forceinline__ unsigned xb_add(unsigned* p, unsigned v) { return __hip_atomic_fetch_add(p, v, __ATOMIC_RELAXED, __HIP_MEMORY_SCOPE_AGENT); }
__device__ __forceinline__ unsigned xb_xcc_id() { return (unsigned)__builtin_amdgcn_s_getreg((3 << 11) | 20) & 0xFu; }
#define XB_SPIN(cond, bar) do { unsigned _sp = 0; while (cond) { __builtin_amdgcn_s_sleep(1); \
    if ((++_sp & 255u) == 0u) { if (xb_ld(&(bar)[XB_TMO])) break; if (_sp > XB_SPIN_CAP) { atomicAdd(&(bar)[XB_TMO], 1u); break; } } } } while (0)
struct XcdBarrier { unsigned* bar; unsigned x; volatile LAS unsigned* st; };
__device__ __forceinline__ XcdBarrier xcd_barrier_post(unsigned* bar, volatile LAS unsigned* st) {
  XcdBarrier b; b.bar = bar; b.x = xb_xcc_id(); b.st = st;
  if (threadIdx.x == 0) (void)xb_add(&bar[XB_XCNT(b.x)], 1u);
  return b;
}
__device__ __forceinline__ void xcd_barrier_complete(unsigned* bar, unsigned x, unsigned& nloc, unsigned& nx) {
  const unsigned G = gridDim.x * gridDim.y * gridDim.z;
  unsigned sum, cnt, mine, sp = 0u;
  for (;;) {
    sum = 0u; cnt = 0u; mine = 0u;
#pragma unroll
    for (unsigned j = 0; j < 16; ++j) { const unsigned c = xb_ld(&bar[XB_XCNT(j)]); sum += c; cnt += (c > 0u) ? 1u : 0u; mine = (j == x) ? c : mine; }
    if (sum == G) break;
    __builtin_amdgcn_s_sleep(1);
    if ((++sp & 255u) == 0u) { if (xb_ld(&bar[XB_TMO])) break; if (sp > XB_SPIN_CAP) { atomicAdd(&bar[XB_TMO], 1u); break; } }
  }
  nloc = mine > 0u ? mine : 1u; nx = cnt > 0u ? cnt : 1u;
}
__device__ __forceinline__ void xcd_barrier(const XcdBarrier& b) {
  asm volatile("s_waitcnt vmcnt(0)" ::: "memory");
  __syncthreads();
  if (threadIdx.x == 0) {
    unsigned* bar = b.bar;
    __builtin_amdgcn_s_waitcnt(0);
    unsigned nloc = b.st[0], nx = b.st[1];
    if (nloc == 0u) { xcd_barrier_complete(bar, b.x, nloc, nx); b.st[0] = nloc; b.st[1] = nx; }
    const unsigned old = xb_add(&bar[XB_XSUB(b.x)], 1u);
    const unsigned gen = old / nloc;
    if (old + 1u == (gen + 1u) * nloc) {
      __builtin_amdgcn_fence(__ATOMIC_RELEASE, "agent");
      asm volatile("s_waitcnt vmcnt(0)" ::: "memory");
      const unsigned og = xb_add(&bar[XB_TOP], 1u);
      const unsigned tg = og / nx;
      if (og + 1u == (tg + 1u) * nx) xb_add(&bar[XB_TOPGEN], 1u);
      else XB_SPIN(xb_ld(&bar[XB_TOPGEN]) == tg, bar);
      __builtin_amdgcn_fence(__ATOMIC_ACQUIRE, "agent");
      xb_add(&bar[XB_XGEN(b.x)], 1u);
      asm volatile("s_waitcnt vmcnt(0)" ::: "memory");
    } else {
      XB_SPIN(xb_ld(&bar[XB_XGEN(b.x)]) == gen, bar);
      __builtin_amdgcn_fence(__ATOMIC_ACQUIRE, "agent");
      asm volatile("s_waitcnt vmcnt(0)" ::: "memory");
    }
  }
  __syncthreads();
}

#if PROBE_LEVEL == 2
#define STAMP(i) do { if (blockIdx.x == 0 && threadIdx.x == 0) ((unsigned long long*)(p.ws + WS_CTL + 1024))[i] = __builtin_amdgcn_s_memrealtime(); } while (0)
#define BSTAMP(blk, i) do { if (blockIdx.x == (blk) && threadIdx.x == 0) ((unsigned long long*)(p.ws + WS_CTL + 1024))[i] = __builtin_amdgcn_s_memrealtime(); } while (0)
#else
#define STAMP(i) do {} while (0)
#define BSTAMP(blk, i) do {} while (0)
#endif
template <int l>
__device__ __forceinline__ void run_layer(const Params& p, LAS unsigned char* lds, const XcdBarrier& gbar) {
  const int NGW = gridDim.x * NWAVES; const int G = gridDim.x, bx = blockIdx.x;
  bf16_t* PROJ = (bf16_t*)(p.ws + WS_PROJ);
  unsigned* ctl = (unsigned*)(p.ws + WS_CTL);

    {
      asm volatile("" ::: "memory");
      pg8::Gemm g{(const bf16_t*)(p.ws + WS_XN), (const bf16_t*)(p.ws + WS_WIN) + (size_t)l * PJ * 1024, 1024, 1024, 1024, 1 << 20, 0};
      OrderAll S; S.init(MPAD / 256, PJ / 256, G, bx);
      EpiProj E{PROJ, (bf16_t*)(p.ws + WS_PROJH)};
      pg8::gemm_phase(lds, g, S, E);
    }
    xcd_barrier(gbar); STAMP(1 + 7 * l + 1);
    { OPQ_TID(); phase_rowpass(pq, l, gwq, NGW, lq);
#if PROBE_LEVEL == 2
      BSTAMP(0, 46 + l);
      {
        int slot = prep_next_slot(bq - G, G), buf = 0;
        const float* gb_ = pq.in[17] + l * 8; const float gb0 = gb_[0], gb1 = gb_[1], gb2 = gb_[2], gb3 = gb_[3], gb4 = gb_[4], gb5 = gb_[5], gb6 = gb_[6], gb7 = gb_[7];
        __syncthreads();
        if (slot < NSLOT) { mlstm_issue(lds, pq, slot, 0, tq); asm volatile("s_waitcnt vmcnt(0)" ::: "memory"); }
        while (slot < NSLOT) {
          const int nslot = prep_next_slot(slot, G);
#if PROBE_LEVEL == 2
          const unsigned long long tw0_ = __builtin_amdgcn_s_memrealtime();
#endif
          lds_barrier();
#if PROBE_LEVEL == 2
          if (tq == 0 && bq == 0) ((unsigned long long*)(pq.ws + WS_CTL + 2048))[11] += __builtin_amdgcn_s_memrealtime() - tw0_;
#endif
          if (nslot < NSLOT) mlstm_issue(lds, pq, nslot, buf ^ 1, tq);
          { const int hh = (slot < 32 * 65 ? slot / 65 : slot - 32 * 65) & 3;
            mlstm_prep(lds, pq, l, slot, buf, hh == 0 ? gb0 : (hh == 1 ? gb1 : (hh == 2 ? gb2 : gb3)), hh == 0 ? gb4 : (hh == 1 ? gb5 : (hh == 2 ? gb6 : gb7)), tq); }
          slot = nslot; buf ^= 1; }
        __syncthreads();
#if PROBE_LEVEL == 2
        const unsigned long long tg0_ = __builtin_amdgcn_s_memrealtime();
#endif
        {
          unsigned* gq = ctl + 16 + l; LAS int* qs_ = (LAS int*)(lds + 147440);
          if (tq == 0) { qs_[0] = (int)atomicAdd(gq, 1u); qs_[1] = (int)atomicAdd(gq, 1u); }
          __syncthreads();
          int cur = gdn_queue_slot(__builtin_amdgcn_readfirstlane(qs_[0])), nxt = gdn_queue_slot(__builtin_amdgcn_readfirstlane(qs_[1]));
          __syncthreads();
          bool have = false;
          while (cur < NSLOT) {
            unsigned pend = 0u; if (tq == 0) pend = atomicAdd(gq, 1u);
            gdn_prep(lds, pq, l, cur, have, nxt, tq);
            have = nxt < NSLOT && gdn_slot_interior(nxt);
            if (tq == 0) qs_[0] = (int)pend;
            lds_barrier();
            cur = nxt; nxt = gdn_queue_slot(__builtin_amdgcn_readfirstlane(qs_[0]));
            lds_barrier();
          }
        }
#if PROBE_LEVEL == 2
        __syncthreads(); if (tq == 0 && bq == 0) ((unsigned long long*)(pq.ws + WS_CTL + 2048))[12] += __builtin_amdgcn_s_memrealtime() - tg0_;
#endif
      }
#else
      {
        int slot = prep_next_slot(bq - G, G), buf = 0;
        const float* gb_ = pq.in[17] + l * 8; const float gb0 = gb_[0], gb1 = gb_[1], gb2 = gb_[2], gb3 = gb_[3], gb4 = gb_[4], gb5 = gb_[5], gb6 = gb_[6], gb7 = gb_[7];
        __syncthreads();
        if (slot < NSLOT) { mlstm_issue(lds, pq, slot, 0, tq); asm volatile("s_waitcnt vmcnt(0)" ::: "memory"); }
        while (slot < NSLOT) {
          const int nslot = prep_next_slot(slot, G);
#if PROBE_LEVEL == 2
          const unsigned long long tw0_ = __builtin_amdgcn_s_memrealtime();
#endif
          lds_barrier();
#if PROBE_LEVEL == 2
          if (tq == 0 && bq == 0) ((unsigned long long*)(pq.ws + WS_CTL + 2048))[11] += __builtin_amdgcn_s_memrealtime() - tw0_;
#endif
          if (nslot < NSLOT) mlstm_issue(lds, pq, nslot, buf ^ 1, tq);
          { const int hh = (slot < 32 * 65 ? slot / 65 : slot - 32 * 65) & 3;
            mlstm_prep(lds, pq, l, slot, buf, hh == 0 ? gb0 : (hh == 1 ? gb1 : (hh == 2 ? gb2 : gb3)), hh == 0 ? gb4 : (hh == 1 ? gb5 : (hh == 2 ? gb6 : gb7)), tq); }
          slot = nslot; buf ^= 1; }
        __syncthreads();
#if PROBE_LEVEL == 2
        const unsigned long long tg0_ = __builtin_amdgcn_s_memrealtime();
#endif
        {
          unsigned* gq = ctl + 16 + l; LAS int* qs_ = (LAS int*)(lds + 147440);
          if (tq == 0) { qs_[0] = (int)atomicAdd(gq, 1u); qs_[1] = (int)atomicAdd(gq, 1u); }
          __syncthreads();
          int cur = gdn_queue_slot(__builtin_amdgcn_readfirstlane(qs_[0])), nxt = gdn_queue_slot(__builtin_amdgcn_readfirstlane(qs_[1]));
          __syncthreads();
          bool have = false;
          while (cur < NSLOT) {
            unsigned pend = 0u; if (tq == 0) pend = atomicAdd(gq, 1u);
            gdn_prep(lds, pq, l, cur, have, nxt, tq);
            have = nxt < NSLOT && gdn_slot_interior(nxt);
            if (tq == 0) qs_[0] = (int)pend;
            lds_barrier();
            cur = nxt; nxt = gdn_queue_slot(__builtin_amdgcn_readfirstlane(qs_[0]));
            lds_barrier();
          }
        }
#if PROBE_LEVEL == 2
        __syncthreads(); if (tq == 0 && bq == 0) ((unsigned long long*)(pq.ws + WS_CTL + 2048))[12] += __builtin_amdgcn_s_memrealtime() - tg0_;
#endif
      }
#endif
    }
    xcd_barrier(gbar); STAMP(1 + 7 * l + 2);
    {
      const float* rstd = (const float*)(p.ws + WS_RSTD); const float* ct = (const float*)(p.ws + WS_ROPE);
      { pg8::Gemm g{PROJ + PC_CQ, (const bf16_t*)(p.ws + WS_WUQ) + (size_t)l * 768 * 384, PJR, 384, 384, 1 << 20, 0};
        OrderAll S; S.init(MPAD / 256, 3, G, bx);
        EpiQ E{rstd, ct, ct + ROPE_N * 16, (bf16_t*)(p.ws + WS_QATT), (bf16_t*)(p.ws + WS_QMETA), (bf16_t*)(p.ws + WS_QS)};
        pg8::gemm_phase(lds, g, S, E); }
      { pg8::Gemm g{PROJ + PC_CKV, (const bf16_t*)(p.ws + WS_WUKV) + (size_t)l * 1024 * 256, PJR, 256, 256, 1 << 20, 0};
        OrderKV S; S.init(129, 4, G, (bx + 119) % G);
        EpiKV E{rstd, (bf16_t*)(p.ws + WS_KV)};
        pg8::gemm_phase(lds, g, S, E); }
    }
    xcd_barrier(gbar); STAMP(1 + 7 * l + 3);
    {
      OPQ_TID();
      if (bq < 32) { for (int k = 0; k < 5; ++k) scan_chain<false>(lds, pq, l, k == 0 ? bq : 32 + bq * 4 + k - 1, tq); }
      else if (bq < 64) { for (int k = 0; k < 5; ++k) scan_chain<true>(lds, pq, l, k == 0 ? bq - 32 : 32 + (bq - 32) * 4 + k - 1, tq); }
      else { for (int u = bq - 64; u < DB * SA_NG; u += G - 64) sattn_unit(lds, pq, l, u / SA_NG, u % SA_NG, tq); }
      BSTAMP(0, 40 + l); BSTAMP(32, 42 + l); BSTAMP(64, 44 + l);
      for (;;) {
        const int idx = queue_next(ctl + 8 + l, lds, tq);
        if (idx >= 1024 + 8) break;
        AttnUnit u;
        if (idx < 1024) { const int qb = 15 - (idx >> 6), bh = idx & 63;
          u.q = (const bf16_t*)(p.ws + WS_QATT) + ((size_t)bh * SEQ + 256 * qb) * 96; u.kv = (const bf16_t*)(p.ws + WS_KV) + (size_t)bh * KVROWS * 160;
          u.chunk0 = 4 * qb; u.ntiles = 4 * qb + 5; u.nq_valid = 256; u.out_row0 = (bh >> 3) * SEQ + 256 * qb; u.h = bh & 7; u.is_meta = 0; }
        else { const int h = idx - 1024;
          u.q = (const bf16_t*)(p.ws + WS_QMETA) + (size_t)h * 256 * 96; u.kv = (const bf16_t*)(p.ws + WS_KV) + (size_t)h * KVROWS * 160;
          u.chunk0 = 0; u.ntiles = 1; u.nq_valid = 16; u.out_row0 = ROW_M; u.h = h; u.is_meta = 1; }
        attn_unit(lds, u, PROJ, (bf16_t*)(p.ws + WS_OA), tq, p.ws);
      }
    }
    xcd_barrier(gbar); STAMP(1 + 7 * l + 4);
#if PROBE_LEVEL == 1
    if (l == 0) {
      probe_checks(p, l, (long long)bx * NTHREADS + tid);
      xcd_barrier(gbar);
      if (bx == 0 && tid == 0) {
        int stage = 9; float e = 0.f;
        for (int s = 8; s >= 2; --s) { const float es = __uint_as_float(ctl[64 + s]); if (es > 1.f) { stage = s; e = es; } }
        if (stage == 9) for (int s = 2; s <= 8; ++s) e = fmaxf(e, __uint_as_float(ctl[64 + s]));
        probe_report(p, stage, e); }
      return;
    }
#endif
    { OPQ_TID(); phase_finalize(lds, pq, l, gwq, NGW, lq); }
    xcd_barrier(gbar); STAMP(1 + 7 * l + 5);
    {
      pg8::Gemm g{(const bf16_t*)(p.ws + WS_OA), (const bf16_t*)(p.ws + WS_WOUT) + (size_t)l * D * DMIX, 512, DMIX, DMIX, 8, SEG_B};
      OrderAll S; S.init(128, 4, G, bx);
      EpiOut E{p.in[0], (bf16_t*)(p.ws + WS_X1B), l};
      pg8::gemm_phase(lds, g, S, E);
    }
    xcd_barrier(gbar); STAMP(1 + 7 * l + 6);
    { OPQ_TID();
      constexpr int NX = (l + 1 < DEPTH) ? 12 : 8;
      if (bq < 3 * NX) {
        const int sl = bq / NX, uu = bq - sl * NX;
        pg8::Gemm g{(const bf16_t*)(p.ws + WS_OA + (size_t)sl * SEG_B), (const bf16_t*)(p.ws + WS_WOUT) + (size_t)l * D * DMIX + sl * 512, 512, DMIX, 512, 1 << 20, 0};
        OrderTail S; S.init(NX / 4, 4, NX, uu);
        EpiPart E{(float*)(p.ws + WS_TPART) + (size_t)sl * 768 * D};
        pg8::gemm_phase(lds, g, S, E);
        BSTAMP(0, 56 + l);
      } else {
        const int gw2 = (bq - 3 * NX) * NWAVES + (tq >> 6), NGW2 = (G - 3 * NX) * NWAVES;
        if (l + 1 < DEPTH) { phase_norm_rows_b(pq, l + 1, gw2, NGW2, lq, 0, 16384); phase_norm_rows_b(pq, l + 1, gw2, NGW2, lq, 16768, ROW_S); }
        else phase_final_norm_b(pq, gw2, NGW2, lq, 0, ROW_S);
        BSTAMP(100, 58 + l);
      }
    }
    xcd_barrier(gbar);
    { OPQ_TID(); phase_tail_rows(pq, l, gwq, NGW, lq); if (l + 1 < DEPTH) phase_norm_rows_b(pq, l + 1, gwq, NGW, lq, 16384, 16768); }
    if (l + 1 < DEPTH) { xcd_barrier(gbar); STAMP(1 + 7 * l + 7); }

}

__global__ void __launch_bounds__(NTHREADS, 2) mk_fwd(Params p) {
  extern __shared__ __attribute__((aligned(16))) unsigned char lds_raw[];
  LAS unsigned char* lds = (LAS unsigned char*)lds_raw;
  cg::grid_group grid = cg::this_grid();
  const int tid = threadIdx.x;
  const int lane = tid & 63, wave = tid >> 6;
  const int gw = blockIdx.x * NWAVES + wave, NGW = gridDim.x * NWAVES;
  const int G = gridDim.x, bx = blockIdx.x;
  bf16_t* PROJ = (bf16_t*)(p.ws + WS_PROJ);
  unsigned* ctl = (unsigned*)(p.ws + WS_CTL);

  if (threadIdx.x < 2) ((LAS unsigned*)(lds + 147424))[threadIdx.x] = 0u;
  __syncthreads();
  const XcdBarrier gbar = xcd_barrier_post((unsigned*)(p.ws + WS_BAR), (volatile LAS unsigned*)(lds + 147424));
  STAMP(0);
#if PROBE_LEVEL == 2
  if (threadIdx.x < 16 && blockIdx.x == 200) ((unsigned long long*)(p.ws + WS_CTL + 2048))[threadIdx.x] = 0ull;
#endif
  phase0(p, lds, tid);
  grid.sync(); STAMP(1);
  run_layer<0>(p, lds, gbar);
  if (NLAYERS_RUN > 1) run_layer<1>(p, lds, gbar);
#if PROBE_LEVEL == 2
  STAMP(15);
  grid.sync();
  if (blockIdx.x == 0) {
    const unsigned long long* ts = (const unsigned long long*)(p.ws + WS_CTL + 1024);
    const long long offs[13] = {O_YP, O_YS, O_PLAT, O_PKR, O_PC, O_PN, O_PM, O_PS, O_PCONV, O_SLAT, O_SKR, O_SC, O_SN};
    unsigned d[13];
    for (int k = 0; k < 6; ++k) d[k] = (unsigned)((ts[k + 1] - ts[k]) / 100);
    for (int k = 0; k < 6; ++k) d[k] = (unsigned)((ts[k + 1] - ts[k]) / 100);
    d[6] = 1; d[7] = (unsigned)((ts[7] - ts[6]) / 100); d[8] = (unsigned)((ts[8] - ts[7]) / 100);
    d[9] = (unsigned)((ts[50] - ts[5]) / 100); d[10] = (unsigned)((ts[52] - ts[5]) / 100); d[11] = (unsigned)((ts[56] - ts[7]) / 100); d[12] = (unsigned)((ts[58] - ts[7]) / 100);
    d[3] = (unsigned)((ts[54] - ts[5]) / 100);
    for (int k = 0; k < 13; ++k) { unsigned n = d[k]; if (k == 6 && n > 64) n = 64; if (k == 5 && n > 8192) n = 8192; if (n > 30000) n = 30000;
      for (unsigned i = threadIdx.x; i < n; i += NTHREADS) p.out[offs[k] + i] = __uint_as_float(0xAAAAAAAAu); }
  }
#endif
}

extern "C" void kernel_launch(void* const* d_in, const int* in_sizes, int n_in, void* d_out, int out_size,
                              void* d_ws, size_t ws_size, hipStream_t stream) {
  constexpr int LDS_BYTES = 144 * 1024;
  static int grid_blocks = 0;
  if (!grid_blocks) {
    int dev = 0, cus = 0, per_cu = 0;
    (void)hipGetDevice(&dev);
    (void)hipDeviceGetAttribute(&cus, hipDeviceAttributeMultiprocessorCount, dev);
    (void)hipFuncSetAttribute((const void*)mk_fwd, hipFuncAttributeMaxDynamicSharedMemorySize, LDS_BYTES);
    (void)hipOccupancyMaxActiveBlocksPerMultiprocessor(&per_cu, (const void*)mk_fwd, NTHREADS, LDS_BYTES);
    if (per_cu < 1) per_cu = 1;
    grid_blocks = cus * 1;
    if (n_in != 25 || (long long)out_size != O_END || ws_size < WS_END2) { fprintf(stderr, "kernel_launch: unexpected sizes n_in=%d out=%d ws=%zu (need %zu)\n", n_in, out_size, ws_size, (size_t)WS_END2); grid_blocks = -1; }
  }
  if (grid_blocks < 0) return;
  (void)hipMemsetAsync((unsigned char*)d_ws + WS_BAR, 0, 14336 + 256 + 64, stream);
  Params p{};
  for (int i = 0; i < 25; ++i) p.in[i] = (const float*)d_in[i];
  p.out = (float*)d_out; p.ws = (unsigned char*)d_ws; p.ph_lo = 0; p.ph_hi = 100; p.probe = 0; p.pad = 0;
  void* args[] = {&p};
  hipError_t e = hipLaunchCooperativeKernel((const void*)mk_fwd, dim3(grid_blocks), dim3(NTHREADS), args, LDS_BYTES, stream);
  if (e != hipSuccess) fprintf(stderr, "cooperative launch failed: %s (grid %d)\n", hipGetErrorString(e), grid_blocks);
}
```

```cpp
#define PROBE_LEVEL 0
#include <hip/hip_runtime.h>
#include <hip/hip_cooperative_groups.h>
#include <cstdio>
#include <cstdint>
namespace cg = cooperative_groups;

#define LAS __attribute__((address_space(3)))
typedef unsigned short bf16_t;
typedef short bf16x8 __attribute__((ext_vector_type(8)));
typedef short s16x4 __attribute__((ext_vector_type(4)));
typedef float f32x4 __attribute__((ext_vector_type(4)));
typedef float f32x2 __attribute__((ext_vector_type(2)));
typedef float f32x16 __attribute__((ext_vector_type(16)));
typedef unsigned u32x4 __attribute__((ext_vector_type(4)));
typedef unsigned u32x2 __attribute__((ext_vector_type(2)));
typedef __bf16 bf16x2_t __attribute__((ext_vector_type(2)));

__device__ __forceinline__ unsigned cvtpk(float lo, float hi) { f32x2 v = {lo, hi}; bf16x2_t b = __builtin_convertvector(v, bf16x2_t); return __builtin_bit_cast(unsigned, b); }
__device__ __forceinline__ bf16_t f2bf(float x) { return (bf16_t)(cvtpk(x, 0.f) & 0xffffu); }
__device__ __forceinline__ float bf2f(bf16_t x) { return __uint_as_float(((unsigned)x) << 16); }
__device__ __forceinline__ float bflo(unsigned w) { return __uint_as_float(w << 16); }
__device__ __forceinline__ float bfhi(unsigned w) { return __uint_as_float(w & 0xffff0000u); }

constexpr int D = 1024, NB = 8, SEQ = 4096, DEPTH = 2, DB = 32, DS = 16, NMETA = 16, NCACHE = 4112;
constexpr int NP = NB * SEQ;
constexpr int NS = DB * DS;
constexpr int ROW_S = NP, ROW_M = NP + NS, MROWS = ROW_M + NMETA, MPAD = 33536;
constexpr int INC = 5808;
constexpr int PJ = 5888;
constexpr int PJR = 2816;
constexpr int RC_MO = 704, RC_ZA = 1216, RC_ZM = 1728, RC_ZG = 2240;
constexpr int PC_CKV = 0, PC_CQ = 256, PC_KR = 640, PC_G16 = 672, PC_MQ = 704, PC_MK = 1216, PC_MV = 1728, PC_MO = 2240,
              PC_GQ = 2752, PC_GK = 3264, PC_GV = 3776, PC_ZA = 4288, PC_ZM = 4800, PC_ZG = 5312, PC_END = 5824;
constexpr int DMIX = 1536;
constexpr int NTHREADS = 512, NWAVES = 8;
constexpr float EPS = 1e-6f;
constexpr float QSCALE = 0.10206207261596575f * 1.4426950408889634f;

constexpr long long O_YP = 0;
constexpr long long O_YS = O_YP + (long long)NB * SEQ * D;
constexpr long long O_PLAT = O_YS + (long long)DB * DS * D;
constexpr long long O_PKR = O_PLAT + (long long)DEPTH * NB * NCACHE * 256;
constexpr long long O_PC = O_PKR + (long long)DEPTH * NB * NCACHE * 32;
constexpr long long O_PN = O_PC + (long long)DEPTH * NB * 4 * 128 * 128;
constexpr long long O_PM = O_PN + (long long)DEPTH * NB * 4 * 128;
constexpr long long O_PS = O_PM + (long long)DEPTH * NB * 4;
constexpr long long O_PCONV = O_PS + (long long)DEPTH * NB * 4 * 128 * 128;
constexpr long long O_SLAT = O_PCONV + (long long)DEPTH * NB * 3 * 1536;
constexpr long long O_SKR = O_SLAT + (long long)DEPTH * DB * DS * 256;
constexpr long long O_SC = O_SKR + (long long)DEPTH * DB * DS * 32;
constexpr long long O_SN = O_SC + (long long)DEPTH * DB * 4 * 128 * 128;
constexpr long long O_SM = O_SN + (long long)DEPTH * DB * 4 * 128;
constexpr long long O_SS = O_SM + (long long)DEPTH * DB * 4;
constexpr long long O_SCONV = O_SS + (long long)DEPTH * DB * 4 * 128 * 128;
constexpr long long O_END = O_SCONV + (long long)DEPTH * DB * 3 * 1536;

constexpr size_t al256(size_t x) { return (x + 255) & ~(size_t)255; }
constexpr size_t WS_CTL = 0;
constexpr size_t WS_BAR = 16384;
constexpr size_t WS_ZERO = WS_BAR + 14336;
constexpr size_t WS_WQ = WS_ZERO + 256;
constexpr size_t WS_ROPE = 32768;
constexpr size_t ROPE_N = 4160;
constexpr size_t WS_WIN = al256(WS_ROPE + ROPE_N * 16 * 4 * 2);
constexpr size_t WS_WUQ = al256(WS_WIN + (size_t)2 * PJ * 1024 * 2);
constexpr size_t WS_WUKV = al256(WS_WUQ + (size_t)2 * 768 * 384 * 2);
constexpr size_t WS_WOUT = al256(WS_WUKV + (size_t)2 * 1024 * 256 * 2);
constexpr size_t WS_WUKR = al256(WS_WOUT + (size_t)2 * 1024 * 1536 * 2);
constexpr size_t WS_WUVT = al256(WS_WUKR + (size_t)2 * 256 * 512 * 2);
constexpr size_t WS_XMETA = al256(WS_WUVT + (size_t)2 * 512 * 256 * 2);
constexpr size_t WS_RSTD = al256(WS_XMETA + 16 * 1024 * 4);
constexpr size_t SEG_B = (size_t)MPAD * 512 * 2;
constexpr size_t WS_OA = al256(WS_RSTD + (size_t)MPAD * 2 * 4);
constexpr size_t WS_XN = WS_OA + SEG_B;
constexpr size_t WS_PROJ = al256(WS_XN + (size_t)MPAD * 1024 * 2);
constexpr size_t WS_PROJH = WS_PROJ + (size_t)MPAD * PJR * 2;
constexpr size_t PH_T = (size_t)MPAD * 128;
constexpr size_t WS_GATES = al256(WS_PROJ + (size_t)MPAD * PJ * 2);
constexpr size_t WS_QATT = al256(WS_GATES + (size_t)MPAD * 16 * 4);
constexpr size_t WS_QMETA = al256(WS_QATT + (size_t)NB * 8 * SEQ * 96 * 2);
constexpr size_t WS_QS = al256(WS_QMETA + (size_t)8 * 256 * 96 * 2);
constexpr int KVROWS = 64 + SEQ;
constexpr size_t WS_KV = al256(WS_QS + (size_t)NS * 768 * 2);
constexpr size_t WS_END0 = al256(WS_KV + (size_t)NB * 8 * KVROWS * 160 * 2);

struct Params {
  const float* in[25];
  float* out;
  unsigned char* ws;
  int ph_lo, ph_hi;
  int probe, pad;
};

__device__ __forceinline__ float wave_sum(float v) {
#pragma unroll
  for (int o = 1; o < 64; o <<= 1) v += __shfl_xor(v, o);
  return v;
}
__device__ __forceinline__ float sigmoidf_(float x) { return __builtin_amdgcn_rcpf(1.f + __builtin_amdgcn_exp2f(-1.4426950408889634f * x)); }
__device__ __forceinline__ float siluf_(float x) { return x * __builtin_amdgcn_rcpf(1.f + __builtin_amdgcn_exp2f(-1.4426950408889634f * x)); }

__device__ __forceinline__ int orig_col(int pc, float& sc) {
  sc = 1.f;
  if (pc < 256) return 384 + pc;
  if (pc < 640) return pc - 256;
  if (pc < 672) return pc;
  if (pc < 688) { int g = pc - 672; return g < 8 ? 2720 + g : 5288 + (g - 8); }
  if (pc < 704) return -1;
  if (pc < 1216) return 1184 + (pc - 704);
  if (pc < 1728) { sc = 0.08838834764831845f; return 1696 + (pc - 1216); }
  if (pc < 2240) return 2208 + (pc - 1728);
  if (pc < 2752) return 2728 + (pc - 2240);
  if (pc < 4288) return 3752 + (pc - 2752);
  if (pc < 4800) return 672 + (pc - 4288);
  if (pc < 5312) return 3240 + (pc - 4800);
  if (pc < 5824) return 5296 + (pc - 5312);
  return -1;
}

template <class F>
__device__ __forceinline__ void transpose_item(F src, int K, bf16_t* WT, LAS float* scr, int kb, int nb, int lane) {
  const int k0 = 64 * kb, n0 = 32 * nb;
#pragma unroll 16
  for (int i = 0; i < 32; ++i) { const int kk = 2 * i + (lane >> 5); scr[kk * 33 + (lane & 31)] = src(k0 + kk, n0 + (lane & 31)); }
  asm volatile("s_waitcnt lgkmcnt(0)" ::: "memory");
  const int c = lane & 7;
#pragma unroll
  for (int j = 0; j < 4; ++j) {
    const int n = (lane >> 3) + 8 * j; const LAS float* s = scr + (8 * c) * 33 + n;
    u32x4 o; o.x = cvtpk(s[0 * 33], s[1 * 33]); o.y = cvtpk(s[2 * 33], s[3 * 33]); o.z = cvtpk(s[4 * 33], s[5 * 33]); o.w = cvtpk(s[6 * 33], s[7 * 33]);
    *(u32x4*)(WT + (size_t)(n0 + n) * K + k0 + 8 * c) = o;
  }
  asm volatile("s_waitcnt lgkmcnt(0)" ::: "memory");
}

template <class F4>
__device__ __forceinline__ void transpose_item4(F4 src4, int K, bf16_t* WT, LAS float* scr  , int kb, int nb, int lane) {
  const int k0 = 32 * kb, n0 = 128 * nb;
  f32x4 v[16];
#pragma unroll
  for (int i = 0; i < 16; ++i) v[i] = src4(k0 + 2 * i + (lane >> 5), n0 + 4 * (lane & 31));
#pragma unroll
  for (int i = 0; i < 16; ++i) *(LAS f32x4*)(scr + (2 * i + (lane >> 5)) * 132 + 4 * (lane & 31)) = v[i];
  asm volatile("s_waitcnt lgkmcnt(0)" ::: "memory");
  const int c = lane & 3;
#pragma unroll
  for (int j = 0; j < 8; ++j) {
    const int n = (lane >> 2) + 16 * j; const LAS float* s = scr + (8 * c) * 132 + n;
    u32x4 o; o.x = cvtpk(s[0 * 132], s[1 * 132]); o.y = cvtpk(s[2 * 132], s[3 * 132]); o.z = cvtpk(s[4 * 132], s[5 * 132]); o.w = cvtpk(s[6 * 132], s[7 * 132]);
    *(u32x4*)(WT + (size_t)(n0 + n) * K + k0 + 8 * c) = o;
  }
  asm volatile("s_waitcnt lgkmcnt(0)" ::: "memory");
}

__device__ __forceinline__ void rms_row_to_bf16(const float* xrow, const float* w, bf16_t* orow, int lane) {
  const f32x4* xr = (const f32x4*)xrow + lane; const f32x4* wr = (const f32x4*)w + lane;
  f32x4 v[4]; float s = 0.f;
#pragma unroll
  for (int j = 0; j < 4; ++j) { v[j] = xr[64 * j]; s += (v[j].x * v[j].x + v[j].y * v[j].y) + (v[j].z * v[j].z + v[j].w * v[j].w); }
  const float rstd = rsqrtf(wave_sum(s) * (1.f / D) + EPS);
  unsigned long long* o8 = (unsigned long long*)orow + lane;
#pragma unroll
  for (int j = 0; j < 4; ++j) { const f32x4 ww = wr[64 * j];
    o8[64 * j] = (unsigned long long)cvtpk(v[j].x * rstd * ww.x, v[j].y * rstd * ww.y) | ((unsigned long long)cvtpk(v[j].z * rstd * ww.z, v[j].w * rstd * ww.w) << 32); }
}

__device__ __forceinline__ const float* xrow_in(const Params& p, int l, int r) {
  if (l == 0) {
    if (r < ROW_S) return p.in[0] + (size_t)r * D;
    if (r < ROW_M) return p.in[1] + (size_t)(r - ROW_S) * D;
    return p.in[9] + (size_t)(r - ROW_M) * D;
  }
  if (r < ROW_S) return p.out + O_YP + (size_t)r * D;
  if (r < ROW_M) return p.out + O_YS + (size_t)(r - ROW_S) * D;
  return (const float*)(p.ws + WS_XMETA) + (size_t)(r - ROW_M) * D;
}
__device__ __forceinline__ float* xrow_out(const Params& p, int r) {
  if (r < ROW_S) return p.out + O_YP + (size_t)r * D;
  if (r < ROW_M) return p.out + O_YS + (size_t)(r - ROW_S) * D;
  return (float*)(p.ws + WS_XMETA) + (size_t)(r - ROW_M) * D;
}

__device__ __forceinline__ void phase_norm_rows(const Params& p, int l, int gw, int NGW, int lane, int rbeg = 0, int rend = MPAD) {
  bf16_t* XN = (bf16_t*)(p.ws + WS_XN);
  const f32x4* wr = (const f32x4*)(p.in[10] + (size_t)l * D) + lane;
  for (int r0 = rbeg + 4 * gw; r0 < rend; r0 += 4 * NGW) {
    f32x4 v[4][4]; float s[4];
#pragma unroll
    for (int i = 0; i < 4; ++i) { const int r = r0 + i;
      if (r < MROWS) { const f32x4* xr = (const f32x4*)xrow_in(p, l, r) + lane;
#pragma unroll
        for (int j = 0; j < 4; ++j) v[i][j] = xr[64 * j]; }
      else {
#pragma unroll
        for (int j = 0; j < 4; ++j) v[i][j] = (f32x4){0.f, 0.f, 0.f, 0.f}; } }
#pragma unroll
    for (int i = 0; i < 4; ++i) { s[i] = 0.f;
#pragma unroll
      for (int j = 0; j < 4; ++j) s[i] += (v[i][j].x * v[i][j].x + v[i][j].y * v[i][j].y) + (v[i][j].z * v[i][j].z + v[i][j].w * v[i][j].w); }
#pragma unroll
    for (int o = 1; o < 64; o <<= 1)
#pragma unroll
      for (int i = 0; i < 4; ++i) s[i] += __shfl_xor(s[i], o);
#pragma unroll
    for (int i = 0; i < 4; ++i) { const float rstd = rsqrtf(s[i] * (1.f / D) + EPS); unsigned long long* o8 = (unsigned long long*)(XN + (size_t)(r0 + i) * D) + lane;
#pragma unroll
      for (int j = 0; j < 4; ++j) { const f32x4 ww = wr[64 * j];
        o8[64 * j] = (unsigned long long)cvtpk(v[i][j].x * rstd * ww.x, v[i][j].y * rstd * ww.y) | ((unsigned long long)cvtpk(v[i][j].z * rstd * ww.z, v[i][j].w * rstd * ww.w) << 32); } }
  }
}

__device__ __forceinline__ void phase0(const Params& p, LAS unsigned char* lds, int tid) {
  const int lane = tid & 63, wave = tid >> 6;
  const int gw = blockIdx.x * NWAVES + wave, NGW = gridDim.x * NWAVES;
  LAS float* scr = (LAS float*)(lds + wave * 16896);
  if (blockIdx.x == 0 && tid < 1024 / 4) ((unsigned*)(p.ws + WS_CTL))[tid] = 0u;
  constexpr int I_WIN = 32 * (PJ / 128), I_WUQ = 12 * 6, I_WUKV = 8 * 8, I_WOUT = 48 * 8, I_WUVT = 8 * 4;
  constexpr int I_L = I_WIN + I_WUQ + I_WUKV + I_WOUT + I_WUVT, I_ALL = 2 * I_L;
  for (int it = gw; it < I_ALL; it += NGW) {
    const int l = it / I_L; int r = it % I_L;
    if (r < I_WIN) {
      const float* W = p.in[11] + (size_t)l * D * INC;
      transpose_item4([&](int k, int n) { float sc; const int oc = orig_col(n, sc); f32x4 v = {0.f, 0.f, 0.f, 0.f}; if (oc >= 0) { v = *(const f32x4*)(W + (size_t)k * INC + oc); v *= sc; } return v; },
                      1024, (bf16_t*)(p.ws + WS_WIN) + (size_t)l * PJ * 1024, scr, r % 32, r / 32, lane);
      continue; }
    r -= I_WIN;
    if (r < I_WUQ) {
      const float* W = p.in[13] + (size_t)l * 384 * 768; const float* qn = p.in[12] + (size_t)l * 384;
      transpose_item4([&](int k, int n) { f32x4 v = *(const f32x4*)(W + (size_t)k * 768 + n); v *= qn[k] * QSCALE; return v; }, 384, (bf16_t*)(p.ws + WS_WUQ) + (size_t)l * 768 * 384, scr, r % 12, r / 12, lane);
      continue; }
    r -= I_WUQ;
    if (r < I_WUKV) {
      const float* Wk = p.in[15] + (size_t)l * 256 * 512; const float* Wv = p.in[16] + (size_t)l * 256 * 512; const float* kn = p.in[14] + (size_t)l * 256;
      transpose_item4([&](int k, int n) { f32x4 v = n < 512 ? *(const f32x4*)(Wk + (size_t)k * 512 + n) : *(const f32x4*)(Wv + (size_t)k * 512 + n - 512); v *= kn[k]; return v; }, 256, (bf16_t*)(p.ws + WS_WUKV) + (size_t)l * 1024 * 256, scr, r % 8, r / 8, lane);
      continue; }
    r -= I_WUKV;
    if (r < I_WOUT) {
      const float* W = p.in[23] + (size_t)l * DMIX * D;
      transpose_item4([&](int k, int n) { return *(const f32x4*)(W + (size_t)k * D + n); }, DMIX, (bf16_t*)(p.ws + WS_WOUT) + (size_t)l * D * DMIX, scr, r % 48, r / 48, lane);
      continue; }
    r -= I_WOUT;
    { const float* Wv = p.in[16] + (size_t)l * 256 * 512;
      transpose_item4([&](int k, int n) { return *(const f32x4*)(Wv + (size_t)k * 512 + n); }, 256, (bf16_t*)(p.ws + WS_WUVT) + (size_t)l * 512 * 256, scr, r % 8, r / 8, lane); }
  }
  const long long gt = (long long)blockIdx.x * NTHREADS + tid, GT = (long long)gridDim.x * NTHREADS;
  { bf16_t* o = (bf16_t*)(p.ws + WS_WUKR); const float* W = p.in[15];
    for (long long i = gt; i < 2LL * 256 * 512; i += GT) o[i] = f2bf(W[i]); }
  { float* ct = (float*)(p.ws + WS_ROPE); float* st = ct + ROPE_N * 16;
    for (long long i = gt; i < (long long)ROPE_N * 16; i += GT) {
      const int pos = (int)(i >> 4), k = (int)(i & 15);
      const float freq = powf(10000.f, -(float)k / 16.f); const float ang = (float)pos * freq;
      float s, c; sincosf(ang, &s, &c); ct[i] = c; st[i] = s; } }
  { LAS int* qs = (LAS int*)(lds + 147440); unsigned* nq = (unsigned*)(p.ws + WS_WQ);
    __syncthreads();
    if (tid == 0) *qs = (int)atomicAdd(nq, 1u);
    __syncthreads();
    int cur = __builtin_amdgcn_readfirstlane(*qs);
    __syncthreads();
    while (cur < MPAD / 32) {
      unsigned pend = 0u; if (tid == 0) pend = atomicAdd(nq, 1u);
      phase_norm_rows(p, 0, wave, 8, lane, cur * 32, cur * 32 + 32);
      if (tid == 0) *qs = (int)pend;
      __syncthreads();
      cur = __builtin_amdgcn_readfirstlane(*qs);
      __syncthreads();
    }
  }
}

namespace pg8 {
constexpr int BM = 256, BK = 64, HALF = 128, HTB = HALF * BK * 2, STAGE_BYTES = 8 * HTB, NXCD = 8, WGM = 8;
__device__ __forceinline__ int lds_byte(int r, int c) { const int st = (r >> 4) * 2 + (c >> 5), rr = r & 15, cc = c & 31, ob = rr * 64 + cc * 2; return st * 1024 + (ob ^ (((ob >> 9) & 1) << 5)); }
__device__ __forceinline__ void stage_rc(int b, int& R, int& C) { const int st = b / 1024, sb = b % 1024, swz = sb ^ (((sb >> 9) & 1) << 5); R = (st >> 1) * 16 + swz / 64; C = (st & 1) * 32 + (swz % 64) / 2; }
__device__ __forceinline__ int perm32(int rho) { const int n = rho >> 4, i = rho & 15; return 8 * (i >> 2) + 4 * n + (i & 3); }
struct Unit { int pm, pn; };
struct Gemm { const bf16_t* A; const bf16_t* Bt; int lda, ldb, K; int kseg; size_t segstride; };
struct StaticOrder {
  int nM, nN, nwg, G, c;
  __device__ void init(int nM_, int nN_, int G_, int c_) { nM = nM_; nN = nN_; nwg = nM * nN; G = G_; c = c_; }
  __device__ bool next(int i, Unit& u) const {
    const long L = (long)i * G + c; if (L >= nwg) return false;
    int wgid = (int)L; { const int q = nwg / NXCD, r = nwg % NXCD, xcd = wgid % NXCD, off = wgid / NXCD; wgid = (xcd < r ? xcd * (q + 1) : r * (q + 1) + (xcd - r) * q) + off; }
    const int nig = WGM * nN, gid = wgid / nig, fm = gid * WGM, gsz = (nM - fm) < WGM ? (nM - fm) : WGM;
    u.pm = fm + ((wgid % nig) % gsz); u.pn = (wgid % nig) / gsz; return true;
  }
};
template <class Epi, class Sched>
__device__ __forceinline__ void gemm_phase(LAS unsigned char* lds, const Gemm g, const Sched& S, const Epi& E) {
  int tid = threadIdx.x; asm volatile("" : "+v"(tid)); const int wid = __builtin_amdgcn_readfirstlane(tid >> 6), lane = tid & 63, wr = wid >> 2, wc = wid & 3, fr = lane & 15, fq = lane >> 4;
  const int nt = g.K / BK;
  unsigned voffA[2], voffB[2];
#pragma unroll
  for (int i = 0; i < 2; ++i) { int R, C; stage_rc(tid * 16 + i * 8192, R, C); const int Rb = (R & ~31) + perm32(R & 31);
    voffA[i] = (unsigned)(R * g.lda + C) * 2u; voffB[i] = (unsigned)(Rb * g.ldb + C) * 2u; }
  const size_t kstep = (size_t)(BK * 2);
  const size_t hstepA = (size_t)HALF * g.lda * 2, hstepB = (size_t)HALF * g.ldb * 2;
  const size_t tstepA = 2 * hstepA, tstepB = 2 * hstepB;
  const unsigned ldsw = (unsigned)wid * 1024u;
  const int aoff = lds_byte(wr * 64 + fr, fq * 8), boff = lds_byte(wc * 32 + fr, fq * 8);
#define PG8_SA(b, h) (((b) * 2 + (h)) * HTB)
#define PG8_SB(b, h) ((4 + (b) * 2 + (h)) * HTB)
#define PG8_STAGE(bufoff, gbase, voff) do { _Pragma("unroll") for (int _i = 0; _i < 2; ++_i) \
    __builtin_amdgcn_global_load_lds((const unsigned*)((const char*)(gbase) + (voff)[_i]), (LAS unsigned*)(lds + (bufoff) + ldsw + _i * 8192), 16, 0, 0); } while (0)
#define PG8_LDA(dst, b, h) do { _Pragma("unroll") for (int m = 0; m < 4; ++m) _Pragma("unroll") for (int k = 0; k < 2; ++k) dst[m][k] = *(const LAS bf16x8*)(lds + PG8_SA(b, h) + aoff + m * 2048 + k * 1024); } while (0)
#define PG8_LDB(dst, b, h) do { _Pragma("unroll") for (int n = 0; n < 2; ++n) _Pragma("unroll") for (int k = 0; k < 2; ++k) dst[n][k] = *(const LAS bf16x8*)(lds + PG8_SB(b, h) + boff + n * 2048 + k * 1024); } while (0)
#define PG8_MMA(ai, bj, At, Bt) do { __builtin_amdgcn_s_setprio(1); _Pragma("unroll") for (int m = 0; m < 4; ++m) _Pragma("unroll") for (int n = 0; n < 2; ++n) _Pragma("unroll") for (int k = 0; k < 2; ++k) \
    acc[ai][bj][m][n] = __builtin_amdgcn_mfma_f32_16x16x32_bf16(Bt[n][k], At[m][k], acc[ai][bj][m][n], 0, 0, 0); __builtin_amdgcn_s_setprio(0); } while (0)
#define PG8_WAIT_V(n) asm volatile("s_waitcnt vmcnt(" #n ")" ::: "memory")
#define PG8_WAIT_L(n) asm volatile("s_waitcnt lgkmcnt(" #n ")" ::: "memory")
#define PG8_BAR __builtin_amdgcn_s_barrier()
#define PG8_SCHED __builtin_amdgcn_sched_barrier(0)
  Unit cur, nxt; int ui = 0;
  if (!S.next(0, cur)) return;
  f32x4 acc[2][2][4][2];
#pragma unroll
  for (int a = 0; a < 2; ++a)
#pragma unroll
    for (int b = 0; b < 2; ++b)
#pragma unroll
      for (int m = 0; m < 4; ++m)
#pragma unroll
        for (int n = 0; n < 2; ++n) acc[a][b][m][n] = (f32x4){0.f, 0.f, 0.f, 0.f};
  bf16x8 At[4][2], B0[2][2], B1[2][2];
  const char* cA = (const char*)g.A + (size_t)S.tile_m(cur.pm) * tstepA; const char* cB = (const char*)g.Bt + (size_t)cur.pn * tstepB;
  PG8_STAGE(PG8_SB(0, 0), cB, voffB); PG8_STAGE(PG8_SB(0, 1), cB + hstepB, voffB); PG8_STAGE(PG8_SA(0, 0), cA, voffA); PG8_STAGE(PG8_SA(0, 1), cA + hstepA, voffA);
  if (wr == 1) PG8_BAR;
  PG8_WAIT_V(2); PG8_BAR;
  PG8_STAGE(PG8_SB(1, 0), cB + kstep, voffB); PG8_STAGE(PG8_SA(1, 0), cA + kstep, voffA); PG8_STAGE(PG8_SB(1, 1), cB + hstepB + kstep, voffB);
  PG8_WAIT_V(6); PG8_BAR;
  for (;;) {
    const bool has_next = S.next(ui + 1, nxt);
    const char* nA = has_next ? (const char*)g.A + (size_t)S.tile_m(nxt.pm) * tstepA : cA; const char* nB = has_next ? (const char*)g.Bt + (size_t)nxt.pn * tstepB : cB;
#pragma unroll 1
    for (int t = 0; t < nt; t += 2) {
      const bool last = (t == nt - 2);
      const int sg1 = t / g.kseg, sg2 = (t + 2) / g.kseg;
      const char* a1 = cA + (size_t)sg1 * g.segstride + (size_t)(t + 1 - sg1 * g.kseg) * kstep;
      const char* a2 = last ? nA : cA + (size_t)sg2 * g.segstride + (size_t)(t + 2 - sg2 * g.kseg) * kstep; const char* b2 = last ? nB : cB + (size_t)(t + 2) * kstep;
      const char* a3 = a2 + kstep; const char* b3 = b2 + kstep;
      PG8_LDB(B0, 0, 0); PG8_LDB(B1, 0, 1); PG8_SCHED; PG8_LDA(At, 0, 0); PG8_STAGE(PG8_SA(1, 1), a1 + hstepA, voffA);
      PG8_WAIT_V(8); PG8_WAIT_L(0); PG8_BAR; PG8_MMA(0, 0, At, B0); PG8_MMA(0, 1, At, B1); PG8_BAR; PG8_SCHED;
      PG8_LDA(At, 0, 1); PG8_STAGE(PG8_SB(0, 0), b2, voffB); PG8_STAGE(PG8_SB(0, 1), b2 + hstepB, voffB); PG8_STAGE(PG8_SA(0, 0), a2, voffA);
      PG8_WAIT_V(8); PG8_WAIT_L(0); PG8_BAR; PG8_MMA(1, 0, At, B0); PG8_MMA(1, 1, At, B1); PG8_BAR; PG8_SCHED;
      PG8_LDB(B0, 1, 0); PG8_LDB(B1, 1, 1); PG8_SCHED; PG8_LDA(At, 1, 0); PG8_STAGE(PG8_SA(0, 1), a2 + hstepA, voffA);
      PG8_WAIT_V(8); PG8_WAIT_L(0); PG8_BAR; PG8_MMA(0, 0, At, B0); PG8_MMA(0, 1, At, B1); PG8_BAR; PG8_SCHED;
      PG8_LDA(At, 1, 1); PG8_STAGE(PG8_SB(1, 0), b3, voffB); PG8_STAGE(PG8_SB(1, 1), b3 + hstepB, voffB); PG8_STAGE(PG8_SA(1, 0), a3, voffA);
      PG8_WAIT_V(8); PG8_WAIT_L(0); PG8_BAR; PG8_MMA(1, 0, At, B0); PG8_MMA(1, 1, At, B1); PG8_BAR; PG8_SCHED;
    }
    if (wr == 0) PG8_BAR;
    E(acc, S.tile_m(cur.pm), cur.pn, wr, wc, fr, fq);
    if (!has_next) break;
#pragma unroll
    for (int a = 0; a < 2; ++a)
#pragma unroll
      for (int b = 0; b < 2; ++b)
#pragma unroll
        for (int m = 0; m < 4; ++m)
#pragma unroll
          for (int n = 0; n < 2; ++n) acc[a][b][m][n] = (f32x4){0.f, 0.f, 0.f, 0.f};
    cur = nxt; cA = nA; cB = nB; ++ui;
    if (wr == 1) PG8_BAR;
  }
  PG8_WAIT_V(0);
  PG8_BAR;
#undef PG8_SA
#undef PG8_SB
#undef PG8_STAGE
#undef PG8_LDA
#undef PG8_LDB
#undef PG8_MMA
#undef PG8_WAIT_V
#undef PG8_WAIT_L
#undef PG8_BAR
#undef PG8_SCHED
}
}

struct OrderAll : pg8::StaticOrder { __device__ __forceinline__ int tile_m(int pm) const { return pm; } };

struct EpiProj {
  bf16_t* O; bf16_t* OH;
  __device__ __forceinline__ static void dest(int c32, bf16_t* O, bf16_t* OH, bf16_t*& base, int& pitch) {
    if (c32 < PC_MQ) { base = O + c32; pitch = PJR; }
    else if (c32 >= PC_ZA) { base = O + (RC_ZA + c32 - PC_ZA); pitch = PJR; }
    else if (c32 >= PC_MO && c32 < PC_GQ) { base = O + (RC_MO + c32 - PC_MO); pitch = PJR; }
    else { const int rel = c32 < PC_MO ? c32 - PC_MQ : c32 - PC_GQ + 1536; base = OH + (size_t)(rel >> 7) * PH_T + (rel & 127); pitch = 128; }
  }
  __device__ __forceinline__ void operator()(const f32x4 (&acc)[2][2][4][2], int tm, int pn, int wr, int wc, int fr, int fq) const {
    const int row0 = tm * 256 + wr * 64 + fr;
    bf16_t* b0; bf16_t* b1; int p0, p1;
    dest(__builtin_amdgcn_readfirstlane(pn * 256 + wc * 32), O, OH, b0, p0); dest(__builtin_amdgcn_readfirstlane(pn * 256 + 128 + wc * 32), O, OH, b1, p1);
#pragma unroll
    for (int ai = 0; ai < 2; ++ai)
#pragma unroll
      for (int m = 0; m < 4; ++m) { int r_ = row0; asm volatile("" : "+v"(r_) :: "memory"); const int r = r_ + ai * 128 + m * 16;
#pragma unroll
        for (int bj = 0; bj < 2; ++bj) { const f32x4 v0 = acc[ai][bj][m][0], v1 = acc[ai][bj][m][1];
          u32x4 w; w.x = cvtpk(v0[0], v0[1]); w.y = cvtpk(v0[2], v0[3]); w.z = cvtpk(v1[0], v1[1]); w.w = cvtpk(v1[2], v1[3]);
          *(u32x4*)((bj ? b1 : b0) + (size_t)r * (bj ? p1 : p0) + 8 * fq) = w; } }
  }
};


struct RowInfo { int kind  , b, t, pos; };
__device__ __forceinline__ RowInfo row_info(int r) {
  RowInfo ri;
  if (r < ROW_S) { ri.kind = 0; ri.b = r >> 12; ri.t = r & 4095; ri.pos = NMETA + ri.t; }
  else if (r < ROW_M) { ri.kind = 1; ri.b = (r - ROW_S) >> 4; ri.t = (r - ROW_S) & 15; ri.pos = NCACHE + ri.t; }
  else if (r < MROWS) { ri.kind = 2; ri.b = 0; ri.t = r - ROW_M; ri.pos = ri.t; }
  else { ri.kind = 3; ri.b = 0; ri.t = 0; ri.pos = 0; }
  return ri;
}
__device__ __forceinline__ float softplusf_(float x) { return x > 20.f ? x : __logf(1.f + __expf(x)); }
__device__ __forceinline__ float logsigmoidf_(float x) { return x >= 0.f ? -__logf(1.f + __expf(-x)) : x - __logf(1.f + __expf(x)); }

__device__ __forceinline__ void phase_rowpass(const Params& p, int l, int gw, int NGW, int lane) {
  const bf16_t* PROJ = (const bf16_t*)(p.ws + WS_PROJ);
  float* RSTD = (float*)(p.ws + WS_RSTD);
  const float* ct = (const float*)(p.ws + WS_ROPE); const float* st = ct + ROPE_N * 16;
  bf16_t* KV = (bf16_t*)(p.ws + WS_KV);
  const f32x4 kn = *(const f32x4*)(p.in[14] + (size_t)l * 256 + 4 * lane);
  for (int r0 = 2 * gw; r0 < MROWS; r0 += 2 * NGW) {
    u32x2 ck[2]; unsigned cq[2][3]; unsigned short krv[2][2]; float skv[2], sq[2];
#pragma unroll
    for (int i = 0; i < 2; ++i) { const bf16_t* pr = PROJ + (size_t)(r0 + i) * PJR;
      ck[i] = *(const u32x2*)(pr + PC_CKV + 4 * lane);
      const unsigned* cqp = (const unsigned*)(pr + PC_CQ + 6 * lane); cq[i][0] = cqp[0]; cq[i][1] = cqp[1]; cq[i][2] = cqp[2];
      krv[i][0] = pr[PC_KR + (lane & 15)]; krv[i][1] = pr[PC_KR + 16 + (lane & 15)]; }
#pragma unroll
    for (int i = 0; i < 2; ++i) { const float c0 = bflo(ck[i].x), c1 = bfhi(ck[i].x), c2 = bflo(ck[i].y), c3 = bfhi(ck[i].y); skv[i] = c0 * c0 + c1 * c1 + c2 * c2 + c3 * c3; sq[i] = 0.f;
#pragma unroll
      for (int j = 0; j < 3; ++j) { const float a = bflo(cq[i][j]), b = bfhi(cq[i][j]); sq[i] += a * a + b * b; } }
#pragma unroll
    for (int o = 1; o < 64; o <<= 1)
#pragma unroll
      for (int i = 0; i < 2; ++i) { skv[i] += __shfl_xor(skv[i], o); sq[i] += __shfl_xor(sq[i], o); }
#pragma unroll
    for (int i = 0; i < 2; ++i) {
      const int r = r0 + i; const RowInfo ri = row_info(r); const bf16_t* pr = PROJ + (size_t)r * PJR;
      const float rs_kv = rsqrtf(skv[i] * (1.f / 256.f) + EPS), rs_q = rsqrtf(sq[i] * (1.f / 384.f) + EPS);
      const f32x4 lat = {bflo(ck[i].x) * rs_kv * kn.x, bfhi(ck[i].x) * rs_kv * kn.y, bflo(ck[i].y) * rs_kv * kn.z, bfhi(ck[i].y) * rs_kv * kn.w};
      if (lane == 0) { RSTD[2 * r] = rs_q; RSTD[2 * r + 1] = rs_kv; }
      float o1 = 0.f, o2 = 0.f;
      if (lane < 16) { const float x1 = bf2f(krv[i][0]), x2 = bf2f(krv[i][1]); const float c = ct[ri.pos * 16 + lane], s = st[ri.pos * 16 + lane]; o1 = x1 * c - x2 * s; o2 = x2 * c + x1 * s; }
      if (ri.kind == 0) {
        float* ol = p.out + O_PLAT + (((size_t)l * NB + ri.b) * NCACHE + NMETA + ri.t) * 256; *(f32x4*)(ol + 4 * lane) = lat;
        if (lane < 16) { float* ok = p.out + O_PKR + (((size_t)l * NB + ri.b) * NCACHE + NMETA + ri.t) * 32; ok[lane] = o1; ok[16 + lane] = o2; }
        {
          const int k0 = 4 * (lane & 7), src = k0 & 15; float v4[4];
#pragma unroll
          for (int e = 0; e < 4; ++e) { const float a1 = __shfl(o1, src + e), a2 = __shfl(o2, src + e); v4[e] = k0 < 16 ? a1 : a2; }
          u32x2 w; w.x = cvtpk(v4[0], v4[1]); w.y = cvtpk(v4[2], v4[3]);
          *(u32x2*)(KV + ((size_t)(ri.b * 8 + (lane >> 3)) * KVROWS + 64 + ri.t) * 160 + 64 + k0) = w; }
      } else if (ri.kind == 1) {
        float* ol = p.out + O_SLAT + (((size_t)l * DB + ri.b) * DS + ri.t) * 256; *(f32x4*)(ol + 4 * lane) = lat;
        if (lane < 16) { float* ok = p.out + O_SKR + (((size_t)l * DB + ri.b) * DS + ri.t) * 32; ok[lane] = o1; ok[16 + lane] = o2; }
      } else {
        for (int b = 0; b < NB; ++b) {
          float* ol = p.out + O_PLAT + (((size_t)l * NB + b) * NCACHE + ri.t) * 256; *(f32x4*)(ol + 4 * lane) = lat;
          if (lane < 16) { float* ok = p.out + O_PKR + (((size_t)l * NB + b) * NCACHE + ri.t) * 32; ok[lane] = o1; ok[16 + lane] = o2;
#pragma unroll
            for (int h = 0; h < 8; ++h) { bf16_t* kd = KV + ((size_t)(b * 8 + h) * KVROWS + ri.t) * 160 + 64; kd[lane] = f2bf(o1); kd[16 + lane] = f2bf(o2); } }
        }
      }
      float* co = nullptr;
      if (ri.kind == 0 && ri.t >= SEQ - 3) co = p.out + O_PCONV + (((size_t)l * NB + ri.b) * 3 + (ri.t - (SEQ - 3))) * 1536;
      if (ri.kind == 1 && ri.t >= DS - 3) co = p.out + O_SCONV + (((size_t)l * DB + ri.b) * 3 + (ri.t - (DS - 3))) * 1536;
      if (co) { const bf16_t* ph = (const bf16_t*)(p.ws + WS_PROJH) + (size_t)(12 + (lane >> 4)) * PH_T + (size_t)r * 128 + 8 * (lane & 15);
        for (int c = lane * 8; c < 1536; c += 512) { const u32x4 w = *(const u32x4*)(ph + (size_t)(c >> 9) * 4 * PH_T);
          *(f32x4*)(co + c) = (f32x4){bflo(w.x), bfhi(w.x), bflo(w.y), bfhi(w.y)}; *(f32x4*)(co + c + 4) = (f32x4){bflo(w.z), bfhi(w.z), bflo(w.w), bfhi(w.w)}; } }
    }
  }
}

struct OrderTail : pg8::StaticOrder { __device__ __forceinline__ int tile_m(int pm) const { return 128 + pm; } };
struct OrderKV : pg8::StaticOrder { __device__ __forceinline__ int tile_m(int pm) const { return pm < 128 ? pm : 130; } };

struct EpiQ {
  const float* rstd; const float* ct; const float* st; bf16_t* QATT; bf16_t* QMETA; bf16_t* QS;
  __device__ __forceinline__ void operator()(const f32x4 (&acc)[2][2][4][2], int tm, int pn, int wr, int wc, int fr, int fq) const {
    float rsv[2][4];
#pragma unroll
    for (int ai = 0; ai < 2; ++ai)
#pragma unroll
      for (int m = 0; m < 4; ++m) { const int r = tm * 256 + ai * 128 + wr * 64 + m * 16 + fr; rsv[ai][m] = r < MROWS ? rstd[2 * r] : 0.f; }
#pragma unroll
    for (int ai = 0; ai < 2; ++ai)
#pragma unroll
      for (int m = 0; m < 4; ++m) {
        int fr_ = fr; asm volatile("" : "+v"(fr_) :: "memory");
        const int r = tm * 256 + ai * 128 + wr * 64 + m * 16 + fr_; const RowInfo ri = row_info(r);
        const float rs = rsv[ai][m];
        bf16_t* dst; int hstride;
        if (ri.kind == 0) { dst = QATT + ((size_t)(ri.b * 8) * SEQ + ri.t) * 96; hstride = SEQ * 96; }
        else if (ri.kind == 1) { dst = QS + (size_t)(r - ROW_S) * 768; hstride = 96; }
        else { dst = QMETA + (size_t)ri.t * 96; hstride = 256 * 96; }
#pragma unroll
        for (int bj = 0; bj < 2; ++bj) {
          const int gb = pn * 256 + bj * 128 + wc * 32; const int h = gb / 96, gm = gb - h * 96;
          float v[8];
#pragma unroll
          for (int j = 0; j < 4; ++j) { v[j] = acc[ai][bj][m][0][j] * rs; v[4 + j] = acc[ai][bj][m][1][j] * rs; }
          if (gm == 64) {
            const float* cp = ct + ri.pos * 16 + 8 * (fq & 1); const float* sp = st + ri.pos * 16 + 8 * (fq & 1);
            const f32x4 c0 = *(const f32x4*)cp, c1 = *(const f32x4*)(cp + 4), s0 = *(const f32x4*)sp, s1 = *(const f32x4*)(sp + 4);
            const float sg = fq < 2 ? -1.f : 1.f;
#pragma unroll
            for (int j = 0; j < 8; ++j) { const float pv = __shfl_xor(v[j], 32); const float c = j < 4 ? c0[j & 3] : c1[j & 3], s = j < 4 ? s0[j & 3] : s1[j & 3];
              v[j] = v[j] * c + sg * pv * s; }
          }
          u32x4 w; w.x = cvtpk(v[0], v[1]); w.y = cvtpk(v[2], v[3]); w.z = cvtpk(v[4], v[5]); w.w = cvtpk(v[6], v[7]);
          if (ri.kind != 3) *(u32x4*)(dst + (size_t)h * hstride + gm + 8 * fq) = w;
        }
      }
  }
};

struct EpiKV {
  const float* rstd; bf16_t* KV;
  __device__ __forceinline__ void operator()(const f32x4 (&acc)[2][2][4][2], int tm, int pn, int wr, int wc, int fr, int fq) const {
#pragma unroll
    for (int ai = 0; ai < 2; ++ai)
#pragma unroll
      for (int m = 0; m < 4; ++m) {
        int fr_ = fr; asm volatile("" : "+v"(fr_) :: "memory");
        const int r = tm * 256 + ai * 128 + wr * 64 + m * 16 + fr_; const RowInfo ri = row_info(r);
        if (ri.kind != 0 && ri.kind != 2) continue;
        const float rs = rstd[2 * r + 1];
#pragma unroll
        for (int bj = 0; bj < 2; ++bj) {
          const int col0 = pn * 256 + bj * 128 + wc * 32 + 8 * fq; const int isv = col0 >= 512; const int cc = col0 & 511; const int h = cc >> 6, d0 = (cc & 63) + (isv ? 96 : 0);
          const f32x4 v0 = acc[ai][bj][m][0] * rs, v1 = acc[ai][bj][m][1] * rs;
          u32x4 w; w.x = cvtpk(v0[0], v0[1]); w.y = cvtpk(v0[2], v0[3]); w.z = cvtpk(v1[0], v1[1]); w.w = cvtpk(v1[2], v1[3]);
          if (ri.kind == 0) *(u32x4*)(KV + ((size_t)(ri.b * 8 + h) * KVROWS + 64 + ri.t) * 160 + d0) = w;
          else for (int b = 0; b < NB; ++b) *(u32x4*)(KV + ((size_t)(b * 8 + h) * KVROWS + ri.t) * 160 + d0) = w;
        }
        asm volatile("" ::: "memory");
      }
  }
};

struct AttnUnit { const bf16_t* q; const bf16_t* kv; int ntiles, chunk0, nq_valid, out_row0, h, is_meta; };
constexpr int AT_KP = 208, AT_VP = 192, AT_KB = 64 * AT_KP, AT_STAGE = AT_KB + 64 * AT_VP;
typedef short v4i16_t __attribute__((ext_vector_type(4)));

__device__ __forceinline__ void attn_unit(LAS unsigned char* lds, const AttnUnit u, const bf16_t* PROJ, bf16_t* OA, int tid, unsigned char* p_ws_probe = nullptr) {
  asm volatile("" : "+v"(tid));
  const int lane = tid & 63, w = tid >> 6, r32 = lane & 31, hi = lane >> 5;
  const int jmax = u.is_meta ? 0 : (1 + u.chunk0 + (w >> 1));
  bf16x8 qf[6];
  { const bf16_t* qp = u.q + (size_t)(32 * w + r32) * 96 + 8 * hi;
#pragma unroll
    for (int s = 0; s < 6; ++s) qf[s] = *(const bf16x8*)(qp + 16 * s); }
  f32x16 o0, o1;
#pragma unroll
  for (int i = 0; i < 16; ++i) { o0[i] = 0.f; o1[i] = 0.f; }
  float mrun = -INFINITY, lrun = 0.f;
  u32x4 sA0, sA1, sA2, sB0, sB1, sB2; sA2 = (u32x4){0u, 0u, 0u, 0u}; sB2 = sA2;
  auto lds_off = [](int c) { const int row = c / 20, cc = c - row * 20; return cc < 12 ? row * AT_KP + cc * 16 : AT_KB + row * AT_VP + (cc - 12) * 16; };
  const int off0 = lds_off(tid), off1 = lds_off(tid + 512), off2 = lds_off(tid < 256 ? tid + 1024 : 0);
#define AT_LOAD(S0, S1, S2, TILE) do { const u32x4* g_ = (const u32x4*)(u.kv + (size_t)(TILE) * 64 * 160); S0 = g_[tid]; S1 = g_[tid + 512]; if (tid < 256) S2 = g_[tid + 1024]; } while (0)
#define AT_STORE(S0, S1, S2, STG) do { LAS unsigned char* nb_ = lds + (STG) * AT_STAGE; *(LAS u32x4*)(nb_ + off0) = S0; *(LAS u32x4*)(nb_ + off1) = S1; if (tid < 256) *(LAS u32x4*)(nb_ + off2) = S2; } while (0)
  AT_LOAD(sB0, sB1, sB2, 0); AT_STORE(sB0, sB1, sB2, 0);
  if (u.ntiles > 1) AT_LOAD(sA0, sA1, sA2, 1);
  if (u.ntiles > 2) AT_LOAD(sB0, sB1, sB2, 2);
  __syncthreads();
  const int koff = r32 * AT_KP + 16 * hi;
  const int l16 = lane & 15, cg = (lane >> 4) & 1;
  const int voff = AT_KB + (4 * hi + (l16 >> 2)) * AT_VP + (16 * cg + 4 * (l16 & 3)) * 2;
#if PROBE_LEVEL == 2
  unsigned long long tl_ = __builtin_amdgcn_s_memrealtime(), aa_[4] = {0ull, 0ull, 0ull, 0ull};
#define AA_T(i) do { const unsigned long long t_ = __builtin_amdgcn_s_memrealtime(); aa_[i] += t_ - tl_; tl_ = t_; } while (0)
#else
#define AA_T(i) do {} while (0)
#endif
  auto compute_tile = [&](int j) {
    LAS unsigned char* sb = lds + (j & 1) * AT_STAGE;
    AA_T(3);
    if (j <= jmax) {
      const float mref = mrun > -1e30f ? mrun : 0.f;
      f32x16 p0, p1;
#pragma unroll
      for (int i = 0; i < 16; ++i) { p0[i] = -mref; p1[i] = -mref; }
      bf16x8 kf0[6], kf1[6];
#pragma unroll
      for (int s = 0; s < 6; ++s) { kf0[s] = *(const LAS bf16x8*)(sb + koff + s * 32); kf1[s] = *(const LAS bf16x8*)(sb + koff + 32 * AT_KP + s * 32); }
      v4i16_t va0[4], va1[4], vb0[4], vb1[4];
#pragma unroll
      for (int ks = 0; ks < 4; ++ks) {
        va0[ks] = __builtin_amdgcn_ds_read_tr16_b64_v4i16((LAS v4i16_t*)(sb + voff + ks * 16 * AT_VP));
        va1[ks] = __builtin_amdgcn_ds_read_tr16_b64_v4i16((LAS v4i16_t*)(sb + voff + ks * 16 * AT_VP + 8 * AT_VP));
        vb0[ks] = __builtin_amdgcn_ds_read_tr16_b64_v4i16((LAS v4i16_t*)(sb + voff + ks * 16 * AT_VP + 64));
        vb1[ks] = __builtin_amdgcn_ds_read_tr16_b64_v4i16((LAS v4i16_t*)(sb + voff + ks * 16 * AT_VP + 8 * AT_VP + 64)); }
      __builtin_amdgcn_sched_barrier(0);
#pragma unroll
      for (int s = 0; s < 6; ++s) {
        p0 = __builtin_amdgcn_mfma_f32_32x32x16_bf16(kf0[s], qf[s], p0, 0, 0, 0);
        p1 = __builtin_amdgcn_mfma_f32_32x32x16_bf16(kf1[s], qf[s], p1, 0, 0, 0);
      }
      asm volatile("" :: "v"(p0), "v"(p1)); AA_T(0);
      if (j == 0) {
#pragma unroll
        for (int i = 8; i < 16; ++i) p0[i] = -INFINITY;
#pragma unroll
        for (int i = 0; i < 16; ++i) p1[i] = -INFINITY;
      }
      float tm = p0[0];
#pragma unroll
      for (int i = 1; i < 16; ++i) tm = fmaxf(tm, p0[i]);
#pragma unroll
      for (int i = 0; i < 16; ++i) tm = fmaxf(tm, p1[i]);
      tm = fmaxf(tm, __shfl_xor(tm, 32));
      if (!__all(tm + (mref - mrun) <= 6.0f)) {
        const float mnew = fmaxf(mrun, tm + mref); const float alpha = __builtin_amdgcn_exp2f(mrun - mnew); mrun = mnew; lrun *= alpha;
        const float shift = mnew - mref;
#pragma unroll
        for (int i = 0; i < 16; ++i) { o0[i] *= alpha; o1[i] *= alpha; p0[i] -= shift; p1[i] -= shift; }
      }
      float ps = 0.f;
#pragma unroll
      for (int i = 0; i < 16; ++i) { p0[i] = __builtin_amdgcn_exp2f(p0[i]); p1[i] = __builtin_amdgcn_exp2f(p1[i]); ps += p0[i] + p1[i]; }
      lrun += ps;
      AA_T(1);
      bf16x8 pb[4];
#pragma unroll
      for (int s = 0; s < 2; ++s) {
        u32x4 a, b;
        a.x = cvtpk(p0[8 * s + 0], p0[8 * s + 1]); a.y = cvtpk(p0[8 * s + 2], p0[8 * s + 3]); a.z = cvtpk(p0[8 * s + 4], p0[8 * s + 5]); a.w = cvtpk(p0[8 * s + 6], p0[8 * s + 7]);
        b.x = cvtpk(p1[8 * s + 0], p1[8 * s + 1]); b.y = cvtpk(p1[8 * s + 2], p1[8 * s + 3]); b.z = cvtpk(p1[8 * s + 4], p1[8 * s + 5]); b.w = cvtpk(p1[8 * s + 6], p1[8 * s + 7]);
        pb[s] = __builtin_bit_cast(bf16x8, a); pb[2 + s] = __builtin_bit_cast(bf16x8, b);
      }
#pragma unroll
      for (int ks = 0; ks < 4; ++ks) {
        const bf16x8 va = {va0[ks][0], va0[ks][1], va0[ks][2], va0[ks][3], va1[ks][0], va1[ks][1], va1[ks][2], va1[ks][3]};
        const bf16x8 vb = {vb0[ks][0], vb0[ks][1], vb0[ks][2], vb0[ks][3], vb1[ks][0], vb1[ks][1], vb1[ks][2], vb1[ks][3]};
        o0 = __builtin_amdgcn_mfma_f32_32x32x16_bf16(va, pb[ks], o0, 0, 0, 0);
        o1 = __builtin_amdgcn_mfma_f32_32x32x16_bf16(vb, pb[ks], o1, 0, 0, 0);
      }
      asm volatile("" :: "v"(o0), "v"(o1)); AA_T(2);
    }
  };
  for (int j = 0; j < u.ntiles; j += 2) {
    compute_tile(j);
    if (j + 1 < u.ntiles) AT_STORE(sA0, sA1, sA2, (j + 1) & 1);
    if (j + 3 < u.ntiles) AT_LOAD(sA0, sA1, sA2, j + 3);
    __syncthreads();
    if (j + 1 >= u.ntiles) break;
    compute_tile(j + 1);
    if (j + 2 < u.ntiles) AT_STORE(sB0, sB1, sB2, j & 1);
    if (j + 4 < u.ntiles) AT_LOAD(sB0, sB1, sB2, j + 4);
    __syncthreads();
  }
#undef AT_LOAD
#undef AT_STORE
#if PROBE_LEVEL == 2
  if (tid == 448 && blockIdx.x == 200) { for (int i = 0; i < 4; ++i) ((unsigned long long*)(p_ws_probe + WS_CTL + 2048))[4 + i] += aa_[i]; }
#endif
  const float ltot = lrun + __shfl_xor(lrun, 32); const float inv = 1.f / ltot;
  const int qi = 32 * w + r32;
  if (qi < u.nq_valid) {
    const bf16_t* zr = PROJ + (size_t)(u.out_row0 + qi) * PJR + RC_ZA + u.h * 64; bf16_t* orow = OA + (size_t)(u.out_row0 + qi) * 512 + u.h * 64;
#pragma unroll
    for (int dvt = 0; dvt < 2; ++dvt)
#pragma unroll
      for (int g = 0; g < 4; ++g) {
        const int dv0 = 32 * dvt + 8 * g + 4 * hi; u32x2 z = *(const u32x2*)(zr + dv0);
        float v[4];
#pragma unroll
        for (int e = 0; e < 4; ++e) v[e] = (dvt ? o1[4 * g + e] : o0[4 * g + e]) * inv;
        z.x = cvtpk(v[0] * siluf_(bflo(z.x)), v[1] * siluf_(bfhi(z.x))); z.y = cvtpk(v[2] * siluf_(bflo(z.y)), v[3] * siluf_(bfhi(z.y)));
        *(u32x2*)(orow + dv0) = z;
      }
  }
  __syncthreads();
}

constexpr int NSLOT = 32 * 65 + 128;
constexpr int MSLOT_B = 57344 + 2048;
constexpr int GSLOT_B = 73728 + 256;
constexpr int MS_Q = 0, MS_QK = 8192, MS_KHT = 12288, MS_VT = 20480, MS_SC_B = 57344;
constexpr int MSC_B = 0, MSC_MLOC = 64, MSC_RS = 128, MSC_DN = 192, MSC_A = 320, MSC_BB = 321;
constexpr int GS_NW = 0, GS_QT = 8192, GS_QK = 16384, GS_KTT = 20480, GS_UT = 28672, GS_SC_B = 73728;
constexpr size_t WS_MSLOT = WS_END0;
constexpr size_t WS_GSLOT = al256(WS_MSLOT + (size_t)NSLOT * MSLOT_B);
constexpr size_t WS_HM = WS_XN;
constexpr size_t WS_OG = WS_XN + SEG_B;
constexpr size_t WS_END1 = al256(WS_GSLOT + (size_t)NSLOT * GSLOT_B);

struct ChunkDesc { int row0, nvalid, kind  , b, h, tok0; };
__device__ __forceinline__ ChunkDesc chunk_of_slot(int slot) {
  ChunkDesc c;
  if (slot < 32 * 65) { const int ch = slot / 65, ci = slot - ch * 65; c.b = ch >> 2; c.h = ch & 3;
    if (ci == 0) { c.kind = 2; c.row0 = ROW_M; c.nvalid = 16; c.tok0 = 0; } else { c.kind = 0; c.row0 = c.b * SEQ + 64 * (ci - 1); c.nvalid = 64; c.tok0 = 64 * (ci - 1); } }
  else { const int ch = slot - 32 * 65; c.b = ch >> 2; c.h = ch & 3; c.kind = 1; c.row0 = ROW_S + 16 * c.b; c.nvalid = 16; c.tok0 = 0; }
  return c;
}
#define SCAN_DPP(old, src, ctrl, rmask) __int_as_float(__builtin_amdgcn_update_dpp(__float_as_int(old), __float_as_int(src), ctrl, rmask, 0xF, false))
__device__ __forceinline__ float scan_add(float v, int lane) {
  (void)lane;
  v += SCAN_DPP(0.f, v, 0x111, 0xF); v += SCAN_DPP(0.f, v, 0x112, 0xF); v += SCAN_DPP(0.f, v, 0x114, 0xF); v += SCAN_DPP(0.f, v, 0x118, 0xF);
  v += SCAN_DPP(0.f, v, 0x142, 0xA); v += SCAN_DPP(0.f, v, 0x143, 0xC);
  return v;
}
__device__ __forceinline__ float scan_max(float v, int lane) {
  (void)lane;
  v = fmaxf(v, SCAN_DPP(-INFINITY, v, 0x111, 0xF)); v = fmaxf(v, SCAN_DPP(-INFINITY, v, 0x112, 0xF)); v = fmaxf(v, SCAN_DPP(-INFINITY, v, 0x114, 0xF)); v = fmaxf(v, SCAN_DPP(-INFINITY, v, 0x118, 0xF));
  v = fmaxf(v, SCAN_DPP(-INFINITY, v, 0x142, 0xA)); v = fmaxf(v, SCAN_DPP(-INFINITY, v, 0x143, 0xC));
  return v;
}
__device__ __forceinline__ float wave_max(float v) { return __int_as_float(__builtin_amdgcn_readlane(__float_as_int(scan_max(v, 0)), 63)); }
__device__ __forceinline__ int kperm_pos(int k) { return (k & ~31) | (((k >> 2) & 3) << 3) | (((k >> 4) & 1) << 2) | (k & 3); }
__device__ __forceinline__ void store_perm8(bf16_t* rowbase, int k0, const u32x4& o) { u32x2 lo = {o.x, o.y}, hi = {o.z, o.w}; const int p0 = kperm_pos(k0); *(u32x2*)(rowbase + p0) = lo; *(u32x2*)(rowbase + p0 + 8) = hi; }
__device__ __forceinline__ float sum8(float v) { v += __shfl_xor(v, 1); v += __shfl_xor(v, 2); v += __shfl_xor(v, 4); return v; }

__device__ __forceinline__ void lds_barrier() { asm volatile("s_waitcnt lgkmcnt(0)\n\ts_barrier" ::: "memory"); }
#if PROBE_LEVEL == 2
#define PP_INIT() unsigned long long tl_ = __builtin_amdgcn_s_memrealtime()
#define PP_T(blk, i) do { lds_barrier(); if (tid == 0 && blockIdx.x == (blk)) { const unsigned long long t_ = __builtin_amdgcn_s_memrealtime(); ((unsigned long long*)(p.ws + WS_CTL + 2048))[(i)] += t_ - tl_; tl_ = t_; } } while (0)
#else
#define PP_INIT() do {} while (0)
#define PP_T(blk, i) do {} while (0)
#endif
constexpr int MP_IMG = 52224, MP_QK = 2 * MP_IMG, MP_SC = MP_QK + 17408, MP_G = MP_SC + 1536;
__device__ __forceinline__ bool prep_slot_skipped(int slot) { return slot < 32 * 65 && slot % 65 == 0 && slot >= 4 * 65; }
__device__ __forceinline__ int prep_next_slot(int slot, int G) { for (slot += G; slot < NSLOT; slot += G) if (!prep_slot_skipped(slot)) return slot; return NSLOT; }
__device__ __forceinline__ void mlstm_issue(LAS unsigned char* lds, const Params& p, int slot, int buf, int tid) {
  const ChunkDesc cd = chunk_of_slot(slot);
  const bf16_t* PROJ = (const bf16_t*)(p.ws + WS_PROJ); const bf16_t* PROJH = (const bf16_t*)(p.ws + WS_PROJH);
  const unsigned char* zero = p.ws + WS_ZERO;
  const int wu = __builtin_amdgcn_readfirstlane(tid >> 6), lane = tid & 63;
#pragma unroll
  for (int it = 0; it < 7; ++it) { const int k = wu + 8 * it;
    if (k < 51) { const int ten = k / 17, i = k - 17 * ten; const int o = i * 1024 + lane * 16, row = o / 272, col = o - row * 272;
      const unsigned char* src = (row < cd.nvalid && col < 256) ? (const unsigned char*)(PROJH + (size_t)(ten * 4 + cd.h) * PH_T + (size_t)(cd.row0 + row) * 128) + col : zero;
      __builtin_amdgcn_global_load_lds((const unsigned*)src, (LAS unsigned*)(lds + buf * MP_IMG + ten * 17408 + i * 1024), 16, 0, 0); } }
  if (wu == 3) { const unsigned char* src = lane < cd.nvalid ? (const unsigned char*)(PROJ + (size_t)(cd.row0 + lane) * PJR + PC_G16) : zero;
    __builtin_amdgcn_global_load_lds((const unsigned*)src, (LAS unsigned*)(lds + MP_G + buf * 1024), 16, 0, 0); }
}
__device__ __forceinline__ void mlstm_prep(LAS unsigned char* lds, const Params& p, int l, int slot, int buf, float bias_i, float bias_f, int tid) {
  asm volatile("" : "+v"(tid));
  PP_INIT();
  const ChunkDesc cd = chunk_of_slot(slot);
  bf16_t* SL = (bf16_t*)(p.ws + WS_MSLOT + (size_t)slot * MSLOT_B); float* SC = (float*)(p.ws + WS_MSLOT + (size_t)slot * MSLOT_B + MS_SC_B);
  const int lane = tid & 63, w = tid >> 6, c16 = lane & 15, q4 = lane >> 4;
  const int L_Q = buf * MP_IMG, L_K = L_Q + 17408, L_V = L_Q + 34816; constexpr int L_QK = MP_QK, L_SC = MP_SC;
  LAS float* sc = (LAS float*)(lds + L_SC);
  if (w == 0) {
    float ig = -INFINITY, fg = 0.f;
    if (lane < cd.nvalid) { const LAS bf16_t* gr = (const LAS bf16_t*)(lds + MP_G + buf * 1024 + lane * 16);
      ig = bf2f(gr[cd.h]) + bias_i; fg = logsigmoidf_(bf2f(gr[4 + cd.h]) + bias_f); }
    const float b = scan_add(fg, lane); const float g = ig - b; const float cm = scan_max(g, lane); const float gmax = __int_as_float(__builtin_amdgcn_readlane(__float_as_int(cm), 63)); const float blast = __int_as_float(__builtin_amdgcn_readlane(__float_as_int(b), 63));
    sc[lane] = b; sc[64 + lane] = g; sc[128 + lane] = b + cm; sc[192 + lane] = __expf(g - gmax);
    SC[MSC_B + lane] = b; SC[MSC_MLOC + lane] = b + cm;
    if (lane == 0) { SC[MSC_A] = blast + gmax; SC[MSC_BB] = blast; }
  }
  if (tid >= 64 && tid < 192) sc[256 + tid - 64] = 0.f;
  lds_barrier();
  PP_T(0, 8);
#pragma unroll
  for (int ti = 0; ti < 2; ++ti) { const int id = 2 * w + ti, tm = id >> 2, tn = id & 3; f32x4 acc = {0.f, 0.f, 0.f, 0.f};
#pragma unroll
    for (int kk = 0; kk < 4; ++kk) { const bf16x8 a = *(const LAS bf16x8*)(lds + L_Q + (16 * tm + c16) * 272 + (32 * kk + 8 * q4) * 2);
      const bf16x8 b = *(const LAS bf16x8*)(lds + L_K + (16 * tn + c16) * 272 + (32 * kk + 8 * q4) * 2);
      acc = __builtin_amdgcn_mfma_f32_16x16x32_bf16(a, b, acc, 0, 0, 0); }
    const int s = 16 * tn + c16; const float gs = sc[64 + s];
#pragma unroll
    for (int i = 0; i < 4; ++i) { const int t = 16 * tm + 4 * q4 + i; const float e = (s <= t) ? __expf(sc[t] + gs - sc[128 + t]) : 0.f;
      ((LAS float*)(lds + L_QK))[t * 68 + s] = (s <= t) ? acc[i] * e : 0.f; } }
  asm volatile("s_waitcnt vmcnt(0)" ::: "memory");
  lds_barrier();
  PP_T(0, 9);
  { const int row = tid >> 3, c8 = tid & 7; const LAS float* qr = (const LAS float*)(lds + L_QK) + row * 68 + c8 * 8; float v[8]; float rs = 0.f;
#pragma unroll
    for (int j = 0; j < 8; ++j) { v[j] = qr[j]; rs += v[j]; }
    u32x4 o; o.x = cvtpk(v[0], v[1]); o.y = cvtpk(v[2], v[3]); o.z = cvtpk(v[4], v[5]); o.w = cvtpk(v[6], v[7]);
    *(u32x4*)(SL + MS_QK + row * 64 + c8 * 8) = o; rs = sum8(rs); if (c8 == 0) SC[MSC_RS + row] = rs; }
#pragma unroll
  for (int k = 0; k < 2; ++k) { const int ci = tid + 512 * k, row = ci >> 4, c = ci & 15; const u32x4 qv = *(const LAS u32x4*)(lds + L_Q + row * 272 + c * 16); store_perm8(SL + MS_Q + row * 128, c * 8, qv); }
#pragma unroll
  for (int k = 0; k < 2; ++k) { const int id = tid + 512 * k, d = id & 127, s8 = id >> 7; float kv[8], vv[8]; float dsum = 0.f;
#pragma unroll
    for (int j = 0; j < 8; ++j) { const int s = 8 * s8 + j; kv[j] = bf2f(*(const LAS bf16_t*)(lds + L_K + s * 272 + d * 2)) * sc[192 + s]; vv[j] = bf2f(*(const LAS bf16_t*)(lds + L_V + s * 272 + d * 2)); }
    u32x4 o; o.x = cvtpk(kv[0], kv[1]); o.y = cvtpk(kv[2], kv[3]); o.z = cvtpk(kv[4], kv[5]); o.w = cvtpk(kv[6], kv[7]);
    dsum = bflo(o.x) + bfhi(o.x) + bflo(o.y) + bfhi(o.y) + bflo(o.z) + bfhi(o.z) + bflo(o.w) + bfhi(o.w);
    *(u32x4*)(SL + MS_KHT + d * 64 + 8 * s8) = o; atomicAdd((float*)(sc + 256 + d), dsum);
    u32x4 ov; ov.x = cvtpk(vv[0], vv[1]); ov.y = cvtpk(vv[2], vv[3]); ov.z = cvtpk(vv[4], vv[5]); ov.w = cvtpk(vv[6], vv[7]);
    *(u32x4*)(SL + MS_VT + d * 64 + 8 * s8) = ov; }
  lds_barrier();
  if (tid < 128) SC[MSC_DN + tid] = sc[256 + tid];
  PP_T(0, 10);
}

__device__ __forceinline__ void gdn_conv_taps(const Params& p, int l, const ChunkDesc& cd, int t, int col  , float (&x)[4][8]) {
  const bf16_t* PROJ = (const bf16_t*)(p.ws + WS_PROJ);
#pragma unroll
  for (int j = 0; j < 4; ++j) {
    const int T = cd.tok0 + t - 3 + j; int row = -1; const float* fsrc = nullptr;
    if (T >= 0) row = (cd.kind == 0 ? cd.b * SEQ : (cd.kind == 1 ? ROW_S + 16 * cd.b : ROW_M)) + T;
    else if (cd.kind == 0) row = ROW_M + 16 + T;
    else if (cd.kind == 1) fsrc = p.in[8] + (((size_t)l * DB + cd.b) * 3 + (3 + T)) * 1536 + col;
    if (row >= 0) { const u32x4 w = *(const u32x4*)((const bf16_t*)(p.ws + WS_PROJH) + (size_t)(12 + (col >> 7)) * PH_T + (size_t)row * 128 + (col & 127));
      x[j][0] = bflo(w.x); x[j][1] = bfhi(w.x); x[j][2] = bflo(w.y); x[j][3] = bfhi(w.y); x[j][4] = bflo(w.z); x[j][5] = bfhi(w.z); x[j][6] = bflo(w.w); x[j][7] = bfhi(w.w); }
    else if (fsrc) { const f32x4 a = *(const f32x4*)fsrc, b = *(const f32x4*)(fsrc + 4); x[j][0] = a.x; x[j][1] = a.y; x[j][2] = a.z; x[j][3] = a.w; x[j][4] = b.x; x[j][5] = b.y; x[j][6] = b.z; x[j][7] = b.w; }
    else {
#pragma unroll
      for (int e = 0; e < 8; ++e) x[j][e] = 0.f; }
  }
}

constexpr int GP_IMG_T = 67 * 272, GP_IMG = 54 * 1024;
__device__ __forceinline__ int gdn_queue_slot(int idx) {
  if (idx < 260) return idx;
  if (idx < 2052) { const int r = idx - 260; return 65 * (4 + (r >> 6)) + 1 + (r & 63); }
  if (idx < 2180) return 2080 + (idx - 2052);
  return NSLOT;
}
__device__ __forceinline__ bool gdn_slot_interior(int slot) { return slot < 32 * 65 && (slot % 65) >= 2; }
__device__ __forceinline__ void gdn_issue(LAS unsigned char* lds, const Params& p, int slot, int tid) {
  const ChunkDesc cd = chunk_of_slot(slot);
  const unsigned char* zero = p.ws + WS_ZERO;
  const unsigned char* src0 = (const unsigned char*)((const bf16_t*)(p.ws + WS_PROJH) + (size_t)(12 + cd.h) * PH_T + (size_t)(cd.b * SEQ + cd.tok0 - 3) * 128);
  const int wu = __builtin_amdgcn_readfirstlane(tid >> 6), lane = tid & 63;
#pragma unroll
  for (int it = 0; it < 7; ++it) { const int k = wu + 8 * it;
    if (k < 54) { const int o = k * 1024 + lane * 16, ten = o / GP_IMG_T, rem = o - ten * GP_IMG_T, row = rem / 272, col = rem - row * 272;
      const unsigned char* src = (ten < 3 && col < 256) ? src0 + (size_t)ten * (4 * PH_T * 2) + row * 256 + col : zero;
      __builtin_amdgcn_global_load_lds((const unsigned*)src, (LAS unsigned*)(lds + k * 1024), 16, 0, 0); } }
}
__device__ __forceinline__ void gdn_prep(LAS unsigned char* lds, const Params& p, int l, int slot, bool have_img, int next_slot, int tid) {
  asm volatile("" : "+v"(tid));
  PP_INIT();
  const ChunkDesc cd = chunk_of_slot(slot);
  const bf16_t* PROJ = (const bf16_t*)(p.ws + WS_PROJ);
  bf16_t* SL = (bf16_t*)(p.ws + WS_GSLOT + (size_t)slot * GSLOT_B); float* SC = (float*)(p.ws + WS_GSLOT + (size_t)slot * GSLOT_B + GS_SC_B);
  const int lane = tid & 63, w = tid >> 6, c16 = lane & 15, q4 = lane >> 4;
  constexpr int RT_P = 528; constexpr int L_Q = 0, L_K = 17408, L_QK = 34816, L_RT = 55296  , L_AM = 89088, L_T = 106496, L_TB = 123904, L_CW = 133120, L_SC = 139264, L_M = 139776;
  LAS float* sc = (LAS float*)(lds + L_SC);
  LAS float* AM = (LAS float*)(lds + L_AM); LAS float* QKf = (LAS float*)(lds + L_QK); LAS float* T = (LAS float*)(lds + L_T);
  LAS float* CW = (LAS float*)(lds + L_CW); LAS float* MB = (LAS float*)(lds + L_M);
  const int t = tid >> 3, part = tid & 7;
  u32x4 xin[3][2][4];
  if (cd.kind == 0 && cd.tok0 > 0) {
    if (!have_img) { gdn_issue(lds, p, slot, tid); asm volatile("s_waitcnt vmcnt(0)" ::: "memory"); }
    lds_barrier();
    const LAS unsigned char* ib = lds + t * 272 + part * 32;
#pragma unroll
    for (int j = 0; j < 4; ++j)
#pragma unroll
      for (int ten = 0; ten < 3; ++ten)
#pragma unroll
        for (int hh = 0; hh < 2; ++hh) xin[ten][hh][j] = *(const LAS u32x4*)(ib + ten * GP_IMG_T + j * 272 + 16 * hh);
  } else {
#pragma unroll
    for (int j = 0; j < 4; ++j) {
      const int Tt = cd.tok0 + t - 3 + j; int row = -1; const float* fsrc = nullptr;
      if (Tt >= 0) row = (cd.kind == 0 ? cd.b * SEQ : (cd.kind == 1 ? ROW_S + 16 * cd.b : ROW_M)) + Tt;
      else if (cd.kind == 0) row = ROW_M + 16 + Tt;
      else if (cd.kind == 1) fsrc = p.in[8] + (((size_t)l * DB + cd.b) * 3 + (3 + Tt)) * 1536;
#pragma unroll
      for (int ten = 0; ten < 3; ++ten)
#pragma unroll
        for (int hh = 0; hh < 2; ++hh) { const int col = ten * 512 + cd.h * 128 + 16 * part + 8 * hh; u32x4 v = {0u, 0u, 0u, 0u};
          if (row >= 0) v = *(const u32x4*)((const bf16_t*)(p.ws + WS_PROJH) + (size_t)(12 + (col >> 7)) * PH_T + (size_t)row * 128 + (col & 127));
          else if (fsrc) { const f32x4 a = *(const f32x4*)(fsrc + col), b = *(const f32x4*)(fsrc + col + 4); v.x = cvtpk(a.x, a.y); v.y = cvtpk(a.z, a.w); v.z = cvtpk(b.x, b.y); v.w = cvtpk(b.z, b.w); }
          xin[ten][hh][j] = v; }
    }
  }
  if (w == 0) {
    float ld = 0.f, be = 0.f;
    if (lane < cd.nvalid) { const bf16_t* pr = PROJ + (size_t)(cd.row0 + lane) * PJR + PC_G16;
      ld = -__expf(p.in[20][l * 4 + cd.h]) * softplusf_(bf2f(pr[8 + cd.h]) + p.in[21][l * 4 + cd.h]); be = sigmoidf_(bf2f(pr[12 + cd.h])); }
    const float G = scan_add(ld, lane); sc[lane] = G; sc[64 + lane] = be;
    if (lane == 63) SC[0] = __expf(G);
  } else if (tid < 64 + 384) { const int i = tid - 64, ten = i >> 7, j = (i >> 5) & 3, c4 = i & 31;
    *(LAS f32x4*)(CW + (ten * 4 + j) * 128 + 4 * c4) = *(const f32x4*)(p.in[19] + ((size_t)l * 4 + j) * 1536 + ten * 512 + cd.h * 128 + 4 * c4); }
  lds_barrier();
  PP_T(1, 0);
  { const float G = sc[t], be = sc[64 + t], eG = __expf(G);
#pragma unroll
    for (int ten = 0; ten < 3; ++ten) {
      float y[16];
#pragma unroll
      for (int hh = 0; hh < 2; ++hh) {
        float a[8];
#pragma unroll
        for (int e = 0; e < 8; ++e) a[e] = 0.f;
#pragma unroll
        for (int j = 0; j < 4; ++j) { const u32x4 v = xin[ten][hh][j]; const LAS float* cw = CW + (ten * 4 + j) * 128 + 16 * part + 8 * hh; const f32x4 w0 = *(const LAS f32x4*)cw, w1 = *(const LAS f32x4*)(cw + 4);
          a[0] += bflo(v.x) * w0.x; a[1] += bfhi(v.x) * w0.y; a[2] += bflo(v.y) * w0.z; a[3] += bfhi(v.y) * w0.w; a[4] += bflo(v.z) * w1.x; a[5] += bfhi(v.z) * w1.y; a[6] += bflo(v.w) * w1.z; a[7] += bfhi(v.w) * w1.w; }
#pragma unroll
        for (int e = 0; e < 8; ++e) y[8 * hh + e] = siluf_(a[e]); }
      if (ten < 2) { float ss = 0.f;
#pragma unroll
        for (int e = 0; e < 16; ++e) ss += y[e] * y[e];
        ss = sum8(ss); const float rn = rsqrtf(ss + EPS) * (ten == 0 ? 0.08838834764831845f : 1.f);
#pragma unroll
        for (int e = 0; e < 16; ++e) y[e] *= rn; }
      if (t >= cd.nvalid) {
#pragma unroll
        for (int e = 0; e < 16; ++e) y[e] = 0.f; }
      if (ten < 2) { u32x4 o0, o1; o0.x = cvtpk(y[0], y[1]); o0.y = cvtpk(y[2], y[3]); o0.z = cvtpk(y[4], y[5]); o0.w = cvtpk(y[6], y[7]);
        o1.x = cvtpk(y[8], y[9]); o1.y = cvtpk(y[10], y[11]); o1.z = cvtpk(y[12], y[13]); o1.w = cvtpk(y[14], y[15]);
        LAS unsigned char* dst = lds + (ten == 0 ? L_Q : L_K) + t * 272 + part * 32; *(LAS u32x4*)dst = o0; *(LAS u32x4*)(dst + 16) = o1; }
      if (ten >= 1) { const float scl = ten == 1 ? be * eG : be; const int cb = ten == 1 ? 128 : 0;
        u32x4 o0, o1; o0.x = cvtpk(scl * y[0], scl * y[1]); o0.y = cvtpk(scl * y[2], scl * y[3]); o0.z = cvtpk(scl * y[4], scl * y[5]); o0.w = cvtpk(scl * y[6], scl * y[7]);
        o1.x = cvtpk(scl * y[8], scl * y[9]); o1.y = cvtpk(scl * y[10], scl * y[11]); o1.z = cvtpk(scl * y[12], scl * y[13]); o1.w = cvtpk(scl * y[14], scl * y[15]);
        LAS unsigned char* dst = lds + L_RT + t * RT_P + (cb + 16 * part) * 2; *(LAS u32x4*)dst = o0; *(LAS u32x4*)(dst + 16) = o1; }
    } }
  lds_barrier();
  PP_T(1, 1);
#pragma unroll
  for (int ti = 0; ti < 4; ++ti) { const int id = 4 * w + ti, isq = id >> 4, tm = (id >> 2) & 3, tn = id & 3; f32x4 acc = {0.f, 0.f, 0.f, 0.f};
#pragma unroll
    for (int kk = 0; kk < 4; ++kk) { const bf16x8 a = *(const LAS bf16x8*)(lds + (isq ? L_Q : L_K) + (16 * tm + c16) * 272 + (32 * kk + 8 * q4) * 2);
      const bf16x8 b = *(const LAS bf16x8*)(lds + L_K + (16 * tn + c16) * 272 + (32 * kk + 8 * q4) * 2);
      acc = __builtin_amdgcn_mfma_f32_16x16x32_bf16(a, b, acc, 0, 0, 0); }
    const int s = 16 * tn + c16; const float Gs = sc[s];
#pragma unroll
    for (int i = 0; i < 4; ++i) { const int tt = 16 * tm + 4 * q4 + i; const float e = __expf(sc[tt] - Gs);
      if (isq) QKf[tt * 68 + s] = (s <= tt) ? acc[i] * e : 0.f; else AM[tt * 68 + s] = (s < tt) ? sc[64 + tt] * acc[i] * e : 0.f; } }
  lds_barrier();
  PP_T(1, 2);
  if (tid < 64) { const int bi = tid >> 4, cc = tid & 15; float x[16];
#pragma unroll
    for (int r = 0; r < 16; ++r) { float a = (r == cc) ? 1.f : 0.f;
#pragma unroll
      for (int s = 0; s < r; ++s) a -= AM[(16 * bi + r) * 68 + 16 * bi + s] * x[s];
      x[r] = a; T[(16 * bi + r) * 68 + 16 * bi + cc] = a; }
  } else {
    const int u = tid - 64; const float Glast = sc[63];
    for (int ci = u; ci < 1024; ci += 448) { const int row = ci >> 4, cq = ci & 15; const u32x4 v = *(const LAS u32x4*)(lds + L_Q + row * 272 + cq * 16); const float e = __expf(sc[row]);
      u32x4 o; o.x = cvtpk(bflo(v.x) * e, bfhi(v.x) * e); o.y = cvtpk(bflo(v.y) * e, bfhi(v.y) * e); o.z = cvtpk(bflo(v.z) * e, bfhi(v.z) * e); o.w = cvtpk(bflo(v.w) * e, bfhi(v.w) * e);
      store_perm8(SL + GS_QT + row * 128, cq * 8, o); }
    for (int id = u; id < 1024; id += 448) { const int d = id & 127, s8 = id >> 7; float kv[8];
#pragma unroll
      for (int j = 0; j < 8; ++j) { const int s = 8 * s8 + j; kv[j] = bf2f(*(const LAS bf16_t*)(lds + L_K + s * 272 + d * 2)) * __expf(Glast - sc[s]); }
      u32x4 o; o.x = cvtpk(kv[0], kv[1]); o.y = cvtpk(kv[2], kv[3]); o.z = cvtpk(kv[4], kv[5]); o.w = cvtpk(kv[6], kv[7]);
      store_perm8(SL + GS_KTT + d * 64, 8 * s8, o); }
    for (int ci = u; ci < 512; ci += 448) { const int row = ci >> 3, c8 = ci & 7; const LAS float* qr = QKf + row * 68 + c8 * 8;
      u32x4 o; o.x = cvtpk(qr[0], qr[1]); o.y = cvtpk(qr[2], qr[3]); o.z = cvtpk(qr[4], qr[5]); o.w = cvtpk(qr[6], qr[7]);
      store_perm8(SL + GS_QK + row * 64, c8 * 8, o); }
    for (int e = u; e < 6 * 256; e += 448) { const int bp = e >> 8, r = (e >> 4) & 15, cc = e & 15;
      const int bi = bp < 3 ? 0 : (bp < 5 ? 1 : 2), bj = bp < 3 ? bp + 1 : (bp < 5 ? bp - 1 : 3); T[(16 * bi + r) * 68 + 16 * bj + cc] = 0.f; }
  }
  lds_barrier();
  if (next_slot < NSLOT && gdn_slot_interior(next_slot)) gdn_issue(lds, p, next_slot, tid);
  PP_T(1, 3);
  { auto split4 = [](const f32x4& x, v4i16_t& hi, v4i16_t& lo) {
#pragma unroll
      for (int i = 0; i < 4; ++i) { const bf16_t h = f2bf(x[i]); hi[i] = (short)h; lo[i] = (short)f2bf(x[i] - bf2f(h)); } };
#pragma unroll
    for (int bi = 1; bi < 4; ++bi) {
      if (w < bi) { const int bj = w; f32x4 m = {0.f, 0.f, 0.f, 0.f};
        for (int kb = bj; kb < bi; ++kb) {
          const f32x4 av = *(const LAS f32x4*)(AM + (16 * bi + c16) * 68 + 16 * kb + 4 * q4);
          f32x4 tv;
#pragma unroll
          for (int i = 0; i < 4; ++i) tv[i] = T[(16 * kb + 4 * q4 + i) * 68 + 16 * bj + c16];
          v4i16_t ah, al, th, tl; split4(av, ah, al); split4(tv, th, tl);
          m = __builtin_amdgcn_mfma_f32_16x16x16bf16_1k(ah, th, m, 0, 0, 0); m = __builtin_amdgcn_mfma_f32_16x16x16bf16_1k(ah, tl, m, 0, 0, 0); m = __builtin_amdgcn_mfma_f32_16x16x16bf16_1k(al, th, m, 0, 0, 0); }
        const f32x4 dv = *(const LAS f32x4*)(T + (16 * bi + c16) * 68 + 16 * bi + 4 * q4);
        v4i16_t dh, dl, mh, ml; split4(dv, dh, dl); split4(m, mh, ml);
        f32x4 r = {0.f, 0.f, 0.f, 0.f};
        r = __builtin_amdgcn_mfma_f32_16x16x16bf16_1k(dh, mh, r, 0, 0, 0); r = __builtin_amdgcn_mfma_f32_16x16x16bf16_1k(dh, ml, r, 0, 0, 0); r = __builtin_amdgcn_mfma_f32_16x16x16bf16_1k(dl, mh, r, 0, 0, 0);
#pragma unroll
        for (int i = 0; i < 4; ++i) T[(16 * bi + 4 * q4 + i) * 68 + 16 * bj + c16] = -r[i]; }
      lds_barrier();
    } }
  { const int row = tid >> 3, c8 = tid & 7; const LAS float* tr = T + row * 68 + c8 * 8;
    u32x4 o; o.x = cvtpk(tr[0], tr[1]); o.y = cvtpk(tr[2], tr[3]); o.z = cvtpk(tr[4], tr[5]); o.w = cvtpk(tr[6], tr[7]);
    *(LAS u32x4*)(lds + L_TB + row * 144 + c8 * 16) = o; }
  asm volatile("s_waitcnt vmcnt(0)" ::: "memory");
  lds_barrier();
  PP_T(1, 4);
  { const int l16 = lane & 15; const int troff = (8 * q4 + (l16 >> 2)) * RT_P + (4 * (l16 & 3)) * 2;
#pragma unroll
  for (int ti = 0; ti < 8; ++ti) { const int id = 8 * w + ti; f32x4 acc = {0.f, 0.f, 0.f, 0.f};
    if (id < 32) { const int mt = id >> 3, nt = id & 7;
#pragma unroll
      for (int ks = 0; ks < 2; ++ks) { const bf16x8 a = *(const LAS bf16x8*)(lds + L_TB + (16 * mt + c16) * 144 + (32 * ks + 8 * q4) * 2);
        const v4i16_t b0 = __builtin_amdgcn_ds_read_tr16_b64_v4i16((LAS v4i16_t*)(lds + L_RT + troff + (32 * ks) * RT_P + (16 * nt) * 2));
        const v4i16_t b1 = __builtin_amdgcn_ds_read_tr16_b64_v4i16((LAS v4i16_t*)(lds + L_RT + troff + (32 * ks + 4) * RT_P + (16 * nt) * 2));
        const bf16x8 b = {b0[0], b0[1], b0[2], b0[3], b1[0], b1[1], b1[2], b1[3]};
        acc = __builtin_amdgcn_mfma_f32_16x16x32_bf16(a, b, acc, 0, 0, 0); }
      u32x2 o; o.x = cvtpk(acc[0], acc[1]); o.y = cvtpk(acc[2], acc[3]);
      *(u32x2*)(SL + GS_UT + (16 * nt + c16) * 64 + 16 * mt + 4 * q4) = o;
    } else { const int mt = (id - 32) >> 2, nt = (id - 32) & 3;
#pragma unroll
      for (int ks = 0; ks < 2; ++ks) {
        const v4i16_t a0 = __builtin_amdgcn_ds_read_tr16_b64_v4i16((LAS v4i16_t*)(lds + L_RT + troff + (32 * ks) * RT_P + (128 + 16 * mt) * 2));
        const v4i16_t a1 = __builtin_amdgcn_ds_read_tr16_b64_v4i16((LAS v4i16_t*)(lds + L_RT + troff + (32 * ks + 4) * RT_P + (128 + 16 * mt) * 2));
        const bf16x8 a = {a0[0], a0[1], a0[2], a0[3], a1[0], a1[1], a1[2], a1[3]};
        const bf16x8 b = *(const LAS bf16x8*)(lds + L_TB + (16 * nt + c16) * 144 + (32 * ks + 8 * q4) * 2);
        acc = __builtin_amdgcn_mfma_f32_16x16x32_bf16(a, b, acc, 0, 0, 0); }
      u32x2 o; o.x = cvtpk(-acc[0], -acc[1]); o.y = cvtpk(-acc[2], -acc[3]);
      *(u32x2*)(SL + GS_NW + (16 * nt + c16) * 128 + 32 * (mt >> 1) + 8 * q4 + 4 * (mt & 1)) = o;
    } } }
  lds_barrier();
  PP_T(1, 5);
}

constexpr int SC_STAGE = 62464, SC_MISC = 2 * SC_STAGE;
__device__ __forceinline__ bf16x8 pack_acc2(const f32x4& a, const f32x4& b) { u32x4 o; o.x = cvtpk(a[0], a[1]); o.y = cvtpk(a[2], a[3]); o.z = cvtpk(b[0], b[1]); o.w = cvtpk(b[2], b[3]); return __builtin_bit_cast(bf16x8, o); }
__device__ __forceinline__ bf16x8 lda_perm(const LAS unsigned char* base) { return *(const LAS bf16x8*)base; }

template <bool GDN>
__device__ __forceinline__ void scan_chain(LAS unsigned char* lds, const Params& p, int l, int chain  , int tid) {
  asm volatile("" : "+v"(tid));
  const int lane = tid & 63, w = tid >> 6, c16 = lane & 15, q4 = lane >> 4;
  const bool samp = chain >= 32; const int ch = samp ? chain - 32 : chain; const int b = ch >> 2, h = ch & 3;
  const int slot0 = samp ? 32 * 65 + ch : ch * 65, nch = samp ? 1 : 65;
  const unsigned char* slots = p.ws + (GDN ? WS_GSLOT : WS_MSLOT); constexpr int SLOT_B = GDN ? GSLOT_B : MSLOT_B;
  constexpr int NLD = GDN ? 7 : 5;
  bf16_t* OUT = (bf16_t*)(p.ws + (GDN ? WS_OG : WS_HM));
  LAS float* nvec = (LAS float*)(lds + SC_MISC); LAS float* c1 = nvec + 128; LAS float* c2 = nvec + 192;
  f32x4 S[8]; float mrun = 0.f;
  const int vcol = 16 * w + c16;
  if (!samp) {
#pragma unroll
    for (int i = 0; i < 8; ++i) S[i] = (f32x4){0.f, 0.f, 0.f, 0.f};
    if (!GDN && tid < 128) nvec[tid] = 0.f;
  } else if (GDN) {
    const float* S0 = p.in[7] + (((size_t)l * DB + b) * 4 + h) * 128 * 128;
#pragma unroll
    for (int i = 0; i < 8; ++i)
#pragma unroll
      for (int r = 0; r < 4; ++r) S[i][r] = S0[(size_t)(16 * i + 4 * q4 + r) * 128 + vcol];
  } else {
    const float* C0 = p.in[4] + (((size_t)l * DB + b) * 4 + h) * 128 * 128;
#pragma unroll
    for (int i = 0; i < 8; ++i) S[i] = *(const f32x4*)(C0 + (size_t)vcol * 128 + 16 * i + 4 * q4);
    if (tid < 128) nvec[tid] = p.in[5][(((size_t)l * DB + b) * 4 + h) * 128 + tid];
    mrun = p.in[6][((size_t)l * DB + b) * 4 + h];
  }
  auto lds_dst = [](int ci) -> int {
    if (GDN) { if (ci < 1024) return (ci >> 4) * 272 + (ci & 15) * 16; if (ci < 2048) { ci -= 1024; return 17408 + (ci >> 4) * 272 + (ci & 15) * 16; }
      if (ci < 2560) { ci -= 2048; return 34816 + (ci >> 3) * 144 + (ci & 7) * 16; } ci -= 2560; return 44032 + (ci >> 3) * 144 + (ci & 7) * 16; }
    else { if (ci < 1024) return (ci >> 4) * 272 + (ci & 15) * 16; if (ci < 1536) { ci -= 1024; return 17408 + (ci >> 3) * 144 + (ci & 7) * 16; }
      ci -= 1536; return 26624 + (ci >> 3) * 144 + (ci & 7) * 16; } };
  constexpr int L_A0 = 0;
  constexpr int L_QT = 17408;
  constexpr int L_QK = GDN ? 34816 : 17408;
  constexpr int L_KT = GDN ? 44032 : 26624;
  constexpr int L_SCAL = 45056;
  u32x4 stA[NLD], stB[NLD]; u32x4 scA = {0u, 0u, 0u, 0u}; u32x2 utA[4], utB[4]; float glA = 1.f, glB = 1.f; bf16x8 bvA[2];
  u32x2 utc[4]; float glc = 1.f; bf16x8 bvc[2];
#define SC_LOAD(ST, UT, GL, CH) do { const unsigned char* s_ = slots + (size_t)((!samp && (CH) == 0) ? h * 65 : slot0 + (CH)) * SLOT_B;     const u32x4* g_ = (const u32x4*)s_; const bf16_t* sb_ = (const bf16_t*)s_; \
    _Pragma("unroll") for (int k = 0; k < NLD; ++k) ST[k] = g_[tid + 512 * k]; \
    if (GDN) { _Pragma("unroll") for (int mt = 0; mt < 4; ++mt) UT[mt] = *(const u32x2*)(sb_ + GS_UT + vcol * 64 + 16 * mt + 4 * q4); GL = ((const float*)(s_ + GS_SC_B))[0]; } \
    else { if (tid < 84) scA = g_[3584 + tid]; _Pragma("unroll") for (int ks = 0; ks < 2; ++ks) bvA[ks] = *(const bf16x8*)(sb_ + MS_VT + vcol * 64 + 32 * ks + 8 * q4); } } while (0)
#define SC_STORE(ST, UT, GL, STG) do { LAS unsigned char* nb_ = lds + (STG) * SC_STAGE; \
    _Pragma("unroll") for (int k = 0; k < NLD; ++k) *(LAS u32x4*)(nb_ + lds_dst(tid + 512 * k)) = ST[k]; \
    if (GDN) { _Pragma("unroll") for (int mt = 0; mt < 4; ++mt) utc[mt] = UT[mt]; glc = GL; } \
    else { if (tid < 84) *(LAS u32x4*)(nb_ + L_SCAL + tid * 16) = scA; bvc[0] = bvA[0]; bvc[1] = bvA[1]; } } while (0)
#if PROBE_LEVEL == 2
#define SS_T(i) do { if (GDN) { const unsigned long long t_ = __builtin_amdgcn_s_memrealtime(); sacc_[(i)] += t_ - tl_; tl_ = t_; } } while (0)
  unsigned long long tl_ = __builtin_amdgcn_s_memrealtime(); unsigned long long sacc_[4] = {0ull, 0ull, 0ull, 0ull};
#else
#define SS_T(i) do {} while (0)
#endif
  f32x4 o[4];
  auto step = [&](const int c) {
    LAS unsigned char* cur = lds + (c & 1) * SC_STAGE;
    SS_T(3);
    bf16x8 Sb[4];
#pragma unroll
    for (int kk = 0; kk < 4; ++kk) Sb[kk] = pack_acc2(S[2 * kk], S[2 * kk + 1]);
    if (GDN) {
      f32x4 dl[4];
#pragma unroll
      for (int mt = 0; mt < 4; ++mt) { const u32x2 u = utc[mt]; dl[mt] = (f32x4){bflo(u.x), bfhi(u.x), bflo(u.y), bfhi(u.y)}; o[mt] = (f32x4){0.f, 0.f, 0.f, 0.f}; }
#pragma unroll
      for (int mt = 0; mt < 4; ++mt)
#pragma unroll
        for (int kk = 0; kk < 4; ++kk) {
          const bf16x8 aw = lda_perm(cur + L_A0 + (16 * mt + c16) * 272 + (32 * kk + 8 * q4) * 2);
          const bf16x8 aq = lda_perm(cur + L_QT + (16 * mt + c16) * 272 + (32 * kk + 8 * q4) * 2);
          dl[mt] = __builtin_amdgcn_mfma_f32_16x16x32_bf16(aw, Sb[kk], dl[mt], 0, 0, 0);
          o[mt] = __builtin_amdgcn_mfma_f32_16x16x32_bf16(aq, Sb[kk], o[mt], 0, 0, 0); }
      bf16x8 Db[2];
#pragma unroll
      for (int ks = 0; ks < 2; ++ks) Db[ks] = pack_acc2(dl[2 * ks], dl[2 * ks + 1]);
      asm volatile("" :: "v"(Db[0]), "v"(Db[1])); SS_T(0);
#pragma unroll
      for (int mt = 0; mt < 4; ++mt)
#pragma unroll
        for (int ks = 0; ks < 2; ++ks) { const bf16x8 a = lda_perm(cur + L_QK + (16 * mt + c16) * 144 + (32 * ks + 8 * q4) * 2);
          o[mt] = __builtin_amdgcn_mfma_f32_16x16x32_bf16(a, Db[ks], o[mt], 0, 0, 0); }
      const float gl = glc;
#pragma unroll
      for (int i = 0; i < 8; ++i) { S[i] *= gl;
#pragma unroll
        for (int ks = 0; ks < 2; ++ks) { const bf16x8 a = lda_perm(cur + L_KT + (16 * i + c16) * 144 + (32 * ks + 8 * q4) * 2);
          S[i] = __builtin_amdgcn_mfma_f32_16x16x32_bf16(a, Db[ks], S[i], 0, 0, 0); } }
    } else {
      const LAS float* scal = (const LAS float*)(cur + L_SCAL);
      bf16x8 bv[2];
#pragma unroll
      for (int ks = 0; ks < 2; ++ks) bv[ks] = bvc[ks];
      { const int t = tid >> 3, part = tid & 7; const LAS unsigned char* qr = cur + L_A0 + t * 272 + part * 32; float a = 0.f;
        const u32x4 q0 = *(const LAS u32x4*)qr, q1 = *(const LAS u32x4*)(qr + 16);
        const LAS float* n0 = nvec + 32 * (part >> 1) + 8 * (part & 1); const LAS float* n1 = n0 + 16;
        a += bflo(q0.x) * n0[0] + bfhi(q0.x) * n0[1] + bflo(q0.y) * n0[2] + bfhi(q0.y) * n0[3] + bflo(q0.z) * n1[0] + bfhi(q0.z) * n1[1] + bflo(q0.w) * n1[2] + bfhi(q0.w) * n1[3];
        a += bflo(q1.x) * n0[4] + bfhi(q1.x) * n0[5] + bflo(q1.y) * n0[6] + bfhi(q1.y) * n0[7] + bflo(q1.z) * n1[4] + bfhi(q1.z) * n1[5] + bflo(q1.w) * n1[6] + bfhi(q1.w) * n1[7];
        a = sum8(a);
        if (part == 0) { const float inter = scal[MSC_B + t] + mrun, ml = scal[MSC_MLOC + t]; const float mt_ = fmaxf(inter, ml);
          const float w1 = __expf(inter - mt_), w2 = __expf(ml - mt_); const float den = w1 * a + w2 * scal[MSC_RS + t];
          const float sc_ = 1.f / fmaxf(fabsf(den), __expf(-mt_)); c1[t] = w1 * sc_; c2[t] = w2 * sc_; } }
      f32x4 a1[4], a2[4];
#pragma unroll
      for (int mt = 0; mt < 4; ++mt) { a1[mt] = (f32x4){0.f, 0.f, 0.f, 0.f}; a2[mt] = (f32x4){0.f, 0.f, 0.f, 0.f};
#pragma unroll
        for (int kk = 0; kk < 4; ++kk) { const bf16x8 aq = lda_perm(cur + L_A0 + (16 * mt + c16) * 272 + (32 * kk + 8 * q4) * 2);
          a1[mt] = __builtin_amdgcn_mfma_f32_16x16x32_bf16(aq, Sb[kk], a1[mt], 0, 0, 0); }
#pragma unroll
        for (int ks = 0; ks < 2; ++ks) { const bf16x8 a = *(const LAS bf16x8*)(cur + L_QK + (16 * mt + c16) * 144 + (32 * ks + 8 * q4) * 2);
          a2[mt] = __builtin_amdgcn_mfma_f32_16x16x32_bf16(a, bv[ks], a2[mt], 0, 0, 0); } }
      lds_barrier();
#pragma unroll
      for (int mt = 0; mt < 4; ++mt)
#pragma unroll
        for (int r = 0; r < 4; ++r) { const int t = 16 * mt + 4 * q4 + r; o[mt][r] = c1[t] * a1[mt][r] + c2[t] * a2[mt][r]; }
      const float A = scal[MSC_A], B = scal[MSC_BB]; const float mnew = fmaxf(B + mrun, A); const float alpha = __expf(B + mrun - mnew), beta = __expf(A - mnew);
#pragma unroll
      for (int i = 0; i < 8; ++i) { f32x4 X = {0.f, 0.f, 0.f, 0.f};
#pragma unroll
        for (int ks = 0; ks < 2; ++ks) { const bf16x8 a = *(const LAS bf16x8*)(cur + L_KT + (16 * i + c16) * 144 + (32 * ks + 8 * q4) * 2);
          X = __builtin_amdgcn_mfma_f32_16x16x32_bf16(a, bv[ks], X, 0, 0, 0); }
        S[i] = S[i] * alpha + X * beta; }
      if (tid < 128) nvec[tid] = alpha * nvec[tid] + beta * scal[MSC_DN + tid];
      mrun = mnew;
    }
    asm volatile("" :: "v"(S[0]), "v"(S[7])); SS_T(1);
  };
  auto emit = [&](const int c) {
    const int nvalid = samp ? 16 : (c == 0 ? 16 : 64);
    const int row0 = samp ? ROW_S + 16 * b : (c == 0 ? ROW_M : b * SEQ + 64 * (c - 1));
    { bf16_t* op = OUT + (size_t)(row0 + 4 * q4) * 512 + h * 128 + vcol;
#pragma unroll
      for (int mt = 0; mt < 4; ++mt) if (16 * mt < nvalid) {
#pragma unroll
        for (int r = 0; r < 4; ++r) op[(16 * mt + r) * 512] = f2bf(o[mt][r]); } }
    SS_T(2);
  };
  if (GDN) {
    SC_LOAD(stB, utB, glB, 0); SC_STORE(stB, utB, glB, 0);
    if (nch > 1) SC_LOAD(stA, utA, glA, 1);
    lds_barrier();
    for (int c = 0; c < nch; c += 2) {
      if (c + 2 < nch) SC_LOAD(stB, utB, glB, c + 2);
      step(c);
      if (c + 1 < nch) SC_STORE(stA, utA, glA, 1);
      emit(c);
      lds_barrier();
      if (c + 1 >= nch) break;
      if (c + 3 < nch) SC_LOAD(stA, utA, glA, c + 3);
      step(c + 1);
      if (c + 2 < nch) SC_STORE(stB, utB, glB, 0);
      emit(c + 1);
      lds_barrier();
    }
  } else {
    SC_LOAD(stA, utA, glA, 0); SC_STORE(stA, utA, glA, 0);
    lds_barrier();
    for (int c = 0; c < nch; ++c) {
      if (c + 1 < nch) SC_LOAD(stA, utA, glA, c + 1);
      step(c);
      if (c + 1 < nch) SC_STORE(stA, utA, glA, (c + 1) & 1);
      emit(c);
      lds_barrier();
    }
  }
#undef SC_LOAD
#undef SC_STORE
#if PROBE_LEVEL == 2
  if (GDN && tid == 0 && blockIdx.x == 32 && !samp) { for (int i = 0; i < 4; ++i) ((unsigned long long*)(p.ws + WS_CTL + 2048))[i] += sacc_[i]; }
#endif
  if (GDN) { float* So = p.out + (samp ? O_SS + (((size_t)l * DB + b) * 4 + h) * 16384 : O_PS + (((size_t)l * NB + b) * 4 + h) * 16384);
#pragma unroll
    for (int i = 0; i < 8; ++i)
#pragma unroll
      for (int r = 0; r < 4; ++r) So[(size_t)(16 * i + 4 * q4 + r) * 128 + vcol] = S[i][r];
  } else { float* Co = p.out + (samp ? O_SC + (((size_t)l * DB + b) * 4 + h) * 16384 : O_PC + (((size_t)l * NB + b) * 4 + h) * 16384);
#pragma unroll
    for (int i = 0; i < 8; ++i) *(f32x4*)(Co + (size_t)vcol * 128 + 16 * i + 4 * q4) = S[i];
    if (tid < 128) (p.out + (samp ? O_SN + (((size_t)l * DB + b) * 4 + h) * 128 : O_PN + (((size_t)l * NB + b) * 4 + h) * 128))[tid] = nvec[tid];
    if (tid == 0) (p.out + (samp ? O_SM + ((size_t)l * DB + b) * 4 + h : O_PM + ((size_t)l * NB + b) * 4 + h))[0] = mrun;
  }
  __syncthreads();
}


constexpr int SA_KP = 592;
constexpr int SA_KT = 64 * SA_KP;
constexpr int SA_QOFF = SA_KT;
constexpr int SA_NG = 2;
constexpr int SA_PART = 128 * 264;
constexpr size_t WS_SAPART = WS_END1;
constexpr size_t WS_TPART = al256(WS_SAPART + (size_t)DB * SA_NG * SA_PART * 4);
constexpr size_t WS_X1B = al256(WS_TPART + (size_t)3 * 768 * 1024 * 4);
constexpr size_t WS_END2 = al256(WS_X1B + (size_t)NP * D * 2);

__device__ __forceinline__ void sattn_unit(LAS unsigned char* lds, const Params& p, int l, int b, int g, int tid) {
  asm volatile("" : "+v"(tid));
  const int lane = tid & 63, w = tid >> 6, c16 = lane & 15, q4 = lane >> 4;
  const bf16_t* QS = (const bf16_t*)(p.ws + WS_QS) + (size_t)b * 16 * 768;
  { const int h = w; const bf16_t* WK = (const bf16_t*)(p.ws + WS_WUKR) + (size_t)l * 256 * 512 + h * 64;
    bf16x8 a[2];
#pragma unroll
    for (int ks = 0; ks < 2; ++ks) a[ks] = *(const bf16x8*)(QS + (size_t)c16 * 768 + h * 96 + 32 * ks + 8 * q4);
#pragma unroll
    for (int nt = 0; nt < 16; ++nt) { f32x4 acc = {0.f, 0.f, 0.f, 0.f};
#pragma unroll
      for (int ks = 0; ks < 2; ++ks) { const bf16x8 bb = *(const bf16x8*)(WK + (size_t)(16 * nt + c16) * 512 + 32 * ks + 8 * q4);
        acc = __builtin_amdgcn_mfma_f32_16x16x32_bf16(a[ks], bb, acc, 0, 0, 0); }
#pragma unroll
      for (int r = 0; r < 4; ++r) { const int t = 4 * q4 + r; *(LAS bf16_t*)(lds + SA_QOFF + (t * 8 + h) * SA_KP + (16 * nt + c16) * 2) = f2bf(acc[r]); } }
    { const int row = tid >> 2, part = tid & 3, t = row >> 3, hh = row & 7;
      *(LAS u32x4*)(lds + SA_QOFF + row * SA_KP + 512 + part * 16) = *(const u32x4*)(QS + (size_t)t * 768 + hh * 96 + 64 + part * 8); } }
  const LAS unsigned char* qrow = lds + SA_QOFF + (16 * w + c16) * SA_KP + (8 * q4) * 2;
  const int tile0 = (64 / SA_NG) * g, ntile = g == SA_NG - 1 ? 64 / SA_NG + 1 : 64 / SA_NG;
  const float* CL = p.in[2] + ((size_t)l * DB + b) * NCACHE * 256; const float* CK = p.in[3] + ((size_t)l * DB + b) * NCACHE * 32;
  const float* NL = p.out + O_SLAT + ((size_t)l * DB + b) * DS * 256; const float* NK = p.out + O_SKR + ((size_t)l * DB + b) * DS * 32;
  f32x4 stA[9], stB[9];
#define SA_LOAD(ST, TILE) do { const int tl_ = (TILE); int tj = tid; asm volatile("" : "+v"(tj)); \
    if (tl_ < NCACHE / 64) { const f32x4* cl_ = (const f32x4*)(CL + (size_t)tl_ * 64 * 256) + tj; \
      _Pragma("unroll") for (int k = 0; k < 8; ++k) ST[k] = cl_[512 * k]; \
      ST[8] = ((const f32x4*)(CK + (size_t)tl_ * 64 * 32))[tj]; } \
    else { \
      _Pragma("unroll") for (int k = 0; k < 8; ++k) { const int kg = tl_ * 64 + (tj >> 6) + 8 * k, part = tj & 63; f32x4 v = {0.f, 0.f, 0.f, 0.f}; \
        if (kg < NCACHE) v = *(const f32x4*)(CL + (size_t)kg * 256 + 4 * part); else if (kg < NCACHE + DS) v = *(const f32x4*)(NL + (size_t)(kg - NCACHE) * 256 + 4 * part); ST[k] = v; } \
      { const int kg = tl_ * 64 + (tj >> 3), part = tj & 7; f32x4 v = {0.f, 0.f, 0.f, 0.f}; \
        if (kg < NCACHE) v = *(const f32x4*)(CK + (size_t)kg * 32 + 4 * part); else if (kg < NCACHE + DS) v = *(const f32x4*)(NK + (size_t)(kg - NCACHE) * 32 + 4 * part); ST[8] = v; } } } while (0)
#define SA_STORE(ST) do { int tj = tid; asm volatile("" : "+v"(tj)); \
    _Pragma("unroll") for (int k = 0; k < 8; ++k) { u32x2 o; o.x = cvtpk(ST[k].x, ST[k].y); o.y = cvtpk(ST[k].z, ST[k].w); \
      *(LAS u32x2*)(lds + ((tj >> 6) + 8 * k) * SA_KP + (tj & 63) * 8) = o; } \
    { u32x2 o; o.x = cvtpk(ST[8].x, ST[8].y); o.y = cvtpk(ST[8].z, ST[8].w); *(LAS u32x2*)(lds + (tj >> 3) * SA_KP + 512 + (tj & 7) * 8) = o; } } while (0)
  SA_LOAD(stB, tile0); SA_STORE(stB);
  if (ntile > 1) SA_LOAD(stA, tile0 + 1);
  if (ntile > 2) SA_LOAD(stB, tile0 + 2);
  __syncthreads();
  f32x4 O[16];
#pragma unroll
  for (int i = 0; i < 16; ++i) O[i] = (f32x4){0.f, 0.f, 0.f, 0.f};
  float mrun = -INFINITY, lrun = 0.f;
  auto compute_tile = [&](int j) {
    LAS unsigned char* kb = lds;
    f32x4 s[4];
#pragma unroll
    for (int mt = 0; mt < 4; ++mt) s[mt] = (f32x4){0.f, 0.f, 0.f, 0.f};
#pragma unroll
    for (int ks = 0; ks < 9; ++ks) { const bf16x8 qf = *(const LAS bf16x8*)(qrow + 64 * ks);
#pragma unroll
      for (int mt = 0; mt < 4; ++mt) { const bf16x8 a = *(const LAS bf16x8*)(kb + (16 * mt + c16) * SA_KP + (32 * ks + 8 * q4) * 2);
        s[mt] = __builtin_amdgcn_mfma_f32_16x16x32_bf16(a, qf, s[mt], 0, 0, 0); }
      if (ks % 3 == 2) __builtin_amdgcn_sched_barrier(0); }
    const int kbase = (tile0 + j) * 64;
    float tm = -INFINITY;
#pragma unroll
    for (int mt = 0; mt < 4; ++mt)
#pragma unroll
      for (int r = 0; r < 4; ++r) { if (kbase + 16 * mt + 4 * q4 + r >= NCACHE + DS) s[mt][r] = -INFINITY; tm = fmaxf(tm, s[mt][r]); }
    tm = fmaxf(tm, __shfl_xor(tm, 16)); tm = fmaxf(tm, __shfl_xor(tm, 32));
    const float mnew = fmaxf(mrun, tm); const float alpha = __builtin_amdgcn_exp2f(mrun - mnew); mrun = mnew; float ps = 0.f;
#pragma unroll
    for (int mt = 0; mt < 4; ++mt)
#pragma unroll
      for (int r = 0; r < 4; ++r) { s[mt][r] = __builtin_amdgcn_exp2f(s[mt][r] - mnew); ps += s[mt][r]; }
    lrun = lrun * alpha + ps;
    bf16x8 pb[2];
#pragma unroll
    for (int ks = 0; ks < 2; ++ks) pb[ks] = pack_acc2(s[2 * ks], s[2 * ks + 1]);
    const int vo = (4 * q4 + (c16 >> 2)) * SA_KP + (4 * (c16 & 3)) * 2;
#pragma unroll
    for (int nt = 0; nt < 16; ++nt) { O[nt] *= alpha;
#pragma unroll
      for (int ks = 0; ks < 2; ++ks) {
        const v4i16_t a0 = __builtin_amdgcn_ds_read_tr16_b64_v4i16((LAS v4i16_t*)(kb + vo + (32 * ks) * SA_KP + nt * 32));
        const v4i16_t a1 = __builtin_amdgcn_ds_read_tr16_b64_v4i16((LAS v4i16_t*)(kb + vo + (32 * ks + 16) * SA_KP + nt * 32));
        const bf16x8 va = {a0[0], a0[1], a0[2], a0[3], a1[0], a1[1], a1[2], a1[3]};
        O[nt] = __builtin_amdgcn_mfma_f32_16x16x32_bf16(va, pb[ks], O[nt], 0, 0, 0); }
      if ((nt & 7) == 7) __builtin_amdgcn_sched_barrier(0); }
  };
  for (int j = 0; j < ntile; j += 2) {
    compute_tile(j);
    __syncthreads();
    if (j + 1 < ntile) SA_STORE(stA);
    __syncthreads();
    if (j + 3 < ntile) SA_LOAD(stA, tile0 + j + 3);
    if (j + 1 >= ntile) break;
    compute_tile(j + 1);
    __syncthreads();
    if (j + 2 < ntile) SA_STORE(stB);
    __syncthreads();
    if (j + 4 < ntile) SA_LOAD(stB, tile0 + j + 4);
  }
#undef SA_LOAD
#undef SA_STORE
  float* P = (float*)(p.ws + WS_SAPART) + (size_t)(b * SA_NG + g) * SA_PART + (size_t)(16 * w + c16) * 264;
#pragma unroll
  for (int nt = 0; nt < 16; ++nt) *(f32x4*)(P + 16 * nt + 4 * q4) = O[nt];
  lrun += __shfl_xor(lrun, 16); lrun += __shfl_xor(lrun, 32);
  if (q4 == 0) { P[256] = mrun; P[257] = lrun; }
  __syncthreads();
}

__device__ __forceinline__ void phase_finalize(LAS unsigned char* lds, const Params& p, int l, int gw, int NGW, int lane) {
  const bf16_t* PROJ = (const bf16_t*)(p.ws + WS_PROJ);
  bf16_t* HM = (bf16_t*)(p.ws + WS_HM); bf16_t* OG = (bf16_t*)(p.ws + WS_OG); bf16_t* OA = (bf16_t*)(p.ws + WS_OA);
  const float* mnw = p.in[18] + (size_t)l * 512; const float* gnw = p.in[22] + (size_t)l * 128;
  { const int un = gw >> 3, wv = gw & 7;
    if (un < DB * 8) {
      const int b = un >> 3, h = un & 7, c16 = lane & 15, q4 = lane >> 4;
      const float* P = (const float*)(p.ws + WS_SAPART) + (size_t)(b * SA_NG) * SA_PART + (size_t)(c16 * 8 + h) * 264;
      float mg[SA_NG], M = -INFINITY;
#pragma unroll
      for (int g = 0; g < SA_NG; ++g) { mg[g] = P[(size_t)g * SA_PART + 256]; M = fmaxf(M, mg[g]); }
      float L = 0.f;
#pragma unroll
      for (int g = 0; g < SA_NG; ++g) { mg[g] = __builtin_amdgcn_exp2f(mg[g] - M); L += P[(size_t)g * SA_PART + 257] * mg[g]; }
      const float invL = 1.f / L;
      const bf16_t* WT = (const bf16_t*)(p.ws + WS_WUVT) + (size_t)l * 512 * 256 + (size_t)(h * 64) * 256;
      const int ks = wv;
      f32x4 v0 = {0.f, 0.f, 0.f, 0.f}, v1 = {0.f, 0.f, 0.f, 0.f};
#pragma unroll
      for (int g = 0; g < SA_NG; ++g) { const float* pg = P + (size_t)g * SA_PART + 32 * ks + 8 * q4; v0 += *(const f32x4*)pg * mg[g]; v1 += *(const f32x4*)(pg + 4) * mg[g]; }
      v0 *= invL; v1 *= invL;
      u32x4 aw; aw.x = cvtpk(v0[0], v0[1]); aw.y = cvtpk(v0[2], v0[3]); aw.z = cvtpk(v1[0], v1[1]); aw.w = cvtpk(v1[2], v1[3]);
      const bf16x8 af = __builtin_bit_cast(bf16x8, aw);
      LAS f32x4* red = (LAS f32x4*)lds;
#pragma unroll
      for (int nt = 0; nt < 4; ++nt) { const bf16x8 bf = *(const bf16x8*)(WT + (size_t)(16 * nt + c16) * 256 + 32 * ks + 8 * q4);
        const f32x4 acc = __builtin_amdgcn_mfma_f32_16x16x32_bf16(af, bf, (f32x4){0.f, 0.f, 0.f, 0.f}, 0, 0, 0);
        red[(wv * 4 + nt) * 64 + lane] = acc; }
      __syncthreads();
      if (wv < 4) { const int nt = wv; f32x4 s = red[nt * 64 + lane];
#pragma unroll
        for (int w2 = 1; w2 < 8; ++w2) s += red[(w2 * 4 + nt) * 64 + lane];
#pragma unroll
        for (int r = 0; r < 4; ++r) { const int t = 4 * q4 + r, row = ROW_S + b * 16 + t, col = h * 64 + 16 * nt + c16;
          OA[(size_t)row * 512 + col] = f2bf(s[r] * siluf_(bf2f(PROJ[(size_t)row * PJR + RC_ZA + col]))); } }
      __syncthreads();
    } }
  { const int hh = lane >> 4, c8 = (lane & 15) * 8, col = hh * 128 + c8;
    const f32x4 mn0 = *(const f32x4*)(mnw + col), mn1 = *(const f32x4*)(mnw + col + 4), gn0 = *(const f32x4*)(gnw + c8), gn1 = *(const f32x4*)(gnw + c8 + 4);
    for (int r0 = 2 * gw; r0 < MROWS; r0 += 2 * NGW) {
      u32x4 hv[2], ov[2], zm[2], gv[2], zg[2];
#pragma unroll
      for (int i = 0; i < 2; ++i) { const int r = r0 + i; const bf16_t* pr = PROJ + (size_t)r * PJR;
        hv[i] = *(const u32x4*)(HM + (size_t)r * 512 + col); ov[i] = *(const u32x4*)(pr + RC_MO + col); zm[i] = *(const u32x4*)(pr + RC_ZM + col);
        gv[i] = *(const u32x4*)(OG + (size_t)r * 512 + col); zg[i] = *(const u32x4*)(pr + RC_ZG + col); }
      float a[2][8], g[2][8], sm[2], sg[2];
#pragma unroll
      for (int i = 0; i < 2; ++i) {
        const unsigned hw[4] = {hv[i].x, hv[i].y, hv[i].z, hv[i].w}, ow[4] = {ov[i].x, ov[i].y, ov[i].z, ov[i].w}, gw4[4] = {gv[i].x, gv[i].y, gv[i].z, gv[i].w};
        sm[i] = 0.f; sg[i] = 0.f;
#pragma unroll
        for (int e = 0; e < 4; ++e) { a[i][2 * e] = bflo(hw[e]) * sigmoidf_(bflo(ow[e])); a[i][2 * e + 1] = bfhi(hw[e]) * sigmoidf_(bfhi(ow[e])); g[i][2 * e] = bflo(gw4[e]); g[i][2 * e + 1] = bfhi(gw4[e]);
          sm[i] += a[i][2 * e] * a[i][2 * e] + a[i][2 * e + 1] * a[i][2 * e + 1]; sg[i] += g[i][2 * e] * g[i][2 * e] + g[i][2 * e + 1] * g[i][2 * e + 1]; } }
#pragma unroll
      for (int o = 1; o < 16; o <<= 1)
#pragma unroll
        for (int i = 0; i < 2; ++i) { sm[i] += __shfl_xor(sm[i], o); sg[i] += __shfl_xor(sg[i], o); }
#pragma unroll
      for (int i = 0; i < 2; ++i) { const int r = r0 + i; const float rm = rsqrtf(sm[i] * (1.f / 128.f) + EPS), rg = rsqrtf(sg[i] * (1.f / 128.f) + EPS);
        const unsigned zw[4] = {zm[i].x, zm[i].y, zm[i].z, zm[i].w}, yw[4] = {zg[i].x, zg[i].y, zg[i].z, zg[i].w};
        const float mnv[8] = {mn0.x, mn0.y, mn0.z, mn0.w, mn1.x, mn1.y, mn1.z, mn1.w}, gnv[8] = {gn0.x, gn0.y, gn0.z, gn0.w, gn1.x, gn1.y, gn1.z, gn1.w};
        unsigned om[4], og[4];
#pragma unroll
        for (int e = 0; e < 4; ++e) { om[e] = cvtpk(a[i][2 * e] * rm * mnv[2 * e] * siluf_(bflo(zw[e])), a[i][2 * e + 1] * rm * mnv[2 * e + 1] * siluf_(bfhi(zw[e])));
          og[e] = cvtpk(g[i][2 * e] * rg * gnv[2 * e] * siluf_(bflo(yw[e])), g[i][2 * e + 1] * rg * gnv[2 * e + 1] * siluf_(bfhi(yw[e]))); }
        *(u32x4*)(HM + (size_t)r * 512 + col) = (u32x4){om[0], om[1], om[2], om[3]}; *(u32x4*)(OG + (size_t)r * 512 + col) = (u32x4){og[0], og[1], og[2], og[3]}; }
    } }
#if PROBE_LEVEL == 2
  if (gw == 7 && lane == 0) ((unsigned long long*)(p.ws + WS_CTL + 1024))[52 + l] = __builtin_amdgcn_s_memrealtime();
  if (gw == 807 && lane == 0) ((unsigned long long*)(p.ws + WS_CTL + 1024))[54 + l] = __builtin_amdgcn_s_memrealtime();
#endif
}

struct EpiOut {
  const float* xp; bf16_t* xb; int l;
  __device__ __forceinline__ void operator()(const f32x4 (&acc)[2][2][4][2], int tm, int pn, int wr, int wc, int fr, int fq) const {
#pragma unroll
    for (int ai = 0; ai < 2; ++ai) {
      int fr_ = fr; asm volatile("" : "+v"(fr_) :: "memory");
      f32x4 xa[4][2][2];
#pragma unroll
      for (int m = 0; m < 4; ++m) { const int r = tm * 256 + ai * 128 + wr * 64 + m * 16 + fr_;
#pragma unroll
        for (int bj = 0; bj < 2; ++bj) { const int col0 = pn * 256 + bj * 128 + wc * 32 + 8 * fq;
          if (l == 0) { const float* xi = xp + (size_t)r * D + col0; xa[m][bj][0] = *(const f32x4*)xi; xa[m][bj][1] = *(const f32x4*)(xi + 4); }
          else { const u32x4 w = *(const u32x4*)(xb + (size_t)r * D + col0); xa[m][bj][0] = (f32x4){bflo(w.x), bfhi(w.x), bflo(w.y), bfhi(w.y)}; xa[m][bj][1] = (f32x4){bflo(w.z), bfhi(w.z), bflo(w.w), bfhi(w.w)}; } } }
#pragma unroll
      for (int m = 0; m < 4; ++m) { const int r = tm * 256 + ai * 128 + wr * 64 + m * 16 + fr_;
#pragma unroll
        for (int bj = 0; bj < 2; ++bj) { const int col0 = pn * 256 + bj * 128 + wc * 32 + 8 * fq;
          const f32x4 y0 = xa[m][bj][0] + acc[ai][bj][m][0], y1 = xa[m][bj][1] + acc[ai][bj][m][1];
          u32x4 w; w.x = cvtpk(y0.x, y0.y); w.y = cvtpk(y0.z, y0.w); w.z = cvtpk(y1.x, y1.y); w.w = cvtpk(y1.z, y1.w);
          *(u32x4*)(xb + (size_t)r * D + col0) = w; } }
    }
  }
};

__device__ __forceinline__ void phase_norm_rows_b(const Params& p, int lnext, int gw, int NGW, int lane, int rbeg, int rend) {
  const bf16_t* XB = (const bf16_t*)(p.ws + WS_X1B); bf16_t* XN = (bf16_t*)(p.ws + WS_XN);
  const float* nw = p.in[10] + (size_t)lnext * D + 16 * lane;
  const f32x4 w0 = *(const f32x4*)nw, w1 = *(const f32x4*)(nw + 4), w2 = *(const f32x4*)(nw + 8), w3 = *(const f32x4*)(nw + 12);
  for (int r0 = rbeg + 4 * gw; r0 < rend; r0 += 4 * NGW) {
    u32x4 v[4][2]; float s[4];
#pragma unroll
    for (int i = 0; i < 4; ++i) { const u32x4* xr = (const u32x4*)(XB + (size_t)(r0 + i) * D + 16 * lane); v[i][0] = xr[0]; v[i][1] = xr[1]; }
    float f[4][16];
#pragma unroll
    for (int i = 0; i < 4; ++i) { const unsigned ww[8] = {v[i][0].x, v[i][0].y, v[i][0].z, v[i][0].w, v[i][1].x, v[i][1].y, v[i][1].z, v[i][1].w}; s[i] = 0.f;
#pragma unroll
      for (int e = 0; e < 8; ++e) { f[i][2 * e] = bflo(ww[e]); f[i][2 * e + 1] = bfhi(ww[e]); s[i] += f[i][2 * e] * f[i][2 * e] + f[i][2 * e + 1] * f[i][2 * e + 1]; } }
#pragma unroll
    for (int o = 1; o < 64; o <<= 1)
#pragma unroll
      for (int i = 0; i < 4; ++i) s[i] += __shfl_xor(s[i], o);
#pragma unroll
    for (int i = 0; i < 4; ++i) { const float rstd = rsqrtf(s[i] * (1.f / D) + EPS); const float wv[16] = {w0.x, w0.y, w0.z, w0.w, w1.x, w1.y, w1.z, w1.w, w2.x, w2.y, w2.z, w2.w, w3.x, w3.y, w3.z, w3.w};
      u32x4 o0, o1; unsigned ow[8];
#pragma unroll
      for (int e = 0; e < 8; ++e) ow[e] = cvtpk(f[i][2 * e] * rstd * wv[2 * e], f[i][2 * e + 1] * rstd * wv[2 * e + 1]);
      o0 = (u32x4){ow[0], ow[1], ow[2], ow[3]}; o1 = (u32x4){ow[4], ow[5], ow[6], ow[7]};
      u32x4* xo = (u32x4*)(XN + (size_t)(r0 + i) * D + 16 * lane); xo[0] = o0; xo[1] = o1; }
  }
}
__device__ __forceinline__ void phase_final_norm_b(const Params& p, int gw, int NGW, int lane, int rbeg, int rend) {
  const bf16_t* XB = (const bf16_t*)(p.ws + WS_X1B);
  const float* nw = p.in[24] + 16 * lane;
  const f32x4 w0 = *(const f32x4*)nw, w1 = *(const f32x4*)(nw + 4), w2 = *(const f32x4*)(nw + 8), w3 = *(const f32x4*)(nw + 12);
  for (int r0 = rbeg + 4 * gw; r0 < rend; r0 += 4 * NGW) {
    u32x4 v[4][2]; float s[4];
#pragma unroll
    for (int i = 0; i < 4; ++i) { const u32x4* xr = (const u32x4*)(XB + (size_t)(r0 + i) * D + 16 * lane); v[i][0] = xr[0]; v[i][1] = xr[1]; }
    float f[4][16];
#pragma unroll
    for (int i = 0; i < 4; ++i) { const unsigned ww[8] = {v[i][0].x, v[i][0].y, v[i][0].z, v[i][0].w, v[i][1].x, v[i][1].y, v[i][1].z, v[i][1].w}; s[i] = 0.f;
#pragma unroll
      for (int e = 0; e < 8; ++e) { f[i][2 * e] = bflo(ww[e]); f[i][2 * e + 1] = bfhi(ww[e]); s[i] += f[i][2 * e] * f[i][2 * e] + f[i][2 * e + 1] * f[i][2 * e + 1]; } }
#pragma unroll
    for (int o = 1; o < 64; o <<= 1)
#pragma unroll
      for (int i = 0; i < 4; ++i) s[i] += __shfl_xor(s[i], o);
#pragma unroll
    for (int i = 0; i < 4; ++i) { const float rstd = rsqrtf(s[i] * (1.f / D) + EPS);
      f32x4* yo = (f32x4*)(p.out + O_YP + (size_t)(r0 + i) * D + 16 * lane);
      yo[0] = (f32x4){f[i][0] * rstd * w0.x, f[i][1] * rstd * w0.y, f[i][2] * rstd * w0.z, f[i][3] * rstd * w0.w};
      yo[1] = (f32x4){f[i][4] * rstd * w1.x, f[i][5] * rstd * w1.y, f[i][6] * rstd * w1.z, f[i][7] * rstd * w1.w};
      yo[2] = (f32x4){f[i][8] * rstd * w2.x, f[i][9] * rstd * w2.y, f[i][10] * rstd * w2.z, f[i][11] * rstd * w2.w};
      yo[3] = (f32x4){f[i][12] * rstd * w3.x, f[i][13] * rstd * w3.y, f[i][14] * rstd * w3.z, f[i][15] * rstd * w3.w}; }
  }
}

__device__ __forceinline__ void phase_final_norm(const Params& p, int gw, int NGW, int lane, int rbeg, int rend) {
  const f32x4* wr = (const f32x4*)p.in[24] + lane;
  for (int r0 = rbeg + 4 * gw; r0 < rend; r0 += 4 * NGW) {
    f32x4 v[4][4]; float s[4];
#pragma unroll
    for (int i = 0; i < 4; ++i) { const f32x4* xr = (const f32x4*)xrow_out(p, r0 + i) + lane;
#pragma unroll
      for (int j = 0; j < 4; ++j) v[i][j] = xr[64 * j]; }
#pragma unroll
    for (int i = 0; i < 4; ++i) { s[i] = 0.f;
#pragma unroll
      for (int j = 0; j < 4; ++j) s[i] += (v[i][j].x * v[i][j].x + v[i][j].y * v[i][j].y) + (v[i][j].z * v[i][j].z + v[i][j].w * v[i][j].w); }
#pragma unroll
    for (int o = 1; o < 64; o <<= 1)
#pragma unroll
      for (int i = 0; i < 4; ++i) s[i] += __shfl_xor(s[i], o);
#pragma unroll
    for (int i = 0; i < 4; ++i) { const float rstd = rsqrtf(s[i] * (1.f / D) + EPS); f32x4* xr = (f32x4*)xrow_out(p, r0 + i) + lane;
#pragma unroll
      for (int j = 0; j < 4; ++j) xr[64 * j] = v[i][j] * rstd * wr[64 * j]; }
  }
}


struct EpiPart {
  float* part;
  __device__ __forceinline__ void operator()(const f32x4 (&acc)[2][2][4][2], int tm, int pn, int wr, int wc, int fr, int fq) const {
#pragma unroll
    for (int ai = 0; ai < 2; ++ai)
#pragma unroll
      for (int m = 0; m < 4; ++m) {
        int fr_ = fr; asm volatile("" : "+v"(fr_) :: "memory");
        const int rr = (tm - 128) * 256 + ai * 128 + wr * 64 + m * 16 + fr_; float* pr = part + (size_t)rr * D;
#pragma unroll
        for (int bj = 0; bj < 2; ++bj) { const int col0 = pn * 256 + bj * 128 + wc * 32 + 8 * fq; *(f32x4*)(pr + col0) = acc[ai][bj][m][0]; *(f32x4*)(pr + col0 + 4) = acc[ai][bj][m][1]; }
      }
  }
};
__device__ __forceinline__ void phase_tail_rows(const Params& p, int l, int gw, int NGW, int lane) {
  const float* TP = (const float*)(p.ws + WS_TPART);
  bf16_t* XN = (bf16_t*)(p.ws + WS_XN);
  const int rend = (l + 1 < DEPTH) ? MPAD : ROW_M;
  for (int r = ROW_S + gw; r < rend; r += NGW) {
    if (r >= MROWS) { u32x4 z = {0u, 0u, 0u, 0u}; ((u32x4*)(XN + (size_t)r * D))[lane] = z; ((u32x4*)(XN + (size_t)r * D))[lane + 64] = z; continue; }
    const f32x4* xi = (const f32x4*)xrow_in(p, l, r) + lane; f32x4 v[4]; float s = 0.f;
#pragma unroll
    for (int j = 0; j < 4; ++j) { v[j] = xi[64 * j];
#pragma unroll
      for (int sl = 0; sl < 3; ++sl) v[j] += ((const f32x4*)(TP + ((size_t)sl * 768 + (r - ROW_S)) * D))[lane + 64 * j];
      s += (v[j].x * v[j].x + v[j].y * v[j].y) + (v[j].z * v[j].z + v[j].w * v[j].w); }
    const float rstd = rsqrtf(wave_sum(s) * (1.f / D) + EPS);
    if (l + 1 < DEPTH) {
      f32x4* xo = (f32x4*)xrow_out(p, r) + lane; const f32x4* wr = (const f32x4*)(p.in[10] + (size_t)(l + 1) * D) + lane; unsigned long long* o8 = (unsigned long long*)(XN + (size_t)r * D) + lane;
#pragma unroll
      for (int j = 0; j < 4; ++j) { xo[64 * j] = v[j]; const f32x4 ww = wr[64 * j];
        o8[64 * j] = (unsigned long long)cvtpk(v[j].x * rstd * ww.x, v[j].y * rstd * ww.y) | ((unsigned long long)cvtpk(v[j].z * rstd * ww.z, v[j].w * rstd * ww.w) << 32); }
    } else {
      f32x4* xo = (f32x4*)xrow_out(p, r) + lane; const f32x4* wr = (const f32x4*)p.in[24] + lane;
#pragma unroll
      for (int j = 0; j < 4; ++j) xo[64 * j] = v[j] * rstd * wr[64 * j];
    }
  }
}
#ifndef NLAYERS_RUN
#define NLAYERS_RUN DEPTH
#endif
__device__ __forceinline__ void probe_report(const Params& p, int stage, float err) {
  int mag = 0; if (err > 0.f) { float lg = log10f(err) + 5.f; mag = lg < 0.f ? 0 : (lg > 9.f ? 9 : (int)lg); }
  p.out[0] = (float)(10 * stage + mag) * 1000.f;
}
__device__ __forceinline__ unsigned hash_u(unsigned x) { x ^= x >> 16; x *= 0x7feb352du; x ^= x >> 15; x *= 0x846ca68bu; x ^= x >> 16; return x; }
__device__ __forceinline__ float nerr(float got, float want, float scale) { return fabsf(got - want) / (0.03f * fabsf(want) + 0.03f * scale + 1e-6f); }

__device__ __forceinline__ void probe_checks(const Params& p, int l, long long gt) {
  unsigned* ctl = (unsigned*)(p.ws + WS_CTL);
  const bf16_t* PROJ = (const bf16_t*)(p.ws + WS_PROJ);
  const float* RSTD = (const float*)(p.ws + WS_RSTD);
  const float* ct = (const float*)(p.ws + WS_ROPE); const float* st = ct + ROPE_N * 16;
  const bf16_t* KV = (const bf16_t*)(p.ws + WS_KV);
  const bf16_t* QATT = (const bf16_t*)(p.ws + WS_QATT); const bf16_t* QMETA = (const bf16_t*)(p.ws + WS_QMETA); const bf16_t* QS = (const bf16_t*)(p.ws + WS_QS);
  if (gt < 2048) {
    unsigned hh = hash_u((unsigned)gt + 77u); int r = (int)(hh % MROWS); if ((gt & 7) == 0) r = ROW_M + (int)(hh % 16); if ((gt & 7) == 1) r = ROW_S + (int)(hh % 512);
    hh = hash_u(hh); const int h = (int)(hh % 8); hh = hash_u(hh); const int d = (int)(hh % 96);
    const RowInfo ri = row_info(r); const bf16_t* pr = PROJ + (size_t)r * PJR + PC_CQ;
    float ss = 0.f; for (int k = 0; k < 384; ++k) { const float c = bf2f(pr[k]); ss += c * c; }
    const float rs = rsqrtf(ss / 384.f + EPS);
    auto raw = [&](int dd) { float a = 0.f; for (int k = 0; k < 384; ++k) a += bf2f(pr[k]) * p.in[12][l * 384 + k] * p.in[13][((size_t)l * 384 + k) * 768 + h * 96 + dd]; return a * rs * QSCALE; };
    float want;
    if (d < 64) want = raw(d);
    else { const int i = (d - 64) & 15; const float x1 = raw(64 + i), x2 = raw(80 + i), c = ct[ri.pos * 16 + i], s = st[ri.pos * 16 + i]; want = d < 80 ? x1 * c - x2 * s : x2 * c + x1 * s; }
    float got;
    if (ri.kind == 0) got = bf2f(QATT[((size_t)(ri.b * 8 + h) * SEQ + ri.t) * 96 + d]);
    else if (ri.kind == 1) got = bf2f(QS[(size_t)(r - ROW_S) * 768 + h * 96 + d]);
    else got = bf2f(QMETA[((size_t)h * 256 + ri.t) * 96 + d]);
    atomicMax(ctl + 66, __float_as_uint(nerr(got, want, 0.15f)));
  } else if (gt < 4096) {
    unsigned hh = hash_u((unsigned)gt + 99u); int r = (int)(hh % NP); if ((gt & 7) == 0) r = ROW_M + (int)(hh % 16);
    hh = hash_u(hh); const int col = (int)(hh % 1024); hh = hash_u(hh); const int bsel = (int)(hh % 8);
    const RowInfo ri = row_info(r); const bf16_t* pr = PROJ + (size_t)r * PJR + PC_CKV;
    float a = 0.f; const float* W = (col < 512 ? p.in[15] : p.in[16]) + (size_t)l * 256 * 512 + (col & 511);
    for (int k = 0; k < 256; ++k) a += bf2f(pr[k]) * p.in[14][l * 256 + k] * W[(size_t)k * 512];
    a *= RSTD[2 * r + 1];
    const int h = (col & 511) >> 6, d0 = (col & 63) + (col >= 512 ? 96 : 0);
    const int b = ri.kind == 0 ? ri.b : bsel; const int krow = ri.kind == 0 ? 64 + ri.t : ri.t;
    const bf16_t* kvr = KV + ((size_t)(b * 8 + h) * KVROWS + krow) * 160;
    float e = nerr(bf2f(kvr[d0]), a, 0.2f);
    const int i = col & 31; const float* okr = p.out + O_PKR + (((size_t)l * NB + b) * NCACHE + (ri.kind == 0 ? NMETA + ri.t : ri.t)) * 32;
    e = fmaxf(e, nerr(bf2f(kvr[64 + i]), okr[i], 0.2f));
    atomicMax(ctl + 67, __float_as_uint(e));
  } else if (gt < 4096 + 1536) {
    unsigned hh = hash_u((unsigned)gt + 1234u); const bool meta = (gt & 15) == 0;
    const int b = (int)(hh % 8); hh = hash_u(hh); const int h = (int)(hh % 8); hh = hash_u(hh); int t = (int)(hh % SEQ); if ((gt & 3) == 1) t &= 255; if (meta) t &= 15; hh = hash_u(hh); const int dv = (int)(hh % 64);
    const bf16_t* q = meta ? QMETA + ((size_t)h * 256 + t) * 96 : QATT + ((size_t)(b * 8 + h) * SEQ + t) * 96;
    const bf16_t* kvb = KV + (size_t)(b * 8 + h) * KVROWS * 160;
    const int nown = meta ? 0 : 64 * (t / 64 + 1);
    float mx = -INFINITY, lsum = 0.f, osum = 0.f;
    for (int pass = 0; pass < 2; ++pass)
      for (int k = 0; k < 16 + nown; ++k) { const bf16_t* kr = kvb + (size_t)(k < 16 ? k : 64 + (k - 16)) * 160;
        float s = 0.f; for (int d = 0; d < 96; ++d) s += bf2f(q[d]) * bf2f(kr[d]);
        if (pass == 0) mx = fmaxf(mx, s); else { const float pe = exp2f(s - mx); lsum += pe; osum += pe * bf2f(kr[96 + dv]); } }
    const int r = meta ? ROW_M + t : b * SEQ + t;
    const bf16_t* xn = (const bf16_t*)(p.ws + WS_XN) + (size_t)r * 1024; const bf16_t* wz = (const bf16_t*)(p.ws + WS_WIN) + ((size_t)l * PJ + PC_ZA + h * 64 + dv) * 1024;
    float z = 0.f; for (int k = 0; k < 1024; ++k) z += bf2f(xn[k]) * bf2f(wz[k]);
    const float want = osum / lsum * siluf_(z);
    const float got = bf2f(PROJ[(size_t)r * PJR + RC_ZA + h * 64 + dv]);
    atomicMax(ctl + 68, __float_as_uint(nerr(got, want, 0.02f)));
  }
}


__device__ __forceinline__ int queue_next(unsigned* ctr, LAS unsigned char* lds, int tid) {
  LAS int* slot = (LAS int*)(lds + 147440);
  if (tid == 0) *slot = (int)atomicAdd(ctr, 1u);
  __syncthreads();
  const int v = *slot;
  __syncthreads();
  return v;
}

#define OPQ_TID() int tq = threadIdx.x; asm volatile("" : "+v"(tq)); const Params& pq = p; int bq = blockIdx.x; asm volatile("" : "+s"(bq)); const int lq = tq & 63; const int gwq = blockIdx.x * NWAVES + (tq >> 6); (void)lq; (void)gwq

#define XB_TMO      128
#define XB_XCNT(j)  (256  + 64 * (j))
#define XB_XSUB(j)  (1280 + 64 * (j))
#define XB_XGEN(j)  (2304 + 64 * (j))
#define XB_TOP      3328
#define XB_TOPGEN   3392
#define XCD_BAR_WORDS 3456
#define XB_SPIN_CAP (1u << 22)
__device__ __forceinline__ unsigned xb_ld(unsigned* p)              { return __hip_atomic_load(p, __ATOMIC_RELAXED, __HIP_MEMORY_SCOPE_AGENT); }
__device__ __forceinline__ unsigned xb_add(unsigned* p, unsigned v) { return __hip_atomic_fetch_add(p, v, __ATOMIC_RELAXED, __HIP_MEMORY_SCOPE_AGENT); }
__device__ __forceinline__ unsigned xb_xcc_id() { return (unsigned)__builtin_amdgcn_s_getreg((3 << 11) | 20) & 0xFu; }
#define XB_SPIN(cond, bar) do { unsigned _sp = 0; while (cond) { __builtin_amdgcn_s_sleep(1); \
    if ((++_sp & 255u) == 0u) { if (xb_ld(&(bar)[XB_TMO])) break; if (_sp > XB_SPIN_CAP) { atomicAdd(&(bar)[XB_TMO], 1u); break; } } } } while (0)
struct XcdBarrier { unsigned* bar; unsigned x; volatile LAS unsigned* st; };
__device__ __forceinline__ XcdBarrier xcd_barrier_post(unsigned* bar, volatile LAS unsigned* st) {
  XcdBarrier b; b.bar = bar; b.x = xb_xcc_id(); b.st = st;
  if (threadIdx.x == 0) (void)xb_add(&bar[XB_XCNT(b.x)], 1u);
  return b;
}
__device__ __forceinline__ void xcd_barrier_complete(unsigned* bar, unsigned x, unsigned& nloc, unsigned& nx) {
  const unsigned G = gridDim.x * gridDim.y * gridDim.z;
  unsigned sum, cnt, mine, sp = 0u;
  for (;;) {
    sum = 0u; cnt = 0u; mine = 0u;
#pragma unroll
    for (unsigned j = 0; j < 16; ++j) { const unsigned c = xb_ld(&bar[XB_XCNT(j)]); sum += c; cnt += (c > 0u) ? 1u : 0u; mine = (j == x) ? c : mine; }
    if (sum == G) break;
    __builtin_amdgcn_s_sleep(1);
    if ((++sp & 255u) == 0u) { if (xb_ld(&bar[XB_TMO])) break; if (sp > XB_SPIN_CAP) { atomicAdd(&bar[XB_TMO], 1u); break; } }
  }
  nloc = mine > 0u ? mine : 1u; nx = cnt > 0u ? cnt : 1u;
}
__device__ __forceinline__ void xcd_barrier(const XcdBarrier& b) {
  asm volatile("s_waitcnt vmcnt(0)" ::: "memory");
  __syncthreads();
  if (threadIdx.x == 0) {
    unsigned* bar = b.bar;
    __builtin_amdgcn_s_waitcnt(0);
    unsigned nloc = b.st[0], nx = b.st[1];
    if (nloc == 0u) { xcd_barrier_complete(bar, b.x, nloc, nx); b.st[0] = nloc; b.st[1] = nx; }
    const unsigned old = xb_add(&bar[XB_XSUB(b.x)], 1u);
    const unsigned gen = old / nloc;
    if (old + 1u == (gen + 1u) * nloc) {
      __builtin_amdgcn_fence(__ATOMIC_RELEASE, "agent");
      asm volatile("s_waitcnt vmcnt(0)" ::: "memory");
      const unsigned og = xb_add(&bar[XB_TOP], 1u);
      const unsigned tg = og / nx;
      if (og + 1u == (tg + 1u) * nx) xb_add(&bar[XB_TOPGEN], 1u);
      else XB_SPIN(xb_ld(&bar[XB_TOPGEN]) == tg, bar);
      __builtin_amdgcn_fence(__ATOMIC_ACQUIRE, "agent");
      xb_add(&bar[XB_XGEN(b.x)], 1u);
      asm volatile("s_waitcnt vmcnt(0)" ::: "memory");
    } else {
      XB_SPIN(xb_ld(&bar[XB_XGEN(b.x)]) == gen, bar);
      __builtin_amdgcn_fence(__ATOMIC_ACQUIRE, "agent");
      asm volatile("s_waitcnt vmcnt(0)" ::: "memory");
    }
  }
  __syncthreads();
}

#if PROBE_LEVEL == 2
#define STAMP(i) do { if (blockIdx.x == 0 && threadIdx.x == 0) ((unsigned long long*)(p.ws + WS_CTL + 1024))[i] = __builtin_amdgcn_s_memrealtime(); } while (0)
#define BSTAMP(blk, i) do { if (blockIdx.x == (blk) && threadIdx.x == 0) ((unsigned long long*)(p.ws + WS_CTL + 1024))[i] = __builtin_amdgcn_s_memrealtime(); } while (0)
#else
#define STAMP(i) do {} while (0)
#define BSTAMP(blk, i) do {} while (0)
#endif
template <int l>
__device__ __forceinline__ void run_layer(const Params& p, LAS unsigned char* lds, const XcdBarrier& gbar) {
  const int NGW = gridDim.x * NWAVES; const int G = gridDim.x, bx = blockIdx.x;
  bf16_t* PROJ = (bf16_t*)(p.ws + WS_PROJ);
  unsigned* ctl = (unsigned*)(p.ws + WS_CTL);

    {
      asm volatile("" ::: "memory");
      pg8::Gemm g{(const bf16_t*)(p.ws + WS_XN), (const bf16_t*)(p.ws + WS_WIN) + (size_t)l * PJ * 1024, 1024, 1024, 1024, 1 << 20, 0};
      OrderAll S; S.init(MPAD / 256, PJ / 256, G, bx);
      EpiProj E{PROJ, (bf16_t*)(p.ws + WS_PROJH)};
      pg8::gemm_phase(lds, g, S, E);
    }
    xcd_barrier(gbar); STAMP(1 + 7 * l + 1);
    { OPQ_TID(); phase_rowpass(pq, l, gwq, NGW, lq);
#if PROBE_LEVEL == 2
      BSTAMP(0, 46 + l);
      {
        int slot = prep_next_slot(bq - G, G), buf = 0;
        const float* gb_ = pq.in[17] + l * 8; const float gb0 = gb_[0], gb1 = gb_[1], gb2 = gb_[2], gb3 = gb_[3], gb4 = gb_[4], gb5 = gb_[5], gb6 = gb_[6], gb7 = gb_[7];
        __syncthreads();
        if (slot < NSLOT) { mlstm_issue(lds, pq, slot, 0, tq); asm volatile("s_waitcnt vmcnt(0)" ::: "memory"); }
        while (slot < NSLOT) {
          const int nslot = prep_next_slot(slot, G);
#if PROBE_LEVEL == 2
          const unsigned long long tw0_ = __builtin_amdgcn_s_memrealtime();
#endif
          lds_barrier();
#if PROBE_LEVEL == 2
          if (tq == 0 && bq == 0) ((unsigned long long*)(pq.ws + WS_CTL + 2048))[11] += __builtin_amdgcn_s_memrealtime() - tw0_;
#endif
          if (nslot < NSLOT) mlstm_issue(lds, pq, nslot, buf ^ 1, tq);
          { const int hh = (slot < 32 * 65 ? slot / 65 : slot - 32 * 65) & 3;
            mlstm_prep(lds, pq, l, slot, buf, hh == 0 ? gb0 : (hh == 1 ? gb1 : (hh == 2 ? gb2 : gb3)), hh == 0 ? gb4 : (hh == 1 ? gb5 : (hh == 2 ? gb6 : gb7)), tq); }
          slot = nslot; buf ^= 1; }
        __syncthreads();
#if PROBE_LEVEL == 2
        const unsigned long long tg0_ = __builtin_amdgcn_s_memrealtime();
#endif
        {
          unsigned* gq = ctl + 16 + l; LAS int* qs_ = (LAS int*)(lds + 147440);
          if (tq == 0) { qs_[0] = (int)atomicAdd(gq, 1u); qs_[1] = (int)atomicAdd(gq, 1u); }
          __syncthreads();
          int cur = gdn_queue_slot(__builtin_amdgcn_readfirstlane(qs_[0])), nxt = gdn_queue_slot(__builtin_amdgcn_readfirstlane(qs_[1]));
          __syncthreads();
          bool have = false;
          while (cur < NSLOT) {
            unsigned pend = 0u; if (tq == 0) pend = atomicAdd(gq, 1u);
            gdn_prep(lds, pq, l, cur, have, nxt, tq);
            have = nxt < NSLOT && gdn_slot_interior(nxt);
            if (tq == 0) qs_[0] = (int)pend;
            lds_barrier();
            cur = nxt; nxt = gdn_queue_slot(__builtin_amdgcn_readfirstlane(qs_[0]));
            lds_barrier();
          }
        }
#if PROBE_LEVEL == 2
        __syncthreads(); if (tq == 0 && bq == 0) ((unsigned long long*)(pq.ws + WS_CTL + 2048))[12] += __builtin_amdgcn_s_memrealtime() - tg0_;
#endif
      }
#else
      {
        int slot = prep_next_slot(bq - G, G), buf = 0;
        const float* gb_ = pq.in[17] + l * 8; const float gb0 = gb_[0], gb1 = gb_[1], gb2 = gb_[2], gb3 = gb_[3], gb4 = gb_[4], gb5 = gb_[5], gb6 = gb_[6], gb7 = gb_[7];
        __syncthreads();
        if (slot < NSLOT) { mlstm_issue(lds, pq, slot, 0, tq); asm volatile("s_waitcnt vmcnt(0)" ::: "memory"); }
        while (slot < NSLOT) {
          const int nslot = prep_next_slot(slot, G);
#if PROBE_LEVEL == 2
          const unsigned long long tw0_ = __builtin_amdgcn_s_memrealtime();
#endif
          lds_barrier();
#if PROBE_LEVEL == 2
          if (tq == 0 && bq == 0) ((unsigned long long*)(pq.ws + WS_CTL + 2048))[11] += __builtin_amdgcn_s_memrealtime() - tw0_;
#endif
          if (nslot < NSLOT) mlstm_issue(lds, pq, nslot, buf ^ 1, tq);
          { const int hh = (slot < 32 * 65 ? slot / 65 : slot - 32 * 65) & 3;
            mlstm_prep(lds, pq, l, slot, buf, hh == 0 ? gb0 : (hh == 1 ? gb1 : (hh == 2 ? gb2 : gb3)), hh == 0 ? gb4 : (hh == 1 ? gb5 : (hh == 2 ? gb6 : gb7)), tq); }
          slot = nslot; buf ^= 1; }
        __syncthreads();
#if PROBE_LEVEL == 2
        const unsigned long long tg0_ = __builtin_amdgcn_s_memrealtime();
#endif
        {
          unsigned* gq = ctl + 16 + l; LAS int* qs_ = (LAS int*)(lds + 147440);
          if (tq == 0) { qs_[0] = (int)atomicAdd(gq, 1u); qs_[1] = (int)atomicAdd(gq, 1u); }
          __syncthreads();
          int cur = gdn_queue_slot(__builtin_amdgcn_readfirstlane(qs_[0])), nxt = gdn_queue_slot(__builtin_amdgcn_readfirstlane(qs_[1]));
          __syncthreads();
          bool have = false;
          while (cur < NSLOT) {
            unsigned pend = 0u; if (tq == 0) pend = atomicAdd(gq, 1u);
            gdn_prep(lds, pq, l, cur, have, nxt, tq);
            have = nxt < NSLOT && gdn_slot_interior(nxt);
            if (tq == 0) qs_[0] = (int)pend;
            lds_barrier();
            cur = nxt; nxt = gdn_queue_slot(__builtin_amdgcn_readfirstlane(qs_[0]));
            lds_barrier();
          }
        }
#if PROBE_LEVEL == 2
        __syncthreads(); if (tq == 0 && bq == 0) ((unsigned long long*)(pq.ws + WS_CTL + 2048))[12] += __builtin_amdgcn_s_memrealtime() - tg0_;
#endif
      }
#endif
    }
    xcd_barrier(gbar); STAMP(1 + 7 * l + 2);
    {
      const float* rstd = (const float*)(p.ws + WS_RSTD); const float* ct = (const float*)(p.ws + WS_ROPE);
      { pg8::Gemm g{PROJ + PC_CQ, (const bf16_t*)(p.ws + WS_WUQ) + (size_t)l * 768 * 384, PJR, 384, 384, 1 << 20, 0};
        OrderAll S; S.init(MPAD / 256, 3, G, bx);
        EpiQ E{rstd, ct, ct + ROPE_N * 16, (bf16_t*)(p.ws + WS_QATT), (bf16_t*)(p.ws + WS_QMETA), (bf16_t*)(p.ws + WS_QS)};
        pg8::gemm_phase(lds, g, S, E); }
      { pg8::Gemm g{PROJ + PC_CKV, (const bf16_t*)(p.ws + WS_WUKV) + (size_t)l * 1024 * 256, PJR, 256, 256, 1 << 20, 0};
        OrderKV S; S.init(129, 4, G, (bx + 119) % G);
        EpiKV E{rstd, (bf16_t*)(p.ws + WS_KV)};
        pg8::gemm_phase(lds, g, S, E); }
    }
    xcd_barrier(gbar); STAMP(1 + 7 * l + 3);
    {
      OPQ_TID();
      if (bq < 32) { for (int k = 0; k < 5; ++k) scan_chain<false>(lds, pq, l, k == 0 ? bq : 32 + bq * 4 + k - 1, tq); }
      else if (bq < 64) { for (int k = 0; k < 5; ++k) scan_chain<true>(lds, pq, l, k == 0 ? bq - 32 : 32 + (bq - 32) * 4 + k - 1, tq); }
      else { for (int u = bq - 64; u < DB * SA_NG; u += G - 64) sattn_unit(lds, pq, l, u / SA_NG, u % SA_NG, tq); }
      BSTAMP(0, 40 + l); BSTAMP(32, 42 + l); BSTAMP(64, 44 + l);
      for (;;) {
        const int idx = queue_next(ctl + 8 + l, lds, tq);
        if (idx >= 1024 + 8) break;
        AttnUnit u;
        if (idx < 1024) { const int qb = 15 - (idx >> 6), bh = idx & 63;
          u.q = (const bf16_t*)(p.ws + WS_QATT) + ((size_t)bh * SEQ + 256 * qb) * 96; u.kv = (const bf16_t*)(p.ws + WS_KV) + (size_t)bh * KVROWS * 160;
          u.chunk0 = 4 * qb; u.ntiles = 4 * qb + 5; u.nq_valid = 256; u.out_row0 = (bh >> 3) * SEQ + 256 * qb; u.h = bh & 7; u.is_meta = 0; }
        else { const int h = idx - 1024;
          u.q = (const bf16_t*)(p.ws + WS_QMETA) + (size_t)h * 256 * 96; u.kv = (const bf16_t*)(p.ws + WS_KV) + (size_t)h * KVROWS * 160;
          u.chunk0 = 0; u.ntiles = 1; u.nq_valid = 16; u.out_row0 = ROW_M; u.h = h; u.is_meta = 1; }
        attn_unit(lds, u, PROJ, (bf16_t*)(p.ws + WS_OA), tq, p.ws);
      }
    }
    xcd_barrier(gbar); STAMP(1 + 7 * l + 4);
#if PROBE_LEVEL == 1
    if (l == 0) {
      probe_checks(p, l, (long long)bx * NTHREADS + tid);
      xcd_barrier(gbar);
      if (bx == 0 && tid == 0) {
        int stage = 9; float e = 0.f;
        for (int s = 8; s >= 2; --s) { const float es = __uint_as_float(ctl[64 + s]); if (es > 1.f) { stage = s; e = es; } }
        if (stage == 9) for (int s = 2; s <= 8; ++s) e = fmaxf(e, __uint_as_float(ctl[64 + s]));
        probe_report(p, stage, e); }
      return;
    }
#endif
    { OPQ_TID(); phase_finalize(lds, pq, l, gwq, NGW, lq); }
    xcd_barrier(gbar); STAMP(1 + 7 * l + 5);
    {
      pg8::Gemm g{(const bf16_t*)(p.ws + WS_OA), (const bf16_t*)(p.ws + WS_WOUT) + (size_t)l * D * DMIX, 512, DMIX, DMIX, 8, SEG_B};
      OrderAll S; S.init(128, 4, G, bx);
      EpiOut E{p.in[0], (bf16_t*)(p.ws + WS_X1B), l};
      pg8::gemm_phase(lds, g, S, E);
    }
    xcd_barrier(gbar); STAMP(1 + 7 * l + 6);
    { OPQ_TID();
      constexpr int NX = (l + 1 < DEPTH) ? 12 : 8;
      if (bq < 3 * NX) {
        const int sl = bq / NX, uu = bq - sl * NX;
        pg8::Gemm g{(const bf16_t*)(p.ws + WS_OA + (size_t)sl * SEG_B), (const bf16_t*)(p.ws + WS_WOUT) + (size_t)l * D * DMIX + sl * 512, 512, DMIX, 512, 1 << 20, 0};
        OrderTail S; S.init(NX / 4, 4, NX, uu);
        EpiPart E{(float*)(p.ws + WS_TPART) + (size_t)sl * 768 * D};
        pg8::gemm_phase(lds, g, S, E);
        BSTAMP(0, 56 + l);
      } else {
        const int gw2 = (bq - 3 * NX) * NWAVES + (tq >> 6), NGW2 = (G - 3 * NX) * NWAVES;
        if (l + 1 < DEPTH) { phase_norm_rows_b(pq, l + 1, gw2, NGW2, lq, 0, 16384); phase_norm_rows_b(pq, l + 1, gw2, NGW2, lq, 16768, ROW_S); }
        else phase_final_norm_b(pq, gw2, NGW2, lq, 0, ROW_S);
        BSTAMP(100, 58 + l);
      }
    }
    xcd_barrier(gbar);
    { OPQ_TID(); phase_tail_rows(pq, l, gwq, NGW, lq); if (l + 1 < DEPTH) phase_norm_rows_b(pq, l + 1, gwq, NGW, lq, 16384, 16768); }
    if (l + 1 < DEPTH) { xcd_barrier(gbar); STAMP(1 + 7 * l + 7); }

}

__global__ void __launch_bounds__(NTHREADS, 2) mk_fwd(Params p) {
  extern __shared__ __attribute__((aligned(16))) unsigned char lds_raw[];
  LAS unsigned char* lds = (LAS unsigned char*)lds_raw;
  cg::grid_group grid = cg::this_grid();
  const int tid = threadIdx.x;
  const int lane = tid & 63, wave = tid >> 6;
  const int gw = blockIdx.x * NWAVES + wave, NGW = gridDim.x * NWAVES;
  const int G = gridDim.x, bx = blockIdx.x;
  bf16_t* PROJ = (bf16_t*)(p.ws + WS_PROJ);
  unsigned* ctl = (unsigned*)(p.ws + WS_CTL);

  if (threadIdx.x < 2) ((LAS unsigned*)(lds + 147424))[threadIdx.x] = 0u;
  __syncthreads();
  const XcdBarrier gbar = xcd_barrier_post((unsigned*)(p.ws + WS_BAR), (volatile LAS unsigned*)(lds + 147424));
  STAMP(0);
#if PROBE_LEVEL == 2
  if (threadIdx.x < 16 && blockIdx.x == 200) ((unsigned long long*)(p.ws + WS_CTL + 2048))[threadIdx.x] = 0ull;
#endif
  phase0(p, lds, tid);
  grid.sync(); STAMP(1);
  run_layer<0>(p, lds, gbar);
  if (NLAYERS_RUN > 1) run_layer<1>(p, lds, gbar);
#if PROBE_LEVEL == 2
  STAMP(15);
  grid.sync();
  if (blockIdx.x == 0) {
    const unsigned long long* ts = (const unsigned long long*)(p.ws + WS_CTL + 1024);
    const long long offs[13] = {O_YP, O_YS, O_PLAT, O_PKR, O_PC, O_PN, O_PM, O_PS, O_PCONV, O_SLAT, O_SKR, O_SC, O_SN};
    unsigned d[13];
    for (int k = 0; k < 6; ++k) d[k] = (unsigned)((ts[k + 1] - ts[k]) / 100);
    for (int k = 0; k < 6; ++k) d[k] = (unsigned)((ts[k + 1] - ts[k]) / 100);
    d[6] = 1; d[7] = (unsigned)((ts[7] - ts[6]) / 100); d[8] = (unsigned)((ts[8] - ts[7]) / 100);
    d[9] = (unsigned)((ts[50] - ts[5]) / 100); d[10] = (unsigned)((ts[52] - ts[5]) / 100); d[11] = (unsigned)((ts[56] - ts[7]) / 100); d[12] = (unsigned)((ts[58] - ts[7]) / 100);
    d[3] = (unsigned)((ts[54] - ts[5]) / 100);
    for (int k = 0; k < 13; ++k) { unsigned n = d[k]; if (k == 6 && n > 64) n = 64; if (k == 5 && n > 8192) n = 8192; if (n > 30000) n = 30000;
      for (unsigned i = threadIdx.x; i < n; i += NTHREADS) p.out[offs[k] + i] = __uint_as_float(0xAAAAAAAAu); }
  }
#endif
}

extern "C" void kernel_launch(void* const* d_in, const int* in_sizes, int n_in, void* d_out, int out_size,
                              void* d_ws, size_t ws_size, hipStream_t stream) {
  constexpr int LDS_BYTES = 144 * 1024;
  static int grid_blocks = 0;
  if (!grid_blocks) {
    int dev = 0, cus = 0, per_cu = 0;
    (void)hipGetDevice(&dev);
    (void)hipDeviceGetAttribute(&cus, hipDeviceAttributeMultiprocessorCount, dev);
    (void)hipFuncSetAttribute((const void*)mk_fwd, hipFuncAttributeMaxDynamicSharedMemorySize, LDS_BYTES);
    (void)hipOccupancyMaxActiveBlocksPerMultiprocessor(&per_cu, (const void*)mk_fwd, NTHREADS, LDS_BYTES);
    if (per_cu < 1) per_cu = 1;
    grid_blocks = cus * 1;
    if (n_in != 25 || (long long)out_size != O_END || ws_size < WS_END2) { fprintf(stderr, "kernel_launch: unexpected sizes n_in=%d out=%d ws=%zu (need %zu)\n", n_in, out_size, ws_size, (size_t)WS_END2); grid_blocks = -1; }
  }
  if (grid_blocks < 0) return;
  (void)hipMemsetAsync((unsigned char*)d_ws + WS_BAR, 0, 14336 + 256 + 64, stream);
  Params p{};
  for (int i = 0; i < 25; ++i) p.in[i] = (const float*)d_in[i];
  p.out = (float*)d_out; p.ws = (unsigned char*)d_ws; p.ph_lo = 0; p.ph_hi = 100; p.probe = 0; p.pad = 0;
  void* args[] = {&p};
  hipError_t e = hipLaunchCooperativeKernel((const void*)mk_fwd, dim3(grid_blocks), dim3(NTHREADS), args, LDS_BYTES, stream);
  if (e != hipSuccess) fprintf(stderr, "cooperative launch failed: %s (grid %d)\n", hipGetErrorString(e), grid_blocks);
}
```

```cpp
#define PROBE_LEVEL 0
#include <hip/hip_runtime.h>
#include <hip/hip_cooperative_groups.h>
#include <cstdio>
#include <cstdint>
namespace cg = cooperative_groups;

#define LAS __attribute__((address_space(3)))
typedef unsigned short bf16_t;
typedef short bf16x8 __attribute__((ext_vector_type(8)));
typedef short s16x4 __attribute__((ext_vector_type(4)));
typedef float f32x4 __attribute__((ext_vector_type(4)));
typedef float f32x2 __attribute__((ext_vector_type(2)));
typedef float f32x16 __attribute__((ext_vector_type(16)));
typedef unsigned u32x4 __attribute__((ext_vector_type(4)));
typedef unsigned u32x2 __attribute__((ext_vector_type(2)));
typedef __bf16 bf16x2_t __attribute__((ext_vector_type(2)));

__device__ __forceinline__ unsigned cvtpk(float lo, float hi) { f32x2 v = {lo, hi}; bf16x2_t b = __builtin_convertvector(v, bf16x2_t); return __builtin_bit_cast(unsigned, b); }
__device__ __forceinline__ bf16_t f2bf(float x) { return (bf16_t)(cvtpk(x, 0.f) & 0xffffu); }
__device__ __forceinline__ float bf2f(bf16_t x) { return __uint_as_float(((unsigned)x) << 16); }
__device__ __forceinline__ float bflo(unsigned w) { return __uint_as_float(w << 16); }
__device__ __forceinline__ float bfhi(unsigned w) { return __uint_as_float(w & 0xffff0000u); }

constexpr int D = 1024, NB = 8, SEQ = 4096, DEPTH = 2, DB = 32, DS = 16, NMETA = 16, NCACHE = 4112;
constexpr int NP = NB * SEQ;
constexpr int NS = DB * DS;
constexpr int ROW_S = NP, ROW_M = NP + NS, MROWS = ROW_M + NMETA, MPAD = 33536;
constexpr int INC = 5808;
constexpr int PJ = 5888;
constexpr int PJR = 2816;
constexpr int RC_MO = 704, RC_ZA = 1216, RC_ZM = 1728, RC_ZG = 2240;
constexpr int PC_CKV = 0, PC_CQ = 256, PC_KR = 640, PC_G16 = 672, PC_MQ = 704, PC_MK = 1216, PC_MV = 1728, PC_MO = 2240,
              PC_GQ = 2752, PC_GK = 3264, PC_GV = 3776, PC_ZA = 4288, PC_ZM = 4800, PC_ZG = 5312, PC_END = 5824;
constexpr int DMIX = 1536;
constexpr int NTHREADS = 512, NWAVES = 8;
constexpr float EPS = 1e-6f;
constexpr float QSCALE = 0.10206207261596575f * 1.4426950408889634f;

constexpr long long O_YP = 0;
constexpr long long O_YS = O_YP + (long long)NB * SEQ * D;
constexpr long long O_PLAT = O_YS + (long long)DB * DS * D;
constexpr long long O_PKR = O_PLAT + (long long)DEPTH * NB * NCACHE * 256;
constexpr long long O_PC = O_PKR + (long long)DEPTH * NB * NCACHE * 32;
constexpr long long O_PN = O_PC + (long long)DEPTH * NB * 4 * 128 * 128;
constexpr long long O_PM = O_PN + (long long)DEPTH * NB * 4 * 128;
constexpr long long O_PS = O_PM + (long long)DEPTH * NB * 4;
constexpr long long O_PCONV = O_PS + (long long)DEPTH * NB * 4 * 128 * 128;
constexpr long long O_SLAT = O_PCONV + (long long)DEPTH * NB * 3 * 1536;
constexpr long long O_SKR = O_SLAT + (long long)DEPTH * DB * DS * 256;
constexpr long long O_SC = O_SKR + (long long)DEPTH * DB * DS * 32;
constexpr long long O_SN = O_SC + (long long)DEPTH * DB * 4 * 128 * 128;
constexpr long long O_SM = O_SN + (long long)DEPTH * DB * 4 * 128;
constexpr long long O_SS = O_SM + (long long)DEPTH * DB * 4;
constexpr long long O_SCONV = O_SS + (long long)DEPTH * DB * 4 * 128 * 128;
constexpr long long O_END = O_SCONV + (long long)DEPTH * DB * 3 * 1536;

constexpr size_t al256(size_t x) { return (x + 255) & ~(size_t)255; }
constexpr size_t WS_CTL = 0;
constexpr size_t WS_BAR = 16384;
constexpr size_t WS_ZERO = WS_BAR + 14336;
constexpr size_t WS_WQ = WS_ZERO + 256;
constexpr size_t WS_ROPE = 32768;
constexpr size_t ROPE_N = 4160;
constexpr size_t WS_WIN = al256(WS_ROPE + ROPE_N * 16 * 4 * 2);
constexpr size_t WS_WUQ = al256(WS_WIN + (size_t)2 * PJ * 1024 * 2);
constexpr size_t WS_WUKV = al256(WS_WUQ + (size_t)2 * 768 * 384 * 2);
constexpr size_t WS_WOUT = al256(WS_WUKV + (size_t)2 * 1024 * 256 * 2);
constexpr size_t WS_WUKR = al256(WS_WOUT + (size_t)2 * 1024 * 1536 * 2);
constexpr size_t WS_WUVT = al256(WS_WUKR + (size_t)2 * 256 * 512 * 2);
constexpr size_t WS_XMETA = al256(WS_WUVT + (size_t)2 * 512 * 256 * 2);
constexpr size_t WS_RSTD = al256(WS_XMETA + 16 * 1024 * 4);
constexpr size_t SEG_B = (size_t)MPAD * 512 * 2;
constexpr size_t WS_OA = al256(WS_RSTD + (size_t)MPAD * 2 * 4);
constexpr size_t WS_XN = WS_OA + SEG_B;
constexpr size_t WS_PROJ = al256(WS_XN + (size_t)MPAD * 1024 * 2);
constexpr size_t WS_PROJH = WS_PROJ + (size_t)MPAD * PJR * 2;
constexpr size_t PH_T = (size_t)MPAD * 128;
constexpr size_t WS_GATES = al256(WS_PROJ + (size_t)MPAD * PJ * 2);
constexpr size_t WS_QATT = al256(WS_GATES + (size_t)MPAD * 16 * 4);
constexpr size_t WS_QMETA = al256(WS_QATT + (size_t)NB * 8 * SEQ * 96 * 2);
constexpr size_t WS_QS = al256(WS_QMETA + (size_t)8 * 256 * 96 * 2);
constexpr int KVROWS = 64 + SEQ;
constexpr size_t WS_KV = al256(WS_QS + (size_t)NS * 768 * 2);
constexpr size_t WS_END0 = al256(WS_KV + (size_t)NB * 8 * KVROWS * 160 * 2);

struct Params {
  const float* in[25];
  float* out;
  unsigned char* ws;
  int ph_lo, ph_hi;
  int probe, pad;
};

__device__ __forceinline__ float wave_sum(float v) {
#pragma unroll
  for (int o = 1; o < 64; o <<= 1) v += __shfl_xor(v, o);
  return v;
}
__device__ __forceinline__ float sigmoidf_(float x) { return __builtin_amdgcn_rcpf(1.f + __builtin_amdgcn_exp2f(-1.4426950408889634f * x)); }
__device__ __forceinline__ float siluf_(float x) { return x * __builtin_amdgcn_rcpf(1.f + __builtin_amdgcn_exp2f(-1.4426950408889634f * x)); }

__device__ __forceinline__ int orig_col(int pc, float& sc) {
  sc = 1.f;
  if (pc < 256) return 384 + pc;
  if (pc < 640) return pc - 256;
  if (pc < 672) return pc;
  if (pc < 688) { int g = pc - 672; return g < 8 ? 2720 + g : 5288 + (g - 8); }
  if (pc < 704) return -1;
  if (pc < 1216) return 1184 + (pc - 704);
  if (pc < 1728) { sc = 0.08838834764831845f; return 1696 + (pc - 1216); }
  if (pc < 2240) return 2208 + (pc - 1728);
  if (pc < 2752) return 2728 + (pc - 2240);
  if (pc < 4288) return 3752 + (pc - 2752);
  if (pc < 4800) return 672 + (pc - 4288);
  if (pc < 5312) return 3240 + (pc - 4800);
  if (pc < 5824) return 5296 + (pc - 5312);
  return -1;
}

template <class F>
__device__ __forceinline__ void transpose_item(F src, int K, bf16_t* WT, LAS float* scr, int kb, int nb, int lane) {
  const int k0 = 64 * kb, n0 = 32 * nb;
#pragma unroll 16
  for (int i = 0; i < 32; ++i) { const int kk = 2 * i + (lane >> 5); scr[kk * 33 + (lane & 31)] = src(k0 + kk, n0 + (lane & 31)); }
  asm volatile("s_waitcnt lgkmcnt(0)" ::: "memory");
  const int c = lane & 7;
#pragma unroll
  for (int j = 0; j < 4; ++j) {
    const int n = (lane >> 3) + 8 * j; const LAS float* s = scr + (8 * c) * 33 + n;
    u32x4 o; o.x = cvtpk(s[0 * 33], s[1 * 33]); o.y = cvtpk(s[2 * 33], s[3 * 33]); o.z = cvtpk(s[4 * 33], s[5 * 33]); o.w = cvtpk(s[6 * 33], s[7 * 33]);
    *(u32x4*)(WT + (size_t)(n0 + n) * K + k0 + 8 * c) = o;
  }
  asm volatile("s_waitcnt lgkmcnt(0)" ::: "memory");
}

template <class F4>
__device__ __forceinline__ void transpose_item4(F4 src4, int K, bf16_t* WT, LAS float* scr  , int kb, int nb, int lane) {
  const int k0 = 32 * kb, n0 = 128 * nb;
  f32x4 v[16];
#pragma unroll
  for (int i = 0; i < 16; ++i) v[i] = src4(k0 + 2 * i + (lane >> 5), n0 + 4 * (lane & 31));
#pragma unroll
  for (int i = 0; i < 16; ++i) *(LAS f32x4*)(scr + (2 * i + (lane >> 5)) * 132 + 4 * (lane & 31)) = v[i];
  asm volatile("s_waitcnt lgkmcnt(0)" ::: "memory");
  const int c = lane & 3;
#pragma unroll
  for (int j = 0; j < 8; ++j) {
    const int n = (lane >> 2) + 16 * j; const LAS float* s = scr + (8 * c) * 132 + n;
    u32x4 o; o.x = cvtpk(s[0 * 132], s[1 * 132]); o.y = cvtpk(s[2 * 132], s[3 * 132]); o.z = cvtpk(s[4 * 132], s[5 * 132]); o.w = cvtpk(s[6 * 132], s[7 * 132]);
    *(u32x4*)(WT + (size_t)(n0 + n) * K + k0 + 8 * c) = o;
  }
  asm volatile("s_waitcnt lgkmcnt(0)" ::: "memory");
}

__device__ __forceinline__ void rms_row_to_bf16(const float* xrow, const float* w, bf16_t* orow, int lane) {
  const f32x4* xr = (const f32x4*)xrow + lane; const f32x4* wr = (const f32x4*)w + lane;
  f32x4 v[4]; float s = 0.f;
#pragma unroll
  for (int j = 0; j < 4; ++j) { v[j] = xr[64 * j]; s += (v[j].x * v[j].x + v[j].y * v[j].y) + (v[j].z * v[j].z + v[j].w * v[j].w); }
  const float rstd = rsqrtf(wave_sum(s) * (1.f / D) + EPS);
  unsigned long long* o8 = (unsigned long long*)orow + lane;
#pragma unroll
  for (int j = 0; j < 4; ++j) { const f32x4 ww = wr[64 * j];
    o8[64 * j] = (unsigned long long)cvtpk(v[j].x * rstd * ww.x, v[j].y * rstd * ww.y) | ((unsigned long long)cvtpk(v[j].z * rstd * ww.z, v[j].w * rstd * ww.w) << 32); }
}

__device__ __forceinline__ const float* xrow_in(const Params& p, int l, int r) {
  if (l == 0) {
    if (r < ROW_S) return p.in[0] + (size_t)r * D;
    if (r < ROW_M) return p.in[1] + (size_t)(r - ROW_S) * D;
    return p.in[9] + (size_t)(r - ROW_M) * D;
  }
  if (r < ROW_S) return p.out + O_YP + (size_t)r * D;
  if (r < ROW_M) return p.out + O_YS + (size_t)(r - ROW_S) * D;
  return (const float*)(p.ws + WS_XMETA) + (size_t)(r - ROW_M) * D;
}
__device__ __forceinline__ float* xrow_out(const Params& p, int r) {
  if (r < ROW_S) return p.out + O_YP + (size_t)r * D;
  if (r < ROW_M) return p.out + O_YS + (size_t)(r - ROW_S) * D;
  return (float*)(p.ws + WS_XMETA) + (size_t)(r - ROW_M) * D;
}

__device__ __forceinline__ void phase_norm_rows(const Params& p, int l, int gw, int NGW, int lane, int rbeg = 0, int rend = MPAD) {
  bf16_t* XN = (bf16_t*)(p.ws + WS_XN);
  const f32x4* wr = (const f32x4*)(p.in[10] + (size_t)l * D) + lane;
  for (int r0 = rbeg + 4 * gw; r0 < rend; r0 += 4 * NGW) {
    f32x4 v[4][4]; float s[4];
#pragma unroll
    for (int i = 0; i < 4; ++i) { const int r = r0 + i;
      if (r < MROWS) { const f32x4* xr = (const f32x4*)xrow_in(p, l, r) + lane;
#pragma unroll
        for (int j = 0; j < 4; ++j) v[i][j] = xr[64 * j]; }
      else {
#pragma unroll
        for (int j = 0; j < 4; ++j) v[i][j] = (f32x4){0.f, 0.f, 0.f, 0.f}; } }
#pragma unroll
    for (int i = 0; i < 4; ++i) { s[i] = 0.f;
#pragma unroll
      for (int j = 0; j < 4; ++j) s[i] += (v[i][j].x * v[i][j].x + v[i][j].y * v[i][j].y) + (v[i][j].z * v[i][j].z + v[i][j].w * v[i][j].w); }
#pragma unroll
    for (int o = 1; o < 64; o <<= 1)
#pragma unroll
      for (int i = 0; i < 4; ++i) s[i] += __shfl_xor(s[i], o);
#pragma unroll
    for (int i = 0; i < 4; ++i) { const float rstd = rsqrtf(s[i] * (1.f / D) + EPS); unsigned long long* o8 = (unsigned long long*)(XN + (size_t)(r0 + i) * D) + lane;
#pragma unroll
      for (int j = 0; j < 4; ++j) { const f32x4 ww = wr[64 * j];
        o8[64 * j] = (unsigned long long)cvtpk(v[i][j].x * rstd * ww.x, v[i][j].y * rstd * ww.y) | ((unsigned long long)cvtpk(v[i][j].z * rstd * ww.z, v[i][j].w * rstd * ww.w) << 32); } }
  }
}

__device__ __forceinline__ void phase0(const Params& p, LAS unsigned char* lds, int tid) {
  const int lane = tid & 63, wave = tid >> 6;
  const int gw = blockIdx.x * NWAVES + wave, NGW = gridDim.x * NWAVES;
  LAS float* scr = (LAS float*)(lds + wave * 16896);
  if (blockIdx.x == 0 && tid < 1024 / 4) ((unsigned*)(p.ws + WS_CTL))[tid] = 0u;
  constexpr int I_WIN = 32 * (PJ / 128), I_WUQ = 12 * 6, I_WUKV = 8 * 8, I_WOUT = 48 * 8, I_WUVT = 8 * 4;
  constexpr int I_L = I_WIN + I_WUQ + I_WUKV + I_WOUT + I_WUVT, I_ALL = 2 * I_L;
  for (int it = gw; it < I_ALL; it += NGW) {
    const int l = it / I_L; int r = it % I_L;
    if (r < I_WIN) {
      const float* W = p.in[11] + (size_t)l * D * INC;
      transpose_item4([&](int k, int n) { float sc; const int oc = orig_col(n, sc); f32x4 v = {0.f, 0.f, 0.f, 0.f}; if (oc >= 0) { v = *(const f32x4*)(W + (size_t)k * INC + oc); v *= sc; } return v; },
                      1024, (bf16_t*)(p.ws + WS_WIN) + (size_t)l * PJ * 1024, scr, r % 32, r / 32, lane);
      continue; }
    r -= I_WIN;
    if (r < I_WUQ) {
      const float* W = p.in[13] + (size_t)l * 384 * 768; const float* qn = p.in[12] + (size_t)l * 384;
      transpose_item4([&](int k, int n) { f32x4 v = *(const f32x4*)(W + (size_t)k * 768 + n); v *= qn[k] * QSCALE; return v; }, 384, (bf16_t*)(p.ws + WS_WUQ) + (size_t)l * 768 * 384, scr, r % 12, r / 12, lane);
      continue; }
    r -= I_WUQ;
    if (r < I_WUKV) {
      const float* Wk = p.in[15] + (size_t)l * 256 * 512; const float* Wv = p.in[16] + (size_t)l * 256 * 512; const float* kn = p.in[14] + (size_t)l * 256;
      transpose_item4([&](int k, int n) { f32x4 v = n < 512 ? *(const f32x4*)(Wk + (size_t)k * 512 + n) : *(const f32x4*)(Wv + (size_t)k * 512 + n - 512); v *= kn[k]; return v; }, 256, (bf16_t*)(p.ws + WS_WUKV) + (size_t)l * 1024 * 256, scr, r % 8, r / 8, lane);
      continue; }
    r -= I_WUKV;
    if (r < I_WOUT) {
      const float* W = p.in[23] + (size_t)l * DMIX * D;
      transpose_item4([&](int k, int n) { return *(const f32x4*)(W + (size_t)k * D + n); }, DMIX, (bf16_t*)(p.ws + WS_WOUT) + (size_t)l * D * DMIX, scr, r % 48, r / 48, lane);
      continue; }
    r -= I_WOUT;
    { const float* Wv = p.in[16] + (size_t)l * 256 * 512;
      transpose_item4([&](int k, int n) { return *(const f32x4*)(Wv + (size_t)k * 512 + n); }, 256, (bf16_t*)(p.ws + WS_WUVT) + (size_t)l * 512 * 256, scr, r % 8, r / 8, lane); }
  }
  const long long gt = (long long)blockIdx.x * NTHREADS + tid, GT = (long long)gridDim.x * NTHREADS;
  { bf16_t* o = (bf16_t*)(p.ws + WS_WUKR); const float* W = p.in[15];
    for (long long i = gt; i < 2LL * 256 * 512; i += GT) o[i] = f2bf(W[i]); }
  { float* ct = (float*)(p.ws + WS_ROPE); float* st = ct + ROPE_N * 16;
    for (long long i = gt; i < (long long)ROPE_N * 16; i += GT) {
      const int pos = (int)(i >> 4), k = (int)(i & 15);
      const float freq = powf(10000.f, -(float)k / 16.f); const float ang = (float)pos * freq;
      float s, c; sincosf(ang, &s, &c); ct[i] = c; st[i] = s; } }
  { LAS int* qs = (LAS int*)(lds + 147440); unsigned* nq = (unsigned*)(p.ws + WS_WQ);
    __syncthreads();
    if (tid == 0) *qs = (int)atomicAdd(nq, 1u);
    __syncthreads();
    int cur = __builtin_amdgcn_readfirstlane(*qs);
    __syncthreads();
    while (cur < MPAD / 32) {
      unsigned pend = 0u; if (tid == 0) pend = atomicAdd(nq, 1u);
      phase_norm_rows(p, 0, wave, 8, lane, cur * 32, cur * 32 + 32);
      if (tid == 0) *qs = (int)pend;
      __syncthreads();
      cur = __builtin_amdgcn_readfirstlane(*qs);
      __syncthreads();
    }
  }
}

namespace pg8 {
constexpr int BM = 256, BK = 64, HALF = 128, HTB = HALF * BK * 2, STAGE_BYTES = 8 * HTB, NXCD = 8, WGM = 8;
__device__ __forceinline__ int lds_byte(int r, int c) { const int st = (r >> 4) * 2 + (c >> 5), rr = r & 15, cc = c & 31, ob = rr * 64 + cc * 2; return st * 1024 + (ob ^ (((ob >> 9) & 1) << 5)); }
__device__ __forceinline__ void stage_rc(int b, int& R, int& C) { const int st = b / 1024, sb = b % 1024, swz = sb ^ (((sb >> 9) & 1) << 5); R = (st >> 1) * 16 + swz / 64; C = (st & 1) * 32 + (swz % 64) / 2; }
__device__ __forceinline__ int perm32(int rho) { const int n = rho >> 4, i = rho & 15; return 8 * (i >> 2) + 4 * n + (i & 3); }
struct Unit { int pm, pn; };
struct Gemm { const bf16_t* A; const bf16_t* Bt; int lda, ldb, K; int kseg; size_t segstride; };
struct StaticOrder {
  int nM, nN, nwg, G, c;
  __device__ void init(int nM_, int nN_, int G_, int c_) { nM = nM_; nN = nN_; nwg = nM * nN; G = G_; c = c_; }
  __device__ bool next(int i, Unit& u) const {
    const long L = (long)i * G + c; if (L >= nwg) return false;
    int wgid = (int)L; { const int q = nwg / NXCD, r = nwg % NXCD, xcd = wgid % NXCD, off = wgid / NXCD; wgid = (xcd < r ? xcd * (q + 1) : r * (q + 1) + (xcd - r) * q) + off; }
    const int nig = WGM * nN, gid = wgid / nig, fm = gid * WGM, gsz = (nM - fm) < WGM ? (nM - fm) : WGM;
    u.pm = fm + ((wgid % nig) % gsz); u.pn = (wgid % nig) / gsz; return true;
  }
};
template <class Epi, class Sched>
__device__ __forceinline__ void gemm_phase(LAS unsigned char* lds, const Gemm g, const Sched& S, const Epi& E) {
  int tid = threadIdx.x; asm volatile("" : "+v"(tid)); const int wid = __builtin_amdgcn_readfirstlane(tid >> 6), lane = tid & 63, wr = wid >> 2, wc = wid & 3, fr = lane & 15, fq = lane >> 4;
  const int nt = g.K / BK;
  unsigned voffA[2], voffB[2];
#pragma unroll
  for (int i = 0; i < 2; ++i) { int R, C; stage_rc(tid * 16 + i * 8192, R, C); const int Rb = (R & ~31) + perm32(R & 31);
    voffA[i] = (unsigned)(R * g.lda + C) * 2u; voffB[i] = (unsigned)(Rb * g.ldb + C) * 2u; }
  const size_t kstep = (size_t)(BK * 2);
  const size_t hstepA = (size_t)HALF * g.lda * 2, hstepB = (size_t)HALF * g.ldb * 2;
  const size_t tstepA = 2 * hstepA, tstepB = 2 * hstepB;
  const unsigned ldsw = (unsigned)wid * 1024u;
  const int aoff = lds_byte(wr * 64 + fr, fq * 8), boff = lds_byte(wc * 32 + fr, fq * 8);
#define PG8_SA(b, h) (((b) * 2 + (h)) * HTB)
#define PG8_SB(b, h) ((4 + (b) * 2 + (h)) * HTB)
#define PG8_STAGE(bufoff, gbase, voff) do { _Pragma("unroll") for (int _i = 0; _i < 2; ++_i) \
    __builtin_amdgcn_global_load_lds((const unsigned*)((const char*)(gbase) + (voff)[_i]), (LAS unsigned*)(lds + (bufoff) + ldsw + _i * 8192), 16, 0, 0); } while (0)
#define PG8_LDA(dst, b, h) do { _Pragma("unroll") for (int m = 0; m < 4; ++m) _Pragma("unroll") for (int k = 0; k < 2; ++k) dst[m][k] = *(const LAS bf16x8*)(lds + PG8_SA(b, h) + aoff + m * 2048 + k * 1024); } while (0)
#define PG8_LDB(dst, b, h) do { _Pragma("unroll") for (int n = 0; n < 2; ++n) _Pragma("unroll") for (int k = 0; k < 2; ++k) dst[n][k] = *(const LAS bf16x8*)(lds + PG8_SB(b, h) + boff + n * 2048 + k * 1024); } while (0)
#define PG8_MMA(ai, bj, At, Bt) do { __builtin_amdgcn_s_setprio(1); _Pragma("unroll") for (int m = 0; m < 4; ++m) _Pragma("unroll") for (int n = 0; n < 2; ++n) _Pragma("unroll") for (int k = 0; k < 2; ++k) \
    acc[ai][bj][m][n] = __builtin_amdgcn_mfma_f32_16x16x32_bf16(Bt[n][k], At[m][k], acc[ai][bj][m][n], 0, 0, 0); __builtin_amdgcn_s_setprio(0); } while (0)
#define PG8_WAIT_V(n) asm volatile("s_waitcnt vmcnt(" #n ")" ::: "memory")
#define PG8_WAIT_L(n) asm volatile("s_waitcnt lgkmcnt(" #n ")" ::: "memory")
#define PG8_BAR __builtin_amdgcn_s_barrier()
#define PG8_SCHED __builtin_amdgcn_sched_barrier(0)
  Unit cur, nxt; int ui = 0;
  if (!S.next(0, cur)) return;
  f32x4 acc[2][2][4][2];
#pragma unroll
  for (int a = 0; a < 2; ++a)
#pragma unroll
    for (int b = 0; b < 2; ++b)
#pragma unroll
      for (int m = 0; m < 4; ++m)
#pragma unroll
        for (int n = 0; n < 2; ++n) acc[a][b][m][n] = (f32x4){0.f, 0.f, 0.f, 0.f};
  bf16x8 At[4][2], B0[2][2], B1[2][2];
  const char* cA = (const char*)g.A + (size_t)S.tile_m(cur.pm) * tstepA; const char* cB = (const char*)g.Bt + (size_t)cur.pn * tstepB;
  PG8_STAGE(PG8_SB(0, 0), cB, voffB); PG8_STAGE(PG8_SB(0, 1), cB + hstepB, voffB); PG8_STAGE(PG8_SA(0, 0), cA, voffA); PG8_STAGE(PG8_SA(0, 1), cA + hstepA, voffA);
  if (wr == 1) PG8_BAR;
  PG8_WAIT_V(2); PG8_BAR;
  PG8_STAGE(PG8_SB(1, 0), cB + kstep, voffB); PG8_STAGE(PG8_SA(1, 0), cA + kstep, voffA); PG8_STAGE(PG8_SB(1, 1), cB + hstepB + kstep, voffB);
  PG8_WAIT_V(6); PG8_BAR;
  for (;;) {
    const bool has_next = S.next(ui + 1, nxt);
    const char* nA = has_next ? (const char*)g.A + (size_t)S.tile_m(nxt.pm) * tstepA : cA; const char* nB = has_next ? (const char*)g.Bt + (size_t)nxt.pn * tstepB : cB;
#pragma unroll 1
    for (int t = 0; t < nt; t += 2) {
      const bool last = (t == nt - 2);
      const int sg1 = t / g.kseg, sg2 = (t + 2) / g.kseg;
      const char* a1 = cA + (size_t)sg1 * g.segstride + (size_t)(t + 1 - sg1 * g.kseg) * kstep;
      const char* a2 = last ? nA : cA + (size_t)sg2 * g.segstride + (size_t)(t + 2 - sg2 * g.kseg) * kstep; const char* b2 = last ? nB : cB + (size_t)(t + 2) * kstep;
      const char* a3 = a2 + kstep; const char* b3 = b2 + kstep;
      PG8_LDB(B0, 0, 0); PG8_LDB(B1, 0, 1); PG8_SCHED; PG8_LDA(At, 0, 0); PG8_STAGE(PG8_SA(1, 1), a1 + hstepA, voffA);
      PG8_WAIT_V(8); PG8_WAIT_L(0); PG8_BAR; PG8_MMA(0, 0, At, B0); PG8_MMA(0, 1, At, B1); PG8_BAR; PG8_SCHED;
      PG8_LDA(At, 0, 1); PG8_STAGE(PG8_SB(0, 0), b2, voffB); PG8_STAGE(PG8_SB(0, 1), b2 + hstepB, voffB); PG8_STAGE(PG8_SA(0, 0), a2, voffA);
      PG8_WAIT_V(8); PG8_WAIT_L(0); PG8_BAR; PG8_MMA(1, 0, At, B0); PG8_MMA(1, 1, At, B1); PG8_BAR; PG8_SCHED;
      PG8_LDB(B0, 1, 0); PG8_LDB(B1, 1, 1); PG8_SCHED; PG8_LDA(At, 1, 0); PG8_STAGE(PG8_SA(0, 1), a2 + hstepA, voffA);
      PG8_WAIT_V(8); PG8_WAIT_L(0); PG8_BAR; PG8_MMA(0, 0, At, B0); PG8_MMA(0, 1, At, B1); PG8_BAR; PG8_SCHED;
      PG8_LDA(At, 1, 1); PG8_STAGE(PG8_SB(1, 0), b3, voffB); PG8_STAGE(PG8_SB(1, 1), b3 + hstepB, voffB); PG8_STAGE(PG8_SA(1, 0), a3, voffA);
      PG8_WAIT_V(8); PG8_WAIT_L(0); PG8_BAR; PG8_MMA(1, 0, At, B0); PG8_MMA(1, 1, At, B1); PG8_BAR; PG8_SCHED;
    }
    if (wr == 0) PG8_BAR;
    E(acc, S.tile_m(cur.pm), cur.pn, wr, wc, fr, fq);
    if (!has_next) break;
#pragma unroll
    for (int a = 0; a < 2; ++a)
#pragma unroll
      for (int b = 0; b < 2; ++b)
#pragma unroll
        for (int m = 0; m < 4; ++m)
#pragma unroll
          for (int n = 0; n < 2; ++n) acc[a][b][m][n] = (f32x4){0.f, 0.f, 0.f, 0.f};
    cur = nxt; cA = nA; cB = nB; ++ui;
    if (wr == 1) PG8_BAR;
  }
  PG8_WAIT_V(0);
  PG8_BAR;
#undef PG8_SA
#undef PG8_SB
#undef PG8_STAGE
#undef PG8_LDA
#undef PG8_LDB
#undef PG8_MMA
#undef PG8_WAIT_V
#undef PG8_WAIT_L
#undef PG8_BAR
#undef PG8_SCHED
}
}

struct OrderAll : pg8::StaticOrder { __device__ __forceinline__ int tile_m(int pm) const { return pm; } };

struct EpiProj {
  bf16_t* O; bf16_t* OH;
  __device__ __forceinline__ static void dest(int c32, bf16_t* O, bf16_t* OH, bf16_t*& base, int& pitch) {
    if (c32 < PC_MQ) { base = O + c32; pitch = PJR; }
    else if (c32 >= PC_ZA) { base = O + (RC_ZA + c32 - PC_ZA); pitch = PJR; }
    else if (c32 >= PC_MO && c32 < PC_GQ) { base = O + (RC_MO + c32 - PC_MO); pitch = PJR; }
    else { const int rel = c32 < PC_MO ? c32 - PC_MQ : c32 - PC_GQ + 1536; base = OH + (size_t)(rel >> 7) * PH_T + (rel & 127); pitch = 128; }
  }
  __device__ __forceinline__ void operator()(const f32x4 (&acc)[2][2][4][2], int tm, int pn, int wr, int wc, int fr, int fq) const {
    const int row0 = tm * 256 + wr * 64 + fr;
    bf16_t* b0; bf16_t* b1; int p0, p1;
    dest(__builtin_amdgcn_readfirstlane(pn * 256 + wc * 32), O, OH, b0, p0); dest(__builtin_amdgcn_readfirstlane(pn * 256 + 128 + wc * 32), O, OH, b1, p1);
#pragma unroll
    for (int ai = 0; ai < 2; ++ai)
#pragma unroll
      for (int m = 0; m < 4; ++m) { int r_ = row0; asm volatile("" : "+v"(r_) :: "memory"); const int r = r_ + ai * 128 + m * 16;
#pragma unroll
        for (int bj = 0; bj < 2; ++bj) { const f32x4 v0 = acc[ai][bj][m][0], v1 = acc[ai][bj][m][1];
          u32x4 w; w.x = cvtpk(v0[0], v0[1]); w.y = cvtpk(v0[2], v0[3]); w.z = cvtpk(v1[0], v1[1]); w.w = cvtpk(v1[2], v1[3]);
          *(u32x4*)((bj ? b1 : b0) + (size_t)r * (bj ? p1 : p0) + 8 * fq) = w; } }
  }
};


struct RowInfo { int kind  , b, t, pos; };
__device__ __forceinline__ RowInfo row_info(int r) {
  RowInfo ri;
  if (r < ROW_S) { ri.kind = 0; ri.b = r >> 12; ri.t = r & 4095; ri.pos = NMETA + ri.t; }
  else if (r < ROW_M) { ri.kind = 1; ri.b = (r - ROW_S) >> 4; ri.t = (r - ROW_S) & 15; ri.pos = NCACHE + ri.t; }
  else if (r < MROWS) { ri.kind = 2; ri.b = 0; ri.t = r - ROW_M; ri.pos = ri.t; }
  else { ri.kind = 3; ri.b = 0; ri.t = 0; ri.pos = 0; }
  return ri;
}
__device__ __forceinline__ float softplusf_(float x) { return x > 20.f ? x : __logf(1.f + __expf(x)); }
__device__ __forceinline__ float logsigmoidf_(float x) { return x >= 0.f ? -__logf(1.f + __expf(-x)) : x - __logf(1.f + __expf(x)); }

__device__ __forceinline__ void phase_rowpass(const Params& p, int l, int gw, int NGW, int lane) {
  const bf16_t* PROJ = (const bf16_t*)(p.ws + WS_PROJ);
  float* RSTD = (float*)(p.ws + WS_RSTD);
  const float* ct = (const float*)(p.ws + WS_ROPE); const float* st = ct + ROPE_N * 16;
  bf16_t* KV = (bf16_t*)(p.ws + WS_KV);
  const f32x4 kn = *(const f32x4*)(p.in[14] + (size_t)l * 256 + 4 * lane);
  for (int r0 = 2 * gw; r0 < MROWS; r0 += 2 * NGW) {
    u32x2 ck[2]; unsigned cq[2][3]; unsigned short krv[2][2]; float skv[2], sq[2];
#pragma unroll
    for (int i = 0; i < 2; ++i) { const bf16_t* pr = PROJ + (size_t)(r0 + i) * PJR;
      ck[i] = *(const u32x2*)(pr + PC_CKV + 4 * lane);
      const unsigned* cqp = (const unsigned*)(pr + PC_CQ + 6 * lane); cq[i][0] = cqp[0]; cq[i][1] = cqp[1]; cq[i][2] = cqp[2];
      krv[i][0] = pr[PC_KR + (lane & 15)]; krv[i][1] = pr[PC_KR + 16 + (lane & 15)]; }
#pragma unroll
    for (int i = 0; i < 2; ++i) { const float c0 = bflo(ck[i].x), c1 = bfhi(ck[i].x), c2 = bflo(ck[i].y), c3 = bfhi(ck[i].y); skv[i] = c0 * c0 + c1 * c1 + c2 * c2 + c3 * c3; sq[i] = 0.f;
#pragma unroll
      for (int j = 0; j < 3; ++j) { const float a = bflo(cq[i][j]), b = bfhi(cq[i][j]); sq[i] += a * a + b * b; } }
#pragma unroll
    for (int o = 1; o < 64; o <<= 1)
#pragma unroll
      for (int i = 0; i < 2; ++i) { skv[i] += __shfl_xor(skv[i], o); sq[i] += __shfl_xor(sq[i], o); }
#pragma unroll
    for (int i = 0; i < 2; ++i) {
      const int r = r0 + i; const RowInfo ri = row_info(r); const bf16_t* pr = PROJ + (size_t)r * PJR;
      const float rs_kv = rsqrtf(skv[i] * (1.f / 256.f) + EPS), rs_q = rsqrtf(sq[i] * (1.f / 384.f) + EPS);
      const f32x4 lat = {bflo(ck[i].x) * rs_kv * kn.x, bfhi(ck[i].x) * rs_kv * kn.y, bflo(ck[i].y) * rs_kv * kn.z, bfhi(ck[i].y) * rs_kv * kn.w};
      if (lane == 0) { RSTD[2 * r] = rs_q; RSTD[2 * r + 1] = rs_kv; }
      float o1 = 0.f, o2 = 0.f;
      if (lane < 16) { const float x1 = bf2f(krv[i][0]), x2 = bf2f(krv[i][1]); const float c = ct[ri.pos * 16 + lane], s = st[ri.pos * 16 + lane]; o1 = x1 * c - x2 * s; o2 = x2 * c + x1 * s; }
      if (ri.kind == 0) {
        float* ol = p.out + O_PLAT + (((size_t)l * NB + ri.b) * NCACHE + NMETA + ri.t) * 256; *(f32x4*)(ol + 4 * lane) = lat;
        if (lane < 16) { float* ok = p.out + O_PKR + (((size_t)l * NB + ri.b) * NCACHE + NMETA + ri.t) * 32; ok[lane] = o1; ok[16 + lane] = o2; }
        {
          const int k0 = 4 * (lane & 7), src = k0 & 15; float v4[4];
#pragma unroll
          for (int e = 0; e < 4; ++e) { const float a1 = __shfl(o1, src + e), a2 = __shfl(o2, src + e); v4[e] = k0 < 16 ? a1 : a2; }
          u32x2 w; w.x = cvtpk(v4[0], v4[1]); w.y = cvtpk(v4[2], v4[3]);
          *(u32x2*)(KV + ((size_t)(ri.b * 8 + (lane >> 3)) * KVROWS + 64 + ri.t) * 160 + 64 + k0) = w; }
      } else if (ri.kind == 1) {
        float* ol = p.out + O_SLAT + (((size_t)l * DB + ri.b) * DS + ri.t) * 256; *(f32x4*)(ol + 4 * lane) = lat;
        if (lane < 16) { float* ok = p.out + O_SKR + (((size_t)l * DB + ri.b) * DS + ri.t) * 32; ok[lane] = o1; ok[16 + lane] = o2; }
      } else {
        for (int b = 0; b < NB; ++b) {
          float* ol = p.out + O_PLAT + (((size_t)l * NB + b) * NCACHE + ri.t) * 256; *(f32x4*)(ol + 4 * lane) = lat;
          if (lane < 16) { float* ok = p.out + O_PKR + (((size_t)l * NB + b) * NCACHE + ri.t) * 32; ok[lane] = o1; ok[16 + lane] = o2;
#pragma unroll
            for (int h = 0; h < 8; ++h) { bf16_t* kd = KV + ((size_t)(b * 8 + h) * KVROWS + ri.t) * 160 + 64; kd[lane] = f2bf(o1); kd[16 + lane] = f2bf(o2); } }
        }
      }
      float* co = nullptr;
      if (ri.kind == 0 && ri.t >= SEQ - 3) co = p.out + O_PCONV + (((size_t)l * NB + ri.b) * 3 + (ri.t - (SEQ - 3))) * 1536;
      if (ri.kind == 1 && ri.t >= DS - 3) co = p.out + O_SCONV + (((size_t)l * DB + ri.b) * 3 + (ri.t - (DS - 3))) * 1536;
      if (co) { const bf16_t* ph = (const bf16_t*)(p.ws + WS_PROJH) + (size_t)(12 + (lane >> 4)) * PH_T + (size_t)r * 128 + 8 * (lane & 15);
        for (int c = lane * 8; c < 1536; c += 512) { const u32x4 w = *(const u32x4*)(ph + (size_t)(c >> 9) * 4 * PH_T);
          *(f32x4*)(co + c) = (f32x4){bflo(w.x), bfhi(w.x), bflo(w.y), bfhi(w.y)}; *(f32x4*)(co + c + 4) = (f32x4){bflo(w.z), bfhi(w.z), bflo(w.w), bfhi(w.w)}; } }
    }
  }
}

struct OrderTail : pg8::StaticOrder { __device__ __forceinline__ int tile_m(int pm) const { return 128 + pm; } };
struct OrderKV : pg8::StaticOrder { __device__ __forceinline__ int tile_m(int pm) const { return pm < 128 ? pm : 130; } };

struct EpiQ {
  const float* rstd; const float* ct; const float* st; bf16_t* QATT; bf16_t* QMETA; bf16_t* QS;
  __device__ __forceinline__ void operator()(const f32x4 (&acc)[2][2][4][2], int tm, int pn, int wr, int wc, int fr, int fq) const {
    float rsv[2][4];
#pragma unroll
    for (int ai = 0; ai < 2; ++ai)
#pragma unroll
      for (int m = 0; m < 4; ++m) { const int r = tm * 256 + ai * 128 + wr * 64 + m * 16 + fr; rsv[ai][m] = r < MROWS ? rstd[2 * r] : 0.f; }
#pragma unroll
    for (int ai = 0; ai < 2; ++ai)
#pragma unroll
      for (int m = 0; m < 4; ++m) {
        int fr_ = fr; asm volatile("" : "+v"(fr_) :: "memory");
        const int r = tm * 256 + ai * 128 + wr * 64 + m * 16 + fr_; const RowInfo ri = row_info(r);
        const float rs = rsv[ai][m];
        bf16_t* dst; int hstride;
        if (ri.kind == 0) { dst = QATT + ((size_t)(ri.b * 8) * SEQ + ri.t) * 96; hstride = SEQ * 96; }
        else if (ri.kind == 1) { dst = QS + (size_t)(r - ROW_S) * 768; hstride = 96; }
        else { dst = QMETA + (size_t)ri.t * 96; hstride = 256 * 96; }
#pragma unroll
        for (int bj = 0; bj < 2; ++bj) {
          const int gb = pn * 256 + bj * 128 + wc * 32; const int h = gb / 96, gm = gb - h * 96;
          float v[8];
#pragma unroll
          for (int j = 0; j < 4; ++j) { v[j] = acc[ai][bj][m][0][j] * rs; v[4 + j] = acc[ai][bj][m][1][j] * rs; }
          if (gm == 64) {
            const float* cp = ct + ri.pos * 16 + 8 * (fq & 1); const float* sp = st + ri.pos * 16 + 8 * (fq & 1);
            const f32x4 c0 = *(const f32x4*)cp, c1 = *(const f32x4*)(cp + 4), s0 = *(const f32x4*)sp, s1 = *(const f32x4*)(sp + 4);
            const float sg = fq < 2 ? -1.f : 1.f;
#pragma unroll
            for (int j = 0; j < 8; ++j) { const float pv = __shfl_xor(v[j], 32); const float c = j < 4 ? c0[j & 3] : c1[j & 3], s = j < 4 ? s0[j & 3] : s1[j & 3];
              v[j] = v[j] * c + sg * pv * s; }
          }
          u32x4 w; w.x = cvtpk(v[0], v[1]); w.y = cvtpk(v[2], v[3]); w.z = cvtpk(v[4], v[5]); w.w = cvtpk(v[6], v[7]);
          if (ri.kind != 3) *(u32x4*)(dst + (size_t)h * hstride + gm + 8 * fq) = w;
        }
      }
  }
};

struct EpiKV {
  const float* rstd; bf16_t* KV;
  __device__ __forceinline__ void operator()(const f32x4 (&acc)[2][2][4][2], int tm, int pn, int wr, int wc, int fr, int fq) const {
#pragma unroll
    for (int ai = 0; ai < 2; ++ai)
#pragma unroll
      for (int m = 0; m < 4; ++m) {
        int fr_ = fr; asm volatile("" : "+v"(fr_) :: "memory");
        const int r = tm * 256 + ai * 128 + wr * 64 + m * 16 + fr_; const RowInfo ri = row_info(r);
        if (ri.kind != 0 && ri.kind != 2) continue;
        const float rs = rstd[2 * r + 1];
#pragma unroll
        for (int bj = 0; bj < 2; ++bj) {
          const int col0 = pn * 256 + bj * 128 + wc * 32 + 8 * fq; const int isv = col0 >= 512; const int cc = col0 & 511; const int h = cc >> 6, d0 = (cc & 63) + (isv ? 96 : 0);
          const f32x4 v0 = acc[ai][bj][m][0] * rs, v1 = acc[ai][bj][m][1] * rs;
          u32x4 w; w.x = cvtpk(v0[0], v0[1]); w.y = cvtpk(v0[2], v0[3]); w.z = cvtpk(v1[0], v1[1]); w.w = cvtpk(v1[2], v1[3]);
          if (ri.kind == 0) *(u32x4*)(KV + ((size_t)(ri.b * 8 + h) * KVROWS + 64 + ri.t) * 160 + d0) = w;
          else for (int b = 0; b < NB; ++b) *(u32x4*)(KV + ((size_t)(b * 8 + h) * KVROWS + ri.t) * 160 + d0) = w;
        }
        asm volatile("" ::: "memory");
      }
  }
};

struct AttnUnit { const bf16_t* q; const bf16_t* kv; int ntiles, chunk0, nq_valid, out_row0, h, is_meta; };
constexpr int AT_KP = 208, AT_VP = 192, AT_KB = 64 * AT_KP, AT_STAGE = AT_KB + 64 * AT_VP;
typedef short v4i16_t __attribute__((ext_vector_type(4)));

__device__ __forceinline__ void attn_unit(LAS unsigned char* lds, const AttnUnit u, const bf16_t* PROJ, bf16_t* OA, int tid, unsigned char* p_ws_probe = nullptr) {
  asm volatile("" : "+v"(tid));
  const int lane = tid & 63, w = tid >> 6, r32 = lane & 31, hi = lane >> 5;
  const int jmax = u.is_meta ? 0 : (1 + u.chunk0 + (w >> 1));
  bf16x8 qf[6];
  { const bf16_t* qp = u.q + (size_t)(32 * w + r32) * 96 + 8 * hi;
#pragma unroll
    for (int s = 0; s < 6; ++s) qf[s] = *(const bf16x8*)(qp + 16 * s); }
  f32x16 o0, o1;
#pragma unroll
  for (int i = 0; i < 16; ++i) { o0[i] = 0.f; o1[i] = 0.f; }
  float mrun = -INFINITY, lrun = 0.f;
  u32x4 sA0, sA1, sA2, sB0, sB1, sB2; sA2 = (u32x4){0u, 0u, 0u, 0u}; sB2 = sA2;
  auto lds_off = [](int c) { const int row = c / 20, cc = c - row * 20; return cc < 12 ? row * AT_KP + cc * 16 : AT_KB + row * AT_VP + (cc - 12) * 16; };
  const int off0 = lds_off(tid), off1 = lds_off(tid + 512), off2 = lds_off(tid < 256 ? tid + 1024 : 0);
#define AT_LOAD(S0, S1, S2, TILE) do { const u32x4* g_ = (const u32x4*)(u.kv + (size_t)(TILE) * 64 * 160); S0 = g_[tid]; S1 = g_[tid + 512]; if (tid < 256) S2 = g_[tid + 1024]; } while (0)
#define AT_STORE(S0, S1, S2, STG) do { LAS unsigned char* nb_ = lds + (STG) * AT_STAGE; *(LAS u32x4*)(nb_ + off0) = S0; *(LAS u32x4*)(nb_ + off1) = S1; if (tid < 256) *(LAS u32x4*)(nb_ + off2) = S2; } while (0)
  AT_LOAD(sB0, sB1, sB2, 0); AT_STORE(sB0, sB1, sB2, 0);
  if (u.ntiles > 1) AT_LOAD(sA0, sA1, sA2, 1);
  if (u.ntiles > 2) AT_LOAD(sB0, sB1, sB2, 2);
  __syncthreads();
  const int koff = r32 * AT_KP + 16 * hi;
  const int l16 = lane & 15, cg = (lane >> 4) & 1;
  const int voff = AT_KB + (4 * hi + (l16 >> 2)) * AT_VP + (16 * cg + 4 * (l16 & 3)) * 2;
#if PROBE_LEVEL == 2
  unsigned long long tl_ = __builtin_amdgcn_s_memrealtime(), aa_[4] = {0ull, 0ull, 0ull, 0ull};
#define AA_T(i) do { const unsigned long long t_ = __builtin_amdgcn_s_memrealtime(); aa_[i] += t_ - tl_; tl_ = t_; } while (0)
#else
#define AA_T(i) do {} while (0)
#endif
  auto compute_tile = [&](int j) {
    LAS unsigned char* sb = lds + (j & 1) * AT_STAGE;
    AA_T(3);
    if (j <= jmax) {
      const float mref = mrun > -1e30f ? mrun : 0.f;
      f32x16 p0, p1;
#pragma unroll
      for (int i = 0; i < 16; ++i) { p0[i] = -mref; p1[i] = -mref; }
      bf16x8 kf0[6], kf1[6];
#pragma unroll
      for (int s = 0; s < 6; ++s) { kf0[s] = *(const LAS bf16x8*)(sb + koff + s * 32); kf1[s] = *(const LAS bf16x8*)(sb + koff + 32 * AT_KP + s * 32); }
      v4i16_t va0[4], va1[4], vb0[4], vb1[4];
#pragma unroll
      for (int ks = 0; ks < 4; ++ks) {
        va0[ks] = __builtin_amdgcn_ds_read_tr16_b64_v4i16((LAS v4i16_t*)(sb + voff + ks * 16 * AT_VP));
        va1[ks] = __builtin_amdgcn_ds_read_tr16_b64_v4i16((LAS v4i16_t*)(sb + voff + ks * 16 * AT_VP + 8 * AT_VP));
        vb0[ks] = __builtin_amdgcn_ds_read_tr16_b64_v4i16((LAS v4i16_t*)(sb + voff + ks * 16 * AT_VP + 64));
        vb1[ks] = __builtin_amdgcn_ds_read_tr16_b64_v4i16((LAS v4i16_t*)(sb + voff + ks * 16 * AT_VP + 8 * AT_VP + 64)); }
      __builtin_amdgcn_sched_barrier(0);
#pragma unroll
      for (int s = 0; s < 6; ++s) {
        p0 = __builtin_amdgcn_mfma_f32_32x32x16_bf16(kf0[s], qf[s], p0, 0, 0, 0);
        p1 = __builtin_amdgcn_mfma_f32_32x32x16_bf16(kf1[s], qf[s], p1, 0, 0, 0);
      }
      asm volatile("" :: "v"(p0), "v"(p1)); AA_T(0);
      if (j == 0) {
#pragma unroll
        for (int i = 8; i < 16; ++i) p0[i] = -INFINITY;
#pragma unroll
        for (int i = 0; i < 16; ++i) p1[i] = -INFINITY;
      }
      float tm = p0[0];
#pragma unroll
      for (int i = 1; i < 16; ++i) tm = fmaxf(tm, p0[i]);
#pragma unroll
      for (int i = 0; i < 16; ++i) tm = fmaxf(tm, p1[i]);
      tm = fmaxf(tm, __shfl_xor(tm, 32));
      if (!__all(tm + (mref - mrun) <= 6.0f)) {
        const float mnew = fmaxf(mrun, tm + mref); const float alpha = __builtin_amdgcn_exp2f(mrun - mnew); mrun = mnew; lrun *= alpha;
        const float shift = mnew - mref;
#pragma unroll
        for (int i = 0; i < 16; ++i) { o0[i] *= alpha; o1[i] *= alpha; p0[i] -= shift; p1[i] -= shift; }
      }
      float ps = 0.f;
#pragma unroll
      for (int i = 0; i < 16; ++i) { p0[i] = __builtin_amdgcn_exp2f(p0[i]); p1[i] = __builtin_amdgcn_exp2f(p1[i]); ps += p0[i] + p1[i]; }
      lrun += ps;
      AA_T(1);
      bf16x8 pb[4];
#pragma unroll
      for (int s = 0; s < 2; ++s) {
        u32x4 a, b;
        a.x = cvtpk(p0[8 * s + 0], p0[8 * s + 1]); a.y = cvtpk(p0[8 * s + 2], p0[8 * s + 3]); a.z = cvtpk(p0[8 * s + 4], p0[8 * s + 5]); a.w = cvtpk(p0[8 * s + 6], p0[8 * s + 7]);
        b.x = cvtpk(p1[8 * s + 0], p1[8 * s + 1]); b.y = cvtpk(p1[8 * s + 2], p1[8 * s + 3]); b.z = cvtpk(p1[8 * s + 4], p1[8 * s + 5]); b.w = cvtpk(p1[8 * s + 6], p1[8 * s + 7]);
        pb[s] = __builtin_bit_cast(bf16x8, a); pb[2 + s] = __builtin_bit_cast(bf16x8, b);
      }
#pragma unroll
      for (int ks = 0; ks < 4; ++ks) {
        const bf16x8 va = {va0[ks][0], va0[ks][1], va0[ks][2], va0[ks][3], va1[ks][0], va1[ks][1], va1[ks][2], va1[ks][3]};
        const bf16x8 vb = {vb0[ks][0], vb0[ks][1], vb0[ks][2], vb0[ks][3], vb1[ks][0], vb1[ks][1], vb1[ks][2], vb1[ks][3]};
        o0 = __builtin_amdgcn_mfma_f32_32x32x16_bf16(va, pb[ks], o0, 0, 0, 0);
        o1 = __builtin_amdgcn_mfma_f32_32x32x16_bf16(vb, pb[ks], o1, 0, 0, 0);
      }
      asm volatile("" :: "v"(o0), "v"(o1)); AA_T(2);
    }
  };
  for (int j = 0; j < u.ntiles; j += 2) {
    compute_tile(j);
    if (j + 1 < u.ntiles) AT_STORE(sA0, sA1, sA2, (j + 1) & 1);
    if (j + 3 < u.ntiles) AT_LOAD(sA0, sA1, sA2, j + 3);
    __syncthreads();
    if (j + 1 >= u.ntiles) break;
    compute_tile(j + 1);
    if (j + 2 < u.ntiles) AT_STORE(sB0, sB1, sB2, j & 1);
    if (j + 4 < u.ntiles) AT_LOAD(sB0, sB1, sB2, j + 4);
    __syncthreads();
  }
#undef AT_LOAD
#undef AT_STORE
#if PROBE_LEVEL == 2
  if (tid == 448 && blockIdx.x == 200) { for (int i = 0; i < 4; ++i) ((unsigned long long*)(p_ws_probe + WS_CTL + 2048))[4 + i] += aa_[i]; }
#endif
  const float ltot = lrun + __shfl_xor(lrun, 32); const float inv = 1.f / ltot;
  const int qi = 32 * w + r32;
  if (qi < u.nq_valid) {
    const bf16_t* zr = PROJ + (size_t)(u.out_row0 + qi) * PJR + RC_ZA + u.h * 64; bf16_t* orow = OA + (size_t)(u.out_row0 + qi) * 512 + u.h * 64;
#pragma unroll
    for (int dvt = 0; dvt < 2; ++dvt)
#pragma unroll
      for (int g = 0; g < 4; ++g) {
        const int dv0 = 32 * dvt + 8 * g + 4 * hi; u32x2 z = *(const u32x2*)(zr + dv0);
        float v[4];
#pragma unroll
        for (int e = 0; e < 4; ++e) v[e] = (dvt ? o1[4 * g + e] : o0[4 * g + e]) * inv;
        z.x = cvtpk(v[0] * siluf_(bflo(z.x)), v[1] * siluf_(bfhi(z.x))); z.y = cvtpk(v[2] * siluf_(bflo(z.y)), v[3] * siluf_(bfhi(z.y)));
        *(u32x2*)(orow + dv0) = z;
      }
  }
  __syncthreads();
}

constexpr int NSLOT = 32 * 65 + 128;
constexpr int MSLOT_B = 57344 + 2048;
constexpr int GSLOT_B = 73728 + 256;
constexpr int MS_Q = 0, MS_QK = 8192, MS_KHT = 12288, MS_VT = 20480, MS_SC_B = 57344;
constexpr int MSC_B = 0, MSC_MLOC = 64, MSC_RS = 128, MSC_DN = 192, MSC_A = 320, MSC_BB = 321;
constexpr int GS_NW = 0, GS_QT = 8192, GS_QK = 16384, GS_KTT = 20480, GS_UT = 28672, GS_SC_B = 73728;
constexpr size_t WS_MSLOT = WS_END0;
constexpr size_t WS_GSLOT = al256(WS_MSLOT + (size_t)NSLOT * MSLOT_B);
constexpr size_t WS_HM = WS_XN;
constexpr size_t WS_OG = WS_XN + SEG_B;
constexpr size_t WS_END1 = al256(WS_GSLOT + (size_t)NSLOT * GSLOT_B);

struct ChunkDesc { int row0, nvalid, kind  , b, h, tok0; };
__device__ __forceinline__ ChunkDesc chunk_of_slot(int slot) {
  ChunkDesc c;
  if (slot < 32 * 65) { const int ch = slot / 65, ci = slot - ch * 65; c.b = ch >> 2; c.h = ch & 3;
    if (ci == 0) { c.kind = 2; c.row0 = ROW_M; c.nvalid = 16; c.tok0 = 0; } else { c.kind = 0; c.row0 = c.b * SEQ + 64 * (ci - 1); c.nvalid = 64; c.tok0 = 64 * (ci - 1); } }
  else { const int ch = slot - 32 * 65; c.b = ch >> 2; c.h = ch & 3; c.kind = 1; c.row0 = ROW_S + 16 * c.b; c.nvalid = 16; c.tok0 = 0; }
  return c;
}
#define SCAN_DPP(old, src, ctrl, rmask) __int_as_float(__builtin_amdgcn_update_dpp(__float_as_int(old), __float_as_int(src), ctrl, rmask, 0xF, false))
__device__ __forceinline__ float scan_add(float v, int lane) {
  (void)lane;
  v += SCAN_DPP(0.f, v, 0x111, 0xF); v += SCAN_DPP(0.f, v, 0x112, 0xF); v += SCAN_DPP(0.f, v, 0x114, 0xF); v += SCAN_DPP(0.f, v, 0x118, 0xF);
  v += SCAN_DPP(0.f, v, 0x142, 0xA); v += SCAN_DPP(0.f, v, 0x143, 0xC);
  return v;
}
__device__ __forceinline__ float scan_max(float v, int lane) {
  (void)lane;
  v = fmaxf(v, SCAN_DPP(-INFINITY, v, 0x111, 0xF)); v = fmaxf(v, SCAN_DPP(-INFINITY, v, 0x112, 0xF)); v = fmaxf(v, SCAN_DPP(-INFINITY, v, 0x114, 0xF)); v = fmaxf(v, SCAN_DPP(-INFINITY, v, 0x118, 0xF));
  v = fmaxf(v, SCAN_DPP(-INFINITY, v, 0x142, 0xA)); v = fmaxf(v, SCAN_DPP(-INFINITY, v, 0x143, 0xC));
  return v;
}
__device__ __forceinline__ float wave_max(float v) { return __int_as_float(__builtin_amdgcn_readlane(__float_as_int(scan_max(v, 0)), 63)); }
__device__ __forceinline__ int kperm_pos(int k) { return (k & ~31) | (((k >> 2) & 3) << 3) | (((k >> 4) & 1) << 2) | (k & 3); }
__device__ __forceinline__ void store_perm8(bf16_t* rowbase, int k0, const u32x4& o) { u32x2 lo = {o.x, o.y}, hi = {o.z, o.w}; const int p0 = kperm_pos(k0); *(u32x2*)(rowbase + p0) = lo; *(u32x2*)(rowbase + p0 + 8) = hi; }
__device__ __forceinline__ float sum8(float v) { v += __shfl_xor(v, 1); v += __shfl_xor(v, 2); v += __shfl_xor(v, 4); return v; }

__device__ __forceinline__ void lds_barrier() { asm volatile("s_waitcnt lgkmcnt(0)\n\ts_barrier" ::: "memory"); }
#if PROBE_LEVEL == 2
#define PP_INIT() unsigned long long tl_ = __builtin_amdgcn_s_memrealtime()
#define PP_T(blk, i) do { lds_barrier(); if (tid == 0 && blockIdx.x == (blk)) { const unsigned long long t_ = __builtin_amdgcn_s_memrealtime(); ((unsigned long long*)(p.ws + WS_CTL + 2048))[(i)] += t_ - tl_; tl_ = t_; } } while (0)
#else
#define PP_INIT() do {} while (0)
#define PP_T(blk, i) do {} while (0)
#endif
constexpr int MP_IMG = 52224, MP_QK = 2 * MP_IMG, MP_SC = MP_QK + 17408, MP_G = MP_SC + 1536;
__device__ __forceinline__ bool prep_slot_skipped(int slot) { return slot < 32 * 65 && slot % 65 == 0 && slot >= 4 * 65; }
__device__ __forceinline__ int prep_next_slot(int slot, int G) { for (slot += G; slot < NSLOT; slot += G) if (!prep_slot_skipped(slot)) return slot; return NSLOT; }
__device__ __forceinline__ void mlstm_issue(LAS unsigned char* lds, const Params& p, int slot, int buf, int tid) {
  const ChunkDesc cd = chunk_of_slot(slot);
  const bf16_t* PROJ = (const bf16_t*)(p.ws + WS_PROJ); const bf16_t* PROJH = (const bf16_t*)(p.ws + WS_PROJH);
  const unsigned char* zero = p.ws + WS_ZERO;
  const int wu = __builtin_amdgcn_readfirstlane(tid >> 6), lane = tid & 63;
#pragma unroll
  for (int it = 0; it < 7; ++it) { const int k = wu + 8 * it;
    if (k < 51) { const int ten = k / 17, i = k - 17 * ten; const int o = i * 1024 + lane * 16, row = o / 272, col = o - row * 272;
      const unsigned char* src = (row < cd.nvalid && col < 256) ? (const unsigned char*)(PROJH + (size_t)(ten * 4 + cd.h) * PH_T + (size_t)(cd.row0 + row) * 128) + col : zero;
      __builtin_amdgcn_global_load_lds((const unsigned*)src, (LAS unsigned*)(lds + buf * MP_IMG + ten * 17408 + i * 1024), 16, 0, 0); } }
  if (wu == 3) { const unsigned char* src = lane < cd.nvalid ? (const unsigned char*)(PROJ + (size_t)(cd.row0 + lane) * PJR + PC_G16) : zero;
    __builtin_amdgcn_global_load_lds((const unsigned*)src, (LAS unsigned*)(lds + MP_G + buf * 1024), 16, 0, 0); }
}
__device__ __forceinline__ void mlstm_prep(LAS unsigned char* lds, const Params& p, int l, int slot, int buf, float bias_i, float bias_f, int tid) {
  asm volatile("" : "+v"(tid));
  PP_INIT();
  const ChunkDesc cd = chunk_of_slot(slot);
  bf16_t* SL = (bf16_t*)(p.ws + WS_MSLOT + (size_t)slot * MSLOT_B); float* SC = (float*)(p.ws + WS_MSLOT + (size_t)slot * MSLOT_B + MS_SC_B);
  const int lane = tid & 63, w = tid >> 6, c16 = lane & 15, q4 = lane >> 4;
  const int L_Q = buf * MP_IMG, L_K = L_Q + 17408, L_V = L_Q + 34816; constexpr int L_QK = MP_QK, L_SC = MP_SC;
  LAS float* sc = (LAS float*)(lds + L_SC);
  if (w == 0) {
    float ig = -INFINITY, fg = 0.f;
    if (lane < cd.nvalid) { const LAS bf16_t* gr = (const LAS bf16_t*)(lds + MP_G + buf * 1024 + lane * 16);
      ig = bf2f(gr[cd.h]) + bias_i; fg = logsigmoidf_(bf2f(gr[4 + cd.h]) + bias_f); }
    const float b = scan_add(fg, lane); const float g = ig - b; const float cm = scan_max(g, lane); const float gmax = __int_as_float(__builtin_amdgcn_readlane(__float_as_int(cm), 63)); const float blast = __int_as_float(__builtin_amdgcn_readlane(__float_as_int(b), 63));
    sc[lane] = b; sc[64 + lane] = g; sc[128 + lane] = b + cm; sc[192 + lane] = __expf(g - gmax);
    SC[MSC_B + lane] = b; SC[MSC_MLOC + lane] = b + cm;
    if (lane == 0) { SC[MSC_A] = blast + gmax; SC[MSC_BB] = blast; }
  }
  if (tid >= 64 && tid < 192) sc[256 + tid - 64] = 0.f;
  lds_barrier();
  PP_T(0, 8);
#pragma unroll
  for (int ti = 0; ti < 2; ++ti) { const int id = 2 * w + ti, tm = id >> 2, tn = id & 3; f32x4 acc = {0.f, 0.f, 0.f, 0.f};
#pragma unroll
    for (int kk = 0; kk < 4; ++kk) { const bf16x8 a = *(const LAS bf16x8*)(lds + L_Q + (16 * tm + c16) * 272 + (32 * kk + 8 * q4) * 2);
      const bf16x8 b = *(const LAS bf16x8*)(lds + L_K + (16 * tn + c16) * 272 + (32 * kk + 8 * q4) * 2);
      acc = __builtin_amdgcn_mfma_f32_16x16x32_bf16(a, b, acc, 0, 0, 0); }
    const int s = 16 * tn + c16; const float gs = sc[64 + s];
#pragma unroll
    for (int i = 0; i < 4; ++i) { const int t = 16 * tm + 4 * q4 + i; const float e = (s <= t) ? __expf(sc[t] + gs - sc[128 + t]) : 0.f;
      ((LAS float*)(lds + L_QK))[t * 68 + s] = (s <= t) ? acc[i] * e : 0.f; } }
  asm volatile("s_waitcnt vmcnt(0)" ::: "memory");
  lds_barrier();
  PP_T(0, 9);
  { const int row = tid >> 3, c8 = tid & 7; const LAS float* qr = (const LAS float*)(lds + L_QK) + row * 68 + c8 * 8; float v[8]; float rs = 0.f;
#pragma unroll
    for (int j = 0; j < 8; ++j) { v[j] = qr[j]; rs += v[j]; }
    u32x4 o; o.x = cvtpk(v[0], v[1]); o.y = cvtpk(v[2], v[3]); o.z = cvtpk(v[4], v[5]); o.w = cvtpk(v[6], v[7]);
    *(u32x4*)(SL + MS_QK + row * 64 + c8 * 8) = o; rs = sum8(rs); if (c8 == 0) SC[MSC_RS + row] = rs; }
#pragma unroll
  for (int k = 0; k < 2; ++k) { const int ci = tid + 512 * k, row = ci >> 4, c = ci & 15; const u32x4 qv = *(const LAS u32x4*)(lds + L_Q + row * 272 + c * 16); store_perm8(SL + MS_Q + row * 128, c * 8, qv); }
#pragma unroll
  for (int k = 0; k < 2; ++k) { const int id = tid + 512 * k, d = id & 127, s8 = id >> 7; float kv[8], vv[8]; float dsum = 0.f;
#pragma unroll
    for (int j = 0; j < 8; ++j) { const int s = 8 * s8 + j; kv[j] = bf2f(*(const LAS bf16_t*)(lds + L_K + s * 272 + d * 2)) * sc[192 + s]; vv[j] = bf2f(*(const LAS bf16_t*)(lds + L_V + s * 272 + d * 2)); }
    u32x4 o; o.x = cvtpk(kv[0], kv[1]); o.y = cvtpk(kv[2], kv[3]); o.z = cvtpk(kv[4], kv[5]); o.w = cvtpk(kv[6], kv[7]);
    dsum = bflo(o.x) + bfhi(o.x) + bflo(o.y) + bfhi(o.y) + bflo(o.z) + bfhi(o.z) + bflo(o.w) + bfhi(o.w);
    *(u32x4*)(SL + MS_KHT + d * 64 + 8 * s8) = o; atomicAdd((float*)(sc + 256 + d), dsum);
    u32x4 ov; ov.x = cvtpk(vv[0], vv[1]); ov.y = cvtpk(vv[2], vv[3]); ov.z = cvtpk(vv[4], vv[5]); ov.w = cvtpk(vv[6], vv[7]);
    *(u32x4*)(SL + MS_VT + d * 64 + 8 * s8) = ov; }
  lds_barrier();
  if (tid < 128) SC[MSC_DN + tid] = sc[256 + tid];
  PP_T(0, 10);
}

__device__ __forceinline__ void gdn_conv_taps(const Params& p, int l, const ChunkDesc& cd, int t, int col  , float (&x)[4][8]) {
  const bf16_t* PROJ = (const bf16_t*)(p.ws + WS_PROJ);
#pragma unroll
  for (int j = 0; j < 4; ++j) {
    const int T = cd.tok0 + t - 3 + j; int row = -1; const float* fsrc = nullptr;
    if (T >= 0) row = (cd.kind == 0 ? cd.b * SEQ : (cd.kind == 1 ? ROW_S + 16 * cd.b : ROW_M)) + T;
    else if (cd.kind == 0) row = ROW_M + 16 + T;
    else if (cd.kind == 1) fsrc = p.in[8] + (((size_t)l * DB + cd.b) * 3 + (3 + T)) * 1536 + col;
    if (row >= 0) { const u32x4 w = *(const u32x4*)((const bf16_t*)(p.ws + WS_PROJH) + (size_t)(12 + (col >> 7)) * PH_T + (size_t)row * 128 + (col & 127));
      x[j][0] = bflo(w.x); x[j][1] = bfhi(w.x); x[j][2] = bflo(w.y); x[j][3] = bfhi(w.y); x[j][4] = bflo(w.z); x[j][5] = bfhi(w.z); x[j][6] = bflo(w.w); x[j][7] = bfhi(w.w); }
    else if (fsrc) { const f32x4 a = *(const f32x4*)fsrc, b = *(const f32x4*)(fsrc + 4); x[j][0] = a.x; x[j][1] = a.y; x[j][2] = a.z; x[j][3] = a.w; x[j][4] = b.x; x[j][5] = b.y; x[j][6] = b.z; x[j][7] = b.w; }
    else {
#pragma unroll
      for (int e = 0; e < 8; ++e) x[j][e] = 0.f; }
  }
}

constexpr int GP_IMG_T = 67 * 272, GP_IMG = 54 * 1024;
__device__ __forceinline__ int gdn_queue_slot(int idx) {
  if (idx < 260) return idx;
  if (idx < 2052) { const int r = idx - 260; return 65 * (4 + (r >> 6)) + 1 + (r & 63); }
  if (idx < 2180) return 2080 + (idx - 2052);
  return NSLOT;
}
__device__ __forceinline__ bool gdn_slot_interior(int slot) { return slot < 32 * 65 && (slot % 65) >= 2; }
__device__ __forceinline__ void gdn_issue(LAS unsigned char* lds, const Params& p, int slot, int tid) {
  const ChunkDesc cd = chunk_of_slot(slot);
  const unsigned char* zero = p.ws + WS_ZERO;
  const unsigned char* src0 = (const unsigned char*)((const bf16_t*)(p.ws + WS_PROJH) + (size_t)(12 + cd.h) * PH_T + (size_t)(cd.b * SEQ + cd.tok0 - 3) * 128);
  const int wu = __builtin_amdgcn_readfirstlane(tid >> 6), lane = tid & 63;
#pragma unroll
  for (int it = 0; it < 7; ++it) { const int k = wu + 8 * it;
    if (k < 54) { const int o = k * 1024 + lane * 16, ten = o / GP_IMG_T, rem = o - ten * GP_IMG_T, row = rem / 272, col = rem - row * 272;
      const unsigned char* src = (ten < 3 && col < 256) ? src0 + (size_t)ten * (4 * PH_T * 2) + row * 256 + col : zero;
      __builtin_amdgcn_global_load_lds((const unsigned*)src, (LAS unsigned*)(lds + k * 1024), 16, 0, 0); } }
}
__device__ __forceinline__ void gdn_prep(LAS unsigned char* lds, const Params& p, int l, int slot, bool have_img, int next_slot, int tid) {
  asm volatile("" : "+v"(tid));
  PP_INIT();
  const ChunkDesc cd = chunk_of_slot(slot);
  const bf16_t* PROJ = (const bf16_t*)(p.ws + WS_PROJ);
  bf16_t* SL = (bf16_t*)(p.ws + WS_GSLOT + (size_t)slot * GSLOT_B); float* SC = (float*)(p.ws + WS_GSLOT + (size_t)slot * GSLOT_B + GS_SC_B);
  const int lane = tid & 63, w = tid >> 6, c16 = lane & 15, q4 = lane >> 4;
  constexpr int RT_P = 528; constexpr int L_Q = 0, L_K = 17408, L_QK = 34816, L_RT = 55296  , L_AM = 89088, L_T = 106496, L_TB = 123904, L_CW = 133120, L_SC = 139264, L_M = 139776;
  LAS float* sc = (LAS float*)(lds + L_SC);
  LAS float* AM = (LAS float*)(lds + L_AM); LAS float* QKf = (LAS float*)(lds + L_QK); LAS float* T = (LAS float*)(lds + L_T);
  LAS float* CW = (LAS float*)(lds + L_CW); LAS float* MB = (LAS float*)(lds + L_M);
  const int t = tid >> 3, part = tid & 7;
  u32x4 xin[3][2][4];
  if (cd.kind == 0 && cd.tok0 > 0) {
    if (!have_img) { gdn_issue(lds, p, slot, tid); asm volatile("s_waitcnt vmcnt(0)" ::: "memory"); }
    lds_barrier();
    const LAS unsigned char* ib = lds + t * 272 + part * 32;
#pragma unroll
    for (int j = 0; j < 4; ++j)
#pragma unroll
      for (int ten = 0; ten < 3; ++ten)
#pragma unroll
        for (int hh = 0; hh < 2; ++hh) xin[ten][hh][j] = *(const LAS u32x4*)(ib + ten * GP_IMG_T + j * 272 + 16 * hh);
  } else {
#pragma unroll
    for (int j = 0; j < 4; ++j) {
      const int Tt = cd.tok0 + t - 3 + j; int row = -1; const float* fsrc = nullptr;
      if (Tt >= 0) row = (cd.kind == 0 ? cd.b * SEQ : (cd.kind == 1 ? ROW_S + 16 * cd.b : ROW_M)) + Tt;
      else if (cd.kind == 0) row = ROW_M + 16 + Tt;
      else if (cd.kind == 1) fsrc = p.in[8] + (((size_t)l * DB + cd.b) * 3 + (3 + Tt)) * 1536;
#pragma unroll
      for (int ten = 0; ten < 3; ++ten)
#pragma unroll
        for (int hh = 0; hh < 2; ++hh) { const int col = ten * 512 + cd.h * 128 + 16 * part + 8 * hh; u32x4 v = {0u, 0u, 0u, 0u};
          if (row >= 0) v = *(const u32x4*)((const bf16_t*)(p.ws + WS_PROJH) + (size_t)(12 + (col >> 7)) * PH_T + (size_t)row * 128 + (col & 127));
          else if (fsrc) { const f32x4 a = *(const f32x4*)(fsrc + col), b = *(const f32x4*)(fsrc + col + 4); v.x = cvtpk(a.x, a.y); v.y = cvtpk(a.z, a.w); v.z = cvtpk(b.x, b.y); v.w = cvtpk(b.z, b.w); }
          xin[ten][hh][j] = v; }
    }
  }
  if (w == 0) {
    float ld = 0.f, be = 0.f;
    if (lane < cd.nvalid) { const bf16_t* pr = PROJ + (size_t)(cd.row0 + lane) * PJR + PC_G16;
      ld = -__expf(p.in[20][l * 4 + cd.h]) * softplusf_(bf2f(pr[8 + cd.h]) + p.in[21][l * 4 + cd.h]); be = sigmoidf_(bf2f(pr[12 + cd.h])); }
    const float G = scan_add(ld, lane); sc[lane] = G; sc[64 + lane] = be;
    MB[lane] = __expf(__int_as_float(__builtin_amdgcn_readlane(__float_as_int(G), 63)) - G);
    if (lane == 63) SC[0] = __expf(G);
  } else if (tid < 64 + 384) { const int i = tid - 64, ten = i >> 7, j = (i >> 5) & 3, c4 = i & 31;
    *(LAS f32x4*)(CW + (ten * 4 + j) * 128 + 4 * c4) = *(const f32x4*)(p.in[19] + ((size_t)l * 4 + j) * 1536 + ten * 512 + cd.h * 128 + 4 * c4); }
  lds_barrier();
  PP_T(1, 0);
  { const float G = sc[t], be = sc[64 + t], eG = __expf(G);
#pragma unroll
    for (int ten = 0; ten < 3; ++ten) {
      float y[16];
#pragma unroll
      for (int hh = 0; hh < 2; ++hh) {
        float a[8];
#pragma unroll
        for (int e = 0; e < 8; ++e) a[e] = 0.f;
#pragma unroll
        for (int j = 0; j < 4; ++j) { const u32x4 v = xin[ten][hh][j]; const LAS float* cw = CW + (ten * 4 + j) * 128 + 16 * part + 8 * hh; const f32x4 w0 = *(const LAS f32x4*)cw, w1 = *(const LAS f32x4*)(cw + 4);
          a[0] += bflo(v.x) * w0.x; a[1] += bfhi(v.x) * w0.y; a[2] += bflo(v.y) * w0.z; a[3] += bfhi(v.y) * w0.w; a[4] += bflo(v.z) * w1.x; a[5] += bfhi(v.z) * w1.y; a[6] += bflo(v.w) * w1.z; a[7] += bfhi(v.w) * w1.w; }
#pragma unroll
        for (int e = 0; e < 8; ++e) y[8 * hh + e] = siluf_(a[e]); }
      if (ten < 2) { float ss = 0.f;
#pragma unroll
        for (int e = 0; e < 16; ++e) ss += y[e] * y[e];
        ss = sum8(ss); const float rn = rsqrtf(ss + EPS) * (ten == 0 ? 0.08838834764831845f : 1.f);
#pragma unroll
        for (int e = 0; e < 16; ++e) y[e] *= rn; }
      if (t >= cd.nvalid) {
#pragma unroll
        for (int e = 0; e < 16; ++e) y[e] = 0.f; }
      if (ten < 2) { u32x4 o0, o1; o0.x = cvtpk(y[0], y[1]); o0.y = cvtpk(y[2], y[3]); o0.z = cvtpk(y[4], y[5]); o0.w = cvtpk(y[6], y[7]);
        o1.x = cvtpk(y[8], y[9]); o1.y = cvtpk(y[10], y[11]); o1.z = cvtpk(y[12], y[13]); o1.w = cvtpk(y[14], y[15]);
        LAS unsigned char* dst = lds + (ten == 0 ? L_Q : L_K) + t * 272 + part * 32; *(LAS u32x4*)dst = o0; *(LAS u32x4*)(dst + 16) = o1; }
      if (ten >= 1) { const float scl = ten == 1 ? be * eG : be; const int cb = ten == 1 ? 128 : 0;
        u32x4 o0, o1; o0.x = cvtpk(scl * y[0], scl * y[1]); o0.y = cvtpk(scl * y[2], scl * y[3]); o0.z = cvtpk(scl * y[4], scl * y[5]); o0.w = cvtpk(scl * y[6], scl * y[7]);
        o1.x = cvtpk(scl * y[8], scl * y[9]); o1.y = cvtpk(scl * y[10], scl * y[11]); o1.z = cvtpk(scl * y[12], scl * y[13]); o1.w = cvtpk(scl * y[14], scl * y[15]);
        LAS unsigned char* dst = lds + L_RT + t * RT_P + (cb + 16 * part) * 2; *(LAS u32x4*)dst = o0; *(LAS u32x4*)(dst + 16) = o1; }
    } }
  lds_barrier();
  PP_T(1, 1);
#pragma unroll
  for (int ti = 0; ti < 4; ++ti) { const int id = 4 * w + ti, isq = id >> 4, tm = (id >> 2) & 3, tn = id & 3; f32x4 acc = {0.f, 0.f, 0.f, 0.f};
#pragma unroll
    for (int kk = 0; kk < 4; ++kk) { const bf16x8 a = *(const LAS bf16x8*)(lds + (isq ? L_Q : L_K) + (16 * tm + c16) * 272 + (32 * kk + 8 * q4) * 2);
      const bf16x8 b = *(const LAS bf16x8*)(lds + L_K + (16 * tn + c16) * 272 + (32 * kk + 8 * q4) * 2);
      acc = __builtin_amdgcn_mfma_f32_16x16x32_bf16(a, b, acc, 0, 0, 0); }
    const int s = 16 * tn + c16; const float Gs = sc[s];
#pragma unroll
    for (int i = 0; i < 4; ++i) { const int tt = 16 * tm + 4 * q4 + i; const float e = __expf(sc[tt] - Gs);
      if (isq) QKf[tt * 68 + s] = (s <= tt) ? acc[i] * e : 0.f; else AM[tt * 68 + s] = (s < tt) ? sc[64 + tt] * acc[i] * e : 0.f; } }
  lds_barrier();
  PP_T(1, 2);
  if (tid < 64) { const int bi = tid >> 4, cc = tid & 15; float x[16];
#pragma unroll
    for (int r = 0; r < 16; ++r) { float a = (r == cc) ? 1.f : 0.f;
#pragma unroll
      for (int s = 0; s < r; ++s) a -= AM[(16 * bi + r) * 68 + 16 * bi + s] * x[s];
      x[r] = a; T[(16 * bi + r) * 68 + 16 * bi + cc] = a; }
  } else {
    const int u = tid - 64; const float Glast = sc[63];
    for (int ci = u; ci < 1024; ci += 448) { const int row = ci >> 4, cq = ci & 15; const u32x4 v = *(const LAS u32x4*)(lds + L_Q + row * 272 + cq * 16); const float e = __expf(sc[row]);
      u32x4 o; o.x = cvtpk(bflo(v.x) * e, bfhi(v.x) * e); o.y = cvtpk(bflo(v.y) * e, bfhi(v.y) * e); o.z = cvtpk(bflo(v.z) * e, bfhi(v.z) * e); o.w = cvtpk(bflo(v.w) * e, bfhi(v.w) * e);
      store_perm8(SL + GS_QT + row * 128, cq * 8, o); }
    for (int id = u; id < 1024; id += 448) { const int d = id & 127, s8 = id >> 7; float kv[8];
#pragma unroll
      for (int j = 0; j < 8; ++j) { const int s = 8 * s8 + j; kv[j] = bf2f(*(const LAS bf16_t*)(lds + L_K + s * 272 + d * 2)) * MB[s]; }
      u32x4 o; o.x = cvtpk(kv[0], kv[1]); o.y = cvtpk(kv[2], kv[3]); o.z = cvtpk(kv[4], kv[5]); o.w = cvtpk(kv[6], kv[7]);
      store_perm8(SL + GS_KTT + d * 64, 8 * s8, o); }
    for (int ci = u; ci < 512; ci += 448) { const int row = ci >> 3, c8 = ci & 7; const LAS float* qr = QKf + row * 68 + c8 * 8;
      u32x4 o; o.x = cvtpk(qr[0], qr[1]); o.y = cvtpk(qr[2], qr[3]); o.z = cvtpk(qr[4], qr[5]); o.w = cvtpk(qr[6], qr[7]);
      store_perm8(SL + GS_QK + row * 64, c8 * 8, o); }
    for (int e = u; e < 6 * 256; e += 448) { const int bp = e >> 8, r = (e >> 4) & 15, cc = e & 15;
      const int bi = bp < 3 ? 0 : (bp < 5 ? 1 : 2), bj = bp < 3 ? bp + 1 : (bp < 5 ? bp - 1 : 3); T[(16 * bi + r) * 68 + 16 * bj + cc] = 0.f; }
  }
  lds_barrier();
  if (next_slot < NSLOT && gdn_slot_interior(next_slot)) gdn_issue(lds, p, next_slot, tid);
  PP_T(1, 3);
  { auto split4 = [](const f32x4& x, v4i16_t& hi, v4i16_t& lo) {
#pragma unroll
      for (int i = 0; i < 4; ++i) { const bf16_t h = f2bf(x[i]); hi[i] = (short)h; lo[i] = (short)f2bf(x[i] - bf2f(h)); } };
#pragma unroll
    for (int bi = 1; bi < 4; ++bi) {
      if (w < bi) { const int bj = w; f32x4 m = {0.f, 0.f, 0.f, 0.f};
        for (int kb = bj; kb < bi; ++kb) {
          const f32x4 av = *(const LAS f32x4*)(AM + (16 * bi + c16) * 68 + 16 * kb + 4 * q4);
          f32x4 tv;
#pragma unroll
          for (int i = 0; i < 4; ++i) tv[i] = T[(16 * kb + 4 * q4 + i) * 68 + 16 * bj + c16];
          v4i16_t ah, al, th, tl; split4(av, ah, al); split4(tv, th, tl);
          m = __builtin_amdgcn_mfma_f32_16x16x16bf16_1k(ah, th, m, 0, 0, 0); m = __builtin_amdgcn_mfma_f32_16x16x16bf16_1k(ah, tl, m, 0, 0, 0); m = __builtin_amdgcn_mfma_f32_16x16x16bf16_1k(al, th, m, 0, 0, 0); }
        const f32x4 dv = *(const LAS f32x4*)(T + (16 * bi + c16) * 68 + 16 * bi + 4 * q4);
        v4i16_t dh, dl, mh, ml; split4(dv, dh, dl); split4(m, mh, ml);
        f32x4 r = {0.f, 0.f, 0.f, 0.f};
        r = __builtin_amdgcn_mfma_f32_16x16x16bf16_1k(dh, mh, r, 0, 0, 0); r = __builtin_amdgcn_mfma_f32_16x16x16bf16_1k(dh, ml, r, 0, 0, 0); r = __builtin_amdgcn_mfma_f32_16x16x16bf16_1k(dl, mh, r, 0, 0, 0);
#pragma unroll
        for (int i = 0; i < 4; ++i) T[(16 * bi + 4 * q4 + i) * 68 + 16 * bj + c16] = -r[i]; }
      lds_barrier();
    } }
  { const int row = tid >> 3, c8 = tid & 7; const LAS float* tr = T + row * 68 + c8 * 8;
    u32x4 o; o.x = cvtpk(tr[0], tr[1]); o.y = cvtpk(tr[2], tr[3]); o.z = cvtpk(tr[4], tr[5]); o.w = cvtpk(tr[6], tr[7]);
    *(LAS u32x4*)(lds + L_TB + row * 144 + c8 * 16) = o; }
  asm volatile("s_waitcnt vmcnt(0)" ::: "memory");
  lds_barrier();
  PP_T(1, 4);
  { const int l16 = lane & 15; const int troff = (8 * q4 + (l16 >> 2)) * RT_P + (4 * (l16 & 3)) * 2;
#pragma unroll
  for (int ti = 0; ti < 8; ++ti) { const int id = 8 * w + ti; f32x4 acc = {0.f, 0.f, 0.f, 0.f};
    if (id < 32) { const int mt = id >> 3, nt = id & 7;
#pragma unroll
      for (int ks = 0; ks < 2; ++ks) { const bf16x8 a = *(const LAS bf16x8*)(lds + L_TB + (16 * mt + c16) * 144 + (32 * ks + 8 * q4) * 2);
        const v4i16_t b0 = __builtin_amdgcn_ds_read_tr16_b64_v4i16((LAS v4i16_t*)(lds + L_RT + troff + (32 * ks) * RT_P + (16 * nt) * 2));
        const v4i16_t b1 = __builtin_amdgcn_ds_read_tr16_b64_v4i16((LAS v4i16_t*)(lds + L_RT + troff + (32 * ks + 4) * RT_P + (16 * nt) * 2));
        const bf16x8 b = {b0[0], b0[1], b0[2], b0[3], b1[0], b1[1], b1[2], b1[3]};
        acc = __builtin_amdgcn_mfma_f32_16x16x32_bf16(a, b, acc, 0, 0, 0); }
      u32x2 o; o.x = cvtpk(acc[0], acc[1]); o.y = cvtpk(acc[2], acc[3]);
      *(u32x2*)(SL + GS_UT + (16 * nt + c16) * 64 + 16 * mt + 4 * q4) = o;
    } else { const int mt = (id - 32) >> 2, nt = (id - 32) & 3;
#pragma unroll
      for (int ks = 0; ks < 2; ++ks) {
        const v4i16_t a0 = __builtin_amdgcn_ds_read_tr16_b64_v4i16((LAS v4i16_t*)(lds + L_RT + troff + (32 * ks) * RT_P + (128 + 16 * mt) * 2));
        const v4i16_t a1 = __builtin_amdgcn_ds_read_tr16_b64_v4i16((LAS v4i16_t*)(lds + L_RT + troff + (32 * ks + 4) * RT_P + (128 + 16 * mt) * 2));
        const bf16x8 a = {a0[0], a0[1], a0[2], a0[3], a1[0], a1[1], a1[2], a1[3]};
        const bf16x8 b = *(const LAS bf16x8*)(lds + L_TB + (16 * nt + c16) * 144 + (32 * ks + 8 * q4) * 2);
        acc = __builtin_amdgcn_mfma_f32_16x16x32_bf16(a, b, acc, 0, 0, 0); }
      u32x2 o; o.x = cvtpk(-acc[0], -acc[1]); o.y = cvtpk(-acc[2], -acc[3]);
      *(u32x2*)(SL + GS_NW + (16 * nt + c16) * 128 + 32 * (mt >> 1) + 8 * q4 + 4 * (mt & 1)) = o;
    } } }
  lds_barrier();
  PP_T(1, 5);
}

constexpr int SC_STAGE = 62464, SC_MISC = 2 * SC_STAGE;
__device__ __forceinline__ bf16x8 pack_acc2(const f32x4& a, const f32x4& b) { u32x4 o; o.x = cvtpk(a[0], a[1]); o.y = cvtpk(a[2], a[3]); o.z = cvtpk(b[0], b[1]); o.w = cvtpk(b[2], b[3]); return __builtin_bit_cast(bf16x8, o); }
__device__ __forceinline__ bf16x8 lda_perm(const LAS unsigned char* base) { return *(const LAS bf16x8*)base; }

template <bool GDN>
__device__ __forceinline__ void scan_chain(LAS unsigned char* lds, const Params& p, int l, int chain  , int tid) {
  asm volatile("" : "+v"(tid));
  const int lane = tid & 63, w = tid >> 6, c16 = lane & 15, q4 = lane >> 4;
  const bool samp = chain >= 32; const int ch = samp ? chain - 32 : chain; const int b = ch >> 2, h = ch & 3;
  const int slot0 = samp ? 32 * 65 + ch : ch * 65, nch = samp ? 1 : 65;
  const unsigned char* slots = p.ws + (GDN ? WS_GSLOT : WS_MSLOT); constexpr int SLOT_B = GDN ? GSLOT_B : MSLOT_B;
  constexpr int NLD = GDN ? 7 : 5;
  bf16_t* OUT = (bf16_t*)(p.ws + (GDN ? WS_OG : WS_HM));
  LAS float* nvec = (LAS float*)(lds + SC_MISC); LAS float* c1 = nvec + 128; LAS float* c2 = nvec + 192;
  f32x4 S[8]; float mrun = 0.f;
  const int vcol = 16 * w + c16;
  if (!samp) {
#pragma unroll
    for (int i = 0; i < 8; ++i) S[i] = (f32x4){0.f, 0.f, 0.f, 0.f};
    if (!GDN && tid < 128) nvec[tid] = 0.f;
  } else if (GDN) {
    const float* S0 = p.in[7] + (((size_t)l * DB + b) * 4 + h) * 128 * 128;
#pragma unroll
    for (int i = 0; i < 8; ++i)
#pragma unroll
      for (int r = 0; r < 4; ++r) S[i][r] = S0[(size_t)(16 * i + 4 * q4 + r) * 128 + vcol];
  } else {
    const float* C0 = p.in[4] + (((size_t)l * DB + b) * 4 + h) * 128 * 128;
#pragma unroll
    for (int i = 0; i < 8; ++i) S[i] = *(const f32x4*)(C0 + (size_t)vcol * 128 + 16 * i + 4 * q4);
    if (tid < 128) nvec[tid] = p.in[5][(((size_t)l * DB + b) * 4 + h) * 128 + tid];
    mrun = p.in[6][((size_t)l * DB + b) * 4 + h];
  }
  auto lds_dst = [](int ci) -> int {
    if (GDN) { if (ci < 1024) return (ci >> 4) * 272 + (ci & 15) * 16; if (ci < 2048) { ci -= 1024; return 17408 + (ci >> 4) * 272 + (ci & 15) * 16; }
      if (ci < 2560) { ci -= 2048; return 34816 + (ci >> 3) * 144 + (ci & 7) * 16; } ci -= 2560; return 44032 + (ci >> 3) * 144 + (ci & 7) * 16; }
    else { if (ci < 1024) return (ci >> 4) * 272 + (ci & 15) * 16; if (ci < 1536) { ci -= 1024; return 17408 + (ci >> 3) * 144 + (ci & 7) * 16; }
      ci -= 1536; return 26624 + (ci >> 3) * 144 + (ci & 7) * 16; } };
  constexpr int L_A0 = 0;
  constexpr int L_QT = 17408;
  constexpr int L_QK = GDN ? 34816 : 17408;
  constexpr int L_KT = GDN ? 44032 : 26624;
  constexpr int L_SCAL = 45056;
  u32x4 stA[NLD], stB[NLD]; u32x4 scA = {0u, 0u, 0u, 0u}; u32x2 utA[4], utB[4]; float glA = 1.f, glB = 1.f; bf16x8 bvA[2];
  u32x2 utc[4]; float glc = 1.f; bf16x8 bvc[2];
#define SC_LOAD(ST, UT, GL, CH) do { const unsigned char* s_ = slots + (size_t)((!samp && (CH) == 0) ? h * 65 : slot0 + (CH)) * SLOT_B;     const u32x4* g_ = (const u32x4*)s_; const bf16_t* sb_ = (const bf16_t*)s_; \
    _Pragma("unroll") for (int k = 0; k < NLD; ++k) ST[k] = g_[tid + 512 * k]; \
    if (GDN) { _Pragma("unroll") for (int mt = 0; mt < 4; ++mt) UT[mt] = *(const u32x2*)(sb_ + GS_UT + vcol * 64 + 16 * mt + 4 * q4); GL = ((const float*)(s_ + GS_SC_B))[0]; } \
    else { if (tid < 84) scA = g_[3584 + tid]; _Pragma("unroll") for (int ks = 0; ks < 2; ++ks) bvA[ks] = *(const bf16x8*)(sb_ + MS_VT + vcol * 64 + 32 * ks + 8 * q4); } } while (0)
#define SC_STORE(ST, UT, GL, STG) do { LAS unsigned char* nb_ = lds + (STG) * SC_STAGE; \
    _Pragma("unroll") for (int k = 0; k < NLD; ++k) *(LAS u32x4*)(nb_ + lds_dst(tid + 512 * k)) = ST[k]; \
    if (GDN) { _Pragma("unroll") for (int mt = 0; mt < 4; ++mt) utc[mt] = UT[mt]; glc = GL; } \
    else { if (tid < 84) *(LAS u32x4*)(nb_ + L_SCAL + tid * 16) = scA; bvc[0] = bvA[0]; bvc[1] = bvA[1]; } } while (0)
#if PROBE_LEVEL == 2
#define SS_T(i) do { if (GDN) { const unsigned long long t_ = __builtin_amdgcn_s_memrealtime(); sacc_[(i)] += t_ - tl_; tl_ = t_; } } while (0)
  unsigned long long tl_ = __builtin_amdgcn_s_memrealtime(); unsigned long long sacc_[4] = {0ull, 0ull, 0ull, 0ull};
#else
#define SS_T(i) do {} while (0)
#endif
  f32x4 o[4];
  auto step = [&](const int c) {
    LAS unsigned char* cur = lds + (c & 1) * SC_STAGE;
    SS_T(3);
    bf16x8 Sb[4];
#pragma unroll
    for (int kk = 0; kk < 4; ++kk) Sb[kk] = pack_acc2(S[2 * kk], S[2 * kk + 1]);
    if (GDN) {
      f32x4 dl[4];
#pragma unroll
      for (int mt = 0; mt < 4; ++mt) { const u32x2 u = utc[mt]; dl[mt] = (f32x4){bflo(u.x), bfhi(u.x), bflo(u.y), bfhi(u.y)}; o[mt] = (f32x4){0.f, 0.f, 0.f, 0.f}; }
#pragma unroll
      for (int mt = 0; mt < 4; ++mt)
#pragma unroll
        for (int kk = 0; kk < 4; ++kk) {
          const bf16x8 aw = lda_perm(cur + L_A0 + (16 * mt + c16) * 272 + (32 * kk + 8 * q4) * 2);
          const bf16x8 aq = lda_perm(cur + L_QT + (16 * mt + c16) * 272 + (32 * kk + 8 * q4) * 2);
          dl[mt] = __builtin_amdgcn_mfma_f32_16x16x32_bf16(aw, Sb[kk], dl[mt], 0, 0, 0);
          o[mt] = __builtin_amdgcn_mfma_f32_16x16x32_bf16(aq, Sb[kk], o[mt], 0, 0, 0); }
      bf16x8 Db[2];
#pragma unroll
      for (int ks = 0; ks < 2; ++ks) Db[ks] = pack_acc2(dl[2 * ks], dl[2 * ks + 1]);
      asm volatile("" :: "v"(Db[0]), "v"(Db[1])); SS_T(0);
#pragma unroll
      for (int mt = 0; mt < 4; ++mt)
#pragma unroll
        for (int ks = 0; ks < 2; ++ks) { const bf16x8 a = lda_perm(cur + L_QK + (16 * mt + c16) * 144 + (32 * ks + 8 * q4) * 2);
          o[mt] = __builtin_amdgcn_mfma_f32_16x16x32_bf16(a, Db[ks], o[mt], 0, 0, 0); }
      const float gl = glc;
#pragma unroll
      for (int i = 0; i < 8; ++i) { S[i] *= gl;
#pragma unroll
        for (int ks = 0; ks < 2; ++ks) { const bf16x8 a = lda_perm(cur + L_KT + (16 * i + c16) * 144 + (32 * ks + 8 * q4) * 2);
          S[i] = __builtin_amdgcn_mfma_f32_16x16x32_bf16(a, Db[ks], S[i], 0, 0, 0); } }
    } else {
      const LAS float* scal = (const LAS float*)(cur + L_SCAL);
      bf16x8 bv[2];
#pragma unroll
      for (int ks = 0; ks < 2; ++ks) bv[ks] = bvc[ks];
      { const int t = tid >> 3, part = tid & 7; const LAS unsigned char* qr = cur + L_A0 + t * 272 + part * 32; float a = 0.f;
        const u32x4 q0 = *(const LAS u32x4*)qr, q1 = *(const LAS u32x4*)(qr + 16);
        const LAS float* n0 = nvec + 32 * (part >> 1) + 8 * (part & 1); const LAS float* n1 = n0 + 16;
        a += bflo(q0.x) * n0[0] + bfhi(q0.x) * n0[1] + bflo(q0.y) * n0[2] + bfhi(q0.y) * n0[3] + bflo(q0.z) * n1[0] + bfhi(q0.z) * n1[1] + bflo(q0.w) * n1[2] + bfhi(q0.w) * n1[3];
        a += bflo(q1.x) * n0[4] + bfhi(q1.x) * n0[5] + bflo(q1.y) * n0[6] + bfhi(q1.y) * n0[7] + bflo(q1.z) * n1[4] + bfhi(q1.z) * n1[5] + bflo(q1.w) * n1[6] + bfhi(q1.w) * n1[7];
        a = sum8(a);
        if (part == 0) { const float inter = scal[MSC_B + t] + mrun, ml = scal[MSC_MLOC + t]; const float mt_ = fmaxf(inter, ml);
          const float w1 = __expf(inter - mt_), w2 = __expf(ml - mt_); const float den = w1 * a + w2 * scal[MSC_RS + t];
          const float sc_ = 1.f / fmaxf(fabsf(den), __expf(-mt_)); c1[t] = w1 * sc_; c2[t] = w2 * sc_; } }
      f32x4 a1[4], a2[4];
#pragma unroll
      for (int mt = 0; mt < 4; ++mt) { a1[mt] = (f32x4){0.f, 0.f, 0.f, 0.f}; a2[mt] = (f32x4){0.f, 0.f, 0.f, 0.f};
#pragma unroll
        for (int kk = 0; kk < 4; ++kk) { const bf16x8 aq = lda_perm(cur + L_A0 + (16 * mt + c16) * 272 + (32 * kk + 8 * q4) * 2);
          a1[mt] = __builtin_amdgcn_mfma_f32_16x16x32_bf16(aq, Sb[kk], a1[mt], 0, 0, 0); }
#pragma unroll
        for (int ks = 0; ks < 2; ++ks) { const bf16x8 a = *(const LAS bf16x8*)(cur + L_QK + (16 * mt + c16) * 144 + (32 * ks + 8 * q4) * 2);
          a2[mt] = __builtin_amdgcn_mfma_f32_16x16x32_bf16(a, bv[ks], a2[mt], 0, 0, 0); } }
      lds_barrier();
#pragma unroll
      for (int mt = 0; mt < 4; ++mt)
#pragma unroll
        for (int r = 0; r < 4; ++r) { const int t = 16 * mt + 4 * q4 + r; o[mt][r] = c1[t] * a1[mt][r] + c2[t] * a2[mt][r]; }
      const float A = scal[MSC_A], B = scal[MSC_BB]; const float mnew = fmaxf(B + mrun, A); const float alpha = __expf(B + mrun - mnew), beta = __expf(A - mnew);
#pragma unroll
      for (int i = 0; i < 8; ++i) { f32x4 X = {0.f, 0.f, 0.f, 0.f};
#pragma unroll
        for (int ks = 0; ks < 2; ++ks) { const bf16x8 a = *(const LAS bf16x8*)(cur + L_KT + (16 * i + c16) * 144 + (32 * ks + 8 * q4) * 2);
          X = __builtin_amdgcn_mfma_f32_16x16x32_bf16(a, bv[ks], X, 0, 0, 0); }
        S[i] = S[i] * alpha + X * beta; }
      if (tid < 128) nvec[tid] = alpha * nvec[tid] + beta * scal[MSC_DN + tid];
      mrun = mnew;
    }
    asm volatile("" :: "v"(S[0]), "v"(S[7])); SS_T(1);
  };
  auto emit = [&](const int c) {
    const int nvalid = samp ? 16 : (c == 0 ? 16 : 64);
    const int row0 = samp ? ROW_S + 16 * b : (c == 0 ? ROW_M : b * SEQ + 64 * (c - 1));
    { bf16_t* op = OUT + (size_t)(row0 + 4 * q4) * 512 + h * 128 + vcol;
#pragma unroll
      for (int mt = 0; mt < 4; ++mt) if (16 * mt < nvalid) {
#pragma unroll
        for (int r = 0; r < 4; ++r) op[(16 * mt + r) * 512] = f2bf(o[mt][r]); } }
    SS_T(2);
  };
  if (GDN) {
    SC_LOAD(stB, utB, glB, 0); SC_STORE(stB, utB, glB, 0);
    if (nch > 1) SC_LOAD(stA, utA, glA, 1);
    lds_barrier();
    for (int c = 0; c < nch; c += 2) {
      if (c + 2 < nch) SC_LOAD(stB, utB, glB, c + 2);
      step(c);
      if (c + 1 < nch) SC_STORE(stA, utA, glA, 1);
      emit(c);
      lds_barrier();
      if (c + 1 >= nch) break;
      if (c + 3 < nch) SC_LOAD(stA, utA, glA, c + 3);
      step(c + 1);
      if (c + 2 < nch) SC_STORE(stB, utB, glB, 0);
      emit(c + 1);
      lds_barrier();
    }
  } else {
    SC_LOAD(stA, utA, glA, 0); SC_STORE(stA, utA, glA, 0);
    lds_barrier();
    for (int c = 0; c < nch; ++c) {
      if (c + 1 < nch) SC_LOAD(stA, utA, glA, c + 1);
      step(c);
      if (c + 1 < nch) SC_STORE(stA, utA, glA, (c + 1) & 1);
      emit(c);
      lds_barrier();
    }
  }
#undef SC_LOAD
#undef SC_STORE
#if PROBE_LEVEL == 2
  if (GDN && tid == 0 && blockIdx.x == 32 && !samp) { for (int i = 0; i < 4; ++i) ((unsigned long long*)(p.ws + WS_CTL + 2048))[i] += sacc_[i]; }
#endif
  if (GDN) { float* So = p.out + (samp ? O_SS + (((size_t)l * DB + b) * 4 + h) * 16384 : O_PS + (((size_t)l * NB + b) * 4 + h) * 16384);
#pragma unroll
    for (int i = 0; i < 8; ++i)
#pragma unroll
      for (int r = 0; r < 4; ++r) So[(size_t)(16 * i + 4 * q4 + r) * 128 + vcol] = S[i][r];
  } else { float* Co = p.out + (samp ? O_SC + (((size_t)l * DB + b) * 4 + h) * 16384 : O_PC + (((size_t)l * NB + b) * 4 + h) * 16384);
#pragma unroll
    for (int i = 0; i < 8; ++i) *(f32x4*)(Co + (size_t)vcol * 128 + 16 * i + 4 * q4) = S[i];
    if (tid < 128) (p.out + (samp ? O_SN + (((size_t)l * DB + b) * 4 + h) * 128 : O_PN + (((size_t)l * NB + b) * 4 + h) * 128))[tid] = nvec[tid];
    if (tid == 0) (p.out + (samp ? O_SM + ((size_t)l * DB + b) * 4 + h : O_PM + ((size_t)l * NB + b) * 4 + h))[0] = mrun;
  }
  __syncthreads();
}


constexpr int SA_KP = 592;
constexpr int SA_KT = 64 * SA_KP;
constexpr int SA_QOFF = SA_KT;
constexpr int SA_NG = 2;
constexpr int SA_PART = 128 * 264;
constexpr size_t WS_SAPART = WS_END1;
constexpr size_t WS_TPART = al256(WS_SAPART + (size_t)DB * SA_NG * SA_PART * 4);
constexpr size_t WS_X1B = al256(WS_TPART + (size_t)3 * 768 * 1024 * 4);
constexpr size_t WS_END2 = al256(WS_X1B + (size_t)NP * D * 2);

__device__ __forceinline__ void sattn_unit(LAS unsigned char* lds, const Params& p, int l, int b, int g, int tid) {
  asm volatile("" : "+v"(tid));
  const int lane = tid & 63, w = tid >> 6, c16 = lane & 15, q4 = lane >> 4;
  const bf16_t* QS = (const bf16_t*)(p.ws + WS_QS) + (size_t)b * 16 * 768;
  { const int h = w; const bf16_t* WK = (const bf16_t*)(p.ws + WS_WUKR) + (size_t)l * 256 * 512 + h * 64;
    bf16x8 a[2];
#pragma unroll
    for (int ks = 0; ks < 2; ++ks) a[ks] = *(const bf16x8*)(QS + (size_t)c16 * 768 + h * 96 + 32 * ks + 8 * q4);
#pragma unroll
    for (int nt = 0; nt < 16; ++nt) { f32x4 acc = {0.f, 0.f, 0.f, 0.f};
#pragma unroll
      for (int ks = 0; ks < 2; ++ks) { const bf16x8 bb = *(const bf16x8*)(WK + (size_t)(16 * nt + c16) * 512 + 32 * ks + 8 * q4);
        acc = __builtin_amdgcn_mfma_f32_16x16x32_bf16(a[ks], bb, acc, 0, 0, 0); }
#pragma unroll
      for (int r = 0; r < 4; ++r) { const int t = 4 * q4 + r; *(LAS bf16_t*)(lds + SA_QOFF + (t * 8 + h) * SA_KP + (16 * nt + c16) * 2) = f2bf(acc[r]); } }
    { const int row = tid >> 2, part = tid & 3, t = row >> 3, hh = row & 7;
      *(LAS u32x4*)(lds + SA_QOFF + row * SA_KP + 512 + part * 16) = *(const u32x4*)(QS + (size_t)t * 768 + hh * 96 + 64 + part * 8); } }
  const LAS unsigned char* qrow = lds + SA_QOFF + (16 * w + c16) * SA_KP + (8 * q4) * 2;
  const int tile0 = (64 / SA_NG) * g, ntile = g == SA_NG - 1 ? 64 / SA_NG + 1 : 64 / SA_NG;
  const float* CL = p.in[2] + ((size_t)l * DB + b) * NCACHE * 256; const float* CK = p.in[3] + ((size_t)l * DB + b) * NCACHE * 32;
  const float* NL = p.out + O_SLAT + ((size_t)l * DB + b) * DS * 256; const float* NK = p.out + O_SKR + ((size_t)l * DB + b) * DS * 32;
  f32x4 stA[9], stB[9];
#define SA_LOAD(ST, TILE) do { const int tl_ = (TILE); int tj = tid; asm volatile("" : "+v"(tj)); \
    if (tl_ < NCACHE / 64) { const f32x4* cl_ = (const f32x4*)(CL + (size_t)tl_ * 64 * 256) + tj; \
      _Pragma("unroll") for (int k = 0; k < 8; ++k) ST[k] = cl_[512 * k]; \
      ST[8] = ((const f32x4*)(CK + (size_t)tl_ * 64 * 32))[tj]; } \
    else { \
      _Pragma("unroll") for (int k = 0; k < 8; ++k) { const int kg = tl_ * 64 + (tj >> 6) + 8 * k, part = tj & 63; f32x4 v = {0.f, 0.f, 0.f, 0.f}; \
        if (kg < NCACHE) v = *(const f32x4*)(CL + (size_t)kg * 256 + 4 * part); else if (kg < NCACHE + DS) v = *(const f32x4*)(NL + (size_t)(kg - NCACHE) * 256 + 4 * part); ST[k] = v; } \
      { const int kg = tl_ * 64 + (tj >> 3), part = tj & 7; f32x4 v = {0.f, 0.f, 0.f, 0.f}; \
        if (kg < NCACHE) v = *(const f32x4*)(CK + (size_t)kg * 32 + 4 * part); else if (kg < NCACHE + DS) v = *(const f32x4*)(NK + (size_t)(kg - NCACHE) * 32 + 4 * part); ST[8] = v; } } } while (0)
#define SA_STORE(ST) do { int tj = tid; asm volatile("" : "+v"(tj)); \
    _Pragma("unroll") for (int k = 0; k < 8; ++k) { u32x2 o; o.x = cvtpk(ST[k].x, ST[k].y); o.y = cvtpk(ST[k].z, ST[k].w); \
      *(LAS u32x2*)(lds + ((tj >> 6) + 8 * k) * SA_KP + (tj & 63) * 8) = o; } \
    { u32x2 o; o.x = cvtpk(ST[8].x, ST[8].y); o.y = cvtpk(ST[8].z, ST[8].w); *(LAS u32x2*)(lds + (tj >> 3) * SA_KP + 512 + (tj & 7) * 8) = o; } } while (0)
  SA_LOAD(stB, tile0); SA_STORE(stB);
  if (ntile > 1) SA_LOAD(stA, tile0 + 1);
  if (ntile > 2) SA_LOAD(stB, tile0 + 2);
  __syncthreads();
  f32x4 O[16];
#pragma unroll
  for (int i = 0; i < 16; ++i) O[i] = (f32x4){0.f, 0.f, 0.f, 0.f};
  float mrun = -INFINITY, lrun = 0.f;
  auto compute_tile = [&](int j) {
    LAS unsigned char* kb = lds;
    f32x4 s[4];
#pragma unroll
    for (int mt = 0; mt < 4; ++mt) s[mt] = (f32x4){0.f, 0.f, 0.f, 0.f};
#pragma unroll
    for (int ks = 0; ks < 9; ++ks) { const bf16x8 qf = *(const LAS bf16x8*)(qrow + 64 * ks);
#pragma unroll
      for (int mt = 0; mt < 4; ++mt) { const bf16x8 a = *(const LAS bf16x8*)(kb + (16 * mt + c16) * SA_KP + (32 * ks + 8 * q4) * 2);
        s[mt] = __builtin_amdgcn_mfma_f32_16x16x32_bf16(a, qf, s[mt], 0, 0, 0); }
      if (ks % 3 == 2) __builtin_amdgcn_sched_barrier(0); }
    const int kbase = (tile0 + j) * 64;
    float tm = -INFINITY;
#pragma unroll
    for (int mt = 0; mt < 4; ++mt)
#pragma unroll
      for (int r = 0; r < 4; ++r) { if (kbase + 16 * mt + 4 * q4 + r >= NCACHE + DS) s[mt][r] = -INFINITY; tm = fmaxf(tm, s[mt][r]); }
    tm = fmaxf(tm, __shfl_xor(tm, 16)); tm = fmaxf(tm, __shfl_xor(tm, 32));
    const float mnew = fmaxf(mrun, tm); const float alpha = __builtin_amdgcn_exp2f(mrun - mnew); mrun = mnew; float ps = 0.f;
#pragma unroll
    for (int mt = 0; mt < 4; ++mt)
#pragma unroll
      for (int r = 0; r < 4; ++r) { s[mt][r] = __builtin_amdgcn_exp2f(s[mt][r] - mnew); ps += s[mt][r]; }
    lrun = lrun * alpha + ps;
    bf16x8 pb[2];
#pragma unroll
    for (int ks = 0; ks < 2; ++ks) pb[ks] = pack_acc2(s[2 * ks], s[2 * ks + 1]);
    const int vo = (4 * q4 + (c16 >> 2)) * SA_KP + (4 * (c16 & 3)) * 2;
#pragma unroll
    for (int nt = 0; nt < 16; ++nt) { O[nt] *= alpha;
#pragma unroll
      for (int ks = 0; ks < 2; ++ks) {
        const v4i16_t a0 = __builtin_amdgcn_ds_read_tr16_b64_v4i16((LAS v4i16_t*)(kb + vo + (32 * ks) * SA_KP + nt * 32));
        const v4i16_t a1 = __builtin_amdgcn_ds_read_tr16_b64_v4i16((LAS v4i16_t*)(kb + vo + (32 * ks + 16) * SA_KP + nt * 32));
        const bf16x8 va = {a0[0], a0[1], a0[2], a0[3], a1[0], a1[1], a1[2], a1[3]};
        O[nt] = __builtin_amdgcn_mfma_f32_16x16x32_bf16(va, pb[ks], O[nt], 0, 0, 0); }
      if ((nt & 7) == 7) __builtin_amdgcn_sched_barrier(0); }
  };
  for (int j = 0; j < ntile; j += 2) {
    compute_tile(j);
    __syncthreads();
    if (j + 1 < ntile) SA_STORE(stA);
    __syncthreads();
    if (j + 3 < ntile) SA_LOAD(stA, tile0 + j + 3);
    if (j + 1 >= ntile) break;
    compute_tile(j + 1);
    __syncthreads();
    if (j + 2 < ntile) SA_STORE(stB);
    __syncthreads();
    if (j + 4 < ntile) SA_LOAD(stB, tile0 + j + 4);
  }
#undef SA_LOAD
#undef SA_STORE
  float* P = (float*)(p.ws + WS_SAPART) + (size_t)(b * SA_NG + g) * SA_PART + (size_t)(16 * w + c16) * 264;
#pragma unroll
  for (int nt = 0; nt < 16; ++nt) *(f32x4*)(P + 16 * nt + 4 * q4) = O[nt];
  lrun += __shfl_xor(lrun, 16); lrun += __shfl_xor(lrun, 32);
  if (q4 == 0) { P[256] = mrun; P[257] = lrun; }
  __syncthreads();
}

__device__ __forceinline__ void phase_finalize(LAS unsigned char* lds, const Params& p, int l, int gw, int NGW, int lane) {
  const bf16_t* PROJ = (const bf16_t*)(p.ws + WS_PROJ);
  bf16_t* HM = (bf16_t*)(p.ws + WS_HM); bf16_t* OG = (bf16_t*)(p.ws + WS_OG); bf16_t* OA = (bf16_t*)(p.ws + WS_OA);
  const float* mnw = p.in[18] + (size_t)l * 512; const float* gnw = p.in[22] + (size_t)l * 128;
  { const int un = gw >> 3, wv = gw & 7;
    if (un < DB * 8) {
      const int b = un >> 3, h = un & 7, c16 = lane & 15, q4 = lane >> 4;
      const float* P = (const float*)(p.ws + WS_SAPART) + (size_t)(b * SA_NG) * SA_PART + (size_t)(c16 * 8 + h) * 264;
      float mg[SA_NG], M = -INFINITY;
#pragma unroll
      for (int g = 0; g < SA_NG; ++g) { mg[g] = P[(size_t)g * SA_PART + 256]; M = fmaxf(M, mg[g]); }
      float L = 0.f;
#pragma unroll
      for (int g = 0; g < SA_NG; ++g) { mg[g] = __builtin_amdgcn_exp2f(mg[g] - M); L += P[(size_t)g * SA_PART + 257] * mg[g]; }
      const float invL = 1.f / L;
      const bf16_t* WT = (const bf16_t*)(p.ws + WS_WUVT) + (size_t)l * 512 * 256 + (size_t)(h * 64) * 256;
      const int ks = wv;
      f32x4 v0 = {0.f, 0.f, 0.f, 0.f}, v1 = {0.f, 0.f, 0.f, 0.f};
#pragma unroll
      for (int g = 0; g < SA_NG; ++g) { const float* pg = P + (size_t)g * SA_PART + 32 * ks + 8 * q4; v0 += *(const f32x4*)pg * mg[g]; v1 += *(const f32x4*)(pg + 4) * mg[g]; }
      v0 *= invL; v1 *= invL;
      u32x4 aw; aw.x = cvtpk(v0[0], v0[1]); aw.y = cvtpk(v0[2], v0[3]); aw.z = cvtpk(v1[0], v1[1]); aw.w = cvtpk(v1[2], v1[3]);
      const bf16x8 af = __builtin_bit_cast(bf16x8, aw);
      LAS f32x4* red = (LAS f32x4*)lds;
#pragma unroll
      for (int nt = 0; nt < 4; ++nt) { const bf16x8 bf = *(const bf16x8*)(WT + (size_t)(16 * nt + c16) * 256 + 32 * ks + 8 * q4);
        const f32x4 acc = __builtin_amdgcn_mfma_f32_16x16x32_bf16(af, bf, (f32x4){0.f, 0.f, 0.f, 0.f}, 0, 0, 0);
        red[(wv * 4 + nt) * 64 + lane] = acc; }
      __syncthreads();
      if (wv < 4) { const int nt = wv; f32x4 s = red[nt * 64 + lane];
#pragma unroll
        for (int w2 = 1; w2 < 8; ++w2) s += red[(w2 * 4 + nt) * 64 + lane];
#pragma unroll
        for (int r = 0; r < 4; ++r) { const int t = 4 * q4 + r, row = ROW_S + b * 16 + t, col = h * 64 + 16 * nt + c16;
          OA[(size_t)row * 512 + col] = f2bf(s[r] * siluf_(bf2f(PROJ[(size_t)row * PJR + RC_ZA + col]))); } }
      __syncthreads();
    } }
  { const int hh = lane >> 4, c8 = (lane & 15) * 8, col = hh * 128 + c8;
    const f32x4 mn0 = *(const f32x4*)(mnw + col), mn1 = *(const f32x4*)(mnw + col + 4), gn0 = *(const f32x4*)(gnw + c8), gn1 = *(const f32x4*)(gnw + c8 + 4);
    for (int r0 = 2 * gw; r0 < MROWS; r0 += 2 * NGW) {
      u32x4 hv[2], ov[2], zm[2], gv[2], zg[2];
#pragma unroll
      for (int i = 0; i < 2; ++i) { const int r = r0 + i; const bf16_t* pr = PROJ + (size_t)r * PJR;
        hv[i] = *(const u32x4*)(HM + (size_t)r * 512 + col); ov[i] = *(const u32x4*)(pr + RC_MO + col); zm[i] = *(const u32x4*)(pr + RC_ZM + col);
        gv[i] = *(const u32x4*)(OG + (size_t)r * 512 + col); zg[i] = *(const u32x4*)(pr + RC_ZG + col); }
      float a[2][8], g[2][8], sm[2], sg[2];
#pragma unroll
      for (int i = 0; i < 2; ++i) {
        const unsigned hw[4] = {hv[i].x, hv[i].y, hv[i].z, hv[i].w}, ow[4] = {ov[i].x, ov[i].y, ov[i].z, ov[i].w}, gw4[4] = {gv[i].x, gv[i].y, gv[i].z, gv[i].w};
        sm[i] = 0.f; sg[i] = 0.f;
#pragma unroll
        for (int e = 0; e < 4; ++e) { a[i][2 * e] = bflo(hw[e]) * sigmoidf_(bflo(ow[e])); a[i][2 * e + 1] = bfhi(hw[e]) * sigmoidf_(bfhi(ow[e])); g[i][2 * e] = bflo(gw4[e]); g[i][2 * e + 1] = bfhi(gw4[e]);
          sm[i] += a[i][2 * e] * a[i][2 * e] + a[i][2 * e + 1] * a[i][2 * e + 1]; sg[i] += g[i][2 * e] * g[i][2 * e] + g[i][2 * e + 1] * g[i][2 * e + 1]; } }
#pragma unroll
      for (int o = 1; o < 16; o <<= 1)
#pragma unroll
        for (int i = 0; i < 2; ++i) { sm[i] += __shfl_xor(sm[i], o); sg[i] += __shfl_xor(sg[i], o); }
#pragma unroll
      for (int i = 0; i < 2; ++i) { const int r = r0 + i; const float rm = rsqrtf(sm[i] * (1.f / 128.f) + EPS), rg = rsqrtf(sg[i] * (1.f / 128.f) + EPS);
        const unsigned zw[4] = {zm[i].x, zm[i].y, zm[i].z, zm[i].w}, yw[4] = {zg[i].x, zg[i].y, zg[i].z, zg[i].w};
        const float mnv[8] = {mn0.x, mn0.y, mn0.z, mn0.w, mn1.x, mn1.y, mn1.z, mn1.w}, gnv[8] = {gn0.x, gn0.y, gn0.z, gn0.w, gn1.x, gn1.y, gn1.z, gn1.w};
        unsigned om[4], og[4];
#pragma unroll
        for (int e = 0; e < 4; ++e) { om[e] = cvtpk(a[i][2 * e] * rm * mnv[2 * e] * siluf_(bflo(zw[e])), a[i][2 * e + 1] * rm * mnv[2 * e + 1] * siluf_(bfhi(zw[e])));
          og[e] = cvtpk(g[i][2 * e] * rg * gnv[2 * e] * siluf_(bflo(yw[e])), g[i][2 * e + 1] * rg * gnv[2 * e + 1] * siluf_(bfhi(yw[e]))); }
        *(u32x4*)(HM + (size_t)r * 512 + col) = (u32x4){om[0], om[1], om[2], om[3]}; *(u32x4*)(OG + (size_t)r * 512 + col) = (u32x4){og[0], og[1], og[2], og[3]}; }
    } }
#if PROBE_LEVEL == 2
  if (gw == 7 && lane == 0) ((unsigned long long*)(p.ws + WS_CTL + 1024))[52 + l] = __builtin_amdgcn_s_memrealtime();
  if (gw == 807 && lane == 0) ((unsigned long long*)(p.ws + WS_CTL + 1024))[54 + l] = __builtin_amdgcn_s_memrealtime();
#endif
}

struct EpiOut {
  const float* xp; bf16_t* xb; int l;
  __device__ __forceinline__ void operator()(const f32x4 (&acc)[2][2][4][2], int tm, int pn, int wr, int wc, int fr, int fq) const {
#pragma unroll
    for (int ai = 0; ai < 2; ++ai) {
      int fr_ = fr; asm volatile("" : "+v"(fr_) :: "memory");
      f32x4 xa[4][2][2];
#pragma unroll
      for (int m = 0; m < 4; ++m) { const int r = tm * 256 + ai * 128 + wr * 64 + m * 16 + fr_;
#pragma unroll
        for (int bj = 0; bj < 2; ++bj) { const int col0 = pn * 256 + bj * 128 + wc * 32 + 8 * fq;
          if (l == 0) { const float* xi = xp + (size_t)r * D + col0; xa[m][bj][0] = *(const f32x4*)xi; xa[m][bj][1] = *(const f32x4*)(xi + 4); }
          else { const u32x4 w = *(const u32x4*)(xb + (size_t)r * D + col0); xa[m][bj][0] = (f32x4){bflo(w.x), bfhi(w.x), bflo(w.y), bfhi(w.y)}; xa[m][bj][1] = (f32x4){bflo(w.z), bfhi(w.z), bflo(w.w), bfhi(w.w)}; } } }
#pragma unroll
      for (int m = 0; m < 4; ++m) { const int r = tm * 256 + ai * 128 + wr * 64 + m * 16 + fr_;
#pragma unroll
        for (int bj = 0; bj < 2; ++bj) { const int col0 = pn * 256 + bj * 128 + wc * 32 + 8 * fq;
          const f32x4 y0 = xa[m][bj][0] + acc[ai][bj][m][0], y1 = xa[m][bj][1] + acc[ai][bj][m][1];
          u32x4 w; w.x = cvtpk(y0.x, y0.y); w.y = cvtpk(y0.z, y0.w); w.z = cvtpk(y1.x, y1.y); w.w = cvtpk(y1.z, y1.w);
          *(u32x4*)(xb + (size_t)r * D + col0) = w; } }
    }
  }
};

__device__ __forceinline__ void phase_norm_rows_b(const Params& p, int lnext, int gw, int NGW, int lane, int rbeg, int rend) {
  const bf16_t* XB = (const bf16_t*)(p.ws + WS_X1B); bf16_t* XN = (bf16_t*)(p.ws + WS_XN);
  const float* nw = p.in[10] + (size_t)lnext * D + 16 * lane;
  const f32x4 w0 = *(const f32x4*)nw, w1 = *(const f32x4*)(nw + 4), w2 = *(const f32x4*)(nw + 8), w3 = *(const f32x4*)(nw + 12);
  for (int r0 = rbeg + 4 * gw; r0 < rend; r0 += 4 * NGW) {
    u32x4 v[4][2]; float s[4];
#pragma unroll
    for (int i = 0; i < 4; ++i) { const u32x4* xr = (const u32x4*)(XB + (size_t)(r0 + i) * D + 16 * lane); v[i][0] = xr[0]; v[i][1] = xr[1]; }
    float f[4][16];
#pragma unroll
    for (int i = 0; i < 4; ++i) { const unsigned ww[8] = {v[i][0].x, v[i][0].y, v[i][0].z, v[i][0].w, v[i][1].x, v[i][1].y, v[i][1].z, v[i][1].w}; s[i] = 0.f;
#pragma unroll
      for (int e = 0; e < 8; ++e) { f[i][2 * e] = bflo(ww[e]); f[i][2 * e + 1] = bfhi(ww[e]); s[i] += f[i][2 * e] * f[i][2 * e] + f[i][2 * e + 1] * f[i][2 * e + 1]; } }
#pragma unroll
    for (int o = 1; o < 64; o <<= 1)
#pragma unroll
      for (int i = 0; i < 4; ++i) s[i] += __shfl_xor(s[i], o);
#pragma unroll
    for (int i = 0; i < 4; ++i) { const float rstd = rsqrtf(s[i] * (1.f / D) + EPS); const float wv[16] = {w0.x, w0.y, w0.z, w0.w, w1.x, w1.y, w1.z, w1.w, w2.x, w2.y, w2.z, w2.w, w3.x, w3.y, w3.z, w3.w};
      u32x4 o0, o1; unsigned ow[8];
#pragma unroll
      for (int e = 0; e < 8; ++e) ow[e] = cvtpk(f[i][2 * e] * rstd * wv[2 * e], f[i][2 * e + 1] * rstd * wv[2 * e + 1]);
      o0 = (u32x4){ow[0], ow[1], ow[2], ow[3]}; o1 = (u32x4){ow[4], ow[5], ow[6], ow[7]};
      u32x4* xo = (u32x4*)(XN + (size_t)(r0 + i) * D + 16 * lane); xo[0] = o0; xo[1] = o1; }
  }
}
__device__ __forceinline__ void phase_final_norm_b(const Params& p, int gw, int NGW, int lane, int rbeg, int rend) {
  const bf16_t* XB = (const bf16_t*)(p.ws + WS_X1B);
  const float* nw = p.in[24] + 16 * lane;
  const f32x4 w0 = *(const f32x4*)nw, w1 = *(const f32x4*)(nw + 4), w2 = *(const f32x4*)(nw + 8), w3 = *(const f32x4*)(nw + 12);
  for (int r0 = rbeg + 4 * gw; r0 < rend; r0 += 4 * NGW) {
    u32x4 v[4][2]; float s[4];
#pragma unroll
    for (int i = 0; i < 4; ++i) { const u32x4* xr = (const u32x4*)(XB + (size_t)(r0 + i) * D + 16 * lane); v[i][0] = xr[0]; v[i][1] = xr[1]; }
    float f[4][16];
#pragma unroll
    for (int i = 0; i < 4; ++i) { const unsigned ww[8] = {v[i][0].x, v[i][0].y, v[i][0].z, v[i][0].w, v[i][1].x, v[i][1].y, v[i][1].z, v[i][1].w}; s[i] = 0.f;
#pragma unroll
      for (int e = 0; e < 8; ++e) { f[i][2 * e] = bflo(ww[e]); f[i][2 * e + 1] = bfhi(ww[e]); s[i] += f[i][2 * e] * f[i][2 * e] + f[i][2 * e + 1] * f[i][2 * e + 1]; } }
#pragma unroll
    for (int o = 1; o < 64; o <<= 1)
#pragma unroll
      for (int i = 0; i < 4; ++i) s[i] += __shfl_xor(s[i], o);
#pragma unroll
    for (int i = 0; i < 4; ++i) { const float rstd = rsqrtf(s[i] * (1.f / D) + EPS);
      f32x4* yo = (f32x4*)(p.out + O_YP + (size_t)(r0 + i) * D + 16 * lane);
      yo[0] = (f32x4){f[i][0] * rstd * w0.x, f[i][1] * rstd * w0.y, f[i][2] * rstd * w0.z, f[i][3] * rstd * w0.w};
      yo[1] = (f32x4){f[i][4] * rstd * w1.x, f[i][5] * rstd * w1.y, f[i][6] * rstd * w1.z, f[i][7] * rstd * w1.w};
      yo[2] = (f32x4){f[i][8] * rstd * w2.x, f[i][9] * rstd * w2.y, f[i][10] * rstd * w2.z, f[i][11] * rstd * w2.w};
      yo[3] = (f32x4){f[i][12] * rstd * w3.x, f[i][13] * rstd * w3.y, f[i][14] * rstd * w3.z, f[i][15] * rstd * w3.w}; }
  }
}

__device__ __forceinline__ void phase_final_norm(const Params& p, int gw, int NGW, int lane, int rbeg, int rend) {
  const f32x4* wr = (const f32x4*)p.in[24] + lane;
  for (int r0 = rbeg + 4 * gw; r0 < rend; r0 += 4 * NGW) {
    f32x4 v[4][4]; float s[4];
#pragma unroll
    for (int i = 0; i < 4; ++i) { const f32x4* xr = (const f32x4*)xrow_out(p, r0 + i) + lane;
#pragma unroll
      for (int j = 0; j < 4; ++j) v[i][j] = xr[64 * j]; }
#pragma unroll
    for (int i = 0; i < 4; ++i) { s[i] = 0.f;
#pragma unroll
      for (int j = 0; j < 4; ++j) s[i] += (v[i][j].x * v[i][j].x + v[i][j].y * v[i][j].y) + (v[i][j].z * v[i][j].z + v[i][j].w * v[i][j].w); }
#pragma unroll
    for (int o = 1; o < 64; o <<= 1)
#pragma unroll
      for (int i = 0; i < 4; ++i) s[i] += __shfl_xor(s[i], o);
#pragma unroll
    for (int i = 0; i < 4; ++i) { const float rstd = rsqrtf(s[i] * (1.f / D) + EPS); f32x4* xr = (f32x4*)xrow_out(p, r0 + i) + lane;
#pragma unroll
      for (int j = 0; j < 4; ++j) xr[64 * j] = v[i][j] * rstd * wr[64 * j]; }
  }
}


struct EpiPart {
  float* part;
  __device__ __forceinline__ void operator()(const f32x4 (&acc)[2][2][4][2], int tm, int pn, int wr, int wc, int fr, int fq) const {
#pragma unroll
    for (int ai = 0; ai < 2; ++ai)
#pragma unroll
      for (int m = 0; m < 4; ++m) {
        int fr_ = fr; asm volatile("" : "+v"(fr_) :: "memory");
        const int rr = (tm - 128) * 256 + ai * 128 + wr * 64 + m * 16 + fr_; float* pr = part + (size_t)rr * D;
#pragma unroll
        for (int bj = 0; bj < 2; ++bj) { const int col0 = pn * 256 + bj * 128 + wc * 32 + 8 * fq; *(f32x4*)(pr + col0) = acc[ai][bj][m][0]; *(f32x4*)(pr + col0 + 4) = acc[ai][bj][m][1]; }
      }
  }
};
__device__ __forceinline__ void phase_tail_rows(const Params& p, int l, int gw, int NGW, int lane) {
  const float* TP = (const float*)(p.ws + WS_TPART);
  bf16_t* XN = (bf16_t*)(p.ws + WS_XN);
  const int rend = (l + 1 < DEPTH) ? MPAD : ROW_M;
  for (int r = ROW_S + gw; r < rend; r += NGW) {
    if (r >= MROWS) { u32x4 z = {0u, 0u, 0u, 0u}; ((u32x4*)(XN + (size_t)r * D))[lane] = z; ((u32x4*)(XN + (size_t)r * D))[lane + 64] = z; continue; }
    const f32x4* xi = (const f32x4*)xrow_in(p, l, r) + lane; f32x4 v[4]; float s = 0.f;
#pragma unroll
    for (int j = 0; j < 4; ++j) { v[j] = xi[64 * j];
#pragma unroll
      for (int sl = 0; sl < 3; ++sl) v[j] += ((const f32x4*)(TP + ((size_t)sl * 768 + (r - ROW_S)) * D))[lane + 64 * j];
      s += (v[j].x * v[j].x + v[j].y * v[j].y) + (v[j].z * v[j].z + v[j].w * v[j].w); }
    const float rstd = rsqrtf(wave_sum(s) * (1.f / D) + EPS);
    if (l + 1 < DEPTH) {
      f32x4* xo = (f32x4*)xrow_out(p, r) + lane; const f32x4* wr = (const f32x4*)(p.in[10] + (size_t)(l + 1) * D) + lane; unsigned long long* o8 = (unsigned long long*)(XN + (size_t)r * D) + lane;
#pragma unroll
      for (int j = 0; j < 4; ++j) { xo[64 * j] = v[j]; const f32x4 ww = wr[64 * j];
        o8[64 * j] = (unsigned long long)cvtpk(v[j].x * rstd * ww.x, v[j].y * rstd * ww.y) | ((unsigned long long)cvtpk(v[j].z * rstd * ww.z, v[j].w * rstd * ww.w) << 32); }
    } else {
      f32x4* xo = (f32x4*)xrow_out(p, r) + lane; const f32x4* wr = (const f32x4*)p.in[24] + lane;
#pragma unroll
      for (int j = 0; j < 4; ++j) xo[64 * j] = v[j] * rstd * wr[64 * j];
    }
  }
}
#ifndef NLAYERS_RUN
#define NLAYERS_RUN DEPTH
#endif
__device__ __forceinline__ void probe_report(const Params& p, int stage, float err) {
  int mag = 0; if (err > 0.f) { float lg = log10f(err) + 5.f; mag = lg < 0.f ? 0 : (lg > 9.f ? 9 : (int)lg); }
  p.out[0] = (float)(10 * stage + mag) * 1000.f;
}
__device__ __forceinline__ unsigned hash_u(unsigned x) { x ^= x >> 16; x *= 0x7feb352du; x ^= x >> 15; x *= 0x846ca68bu; x ^= x >> 16; return x; }
__device__ __forceinline__ float nerr(float got, float want, float scale) { return fabsf(got - want) / (0.03f * fabsf(want) + 0.03f * scale + 1e-6f); }

__device__ __forceinline__ void probe_checks(const Params& p, int l, long long gt) {
  unsigned* ctl = (unsigned*)(p.ws + WS_CTL);
  const bf16_t* PROJ = (const bf16_t*)(p.ws + WS_PROJ);
  const float* RSTD = (const float*)(p.ws + WS_RSTD);
  const float* ct = (const float*)(p.ws + WS_ROPE); const float* st = ct + ROPE_N * 16;
  const bf16_t* KV = (const bf16_t*)(p.ws + WS_KV);
  const bf16_t* QATT = (const bf16_t*)(p.ws + WS_QATT); const bf16_t* QMETA = (const bf16_t*)(p.ws + WS_QMETA); const bf16_t* QS = (const bf16_t*)(p.ws + WS_QS);
  if (gt < 2048) {
    unsigned hh = hash_u((unsigned)gt + 77u); int r = (int)(hh % MROWS); if ((gt & 7) == 0) r = ROW_M + (int)(hh % 16); if ((gt & 7) == 1) r = ROW_S + (int)(hh % 512);
    hh = hash_u(hh); const int h = (int)(hh % 8); hh = hash_u(hh); const int d = (int)(hh % 96);
    const RowInfo ri = row_info(r); const bf16_t* pr = PROJ + (size_t)r * PJR + PC_CQ;
    float ss = 0.f; for (int k = 0; k < 384; ++k) { const float c = bf2f(pr[k]); ss += c * c; }
    const float rs = rsqrtf(ss / 384.f + EPS);
    auto raw = [&](int dd) { float a = 0.f; for (int k = 0; k < 384; ++k) a += bf2f(pr[k]) * p.in[12][l * 384 + k] * p.in[13][((size_t)l * 384 + k) * 768 + h * 96 + dd]; return a * rs * QSCALE; };
    float want;
    if (d < 64) want = raw(d);
    else { const int i = (d - 64) & 15; const float x1 = raw(64 + i), x2 = raw(80 + i), c = ct[ri.pos * 16 + i], s = st[ri.pos * 16 + i]; want = d < 80 ? x1 * c - x2 * s : x2 * c + x1 * s; }
    float got;
    if (ri.kind == 0) got = bf2f(QATT[((size_t)(ri.b * 8 + h) * SEQ + ri.t) * 96 + d]);
    else if (ri.kind == 1) got = bf2f(QS[(size_t)(r - ROW_S) * 768 + h * 96 + d]);
    else got = bf2f(QMETA[((size_t)h * 256 + ri.t) * 96 + d]);
    atomicMax(ctl + 66, __float_as_uint(nerr(got, want, 0.15f)));
  } else if (gt < 4096) {
    unsigned hh = hash_u((unsigned)gt + 99u); int r = (int)(hh % NP); if ((gt & 7) == 0) r = ROW_M + (int)(hh % 16);
    hh = hash_u(hh); const int col = (int)(hh % 1024); hh = hash_u(hh); const int bsel = (int)(hh % 8);
    const RowInfo ri = row_info(r); const bf16_t* pr = PROJ + (size_t)r * PJR + PC_CKV;
    float a = 0.f; const float* W = (col < 512 ? p.in[15] : p.in[16]) + (size_t)l * 256 * 512 + (col & 511);
    for (int k = 0; k < 256; ++k) a += bf2f(pr[k]) * p.in[14][l * 256 + k] * W[(size_t)k * 512];
    a *= RSTD[2 * r + 1];
    const int h = (col & 511) >> 6, d0 = (col & 63) + (col >= 512 ? 96 : 0);
    const int b = ri.kind == 0 ? ri.b : bsel; const int krow = ri.kind == 0 ? 64 + ri.t : ri.t;
    const bf16_t* kvr = KV + ((size_t)(b * 8 + h) * KVROWS + krow) * 160;
    float e = nerr(bf2f(kvr[d0]), a, 0.2f);
    const int i = col & 31; const float* okr = p.out + O_PKR + (((size_t)l * NB + b) * NCACHE + (ri.kind == 0 ? NMETA + ri.t : ri.t)) * 32;
    e = fmaxf(e, nerr(bf2f(kvr[64 + i]), okr[i], 0.2f));
    atomicMax(ctl + 67, __float_as_uint(e));
  } else if (gt < 4096 + 1536) {
    unsigned hh = hash_u((unsigned)gt + 1234u); const bool meta = (gt & 15) == 0;
    const int b = (int)(hh % 8); hh = hash_u(hh); const int h = (int)(hh % 8); hh = hash_u(hh); int t = (int)(hh % SEQ); if ((gt & 3) == 1) t &= 255; if (meta) t &= 15; hh = hash_u(hh); const int dv = (int)(hh % 64);
    const bf16_t* q = meta ? QMETA + ((size_t)h * 256 + t) * 96 : QATT + ((size_t)(b * 8 + h) * SEQ + t) * 96;
    const bf16_t* kvb = KV + (size_t)(b * 8 + h) * KVROWS * 160;
    const int nown = meta ? 0 : 64 * (t / 64 + 1);
    float mx = -INFINITY, lsum = 0.f, osum = 0.f;
    for (int pass = 0; pass < 2; ++pass)
      for (int k = 0; k < 16 + nown; ++k) { const bf16_t* kr = kvb + (size_t)(k < 16 ? k : 64 + (k - 16)) * 160;
        float s = 0.f; for (int d = 0; d < 96; ++d) s += bf2f(q[d]) * bf2f(kr[d]);
        if (pass == 0) mx = fmaxf(mx, s); else { const float pe = exp2f(s - mx); lsum += pe; osum += pe * bf2f(kr[96 + dv]); } }
    const int r = meta ? ROW_M + t : b * SEQ + t;
    const bf16_t* xn = (const bf16_t*)(p.ws + WS_XN) + (size_t)r * 1024; const bf16_t* wz = (const bf16_t*)(p.ws + WS_WIN) + ((size_t)l * PJ + PC_ZA + h * 64 + dv) * 1024;
    float z = 0.f; for (int k = 0; k < 1024; ++k) z += bf2f(xn[k]) * bf2f(wz[k]);
    const float want = osum / lsum * siluf_(z);
    const float got = bf2f(PROJ[(size_t)r * PJR + RC_ZA + h * 64 + dv]);
    atomicMax(ctl + 68, __float_as_uint(nerr(got, want, 0.02f)));
  }
}


__device__ __forceinline__ int queue_next(unsigned* ctr, LAS unsigned char* lds, int tid) {
  LAS int* slot = (LAS int*)(lds + 147440);
  if (tid == 0) *slot = (int)atomicAdd(ctr, 1u);
  __syncthreads();
  const int v = *slot;
  __syncthreads();
  return v;
}

#define OPQ_TID() int tq = threadIdx.x; asm volatile("" : "+v"(tq)); const Params& pq = p; int bq = blockIdx.x; asm volatile("" : "+s"(bq)); const int lq = tq & 63; const int gwq = blockIdx.x * NWAVES + (tq >> 6); (void)lq; (void)gwq

#define XB_TMO      128
#define XB_XCNT(j)  (256  + 64 * (j))
#define XB_XSUB(j)  (1280 + 64 * (j))
#define XB_XGEN(j)  (2304 + 64 * (j))
#define XB_TOP      3328
#define XB_TOPGEN   3392
#define XCD_BAR_WORDS 3456
#define XB_SPIN_CAP (1u << 22)
__device__ __forceinline__ unsigned xb_ld(unsigned* p)              { return __hip_atomic_load(p, __ATOMIC_RELAXED, __HIP_MEMORY_SCOPE_AGENT); }
__device__ __forceinline__ unsigned xb_add(unsigned* p, unsigned v) { return __hip_atomic_fetch_add(p, v, __ATOMIC_RELAXED, __HIP_MEMORY_SCOPE_AGENT); }
__device__ __forceinline__ unsigned xb_xcc_id() { return (unsigned)__builtin_amdgcn_s_getreg((3 << 11) | 20) & 0xFu; }
#define XB_SPIN(cond, bar) do { unsigned _sp = 0; while (cond) { __builtin_amdgcn_s_sleep(1); \
    if ((++_sp & 255u) == 0u) { if (xb_ld(&(bar)[XB_TMO])) break; if (_sp > XB_SPIN_CAP) { atomicAdd(&(bar)[XB_TMO], 1u); break; } } } } while (0)
struct XcdBarrier { unsigned* bar; unsigned x; volatile LAS unsigned* st; };
__device__ __forceinline__ XcdBarrier xcd_barrier_post(unsigned* bar, volatile LAS unsigned* st) {
  XcdBarrier b; b.bar = bar; b.x = xb_xcc_id(); b.st = st;
  if (threadIdx.x == 0) (void)xb_add(&bar[XB_XCNT(b.x)], 1u);
  return b;
}
__device__ __forceinline__ void xcd_barrier_complete(unsigned* bar, unsigned x, unsigned& nloc, unsigned& nx) {
  const unsigned G = gridDim.x * gridDim.y * gridDim.z;
  unsigned sum, cnt, mine, sp = 0u;
  for (;;) {
    sum = 0u; cnt = 0u; mine = 0u;
#pragma unroll
    for (unsigned j = 0; j < 16; ++j) { const unsigned c = xb_ld(&bar[XB_XCNT(j)]); sum += c; cnt += (c > 0u) ? 1u : 0u; mine = (j == x) ? c : mine; }
    if (sum == G) break;
    __builtin_amdgcn_s_sleep(1);
    if ((++sp & 255u) == 0u) { if (xb_ld(&bar[XB_TMO])) break; if (sp > XB_SPIN_CAP) { atomicAdd(&bar[XB_TMO], 1u); break; } }
  }
  nloc = mine > 0u ? mine : 1u; nx = cnt > 0u ? cnt : 1u;
}
__device__ __forceinline__ void xcd_barrier(const XcdBarrier& b) {
  asm volatile("s_waitcnt vmcnt(0)" ::: "memory");
  __syncthreads();
  if (threadIdx.x == 0) {
    unsigned* bar = b.bar;
    __builtin_amdgcn_s_waitcnt(0);
    unsigned nloc = b.st[0], nx = b.st[1];
    if (nloc == 0u) { xcd_barrier_complete(bar, b.x, nloc, nx); b.st[0] = nloc; b.st[1] = nx; }
    const unsigned old = xb_add(&bar[XB_XSUB(b.x)], 1u);
    const unsigned gen = old / nloc;
    if (old + 1u == (gen + 1u) * nloc) {
      __builtin_amdgcn_fence(__ATOMIC_RELEASE, "agent");
      asm volatile("s_waitcnt vmcnt(0)" ::: "memory");
      const unsigned og = xb_add(&bar[XB_TOP], 1u);
      const unsigned tg = og / nx;
      if (og + 1u == (tg + 1u) * nx) xb_add(&bar[XB_TOPGEN], 1u);
      else XB_SPIN(xb_ld(&bar[XB_TOPGEN]) == tg, bar);
      __builtin_amdgcn_fence(__ATOMIC_ACQUIRE, "agent");
      xb_add(&bar[XB_XGEN(b.x)], 1u);
      asm volatile("s_waitcnt vmcnt(0)" ::: "memory");
    } else {
      XB_SPIN(xb_ld(&bar[XB_XGEN(b.x)]) == gen, bar);
      __builtin_amdgcn_fence(__ATOMIC_ACQUIRE, "agent");
      asm volatile("s_waitcnt vmcnt(0)" ::: "memory");
    }
  }
  __syncthreads();
}

#if PROBE_LEVEL == 2
#define STAMP(i) do { if (blockIdx.x == 0 && threadIdx.x == 0) ((unsigned long long*)(p.ws + WS_CTL + 1024))[i] = __builtin_amdgcn_s_memrealtime(); } while (0)
#define BSTAMP(blk, i) do { if (blockIdx.x == (blk) && threadIdx.x == 0) ((unsigned long long*)(p.ws + WS_CTL + 1024))[i] = __builtin_amdgcn_s_memrealtime(); } while (0)
#else
#define STAMP(i) do {} while (0)
#define BSTAMP(blk, i) do {} while (0)
#endif
template <int l>
__device__ __forceinline__ void run_layer(const Params& p, LAS unsigned char* lds, const XcdBarrier& gbar) {
  const int NGW = gridDim.x * NWAVES; const int G = gridDim.x, bx = blockIdx.x;
  bf16_t* PROJ = (bf16_t*)(p.ws + WS_PROJ);
  unsigned* ctl = (unsigned*)(p.ws + WS_CTL);

    {
      asm volatile("" ::: "memory");
      pg8::Gemm g{(const bf16_t*)(p.ws + WS_XN), (const bf16_t*)(p.ws + WS_WIN) + (size_t)l * PJ * 1024, 1024, 1024, 1024, 1 << 20, 0};
      OrderAll S; S.init(MPAD / 256, PJ / 256, G, bx);
      EpiProj E{PROJ, (bf16_t*)(p.ws + WS_PROJH)};
      pg8::gemm_phase(lds, g, S, E);
    }
    xcd_barrier(gbar); STAMP(1 + 7 * l + 1);
    { OPQ_TID(); phase_rowpass(pq, l, gwq, NGW, lq);
#if PROBE_LEVEL == 2
      BSTAMP(0, 46 + l);
      {
        int slot = prep_next_slot(bq - G, G), buf = 0;
        const float* gb_ = pq.in[17] + l * 8; const float gb0 = gb_[0], gb1 = gb_[1], gb2 = gb_[2], gb3 = gb_[3], gb4 = gb_[4], gb5 = gb_[5], gb6 = gb_[6], gb7 = gb_[7];
        __syncthreads();
        if (slot < NSLOT) { mlstm_issue(lds, pq, slot, 0, tq); asm volatile("s_waitcnt vmcnt(0)" ::: "memory"); }
        while (slot < NSLOT) {
          const int nslot = prep_next_slot(slot, G);
#if PROBE_LEVEL == 2
          const unsigned long long tw0_ = __builtin_amdgcn_s_memrealtime();
#endif
          lds_barrier();
#if PROBE_LEVEL == 2
          if (tq == 0 && bq == 0) ((unsigned long long*)(pq.ws + WS_CTL + 2048))[11] += __builtin_amdgcn_s_memrealtime() - tw0_;
#endif
          if (nslot < NSLOT) mlstm_issue(lds, pq, nslot, buf ^ 1, tq);
          { const int hh = (slot < 32 * 65 ? slot / 65 : slot - 32 * 65) & 3;
            mlstm_prep(lds, pq, l, slot, buf, hh == 0 ? gb0 : (hh == 1 ? gb1 : (hh == 2 ? gb2 : gb3)), hh == 0 ? gb4 : (hh == 1 ? gb5 : (hh == 2 ? gb6 : gb7)), tq); }
          slot = nslot; buf ^= 1; }
        __syncthreads();
#if PROBE_LEVEL == 2
        const unsigned long long tg0_ = __builtin_amdgcn_s_memrealtime();
#endif
        {
          unsigned* gq = ctl + 16 + l; LAS int* qs_ = (LAS int*)(lds + 147440);
          if (tq == 0) { qs_[0] = (int)atomicAdd(gq, 1u); qs_[1] = (int)atomicAdd(gq, 1u); }
          __syncthreads();
          int cur = gdn_queue_slot(__builtin_amdgcn_readfirstlane(qs_[0])), nxt = gdn_queue_slot(__builtin_amdgcn_readfirstlane(qs_[1]));
          __syncthreads();
          bool have = false;
          while (cur < NSLOT) {
            unsigned pend = 0u; if (tq == 0) pend = atomicAdd(gq, 1u);
            gdn_prep(lds, pq, l, cur, have, nxt, tq);
            have = nxt < NSLOT && gdn_slot_interior(nxt);
            if (tq == 0) qs_[0] = (int)pend;
            lds_barrier();
            cur = nxt; nxt = gdn_queue_slot(__builtin_amdgcn_readfirstlane(qs_[0]));
            lds_barrier();
          }
        }
#if PROBE_LEVEL == 2
        __syncthreads(); if (tq == 0 && bq == 0) ((unsigned long long*)(pq.ws + WS_CTL + 2048))[12] += __builtin_amdgcn_s_memrealtime() - tg0_;
#endif
      }
#else
      {
        int slot = prep_next_slot(bq - G, G), buf = 0;
        const float* gb_ = pq.in[17] + l * 8; const float gb0 = gb_[0], gb1 = gb_[1], gb2 = gb_[2], gb3 = gb_[3], gb4 = gb_[4], gb5 = gb_[5], gb6 = gb_[6], gb7 = gb_[7];
        __syncthreads();
        if (slot < NSLOT) { mlstm_issue(lds, pq, slot, 0, tq); asm volatile("s_waitcnt vmcnt(0)" ::: "memory"); }
        while (slot < NSLOT) {
          const int nslot = prep_next_slot(slot, G);
#if PROBE_LEVEL == 2
          const unsigned long long tw0_ = __builtin_amdgcn_s_memrealtime();
#endif
          lds_barrier();
#if PROBE_LEVEL == 2
          if (tq == 0 && bq == 0) ((unsigned long long*)(pq.ws + WS_CTL + 2048))[11] += __builtin_amdgcn_s_memrealtime() - tw0_;
#endif
          if (nslot < NSLOT) mlstm_issue(lds, pq, nslot, buf ^ 1, tq);
          { const int hh = (slot < 32 * 65 ? slot / 65 : slot - 32 * 65) & 3;
            mlstm_prep(lds, pq, l, slot, buf, hh == 0 ? gb0 : (hh == 1 ? gb1 : (hh == 2 ? gb2 : gb3)), hh == 0 ? gb4 : (hh == 1 ? gb5 : (hh == 2 ? gb6 : gb7)), tq); }
          slot = nslot; buf ^= 1; }
        __syncthreads();
#if PROBE_LEVEL == 2
        const unsigned long long tg0_ = __builtin_amdgcn_s_memrealtime();
#endif
        {
          unsigned* gq = ctl + 16 + l; LAS int* qs_ = (LAS int*)(lds + 147440);
          if (tq == 0) { qs_[0] = (int)atomicAdd(gq, 1u); qs_[1] = (int)atomicAdd(gq, 1u); }
          __syncthreads();
          int cur = gdn_queue_slot(__builtin_amdgcn_readfirstlane(qs_[0])), nxt = gdn_queue_slot(__builtin_amdgcn_readfirstlane(qs_[1]));
          __syncthreads();
          bool have = false;
          while (cur < NSLOT) {
            unsigned pend = 0u; if (tq == 0) pend = atomicAdd(gq, 1u);
            gdn_prep(lds, pq, l, cur, have, nxt, tq);
            have = nxt < NSLOT && gdn_slot_interior(nxt);
            if (tq == 0) qs_[0] = (int)pend;
            lds_barrier();
            cur = nxt; nxt = gdn_queue_slot(__builtin_amdgcn_readfirstlane(qs_[0]));
            lds_barrier();
          }
        }
#if PROBE_LEVEL == 2
        __syncthreads(); if (tq == 0 && bq == 0) ((unsigned long long*)(pq.ws + WS_CTL + 2048))[12] += __builtin_amdgcn_s_memrealtime() - tg0_;
#endif
      }
#endif
    }
    xcd_barrier(gbar); STAMP(1 + 7 * l + 2);
    {
      const float* rstd = (const float*)(p.ws + WS_RSTD); const float* ct = (const float*)(p.ws + WS_ROPE);
      { pg8::Gemm g{PROJ + PC_CQ, (const bf16_t*)(p.ws + WS_WUQ) + (size_t)l * 768 * 384, PJR, 384, 384, 1 << 20, 0};
        OrderAll S; S.init(MPAD / 256, 3, G, bx);
        EpiQ E{rstd, ct, ct + ROPE_N * 16, (bf16_t*)(p.ws + WS_QATT), (bf16_t*)(p.ws + WS_QMETA), (bf16_t*)(p.ws + WS_QS)};
        pg8::gemm_phase(lds, g, S, E); }
      { pg8::Gemm g{PROJ + PC_CKV, (const bf16_t*)(p.ws + WS_WUKV) + (size_t)l * 1024 * 256, PJR, 256, 256, 1 << 20, 0};
        OrderKV S; S.init(129, 4, G, (bx + 119) % G);
        EpiKV E{rstd, (bf16_t*)(p.ws + WS_KV)};
        pg8::gemm_phase(lds, g, S, E); }
    }
    xcd_barrier(gbar); STAMP(1 + 7 * l + 3);
    {
      OPQ_TID();
      if (bq < 32) { for (int k = 0; k < 5; ++k) scan_chain<false>(lds, pq, l, k == 0 ? bq : 32 + bq * 4 + k - 1, tq); }
      else if (bq < 64) { for (int k = 0; k < 5; ++k) scan_chain<true>(lds, pq, l, k == 0 ? bq - 32 : 32 + (bq - 32) * 4 + k - 1, tq); }
      else { for (int u = bq - 64; u < DB * SA_NG; u += G - 64) sattn_unit(lds, pq, l, u / SA_NG, u % SA_NG, tq); }
      BSTAMP(0, 40 + l); BSTAMP(32, 42 + l); BSTAMP(64, 44 + l);
      for (;;) {
        const int idx = queue_next(ctl + 8 + l, lds, tq);
        if (idx >= 1024 + 8) break;
        AttnUnit u;
        if (idx < 1024) { const int qb = 15 - (idx >> 6), bh = idx & 63;
          u.q = (const bf16_t*)(p.ws + WS_QATT) + ((size_t)bh * SEQ + 256 * qb) * 96; u.kv = (const bf16_t*)(p.ws + WS_KV) + (size_t)bh * KVROWS * 160;
          u.chunk0 = 4 * qb; u.ntiles = 4 * qb + 5; u.nq_valid = 256; u.out_row0 = (bh >> 3) * SEQ + 256 * qb; u.h = bh & 7; u.is_meta = 0; }
        else { const int h = idx - 1024;
          u.q = (const bf16_t*)(p.ws + WS_QMETA) + (size_t)h * 256 * 96; u.kv = (const bf16_t*)(p.ws + WS_KV) + (size_t)h * KVROWS * 160;
          u.chunk0 = 0; u.ntiles = 1; u.nq_valid = 16; u.out_row0 = ROW_M; u.h = h; u.is_meta = 1; }
        attn_unit(lds, u, PROJ, (bf16_t*)(p.ws + WS_OA), tq, p.ws);
      }
    }
    xcd_barrier(gbar); STAMP(1 + 7 * l + 4);
#if PROBE_LEVEL == 1
    if (l == 0) {
      probe_checks(p, l, (long long)bx * NTHREADS + tid);
      xcd_barrier(gbar);
      if (bx == 0 && tid == 0) {
        int stage = 9; float e = 0.f;
        for (int s = 8; s >= 2; --s) { const float es = __uint_as_float(ctl[64 + s]); if (es > 1.f) { stage = s; e = es; } }
        if (stage == 9) for (int s = 2; s <= 8; ++s) e = fmaxf(e, __uint_as_float(ctl[64 + s]));
        probe_report(p, stage, e); }
      return;
    }
#endif
    { OPQ_TID(); phase_finalize(lds, pq, l, gwq, NGW, lq); }
    xcd_barrier(gbar); STAMP(1 + 7 * l + 5);
    {
      pg8::Gemm g{(const bf16_t*)(p.ws + WS_OA), (const bf16_t*)(p.ws + WS_WOUT) + (size_t)l * D * DMIX, 512, DMIX, DMIX, 8, SEG_B};
      OrderAll S; S.init(128, 4, G, bx);
      EpiOut E{p.in[0], (bf16_t*)(p.ws + WS_X1B), l};
      pg8::gemm_phase(lds, g, S, E);
    }
    xcd_barrier(gbar); STAMP(1 + 7 * l + 6);
    { OPQ_TID();
      constexpr int NX = (l + 1 < DEPTH) ? 12 : 8;
      if (bq < 3 * NX) {
        const int sl = bq / NX, uu = bq - sl * NX;
        pg8::Gemm g{(const bf16_t*)(p.ws + WS_OA + (size_t)sl * SEG_B), (const bf16_t*)(p.ws + WS_WOUT) + (size_t)l * D * DMIX + sl * 512, 512, DMIX, 512, 1 << 20, 0};
        OrderTail S; S.init(NX / 4, 4, NX, uu);
        EpiPart E{(float*)(p.ws + WS_TPART) + (size_t)sl * 768 * D};
        pg8::gemm_phase(lds, g, S, E);
        BSTAMP(0, 56 + l);
      } else {
        const int gw2 = (bq - 3 * NX) * NWAVES + (tq >> 6), NGW2 = (G - 3 * NX) * NWAVES;
        if (l + 1 < DEPTH) { phase_norm_rows_b(pq, l + 1, gw2, NGW2, lq, 0, 16384); phase_norm_rows_b(pq, l + 1, gw2, NGW2, lq, 16768, ROW_S); }
        else phase_final_norm_b(pq, gw2, NGW2, lq, 0, ROW_S);
        BSTAMP(100, 58 + l);
      }
    }
    xcd_barrier(gbar);
    { OPQ_TID(); phase_tail_rows(pq, l, gwq, NGW, lq); if (l + 1 < DEPTH) phase_norm_rows_b(pq, l + 1, gwq, NGW, lq, 16384, 16768); }
    if (l + 1 < DEPTH) { xcd_barrier(gbar); STAMP(1 + 7 * l + 7); }

}

__global__ void __launch_bounds__(NTHREADS, 2) mk_fwd(Params p) {
  extern __shared__ __attribute__((aligned(16))) unsigned char lds_raw[];
  LAS unsigned char* lds = (LAS unsigned char*)lds_raw;
  cg::grid_group grid = cg::this_grid();
  const int tid = threadIdx.x;
  const int lane = tid & 63, wave = tid >> 6;
  const int gw = blockIdx.x * NWAVES + wave, NGW = gridDim.x * NWAVES;
  const int G = gridDim.x, bx = blockIdx.x;
  bf16_t* PROJ = (bf16_t*)(p.ws + WS_PROJ);
  unsigned* ctl = (unsigned*)(p.ws + WS_CTL);

  if (threadIdx.x < 2) ((LAS unsigned*)(lds + 147424))[threadIdx.x] = 0u;
  __syncthreads();
  const XcdBarrier gbar = xcd_barrier_post((unsigned*)(p.ws + WS_BAR), (volatile LAS unsigned*)(lds + 147424));
  STAMP(0);
#if PROBE_LEVEL == 2
  if (threadIdx.x < 16 && blockIdx.x == 200) ((unsigned long long*)(p.ws + WS_CTL + 2048))[threadIdx.x] = 0ull;
#endif
  phase0(p, lds, tid);
  grid.sync(); STAMP(1);
  run_layer<0>(p, lds, gbar);
  if (NLAYERS_RUN > 1) run_layer<1>(p, lds, gbar);
#if PROBE_LEVEL == 2
  STAMP(15);
  grid.sync();
  if (blockIdx.x == 0) {
    const unsigned long long* ts = (const unsigned long long*)(p.ws + WS_CTL + 1024);
    const long long offs[13] = {O_YP, O_YS, O_PLAT, O_PKR, O_PC, O_PN, O_PM, O_PS, O_PCONV, O_SLAT, O_SKR, O_SC, O_SN};
    unsigned d[13];
    for (int k = 0; k < 6; ++k) d[k] = (unsigned)((ts[k + 1] - ts[k]) / 100);
    for (int k = 0; k < 6; ++k) d[k] = (unsigned)((ts[k + 1] - ts[k]) / 100);
    d[6] = 1; d[7] = (unsigned)((ts[7] - ts[6]) / 100); d[8] = (unsigned)((ts[8] - ts[7]) / 100);
    d[9] = (unsigned)((ts[50] - ts[5]) / 100); d[10] = (unsigned)((ts[52] - ts[5]) / 100); d[11] = (unsigned)((ts[56] - ts[7]) / 100); d[12] = (unsigned)((ts[58] - ts[7]) / 100);
    d[3] = (unsigned)((ts[54] - ts[5]) / 100);
    for (int k = 0; k < 13; ++k) { unsigned n = d[k]; if (k == 6 && n > 64) n = 64; if (k == 5 && n > 8192) n = 8192; if (n > 30000) n = 30000;
      for (unsigned i = threadIdx.x; i < n; i += NTHREADS) p.out[offs[k] + i] = __uint_as_float(0xAAAAAAAAu); }
  }
#endif
}

extern "C" void kernel_launch(void* const* d_in, const int* in_sizes, int n_in, void* d_out, int out_size,
                              void* d_ws, size_t ws_size, hipStream_t stream) {
  constexpr int LDS_BYTES = 144 * 1024;
  static int grid_blocks = 0;
  if (!grid_blocks) {
    int dev = 0, cus = 0, per_cu = 0;
    (void)hipGetDevice(&dev);
    (void)hipDeviceGetAttribute(&cus, hipDeviceAttributeMultiprocessorCount, dev);
    (void)hipFuncSetAttribute((const void*)mk_fwd, hipFuncAttributeMaxDynamicSharedMemorySize, LDS_BYTES);
    (void)hipOccupancyMaxActiveBlocksPerMultiprocessor(&per_cu, (const void*)mk_fwd, NTHREADS, LDS_BYTES);
    if (per_cu < 1) per_cu = 1;
    grid_blocks = cus * 1;
    if (n_in != 25 || (long long)out_size != O_END || ws_size < WS_END2) { fprintf(stderr, "kernel_launch: unexpected sizes n_in=%d out=%d ws=%zu (need %zu)\n", n_in, out_size, ws_size, (size_t)WS_END2); grid_blocks = -1; }
  }
  if (grid_blocks < 0) return;
  (void)hipMemsetAsync((unsigned char*)d_ws + WS_BAR, 0, 14336 + 256 + 64, stream);
  Params p{};
  for (int i = 0; i < 25; ++i) p.in[i] = (const float*)d_in[i];
  p.out = (float*)d_out; p.ws = (unsigned char*)d_ws; p.ph_lo = 0; p.ph_hi = 100; p.probe = 0; p.pad = 0;
  void* args[] = {&p};
  hipError_t e = hipLaunchCooperativeKernel((const void*)mk_fwd, dim3(grid_blocks), dim3(NTHREADS), args, LDS_BYTES, stream);
  if (e != hipSuccess) fprintf(stderr, "cooperative launch failed: %s (grid %d)\n", hipGetErrorString(e), grid_blocks);
}
```
